# Optimizing an MI355X kernel written in HIP

```python
import math
import jax, jax.numpy as jnp
from jax import lax
import numpy as np

D_MODEL = 1024
BATCH = 8
SEQ = 2048
DEPTH = 1
DEC_BATCH = 128
DEC_SEQ = 8
PAST_LEN = 16384
PAGE_SIZE = 128

HEAD_DIM = 64
D_A = D_MODEL // 2
H_A = D_A // HEAD_DIM
D_B = D_MODEL // 2
H_B = D_B // HEAD_DIM
LORA_W = 64
LORA_A = 64
CONV_W = 4
MLSTM_CHUNK = 64
NORM_EPS = 1e-6
RWKV_GN_EPS = 64e-5
MLSTM_GN_EPS = 1e-6

SHIFT_W = 3 * D_A + LORA_W + LORA_A
CONV_COLS = 2 * D_B
IN_SIZES = (SHIFT_W, D_A, CONV_COLS, D_B, D_B, H_B, H_B, D_B, D_MODEL, D_MODEL)
N_IN = sum(IN_SIZES)
SHIFT_SIZES = (D_A, D_A, D_A, LORA_W, LORA_A)

kernel_name = "rwkv7_mlstm_gated_parallel_step"


def split_cols(p, sizes):
    idx = np.cumsum(sizes)[:-1].tolist()
    return jnp.split(p, idx, axis=-1)


def rmsnorm(x, g):
    xf = x.astype(jnp.float32)
    y = xf * lax.rsqrt(jnp.mean(xf * xf, axis=-1, keepdims=True) + NORM_EPS)
    return (y * g.astype(jnp.float32)).astype(x.dtype)


def head_layernorm(y, w, b, eps):
    mu = jnp.mean(y, axis=-1, keepdims=True)
    var = jnp.mean(jnp.square(y - mu), axis=-1, keepdims=True)
    H, d = y.shape[-2:]
    return (y - mu) * lax.rsqrt(var + eps) * w.reshape(H, d) + b.reshape(H, d)


def head_rmsnorm(y, w, eps):
    H, d = y.shape[-2:]
    return y * lax.rsqrt(jnp.mean(y * y, axis=-1, keepdims=True) + eps) * w.reshape(H, d)


def rwkv7_mix(r, k, v, wl, al, S0, w_decay2, w0, w_iclr2, a0, k_k, k_a, r_k, ln_w, ln_b):
    f32 = jnp.float32
    B, T, _ = r.shape
    r, k, v, wl, al = (t.astype(f32) for t in (r, k, v, wl, al))
    w = w0.astype(f32) + jnp.tanh(wl) @ w_decay2.astype(f32)
    decay = jnp.exp(-jnp.exp(-jax.nn.softplus(-w) - 0.5))
    a = jax.nn.sigmoid(a0.astype(f32) + al @ w_iclr2.astype(f32))
    heads = lambda t: t.reshape(B, T, H_A, HEAD_DIM)
    kk = heads(k * k_k.astype(f32))
    kk = kk / jnp.maximum(jnp.sqrt(jnp.sum(kk * kk, axis=-1, keepdims=True)), 1e-12)
    k = k * (1.0 + (a - 1.0) * k_a.astype(f32))
    r_h, d_h, k_h, v_h, a_h = heads(r), heads(decay), heads(k), heads(v), heads(a)

    def step(S, inp):
        rt, dt, kt, vt, kkt, at = inp
        sk = jnp.einsum('bhij,bhj->bhi', S, kkt)
        S = (S * dt[:, :, None, :]
             - sk[..., :, None] * (kkt * at)[..., None, :]
             + vt[..., :, None] * kt[..., None, :])
        return S, jnp.einsum('bhij,bhj->bhi', S, rt)

    xs = tuple(jnp.moveaxis(t, 1, 0) for t in (r_h, d_h, k_h, v_h, kk, a_h))
    S_T, y = lax.scan(step, S0.astype(f32), xs)
    y = jnp.moveaxis(y, 0, 1)
    y = head_layernorm(y, ln_w.astype(f32), ln_b.astype(f32), RWKV_GN_EPS)
    bonus = jnp.sum(r_h * k_h * r_k.astype(f32).reshape(H_A, HEAD_DIM), axis=-1, keepdims=True)
    y = y + bonus * v_h
    return y.reshape(B, T, D_A), S_T


def mlstm_chunkwise(q, k, v, i_pre, logf, C0, n0, m0):
    f32 = jnp.float32
    B, T, H, d = q.shape
    L = math.gcd(T, MLSTM_CHUNK)
    NC = T // L
    q, v = q.astype(f32), v.astype(f32)
    k = k.astype(f32) * (1.0 / math.sqrt(d))
    ch4 = lambda t: t.reshape(B, NC, L, H, d).transpose(1, 0, 3, 2, 4)
    ch3 = lambda t: t.astype(f32).reshape(B, NC, L, H).transpose(1, 0, 3, 2)
    causal = jnp.tril(jnp.ones((L, L), dtype=bool))

    def step(carry, inp):
        C, n, m = carry
        qc, kc, vc, ic, fc = inp
        b = jnp.cumsum(fc, axis=-1)
        D = b[..., :, None] - b[..., None, :] + ic[..., None, :]
        D = jnp.where(causal, D, -jnp.inf)
        inter = b + m[..., None]
        m_t = jnp.maximum(jnp.max(D, axis=-1), inter)
        w_ts = jnp.exp(D - m_t[..., None])
        w_in = jnp.exp(inter - m_t)
        s = jnp.einsum('bhtd,bhsd->bhts', qc, kc) * w_ts
        num = (jnp.einsum('bhts,bhsd->bhtd', s, vc)
               + w_in[..., None] * jnp.einsum('bhij,bhtj->bhti', C, qc))
        den = jnp.sum(s, axis=-1) + w_in * jnp.einsum('bhj,bhtj->bht', n, qc)
        h = num / jnp.maximum(jnp.abs(den), jnp.exp(-m_t))[..., None]
        bL = b[..., -1]
        g = bL[..., None] - b + ic
        m_new = jnp.maximum(bL + m, jnp.max(g, axis=-1))
        ws = jnp.exp(g - m_new[..., None])
        dec = jnp.exp(bL + m - m_new)
        C_new = dec[..., None, None] * C + jnp.einsum('bhs,bhsi,bhsj->bhij', ws, vc, kc)
        n_new = dec[..., None] * n + jnp.einsum('bhs,bhsj->bhj', ws, kc)
        return (C_new, n_new, m_new), h

    carry0 = (C0.astype(f32), n0.astype(f32), m0.astype(f32))
    (C_T, n_T, m_T), h = lax.scan(step, carry0, (ch4(q), ch4(k), ch4(v), ch3(i_pre), ch3(logf)))
    h = h.transpose(1, 0, 3, 2, 4).reshape(B, T, H, d)
    return h, C_T, n_T, m_T


def mixer_layer(x, c, shift0, S0, conv0, C0, n0, m0,
                g_norm, w_ada, b_ada, w_in, mu_shift, w_decay2, w0, w_iclr2, a0, k_k, k_a, r_k,
                ln_w, ln_b, conv_w, conv_b, b_i, b_f, gn_w, w_up_a, w_up_b, w_out):
    B, T, _ = x.shape
    f32 = jnp.float32
    ada_shift, ada_scale, ada_gate = jnp.split(jax.nn.silu(c) @ w_ada + b_ada, 3, axis=-1)
    h = rmsnorm(x, g_norm) * (1.0 + ada_scale[:, None]) + ada_shift[:, None]
    p = h @ w_in
    p_shift, z_a, qk_pre, v_b, o_b, i_b, f_b, z_b, gl_a, gl_b = split_cols(p, IN_SIZES)

    prev = jnp.concatenate([shift0[:, None].astype(p.dtype), p_shift[:, :-1]], axis=1)
    ps = p_shift + mu_shift * (prev - p_shift)
    r, k, v, wl, al = split_cols(ps, SHIFT_SIZES)
    y_a, S_T = rwkv7_mix(r, k, v, wl, al, S0, w_decay2, w0, w_iclr2, a0, k_k, k_a, r_k, ln_w, ln_b)
    out_a = (y_a * jax.nn.silu(z_a.astype(f32))).astype(x.dtype)

    buf = jnp.concatenate([conv0.astype(qk_pre.dtype), qk_pre], axis=1)
    conv = conv_b + sum(buf[:, j:j + T] * conv_w[j] for j in range(CONV_W))
    qk = jax.nn.silu(conv)
    q_b, k_b = jnp.split(qk, 2, axis=-1)
    hds = lambda t: t.reshape(B, T, H_B, HEAD_DIM)
    logf = jax.nn.log_sigmoid((f_b + b_f).astype(f32))
    i_pre = (i_b + b_i).astype(f32)
    hb, C_T, n_T, m_T = mlstm_chunkwise(hds(q_b), hds(k_b), hds(v_b), i_pre, logf, C0, n0, m0)
    hb = head_rmsnorm(hb, gn_w.astype(f32), MLSTM_GN_EPS).reshape(B, T, D_B)
    out_b = (jax.nn.sigmoid(o_b.astype(f32)) * hb * jax.nn.silu(z_b.astype(f32))).astype(x.dtype)

    merged = jax.nn.sigmoid(gl_a) * (out_a @ w_up_a) + jax.nn.sigmoid(gl_b) * (out_b @ w_up_b)
    x = x + ada_gate[:, None] * (merged @ w_out)
    conv_T = buf[:, buf.shape[1] - (CONV_W - 1):]
    return x, (p_shift[:, -1], S_T, conv_T, C_T, n_T, m_T)


def trunk(x, c, states, params, g_final):
    new = [[] for _ in range(len(states))]
    for l in range(DEPTH):
        st = tuple(s[l] for s in states)
        pl = tuple(w[l] for w in params)
        x, st_new = mixer_layer(x, c, *st, *pl)
        for lst, s in zip(new, st_new):
            lst.append(s.astype(x.dtype))
    return rmsnorm(x, g_final), tuple(jnp.stack(lst) for lst in new)


def setup_inputs(seed: int = 0) -> dict:
    key = jax.random.key(seed)
    ks = iter(jax.random.split(key, 48))
    f32 = jnp.float32
    nrm = lambda shape, s: jax.random.normal(next(ks), shape, f32) * s
    L = DEPTH
    return {
        "x_prompt": nrm((BATCH, SEQ, D_MODEL), 1.0),
        "x_sample": nrm((DEC_BATCH, DEC_SEQ, D_MODEL), 1.0),
        "c_prompt": nrm((BATCH, D_MODEL), 1.0),
        "c_sample": nrm((DEC_BATCH, D_MODEL), 1.0),
        "state_rwkv_shift": nrm((L, DEC_BATCH, SHIFT_W), 1.0),
        "state_rwkv_S": nrm((L, DEC_BATCH, H_A, HEAD_DIM, HEAD_DIM), 0.1),
        "state_mlstm_conv": nrm((L, DEC_BATCH, CONV_W - 1, CONV_COLS), 1.0),
        "state_mlstm_C": nrm((L, DEC_BATCH, H_B, HEAD_DIM, HEAD_DIM), 0.1),
        "state_mlstm_n": nrm((L, DEC_BATCH, H_B, HEAD_DIM), 0.1),
        "state_mlstm_m": nrm((L, DEC_BATCH, H_B), 1.0),
        "g_norm": 1.0 + nrm((L, D_MODEL), 0.01),
        "w_ada": nrm((L, D_MODEL, 3 * D_MODEL), 0.5 * D_MODEL ** -0.5),
        "b_ada": nrm((L, 3 * D_MODEL), 0.02),
        "w_in": nrm((L, D_MODEL, N_IN), D_MODEL ** -0.5),
        "mu_shift": jax.random.uniform(next(ks), (L, SHIFT_W), f32),
        "w_decay2": nrm((L, LORA_W, D_A), 0.1),
        "w0": jnp.linspace(-2.5, 1.5, D_A, dtype=f32)[None] + nrm((L, D_A), 0.1),
        "w_iclr2": nrm((L, LORA_A, D_A), 0.1),
        "a0": nrm((L, D_A), 0.1),
        "k_k": 0.85 + nrm((L, D_A), 0.02),
        "k_a": 1.0 + nrm((L, D_A), 0.02),
        "r_k": nrm((L, D_A), 0.1),
        "ln_w": 1.0 + nrm((L, D_A), 0.02),
        "ln_b": nrm((L, D_A), 0.02),
        "conv_w": nrm((L, CONV_W, CONV_COLS), CONV_W ** -0.5),
        "conv_b": nrm((L, CONV_COLS), 0.02),
        "b_i": nrm((L, H_B), 0.1),
        "b_f": jnp.linspace(3.0, 6.0, H_B, dtype=f32)[None] + nrm((L, H_B), 0.1),
        "gn_w": 1.0 + nrm((L, D_B), 0.02),
        "w_up_a": nrm((L, D_A, D_MODEL), D_A ** -0.5),
        "w_up_b": nrm((L, D_B, D_MODEL), D_B ** -0.5),
        "w_out": nrm((L, D_MODEL, D_MODEL), D_MODEL ** -0.5),
        "g_final": 1.0 + nrm((D_MODEL,), 0.01),
    }


def reference(x_prompt, x_sample, c_prompt, c_sample,
              state_rwkv_shift, state_rwkv_S, state_mlstm_conv, state_mlstm_C, state_mlstm_n, state_mlstm_m,
              g_norm, w_ada, b_ada, w_in, mu_shift, w_decay2, w0, w_iclr2, a0, k_k, k_a, r_k,
              ln_w, ln_b, conv_w, conv_b, b_i, b_f, gn_w, w_up_a, w_up_b, w_out, g_final):
    params = (g_norm, w_ada, b_ada, w_in, mu_shift, w_decay2, w0, w_iclr2, a0, k_k, k_a, r_k,
              ln_w, ln_b, conv_w, conv_b, b_i, b_f, gn_w, w_up_a, w_up_b, w_out)
    Bp = x_prompt.shape[0]
    dt = x_prompt.dtype
    prompt_states = (
        jnp.zeros((DEPTH, Bp, SHIFT_W), dt),
        jnp.zeros((DEPTH, Bp, H_A, HEAD_DIM, HEAD_DIM), dt),
        jnp.zeros((DEPTH, Bp, CONV_W - 1, CONV_COLS), dt),
        jnp.zeros((DEPTH, Bp, H_B, HEAD_DIM, HEAD_DIM), dt),
        jnp.zeros((DEPTH, Bp, H_B, HEAD_DIM), dt),
        jnp.zeros((DEPTH, Bp, H_B), dt),
    )
    sample_states = (state_rwkv_shift, state_rwkv_S, state_mlstm_conv,
                     state_mlstm_C, state_mlstm_n, state_mlstm_m)
    y_prompt, (p_shift, p_S, p_conv, p_C, p_n, p_m) = trunk(x_prompt, c_prompt, prompt_states, params, g_final)
    y_sample, (s_shift, s_S, s_conv, s_C, s_n, s_m) = trunk(x_sample, c_sample, sample_states, params, g_final)
    return (y_prompt, y_sample, p_shift, p_S, p_conv, p_C, p_n, p_m, s_shift, s_S, s_conv, s_C, s_n, s_m)
```

```cpp
#include <hip/hip_runtime.h>
#include <hip/hip_cooperative_groups.h>
#include <cstdio>
namespace cg = cooperative_groups;

#ifndef MK_MULTI
#define MK_MULTI 1
#endif

typedef unsigned short bf16_t;
typedef short bf16x8 __attribute__((ext_vector_type(8)));
typedef float f32x4 __attribute__((ext_vector_type(4)));

constexpr int NTHR = 512;
constexpr int M_P = 16384, M_S = 1024, M_TOT = 17408;
constexpr int DM = 1024;
constexpr int NSEQ = 136;
constexpr int NP = 6912;
constexpr int N_IN = 6800;
constexpr int C_R = 0, C_K = 512, C_V = 1024, C_WL = 1536, C_AL = 1600, C_ZA = 1664, C_QK = 2176,
              C_VB = 3200, C_OB = 3712, C_IB = 4224, C_FB = 4232, C_ZB = 4240, C_GLA = 4752, C_GLB = 5776;
constexpr int SHIFT_W = 1664;

constexpr size_t O_Y = 0;
constexpr size_t O_PSHIFT = (size_t)M_TOT * DM;
constexpr size_t O_PS = O_PSHIFT + 8 * 1664;
constexpr size_t O_PCONV = O_PS + 8 * 8 * 4096;
constexpr size_t O_PC = O_PCONV + 8 * 3 * 1024;
constexpr size_t O_PN = O_PC + 8 * 8 * 4096;
constexpr size_t O_PM = O_PN + 8 * 8 * 64;
constexpr size_t O_SSHIFT = O_PM + 64;
constexpr size_t O_SS = O_SSHIFT + 128 * 1664;
constexpr size_t O_SCONV = O_SS + (size_t)128 * 8 * 4096;
constexpr size_t O_SC = O_SCONV + 128 * 3 * 1024;
constexpr size_t O_SN = O_SC + (size_t)128 * 8 * 4096;
constexpr size_t O_SM = O_SN + 128 * 8 * 64;
constexpr size_t O_END = O_SM + 1024;

struct Params {
    const float *x_p, *x_s, *c_p, *c_s;
    const float *st_shift, *st_S, *st_conv, *st_C, *st_n, *st_m;
    const float *g_norm, *w_ada, *b_ada, *w_in, *mu_shift, *w_decay2, *w0, *w_iclr2, *a0, *k_k, *k_a, *r_k,
        *ln_w, *ln_b, *conv_w, *conv_b, *b_i, *b_f, *gn_w, *w_up_a, *w_up_b, *w_out, *g_final;
    float* out;
    bf16_t *WinT, *WupaT, *WupbT, *WoutT;
    float* mod;
    bf16_t* P;
    bf16_t *H, *Yraw, *OutB, *Omd, *Aa;
};

constexpr int SMEM_FLOATS = 21504;
__device__ __forceinline__ float bf2f(bf16_t v) { return __uint_as_float(((unsigned)v) << 16); }
__device__ __forceinline__ bf16_t f2bf(float f) { unsigned u = __float_as_uint(f); u += 0x7FFFu + ((u >> 16) & 1u); return (bf16_t)(u >> 16); }
__device__ __forceinline__ unsigned pk2(float lo, float hi) { return (unsigned)f2bf(lo) | ((unsigned)f2bf(hi) << 16); }
__device__ __forceinline__ float sigm(float x) { return 1.f / (1.f + __expf(-x)); }
__device__ __forceinline__ float silu(float x) { return x / (1.f + __expf(-x)); }
__device__ __forceinline__ float wave_sum(float v) {
#pragma unroll
    for (int o = 32; o; o >>= 1) v += __shfl_xor(v, o);
    return v;
}
template <int CTRL> __device__ __forceinline__ float dpp_mov(float v) {
    return __builtin_bit_cast(float, __builtin_amdgcn_update_dpp(0, __builtin_bit_cast(int, v), CTRL, 0xF, 0xF, true));
}
__device__ __forceinline__ float row16_sum(float v) {
    v += dpp_mov<0xB1>(v);
    v += dpp_mov<0x4E>(v);
    v += dpp_mov<0x141>(v);
    v += dpp_mov<0x140>(v);
    return v;
}
__device__ __forceinline__ void tok_info(int m, int& s, int& t) {
    if (m < M_P) { s = m >> 11; t = m & 2047; } else { int q = m - M_P; s = 8 + (q >> 3); t = q & 7; }
}
__device__ __forceinline__ const float* xrow(const Params& p, int m) {
    return m < M_P ? p.x_p + (size_t)m * DM : p.x_s + (size_t)(m - M_P) * DM;
}

__device__ void transpose_tile(const float* __restrict__ src, int Nsrc, bf16_t* __restrict__ dst, int K, int n0, int k0, float* tile) {
    const int tid = threadIdx.x;
    {
        const int nn = tid & 63, kk0 = tid >> 6;
        const int n = n0 + nn;
#pragma unroll
        for (int i = 0; i < 8; ++i) {
            const int kk = kk0 + 8 * i;
            tile[kk * 65 + nn] = (n < Nsrc) ? src[(size_t)(k0 + kk) * Nsrc + n] : 0.f;
        }
    }
    __syncthreads();
    {
        const int kk = tid & 63, nn0 = tid >> 6;
#pragma unroll
        for (int i = 0; i < 8; ++i) {
            const int nn = nn0 + 8 * i;
            dst[(size_t)(n0 + nn) * K + k0 + kk] = f2bf(tile[kk * 65 + nn]);
        }
    }
    __syncthreads();
}

__device__ void phaseA(const Params& p, float* sm, int bid, int nb) {
    const int tid = threadIdx.x;
    constexpr int T_IN = 108 * 16, T_UP = 16 * 8, T_OUT = 16 * 16;
    constexpr int T_ALL = T_IN + 2 * T_UP + T_OUT;
    constexpr int N_ADA = 48 * 17;
    for (int it = bid; it < T_ALL + N_ADA; it += nb) {
        if (it < T_IN) {
            transpose_tile(p.w_in, N_IN, p.WinT, 1024, (it / 16) * 64, (it % 16) * 64, sm);
        } else if (it < T_IN + T_UP) {
            const int i = it - T_IN;
            transpose_tile(p.w_up_a, 1024, p.WupaT, 512, (i / 8) * 64, (i % 8) * 64, sm);
        } else if (it < T_IN + 2 * T_UP) {
            const int i = it - T_IN - T_UP;
            transpose_tile(p.w_up_b, 1024, p.WupbT, 512, (i / 8) * 64, (i % 8) * 64, sm);
        } else if (it < T_ALL) {
            const int i = it - T_IN - 2 * T_UP;
            transpose_tile(p.w_out, 1024, p.WoutT, 1024, (i / 16) * 64, (i % 16) * 64, sm);
        } else {
            const int i = it - T_ALL;
            const int ct = i % 48, rgp = i / 48;
            float* sc = sm;
            float* red = sm + 8192;
            for (int idx = tid; idx < 8 * 1024; idx += NTHR) {
                const int sl = idx >> 10, k = idx & 1023, s = rgp * 8 + sl;
                const float c = s < 8 ? p.c_p[s * 1024 + k] : p.c_s[(s - 8) * 1024 + k];
                sc[idx] = silu(c);
            }
            __syncthreads();
            const int col = tid & 63, kq = tid >> 6;
            float acc[8];
#pragma unroll
            for (int s = 0; s < 8; ++s) acc[s] = 0.f;
            const float* wp = p.w_ada + (size_t)(kq * 128) * 3072 + ct * 64 + col;
            for (int k = 0; k < 128; ++k) {
                const float w = wp[(size_t)k * 3072];
#pragma unroll
                for (int s = 0; s < 8; ++s) acc[s] += sc[s * 1024 + kq * 128 + k] * w;
            }
#pragma unroll
            for (int s = 0; s < 8; ++s) red[(kq * 8 + s) * 64 + col] = acc[s];
            __syncthreads();
            {
                const int s = tid >> 6;
                float v = p.b_ada[ct * 64 + col];
#pragma unroll
                for (int q = 0; q < 8; ++q) v += red[(q * 8 + s) * 64 + col];
                p.mod[(size_t)(rgp * 8 + s) * 3072 + ct * 64 + col] = v;
            }
            __syncthreads();
        }
    }
}

__device__ void phaseB(const Params& p, int bid, int nb) {
    const int wid = threadIdx.x >> 6, lane = threadIdx.x & 63;
    for (int m = bid * 8 + wid; m < M_TOT; m += nb * 8) {
        const float* xr = xrow(p, m);
        int s, t; tok_info(m, s, t);
        const float* md = p.mod + (size_t)s * 3072;
        float4 v[4]; float ss = 0.f;
#pragma unroll
        for (int i = 0; i < 4; ++i) {
            v[i] = *(const float4*)(xr + i * 256 + lane * 4);
            ss += v[i].x * v[i].x + v[i].y * v[i].y + v[i].z * v[i].z + v[i].w * v[i].w;
        }
        ss = wave_sum(ss);
        const float rstd = rsqrtf(ss * (1.f / 1024.f) + 1e-6f);
#pragma unroll
        for (int i = 0; i < 4; ++i) {
            const int c = i * 256 + lane * 4;
            const float4 g = *(const float4*)(p.g_norm + c);
            const float4 sh = *(const float4*)(md + c);
            const float4 sl = *(const float4*)(md + 1024 + c);
            const float h0 = v[i].x * rstd * g.x * (1.f + sl.x) + sh.x;
            const float h1 = v[i].y * rstd * g.y * (1.f + sl.y) + sh.y;
            const float h2 = v[i].z * rstd * g.z * (1.f + sl.z) + sh.z;
            const float h3 = v[i].w * rstd * g.w * (1.f + sl.w) + sh.w;
            uint2 o; o.x = pk2(h0, h1); o.y = pk2(h2, h3);
            *(uint2*)(p.H + (size_t)m * 1024 + c) = o;
        }
    }
}

constexpr int LROW = 72;
constexpr int TBUF = 128 * LROW;
__device__ __forceinline__ void gemm_main(const bf16_t* __restrict__ A, int lda, const bf16_t* __restrict__ B, int ldb, int K,
                                          f32x4 (&acc)[2][4], bf16_t* smem) {
    const int tid = threadIdx.x, wid = tid >> 6, lane = tid & 63, wr = wid >> 1, wc = wid & 1, fr = lane & 15, fq = lane >> 4;
    bf16_t* sA = smem; bf16_t* sB = smem + 2 * TBUF;
    const int lr0 = tid >> 3, kc = tid & 7;
    const bf16_t* ga0 = A + (size_t)lr0 * lda + kc * 8; const bf16_t* ga1 = ga0 + (size_t)64 * lda;
    const bf16_t* gb0 = B + (size_t)lr0 * ldb + kc * 8; const bf16_t* gb1 = gb0 + (size_t)64 * ldb;
    const int so0 = lr0 * LROW + kc * 8, so1 = so0 + 64 * LROW;
    uint4 ra0 = *(const uint4*)ga0, ra1 = *(const uint4*)ga1, rb0 = *(const uint4*)gb0, rb1 = *(const uint4*)gb1;
    *(uint4*)(sA + so0) = ra0; *(uint4*)(sA + so1) = ra1; *(uint4*)(sB + so0) = rb0; *(uint4*)(sB + so1) = rb1;
    __syncthreads();
    const int nt = K >> 6;
    for (int t = 0; t < nt; ++t) {
        const int cur = t & 1;
        if (t + 1 < nt) {
            const int ko = (t + 1) * 64;
            ra0 = *(const uint4*)(ga0 + ko); ra1 = *(const uint4*)(ga1 + ko);
            rb0 = *(const uint4*)(gb0 + ko); rb1 = *(const uint4*)(gb1 + ko);
        }
        const bf16_t* cA = sA + cur * TBUF + (wr * 32 + fr) * LROW + fq * 8;
        const bf16_t* cB = sB + cur * TBUF + (wc * 64 + fr) * LROW + fq * 8;
#pragma unroll
        for (int ks = 0; ks < 2; ++ks) {
            bf16x8 a[2], b[4];
#pragma unroll
            for (int m = 0; m < 2; ++m) a[m] = *(const bf16x8*)(cA + m * 16 * LROW + ks * 32);
#pragma unroll
            for (int n = 0; n < 4; ++n) b[n] = *(const bf16x8*)(cB + n * 16 * LROW + ks * 32);
#pragma unroll
            for (int m = 0; m < 2; ++m)
#pragma unroll
                for (int n = 0; n < 4; ++n) acc[m][n] = __builtin_amdgcn_mfma_f32_16x16x32_bf16(b[n], a[m], acc[m][n], 0, 0, 0);
        }
        if (t + 1 < nt) {
            const int nx = (cur ^ 1) * TBUF;
            *(uint4*)(sA + nx + so0) = ra0; *(uint4*)(sA + nx + so1) = ra1;
            *(uint4*)(sB + nx + so0) = rb0; *(uint4*)(sB + nx + so1) = rb1;
        }
        __syncthreads();
    }
}
__device__ __forceinline__ void acc_zero(f32x4 (&acc)[2][4]) {
#pragma unroll
    for (int m = 0; m < 2; ++m)
#pragma unroll
        for (int n = 0; n < 4; ++n) acc[m][n] = (f32x4){0.f, 0.f, 0.f, 0.f};
}

__device__ void phaseC(const Params& p, float* sm, int bid, int nb) {
    const int tid = threadIdx.x, wid = tid >> 6, lane = tid & 63, wr = wid >> 1, wc = wid & 1, fr = lane & 15, fq = lane >> 4;
    constexpr int NMT = 136, NNT = 54, GRP = 8 * NNT;
    for (int it = bid; it < NMT * NNT; it += nb) {
        const int g = it / GRP, i = it % GRP;
        const int mt = g * 8 + (i & 7), nt = i >> 3;
        f32x4 acc[2][4]; acc_zero(acc);
        gemm_main(p.H + (size_t)mt * 128 * 1024, 1024, p.WinT + (size_t)nt * 128 * 1024, 1024, 1024, acc, (bf16_t*)sm);
#pragma unroll
        for (int m = 0; m < 2; ++m) {
            const int row = mt * 128 + wr * 32 + m * 16 + fr;
#pragma unroll
            for (int n = 0; n < 4; ++n) {
                const int col = nt * 128 + wc * 64 + n * 16 + fq * 4;
                uint2 o; o.x = pk2(acc[m][n][0], acc[m][n][1]); o.y = pk2(acc[m][n][2], acc[m][n][3]);
                *(uint2*)(p.P + (size_t)row * NP + col) = o;
            }
        }
    }
}

__device__ void phaseD(const Params& p, float* sm, int bid, int nb) {
    const int tid = threadIdx.x;
    float* tw = sm;
    float* al = sm + 1024;
    for (int it = bid; it < M_TOT / 16; it += nb) {
        const int m0 = it * 16;
        for (int idx = tid; idx < 16 * 128; idx += NTHR) {
            const int tok = idx >> 7, j = idx & 127, col = C_WL + j, m = m0 + tok;
            int s, t; tok_info(m, s, t);
            const float cur = bf2f(p.P[(size_t)m * NP + col]);
            const float prev = t > 0 ? bf2f(p.P[(size_t)(m - 1) * NP + col]) : (s >= 8 ? p.st_shift[(size_t)(s - 8) * SHIFT_W + col] : 0.f);
            const float v = cur + p.mu_shift[col] * (prev - cur);
            if (j < 64) tw[tok * 64 + j] = tanhf(v); else al[tok * 64 + j - 64] = v;
        }
        __syncthreads();
        const int c = tid;
        float accw[16], acca[16];
#pragma unroll
        for (int i = 0; i < 16; ++i) { accw[i] = 0.f; acca[i] = 0.f; }
        for (int j4 = 0; j4 < 16; ++j4) {
            float wd[4], wi[4];
#pragma unroll
            for (int q = 0; q < 4; ++q) { wd[q] = p.w_decay2[(j4 * 4 + q) * 512 + c]; wi[q] = p.w_iclr2[(j4 * 4 + q) * 512 + c]; }
#pragma unroll
            for (int tok = 0; tok < 16; ++tok) {
                const float4 t4 = *(const float4*)(tw + tok * 64 + j4 * 4);
                const float4 a4 = *(const float4*)(al + tok * 64 + j4 * 4);
                accw[tok] += t4.x * wd[0] + t4.y * wd[1] + t4.z * wd[2] + t4.w * wd[3];
                acca[tok] += a4.x * wi[0] + a4.y * wi[1] + a4.z * wi[2] + a4.w * wi[3];
            }
        }
        const float w0c = p.w0[c], a0c = p.a0[c];
#pragma unroll
        for (int tok = 0; tok < 16; ++tok) {
            const int m = m0 + tok;
            const float sg = sigm(w0c + accw[tok]);
            const float omd = 1.f - __expf(-0.6065306597126334f * sg);
            const float av = sigm(a0c + acca[tok]);
            p.Omd[(size_t)m * 512 + c] = f2bf(omd);
            p.Aa[(size_t)m * 512 + c] = f2bf(av);
        }
        for (int tok = 0; tok < 16; ++tok) {
            const int m = m0 + tok;
            int s, t; tok_info(m, s, t);
            const int T = s < 8 ? 2048 : 8;
            if (t != T - 1) continue;
            float* osh = s < 8 ? p.out + O_PSHIFT + (size_t)s * SHIFT_W : p.out + O_SSHIFT + (size_t)(s - 8) * SHIFT_W;
            float* ocv = s < 8 ? p.out + O_PCONV + (size_t)s * 3072 : p.out + O_SCONV + (size_t)(s - 8) * 3072;
            for (int col = tid; col < SHIFT_W; col += NTHR) osh[col] = bf2f(p.P[(size_t)m * NP + col]);
            for (int idx = tid; idx < 3072; idx += NTHR) {
                const int r = idx >> 10, cc = idx & 1023;
                ocv[idx] = bf2f(p.P[(size_t)(m - 2 + r) * NP + C_QK + cc]);
            }
        }
        __syncthreads();
    }
}

__device__ void rwkv_item(const Params& p, int s, int h, int rg, float* sm) {
    float* s_kk = sm;
    float* s_d = sm + 1024;
    float* s_ka = sm + 2048;
    float* s_kp = sm + 3072;
    float* s_dr = sm + 4096;
    float* s_v = sm + 5120;
    float* s_c = sm + 6144;
    float* s_y = sm + 6176;
    const int tid = threadIdx.x, wid = tid >> 6, lane = tid & 63;
    const int T = s < 8 ? 2048 : 8;
    const int mbase = s < 8 ? s * 2048 : M_P + (s - 8) * 8;
    const int hj = h * 64 + lane;
    const int irow = rg * 16 + (wid & 3) * 4 + (lane >> 4);
    const int c4 = (lane & 15) * 4;
    float S0 = 0.f, S1 = 0.f, S2 = 0.f, S3 = 0.f;
    if (wid < 4 && s >= 8) {
        const float4 v = *(const float4*)(p.st_S + ((size_t)((s - 8) * 8 + h) * 64 + irow) * 64 + c4);
        S0 = v.x; S1 = v.y; S2 = v.z; S3 = v.w;
    }
    const float mu_r = p.mu_shift[C_R + hj], mu_k = p.mu_shift[C_K + hj], mu_v = p.mu_shift[C_V + hj];
    const float kkw = p.k_k[hj], kaw = p.k_a[hj];
    for (int t0 = 0; t0 < T; t0 += 16) {
        const int nT = (T - t0) < 16 ? (T - t0) : 16;
#pragma unroll
        for (int q = 0; q < 2; ++q) {
            const int tt = wid * 2 + q;
            if (tt < nT) {
                const int t = t0 + tt, m = mbase + t;
                const bf16_t* pr = p.P + (size_t)m * NP;
                float r = bf2f(pr[C_R + hj]), k = bf2f(pr[C_K + hj]), v = bf2f(pr[C_V + hj]);
                float rp, kp_, vp;
                if (t > 0) { rp = bf2f(pr[C_R + hj - NP]); kp_ = bf2f(pr[C_K + hj - NP]); vp = bf2f(pr[C_V + hj - NP]); }
                else if (s >= 8) { const float* st = p.st_shift + (size_t)(s - 8) * SHIFT_W; rp = st[C_R + hj]; kp_ = st[C_K + hj]; vp = st[C_V + hj]; }
                else { rp = 0.f; kp_ = 0.f; vp = 0.f; }
                r += mu_r * (rp - r); k += mu_k * (kp_ - k); v += mu_v * (vp - v);
                const float a = bf2f(p.Aa[(size_t)m * 512 + hj]);
                const float d = 1.f - bf2f(p.Omd[(size_t)m * 512 + hj]);
                const float kkr = k * kkw;
                const float nrm = sqrtf(wave_sum(kkr * kkr));
                const float kk = kkr / fmaxf(nrm, 1e-12f);
                const float ka = kk * a;
                const float kp = k * (1.f + (a - 1.f) * kaw);
                const float c1 = wave_sum(ka * r), c2 = wave_sum(kp * r);
                s_kk[tt * 64 + lane] = kk; s_d[tt * 64 + lane] = d; s_ka[tt * 64 + lane] = ka;
                s_kp[tt * 64 + lane] = kp; s_dr[tt * 64 + lane] = d * r; s_v[tt * 64 + lane] = v;
                if (lane == 0) { s_c[tt * 2] = c1; s_c[tt * 2 + 1] = c2; }
            }
        }
        __syncthreads();
        if (wid < 4) {
            for (int tt = 0; tt < nT; ++tt) {
                const float4 kk4 = *(const float4*)(s_kk + tt * 64 + c4);
                const float4 d4 = *(const float4*)(s_d + tt * 64 + c4);
                const float4 ka4 = *(const float4*)(s_ka + tt * 64 + c4);
                const float4 kp4 = *(const float4*)(s_kp + tt * 64 + c4);
                const float4 dr4 = *(const float4*)(s_dr + tt * 64 + c4);
                const float vi = s_v[tt * 64 + irow];
                const float c1 = s_c[tt * 2], c2 = s_c[tt * 2 + 1];
                float p1 = S0 * kk4.x + S1 * kk4.y + S2 * kk4.z + S3 * kk4.w;
                float p2 = S0 * dr4.x + S1 * dr4.y + S2 * dr4.z + S3 * dr4.w;
                p1 = row16_sum(p1); p2 = row16_sum(p2);
                const float y = p2 - p1 * c1 + vi * c2;
                S0 = S0 * d4.x - p1 * ka4.x + vi * kp4.x;
                S1 = S1 * d4.y - p1 * ka4.y + vi * kp4.y;
                S2 = S2 * d4.z - p1 * ka4.z + vi * kp4.z;
                S3 = S3 * d4.w - p1 * ka4.w + vi * kp4.w;
                if ((lane & 15) == 0) s_y[tt * 16 + wid * 4 + (lane >> 4)] = y;
            }
        }
        __syncthreads();
        if (tid < 256) {
            const int tt = tid >> 4, i = tid & 15;
            if (tt < nT) p.Yraw[(size_t)(mbase + t0 + tt) * 512 + h * 64 + rg * 16 + i] = f2bf(s_y[tt * 16 + i]);
        }
    }
    if (wid < 4) {
        float* o = (s < 8 ? p.out + O_PS + (size_t)s * 8 * 4096 : p.out + O_SS + (size_t)(s - 8) * 8 * 4096) + ((size_t)(h * 64 + irow)) * 64 + c4;
        float4 v; v.x = S0; v.y = S1; v.z = S2; v.w = S3;
        *(float4*)o = v;
    }
    __syncthreads();
}

__device__ void mlstm_item(const Params& p, int s, int h, float* sm) {
    float* sq = sm;
    float* sk = sm + 4160;
    float* sv = sm + 8320;
    float* sc = sm + 12480;
    float* sC = sm + 16640;
    float* sn = sm + 20800;
    float* sb = sn + 64;
    float* si = sn + 128;
    float* smt = sn + 192;
    float* swin = sn + 256;
    float* sden = sn + 320;
    float* sws = sn + 384;
    float* slf = sn + 448;
    float* smisc = sn + 512;
    const int tid = threadIdx.x, wid = tid >> 6, lane = tid & 63;
    const int T = s < 8 ? 2048 : 8, L = s < 8 ? 64 : 8, NC = T / L;
    const int mbase = s < 8 ? s * 2048 : M_P + (s - 8) * 8;
    for (int idx = tid; idx < 4096; idx += NTHR) {
        const int i = idx >> 6, j = idx & 63;
        sC[i * 65 + j] = s >= 8 ? p.st_C[(size_t)((s - 8) * 8 + h) * 4096 + idx] : 0.f;
    }
    if (tid < 64) sn[tid] = s >= 8 ? p.st_n[(size_t)((s - 8) * 8 + h) * 64 + tid] : 0.f;
    if (tid == 0) smisc[0] = s >= 8 ? p.st_m[(s - 8) * 8 + h] : 0.f;
    const float cwq[4] = {p.conv_w[0 * 1024 + h * 64 + lane], p.conv_w[1 * 1024 + h * 64 + lane], p.conv_w[2 * 1024 + h * 64 + lane], p.conv_w[3 * 1024 + h * 64 + lane]};
    const float cwk[4] = {p.conv_w[0 * 1024 + 512 + h * 64 + lane], p.conv_w[1 * 1024 + 512 + h * 64 + lane], p.conv_w[2 * 1024 + 512 + h * 64 + lane], p.conv_w[3 * 1024 + 512 + h * 64 + lane]};
    const float cbq = p.conv_b[h * 64 + lane], cbk = p.conv_b[512 + h * 64 + lane];
    const float gnw = p.gn_w[h * 64 + lane];
    const float bi = p.b_i[h], bfv = p.b_f[h];
    __syncthreads();
    for (int c = 0; c < NC; ++c) {
        const int t0 = c * L;
        for (int tt = wid; tt < L; tt += 8) {
            const int t = t0 + tt, m = mbase + t;
            float aq = cbq, ak = cbk;
#pragma unroll
            for (int j = 0; j < 4; ++j) {
                const int tau = t - 3 + j;
                float xq, xk;
                if (tau >= 0) {
                    const bf16_t* pr = p.P + (size_t)(mbase + tau) * NP + C_QK + h * 64 + lane;
                    xq = bf2f(pr[0]); xk = bf2f(pr[512]);
                } else if (s >= 8) {
                    const float* st = p.st_conv + ((size_t)(s - 8) * 3 + (3 + tau)) * 1024 + h * 64 + lane;
                    xq = st[0]; xk = st[512];
                } else { xq = 0.f; xk = 0.f; }
                aq += xq * cwq[j]; ak += xk * cwk[j];
            }
            sq[tt * 65 + lane] = silu(aq);
            sk[tt * 65 + lane] = silu(ak) * 0.125f;
            sv[tt * 65 + lane] = bf2f(p.P[(size_t)m * NP + C_VB + h * 64 + lane]);
        }
        if (tid < L) {
            const int m = mbase + t0 + tid;
            si[tid] = bf2f(p.P[(size_t)m * NP + C_IB + h]) + bi;
            const float f = bf2f(p.P[(size_t)m * NP + C_FB + h]) + bfv;
            slf[tid] = f > 0.f ? -log1pf(__expf(-f)) : f - log1pf(__expf(f));
        }
        __syncthreads();
        if (tid == 0) {
            const float mprev = smisc[0];
            float b = 0.f, run = mprev;
            for (int t = 0; t < L; ++t) {
                b += slf[t];
                run = fmaxf(run, si[t] - b);
                sb[t] = b; smt[t] = b + run; swin[t] = __expf(b + mprev - (b + run));
            }
            const float mnew = b + run;
            smisc[1] = mnew; smisc[2] = __expf(b + mprev - mnew);
            for (int t = 0; t < L; ++t) sws[t] = __expf(b - sb[t] + si[t] - mnew);
        }
        __syncthreads();
        for (int idx = tid; idx < L * L; idx += NTHR) {
            const int t = idx / L, u = idx % L;
            float v = 0.f;
            if (u <= t) {
                float dot = 0.f;
#pragma unroll 8
                for (int d = 0; d < 64; ++d) dot += sq[t * 65 + d] * sk[u * 65 + d];
                v = dot * __expf(sb[t] - sb[u] + si[u] - smt[t]);
            }
            sc[t * 65 + u] = v;
        }
        __syncthreads();
        if (tid < L) {
            float rs = 0.f, qn = 0.f;
            for (int u = 0; u < L; ++u) rs += sc[tid * 65 + u];
            for (int j = 0; j < 64; ++j) qn += sn[j] * sq[tid * 65 + j];
            const float den = rs + swin[tid] * qn;
            sden[tid] = fmaxf(fabsf(den), __expf(-smt[tid]));
        }
        __syncthreads();
        for (int tt = wid; tt < L; tt += 8) {
            float num = 0.f, inter = 0.f;
            for (int u = 0; u <= tt; ++u) num += sc[tt * 65 + u] * sv[u * 65 + lane];
#pragma unroll 8
            for (int j = 0; j < 64; ++j) inter += sC[lane * 65 + j] * sq[tt * 65 + j];
            const float hv = (num + swin[tt] * inter) / sden[tt];
            const float ms = wave_sum(hv * hv) * (1.f / 64.f);
            const float hn = hv * rsqrtf(ms + 1e-6f) * gnw;
            const int m = mbase + t0 + tt;
            const float ob = bf2f(p.P[(size_t)m * NP + C_OB + h * 64 + lane]);
            const float zb = bf2f(p.P[(size_t)m * NP + C_ZB + h * 64 + lane]);
            p.OutB[(size_t)m * 512 + h * 64 + lane] = f2bf(sigm(ob) * hn * silu(zb));
        }
        __syncthreads();
        {
            const float dec = smisc[2];
            const int j = lane;
#pragma unroll
            for (int ii = 0; ii < 8; ++ii) {
                const int i = wid + 8 * ii;
                float a = dec * sC[i * 65 + j];
                for (int u = 0; u < L; ++u) a += sws[u] * sv[u * 65 + i] * sk[u * 65 + j];
                sC[i * 65 + j] = a;
            }
            if (tid < 64) {
                float a = dec * sn[tid];
                for (int u = 0; u < L; ++u) a += sws[u] * sk[u * 65 + tid];
                sn[tid] = a;
            }
            if (tid == 0) smisc[0] = smisc[1];
        }
        __syncthreads();
    }
    {
        float* oC = s < 8 ? p.out + O_PC + (size_t)(s * 8 + h) * 4096 : p.out + O_SC + (size_t)((s - 8) * 8 + h) * 4096;
        float* on = s < 8 ? p.out + O_PN + (size_t)(s * 8 + h) * 64 : p.out + O_SN + (size_t)((s - 8) * 8 + h) * 64;
        float* om = s < 8 ? p.out + O_PM + (s * 8 + h) : p.out + O_SM + ((s - 8) * 8 + h);
        for (int idx = tid; idx < 4096; idx += NTHR) oC[idx] = sC[(idx >> 6) * 65 + (idx & 63)];
        if (tid < 64) on[tid] = sn[tid];
        if (tid == 0) om[0] = smisc[0];
    }
    __syncthreads();
}

__device__ void phaseE(const Params& p, float* sm, int bid, int nb) {
    constexpr int N_RP = 8 * 8 * 4, N_MP = 64, N_RS = 128 * 8 * 4, N_MS = 128 * 8;
    for (int it = bid; it < N_RP + N_MP + N_RS + N_MS; it += nb) {
        if (it < N_RP) { rwkv_item(p, it >> 5, (it >> 2) & 7, it & 3, sm); }
        else if (it < N_RP + N_MP) { const int i = it - N_RP; mlstm_item(p, i >> 3, i & 7, sm); }
        else if (it < N_RP + N_MP + N_RS) { const int i = it - N_RP - N_MP; rwkv_item(p, 8 + (i >> 5), (i >> 2) & 7, i & 3, sm); }
        else { const int i = it - N_RP - N_MP - N_RS; mlstm_item(p, 8 + (i >> 3), i & 7, sm); }
    }
}

__device__ void phaseF(const Params& p, int bid, int nb) {
    const int wid = threadIdx.x >> 6, lane = threadIdx.x & 63;
    for (int it = bid * 8 + wid; it < M_TOT * 8; it += nb * 8) {
        const int m = it >> 3, h = it & 7, hj = h * 64 + lane;
        int s, t; tok_info(m, s, t);
        const float y = bf2f(p.Yraw[(size_t)m * 512 + hj]);
        const float mean = wave_sum(y) * (1.f / 64.f);
        const float dy = y - mean;
        const float var = wave_sum(dy * dy) * (1.f / 64.f);
        float yn = dy * rsqrtf(var + 64e-5f) * p.ln_w[hj] + p.ln_b[hj];
        const bf16_t* pr = p.P + (size_t)m * NP;
        float r = bf2f(pr[C_R + hj]), k = bf2f(pr[C_K + hj]), v = bf2f(pr[C_V + hj]);
        float rp, kp_, vp;
        if (t > 0) { rp = bf2f(pr[C_R + hj - NP]); kp_ = bf2f(pr[C_K + hj - NP]); vp = bf2f(pr[C_V + hj - NP]); }
        else if (s >= 8) { const float* st = p.st_shift + (size_t)(s - 8) * SHIFT_W; rp = st[C_R + hj]; kp_ = st[C_K + hj]; vp = st[C_V + hj]; }
        else { rp = 0.f; kp_ = 0.f; vp = 0.f; }
        r += p.mu_shift[C_R + hj] * (rp - r); k += p.mu_shift[C_K + hj] * (kp_ - k); v += p.mu_shift[C_V + hj] * (vp - v);
        const float a = bf2f(p.Aa[(size_t)m * 512 + hj]);
        const float kp = k * (1.f + (a - 1.f) * p.k_a[hj]);
        const float bonus = wave_sum(r * kp * p.r_k[hj]);
        yn += bonus * v;
        const float z = bf2f(pr[C_ZA + hj]);
        p.Yraw[(size_t)m * 512 + hj] = f2bf(yn * silu(z));
    }
}

__device__ void phaseG(const Params& p, float* sm, int bid, int nb) {
    const int tid = threadIdx.x, wid = tid >> 6, lane = tid & 63, wr = wid >> 1, wc = wid & 1, fr = lane & 15, fq = lane >> 4;
    for (int it = bid; it < 136 * 8; it += nb) {
        const int mt = it >> 3, nt = it & 7;
        f32x4 acc[2][4], mg[2][4];
        acc_zero(acc);
        gemm_main(p.Yraw + (size_t)mt * 128 * 512, 512, p.WupaT + (size_t)nt * 128 * 512, 512, 512, acc, (bf16_t*)sm);
#pragma unroll
        for (int m = 0; m < 2; ++m) {
            const int row = mt * 128 + wr * 32 + m * 16 + fr;
#pragma unroll
            for (int n = 0; n < 4; ++n) {
                const int col = nt * 128 + wc * 64 + n * 16 + fq * 4;
                const uint2 g = *(const uint2*)(p.P + (size_t)row * NP + C_GLA + col);
                mg[m][n][0] = sigm(__uint_as_float(g.x << 16)) * acc[m][n][0];
                mg[m][n][1] = sigm(__uint_as_float(g.x & 0xFFFF0000u)) * acc[m][n][1];
                mg[m][n][2] = sigm(__uint_as_float(g.y << 16)) * acc[m][n][2];
                mg[m][n][3] = sigm(__uint_as_float(g.y & 0xFFFF0000u)) * acc[m][n][3];
            }
        }
        acc_zero(acc);
        gemm_main(p.OutB + (size_t)mt * 128 * 512, 512, p.WupbT + (size_t)nt * 128 * 512, 512, 512, acc, (bf16_t*)sm);
#pragma unroll
        for (int m = 0; m < 2; ++m) {
            const int row = mt * 128 + wr * 32 + m * 16 + fr;
#pragma unroll
            for (int n = 0; n < 4; ++n) {
                const int col = nt * 128 + wc * 64 + n * 16 + fq * 4;
                const uint2 g = *(const uint2*)(p.P + (size_t)row * NP + C_GLB + col);
                const float v0 = mg[m][n][0] + sigm(__uint_as_float(g.x << 16)) * acc[m][n][0];
                const float v1 = mg[m][n][1] + sigm(__uint_as_float(g.x & 0xFFFF0000u)) * acc[m][n][1];
                const float v2 = mg[m][n][2] + sigm(__uint_as_float(g.y << 16)) * acc[m][n][2];
                const float v3 = mg[m][n][3] + sigm(__uint_as_float(g.y & 0xFFFF0000u)) * acc[m][n][3];
                uint2 o; o.x = pk2(v0, v1); o.y = pk2(v2, v3);
                *(uint2*)(p.P + (size_t)row * NP + col) = o;
            }
        }
    }
}

__device__ void phaseH(const Params& p, float* sm, int bid, int nb) {
    const int tid = threadIdx.x, wid = tid >> 6, lane = tid & 63, wr = wid >> 1, wc = wid & 1, fr = lane & 15, fq = lane >> 4;
    for (int it = bid; it < 136 * 8; it += nb) {
        const int mt = it >> 3, nt = it & 7;
        f32x4 acc[2][4]; acc_zero(acc);
        gemm_main(p.P + (size_t)mt * 128 * NP, NP, p.WoutT + (size_t)nt * 128 * 1024, 1024, 1024, acc, (bf16_t*)sm);
#pragma unroll
        for (int m = 0; m < 2; ++m) {
            const int row = mt * 128 + wr * 32 + m * 16 + fr;
            int s, t; tok_info(row, s, t);
            const float* xr = xrow(p, row);
            const float* gt = p.mod + (size_t)s * 3072 + 2048;
#pragma unroll
            for (int n = 0; n < 4; ++n) {
                const int col = nt * 128 + wc * 64 + n * 16 + fq * 4;
                const float4 xv = *(const float4*)(xr + col);
                const float4 gv = *(const float4*)(gt + col);
                float4 o;
                o.x = xv.x + gv.x * acc[m][n][0]; o.y = xv.y + gv.y * acc[m][n][1];
                o.z = xv.z + gv.z * acc[m][n][2]; o.w = xv.w + gv.w * acc[m][n][3];
                *(float4*)(p.out + (size_t)row * 1024 + col) = o;
            }
        }
    }
}

__device__ void phaseI(const Params& p, int bid, int nb) {
    const int wid = threadIdx.x >> 6, lane = threadIdx.x & 63;
    for (int m = bid * 8 + wid; m < M_TOT; m += nb * 8) {
        float* yr = p.out + (size_t)m * 1024;
        float4 v[4]; float ss = 0.f;
#pragma unroll
        for (int i = 0; i < 4; ++i) {
            v[i] = *(const float4*)(yr + i * 256 + lane * 4);
            ss += v[i].x * v[i].x + v[i].y * v[i].y + v[i].z * v[i].z + v[i].w * v[i].w;
        }
        ss = wave_sum(ss);
        const float rstd = rsqrtf(ss * (1.f / 1024.f) + 1e-6f);
#pragma unroll
        for (int i = 0; i < 4; ++i) {
            const int c = i * 256 + lane * 4;
            const float4 g = *(const float4*)(p.g_final + c);
            float4 o; o.x = v[i].x * rstd * g.x; o.y = v[i].y * rstd * g.y; o.z = v[i].z * rstd * g.z; o.w = v[i].w * rstd * g.w;
            *(float4*)(yr + c) = o;
        }
    }
}

#if MK_MULTI
#define PHASE_KERNEL(NAME, CALL) __global__ void __launch_bounds__(NTHR) NAME(Params p) { __shared__ __attribute__((aligned(16))) float sm[SMEM_FLOATS]; const int bid = blockIdx.x, nb = gridDim.x; (void)sm; CALL; }
PHASE_KERNEL(kA, phaseA(p, sm, bid, nb))
PHASE_KERNEL(kB, phaseB(p, bid, nb))
PHASE_KERNEL(kC, phaseC(p, sm, bid, nb))
PHASE_KERNEL(kD, phaseD(p, sm, bid, nb))
PHASE_KERNEL(kE, phaseE(p, sm, bid, nb))
PHASE_KERNEL(kF, phaseF(p, bid, nb))
PHASE_KERNEL(kG, phaseG(p, sm, bid, nb))
PHASE_KERNEL(kH, phaseH(p, sm, bid, nb))
PHASE_KERNEL(kI, phaseI(p, bid, nb))
#else
__global__ void __launch_bounds__(NTHR) fwd_megakernel(Params p) {
    __shared__ __attribute__((aligned(16))) float sm[SMEM_FLOATS];
    cg::grid_group grid = cg::this_grid();
    const int bid = blockIdx.x, nb = gridDim.x;
    phaseA(p, sm, bid, nb); grid.sync();
    phaseB(p, bid, nb); grid.sync();
    phaseC(p, sm, bid, nb); grid.sync();
    phaseD(p, sm, bid, nb); grid.sync();
    phaseE(p, sm, bid, nb); grid.sync();
    phaseF(p, bid, nb); grid.sync();
    phaseG(p, sm, bid, nb); grid.sync();
    phaseH(p, sm, bid, nb); grid.sync();
    phaseI(p, bid, nb);
}
#endif

extern "C" void kernel_launch(void* const* d_in, const int* in_sizes, int n_in, void* d_out, int out_size, void* d_ws, size_t ws_size,
                              hipStream_t stream) {
    Params p{};
    const float* const* in = (const float* const*)d_in;
    p.x_p = in[0]; p.x_s = in[1]; p.c_p = in[2]; p.c_s = in[3];
    p.st_shift = in[4]; p.st_S = in[5]; p.st_conv = in[6]; p.st_C = in[7]; p.st_n = in[8]; p.st_m = in[9];
    p.g_norm = in[10]; p.w_ada = in[11]; p.b_ada = in[12]; p.w_in = in[13]; p.mu_shift = in[14]; p.w_decay2 = in[15];
    p.w0 = in[16]; p.w_iclr2 = in[17]; p.a0 = in[18]; p.k_k = in[19]; p.k_a = in[20]; p.r_k = in[21];
    p.ln_w = in[22]; p.ln_b = in[23]; p.conv_w = in[24]; p.conv_b = in[25]; p.b_i = in[26]; p.b_f = in[27];
    p.gn_w = in[28]; p.w_up_a = in[29]; p.w_up_b = in[30]; p.w_out = in[31]; p.g_final = in[32];
    p.out = (float*)d_out;
    char* ws = (char*)d_ws;
    size_t off = 0;
    p.P = (bf16_t*)(ws + off); off += (size_t)M_TOT * NP * 2;
    p.WinT = (bf16_t*)(ws + off); off += (size_t)NP * 1024 * 2;
    p.WupaT = (bf16_t*)(ws + off); off += (size_t)1024 * 512 * 2;
    p.WupbT = (bf16_t*)(ws + off); off += (size_t)1024 * 512 * 2;
    p.WoutT = (bf16_t*)(ws + off); off += (size_t)1024 * 1024 * 2;
    p.mod = (float*)(ws + off); off += (size_t)NSEQ * 3072 * 4;
    char* os = (char*)d_out;
    p.H = (bf16_t*)os;
    p.Yraw = (bf16_t*)os;
    p.OutB = (bf16_t*)(os + (size_t)M_TOT * 512 * 2);
    p.Omd = (bf16_t*)(os + (size_t)M_TOT * 1024 * 2);
    p.Aa = (bf16_t*)(os + (size_t)M_TOT * 1024 * 2 + (size_t)M_TOT * 512 * 2);
#if MK_MULTI
    const int G = 1024;
    kA<<<G, NTHR, 0, stream>>>(p);
    kB<<<G, NTHR, 0, stream>>>(p);
    kC<<<G, NTHR, 0, stream>>>(p);
    kD<<<G, NTHR, 0, stream>>>(p);
    kE<<<G, NTHR, 0, stream>>>(p);
    kF<<<G, NTHR, 0, stream>>>(p);
    kG<<<G, NTHR, 0, stream>>>(p);
    kH<<<G, NTHR, 0, stream>>>(p);
    kI<<<G, NTHR, 0, stream>>>(p);
#else
    static int grid_blocks = 0;
    if (!grid_blocks) {
        int dev = 0, cus = 0, per_cu = 0;
        hipGetDevice(&dev);
        hipDeviceGetAttribute(&cus, hipDeviceAttributeMultiprocessorCount, dev);
        hipOccupancyMaxActiveBlocksPerMultiprocessor(&per_cu, fwd_megakernel, NTHR, 0);
        if (per_cu > 1) per_cu = 1;
        grid_blocks = cus * per_cu;
    }
    void* args[] = {&p};
    hipError_t e = hipLaunchCooperativeKernel((void*)fwd_megakernel, dim3(grid_blocks), dim3(NTHR), args, 0, stream);
    if (e != hipSuccess) fprintf(stderr, "cooperative launch failed: %s (grid %d)\n", hipGetErrorString(e), grid_blocks);
#endif
}
```

```cpp
#include <hip/hip_runtime.h>
#include <hip/hip_cooperative_groups.h>
#include <cstdio>
namespace cg = cooperative_groups;

#ifndef MK_MULTI
#define MK_MULTI 0
#endif

typedef unsigned short bf16_t;
typedef short bf16x8 __attribute__((ext_vector_type(8)));
typedef float f32x4 __attribute__((ext_vector_type(4)));

constexpr int NTHR = 512;
constexpr int M_P = 16384, M_S = 1024, M_TOT = 17408;
constexpr int DM = 1024;
constexpr int NSEQ = 136;
constexpr int NP = 6912;
constexpr int N_IN = 6800;
constexpr int C_R = 0, C_K = 512, C_V = 1024, C_WL = 1536, C_AL = 1600, C_ZA = 1664, C_QK = 2176,
              C_VB = 3200, C_OB = 3712, C_IB = 4224, C_FB = 4232, C_ZB = 4240, C_GLA = 4752, C_GLB = 5776;
constexpr int SHIFT_W = 1664;

constexpr size_t O_Y = 0;
constexpr size_t O_PSHIFT = (size_t)M_TOT * DM;
constexpr size_t O_PS = O_PSHIFT + 8 * 1664;
constexpr size_t O_PCONV = O_PS + 8 * 8 * 4096;
constexpr size_t O_PC = O_PCONV + 8 * 3 * 1024;
constexpr size_t O_PN = O_PC + 8 * 8 * 4096;
constexpr size_t O_PM = O_PN + 8 * 8 * 64;
constexpr size_t O_SSHIFT = O_PM + 64;
constexpr size_t O_SS = O_SSHIFT + 128 * 1664;
constexpr size_t O_SCONV = O_SS + (size_t)128 * 8 * 4096;
constexpr size_t O_SC = O_SCONV + 128 * 3 * 1024;
constexpr size_t O_SN = O_SC + (size_t)128 * 8 * 4096;
constexpr size_t O_SM = O_SN + 128 * 8 * 64;
constexpr size_t O_END = O_SM + 1024;

struct Params {
    const float *x_p, *x_s, *c_p, *c_s;
    const float *st_shift, *st_S, *st_conv, *st_C, *st_n, *st_m;
    const float *g_norm, *w_ada, *b_ada, *w_in, *mu_shift, *w_decay2, *w0, *w_iclr2, *a0, *k_k, *k_a, *r_k,
        *ln_w, *ln_b, *conv_w, *conv_b, *b_i, *b_f, *gn_w, *w_up_a, *w_up_b, *w_out, *g_final;
    float* out;
    bf16_t *WinT, *WupaT, *WupbT, *WoutT;
    float* mod;
    bf16_t* P;
    bf16_t *H, *Yraw, *OutB, *Omd, *Aa;
};

constexpr int SMEM_FLOATS = 21504;
__device__ __forceinline__ float bf2f(bf16_t v) { return __uint_as_float(((unsigned)v) << 16); }
__device__ __forceinline__ bf16_t f2bf(float f) { unsigned u = __float_as_uint(f); u += 0x7FFFu + ((u >> 16) & 1u); return (bf16_t)(u >> 16); }
__device__ __forceinline__ unsigned pk2(float lo, float hi) { return (unsigned)f2bf(lo) | ((unsigned)f2bf(hi) << 16); }
__device__ __forceinline__ float sigm(float x) { return 1.f / (1.f + __expf(-x)); }
__device__ __forceinline__ float silu(float x) { return x / (1.f + __expf(-x)); }
__device__ __forceinline__ float wave_sum(float v) {
#pragma unroll
    for (int o = 32; o; o >>= 1) v += __shfl_xor(v, o);
    return v;
}
template <int CTRL> __device__ __forceinline__ float dpp_mov(float v) {
    return __builtin_bit_cast(float, __builtin_amdgcn_update_dpp(0, __builtin_bit_cast(int, v), CTRL, 0xF, 0xF, true));
}
__device__ __forceinline__ float row16_sum(float v) {
    v += dpp_mov<0xB1>(v);
    v += dpp_mov<0x4E>(v);
    v += dpp_mov<0x141>(v);
    v += dpp_mov<0x140>(v);
    return v;
}
__device__ __forceinline__ void tok_info(int m, int& s, int& t) {
    if (m < M_P) { s = m >> 11; t = m & 2047; } else { int q = m - M_P; s = 8 + (q >> 3); t = q & 7; }
}
__device__ __forceinline__ const float* xrow(const Params& p, int m) {
    return m < M_P ? p.x_p + (size_t)m * DM : p.x_s + (size_t)(m - M_P) * DM;
}

__device__ void transpose_tile(const float* __restrict__ src, int Nsrc, bf16_t* __restrict__ dst, int K, int n0, int k0, float* tile) {
    const int tid = threadIdx.x;
    {
        const int nn = tid & 63, kk0 = tid >> 6;
        const int n = n0 + nn;
#pragma unroll
        for (int i = 0; i < 8; ++i) {
            const int kk = kk0 + 8 * i;
            tile[kk * 65 + nn] = (n < Nsrc) ? src[(size_t)(k0 + kk) * Nsrc + n] : 0.f;
        }
    }
    __syncthreads();
    {
        const int kk = tid & 63, nn0 = tid >> 6;
#pragma unroll
        for (int i = 0; i < 8; ++i) {
            const int nn = nn0 + 8 * i;
            dst[(size_t)(n0 + nn) * K + k0 + kk] = f2bf(tile[kk * 65 + nn]);
        }
    }
    __syncthreads();
}

__device__ void phaseA(const Params& p, float* sm, int bid, int nb) {
    const int tid = threadIdx.x;
    constexpr int T_IN = 108 * 16, T_UP = 16 * 8, T_OUT = 16 * 16;
    constexpr int T_ALL = T_IN + 2 * T_UP + T_OUT;
    constexpr int N_ADA = 48 * 17;
    for (int it = bid; it < T_ALL + N_ADA; it += nb) {
        if (it < T_IN) {
            transpose_tile(p.w_in, N_IN, p.WinT, 1024, (it / 16) * 64, (it % 16) * 64, sm);
        } else if (it < T_IN + T_UP) {
            const int i = it - T_IN;
            transpose_tile(p.w_up_a, 1024, p.WupaT, 512, (i / 8) * 64, (i % 8) * 64, sm);
        } else if (it < T_IN + 2 * T_UP) {
            const int i = it - T_IN - T_UP;
            transpose_tile(p.w_up_b, 1024, p.WupbT, 512, (i / 8) * 64, (i % 8) * 64, sm);
        } else if (it < T_ALL) {
            const int i = it - T_IN - 2 * T_UP;
            transpose_tile(p.w_out, 1024, p.WoutT, 1024, (i / 16) * 64, (i % 16) * 64, sm);
        } else {
            const int i = it - T_ALL;
            const int ct = i % 48, rgp = i / 48;
            float* sc = sm;
            float* red = sm + 8192;
            for (int idx = tid; idx < 8 * 1024; idx += NTHR) {
                const int sl = idx >> 10, k = idx & 1023, s = rgp * 8 + sl;
                const float c = s < 8 ? p.c_p[s * 1024 + k] : p.c_s[(s - 8) * 1024 + k];
                sc[idx] = silu(c);
            }
            __syncthreads();
            const int col = tid & 63, kq = tid >> 6;
            float acc[8];
#pragma unroll
            for (int s = 0; s < 8; ++s) acc[s] = 0.f;
            const float* wp = p.w_ada + (size_t)(kq * 128) * 3072 + ct * 64 + col;
            for (int k = 0; k < 128; ++k) {
                const float w = wp[(size_t)k * 3072];
#pragma unroll
                for (int s = 0; s < 8; ++s) acc[s] += sc[s * 1024 + kq * 128 + k] * w;
            }
#pragma unroll
            for (int s = 0; s < 8; ++s) red[(kq * 8 + s) * 64 + col] = acc[s];
            __syncthreads();
            {
                const int s = tid >> 6;
                float v = p.b_ada[ct * 64 + col];
#pragma unroll
                for (int q = 0; q < 8; ++q) v += red[(q * 8 + s) * 64 + col];
                p.mod[(size_t)(rgp * 8 + s) * 3072 + ct * 64 + col] = v;
            }
            __syncthreads();
        }
    }
}

__device__ void phaseB(const Params& p, int bid, int nb) {
    const int wid = threadIdx.x >> 6, lane = threadIdx.x & 63;
    for (int m = bid * 8 + wid; m < M_TOT; m += nb * 8) {
        const float* xr = xrow(p, m);
        int s, t; tok_info(m, s, t);
        const float* md = p.mod + (size_t)s * 3072;
        float4 v[4]; float ss = 0.f;
#pragma unroll
        for (int i = 0; i < 4; ++i) {
            v[i] = *(const float4*)(xr + i * 256 + lane * 4);
            ss += v[i].x * v[i].x + v[i].y * v[i].y + v[i].z * v[i].z + v[i].w * v[i].w;
        }
        ss = wave_sum(ss);
        const float rstd = rsqrtf(ss * (1.f / 1024.f) + 1e-6f);
#pragma unroll
        for (int i = 0; i < 4; ++i) {
            const int c = i * 256 + lane * 4;
            const float4 g = *(const float4*)(p.g_norm + c);
            const float4 sh = *(const float4*)(md + c);
            const float4 sl = *(const float4*)(md + 1024 + c);
            const float h0 = v[i].x * rstd * g.x * (1.f + sl.x) + sh.x;
            const float h1 = v[i].y * rstd * g.y * (1.f + sl.y) + sh.y;
            const float h2 = v[i].z * rstd * g.z * (1.f + sl.z) + sh.z;
            const float h3 = v[i].w * rstd * g.w * (1.f + sl.w) + sh.w;
            uint2 o; o.x = pk2(h0, h1); o.y = pk2(h2, h3);
            *(uint2*)(p.H + (size_t)m * 1024 + c) = o;
        }
    }
}

constexpr int LROW = 72;
constexpr int TBUF = 128 * LROW;
__device__ __forceinline__ void gemm_main(const bf16_t* __restrict__ A, int lda, const bf16_t* __restrict__ B, int ldb, int K,
                                          f32x4 (&acc)[2][4], bf16_t* smem) {
    const int tid = threadIdx.x, wid = tid >> 6, lane = tid & 63, wr = wid >> 1, wc = wid & 1, fr = lane & 15, fq = lane >> 4;
    bf16_t* sA = smem; bf16_t* sB = smem + 2 * TBUF;
    const int lr0 = tid >> 3, kc = tid & 7;
    const bf16_t* ga0 = A + (size_t)lr0 * lda + kc * 8; const bf16_t* ga1 = ga0 + (size_t)64 * lda;
    const bf16_t* gb0 = B + (size_t)lr0 * ldb + kc * 8; const bf16_t* gb1 = gb0 + (size_t)64 * ldb;
    const int so0 = lr0 * LROW + kc * 8, so1 = so0 + 64 * LROW;
    uint4 ra0 = *(const uint4*)ga0, ra1 = *(const uint4*)ga1, rb0 = *(const uint4*)gb0, rb1 = *(const uint4*)gb1;
    *(uint4*)(sA + so0) = ra0; *(uint4*)(sA + so1) = ra1; *(uint4*)(sB + so0) = rb0; *(uint4*)(sB + so1) = rb1;
    __syncthreads();
    const int nt = K >> 6;
    for (int t = 0; t < nt; ++t) {
        const int cur = t & 1;
        if (t + 1 < nt) {
            const int ko = (t + 1) * 64;
            ra0 = *(const uint4*)(ga0 + ko); ra1 = *(const uint4*)(ga1 + ko);
            rb0 = *(const uint4*)(gb0 + ko); rb1 = *(const uint4*)(gb1 + ko);
        }
        const bf16_t* cA = sA + cur * TBUF + (wr * 32 + fr) * LROW + fq * 8;
        const bf16_t* cB = sB + cur * TBUF + (wc * 64 + fr) * LROW + fq * 8;
#pragma unroll
        for (int ks = 0; ks < 2; ++ks) {
            bf16x8 a[2], b[4];
#pragma unroll
            for (int m = 0; m < 2; ++m) a[m] = *(const bf16x8*)(cA + m * 16 * LROW + ks * 32);
#pragma unroll
            for (int n = 0; n < 4; ++n) b[n] = *(const bf16x8*)(cB + n * 16 * LROW + ks * 32);
#pragma unroll
            for (int m = 0; m < 2; ++m)
#pragma unroll
                for (int n = 0; n < 4; ++n) acc[m][n] = __builtin_amdgcn_mfma_f32_16x16x32_bf16(b[n], a[m], acc[m][n], 0, 0, 0);
        }
        if (t + 1 < nt) {
            const int nx = (cur ^ 1) * TBUF;
            *(uint4*)(sA + nx + so0) = ra0; *(uint4*)(sA + nx + so1) = ra1;
            *(uint4*)(sB + nx + so0) = rb0; *(uint4*)(sB + nx + so1) = rb1;
        }
        __syncthreads();
    }
}
__device__ __forceinline__ void acc_zero(f32x4 (&acc)[2][4]) {
#pragma unroll
    for (int m = 0; m < 2; ++m)
#pragma unroll
        for (int n = 0; n < 4; ++n) acc[m][n] = (f32x4){0.f, 0.f, 0.f, 0.f};
}

__device__ void phaseC(const Params& p, float* sm, int bid, int nb) {
    const int tid = threadIdx.x, wid = tid >> 6, lane = tid & 63, wr = wid >> 1, wc = wid & 1, fr = lane & 15, fq = lane >> 4;
    constexpr int NMT = 136, NNT = 54, GRP = 8 * NNT;
    for (int it = bid; it < NMT * NNT; it += nb) {
        const int g = it / GRP, i = it % GRP;
        const int mt = g * 8 + (i & 7), nt = i >> 3;
        f32x4 acc[2][4]; acc_zero(acc);
        gemm_main(p.H + (size_t)mt * 128 * 1024, 1024, p.WinT + (size_t)nt * 128 * 1024, 1024, 1024, acc, (bf16_t*)sm);
#pragma unroll
        for (int m = 0; m < 2; ++m) {
            const int row = mt * 128 + wr * 32 + m * 16 + fr;
#pragma unroll
            for (int n = 0; n < 4; ++n) {
                const int col = nt * 128 + wc * 64 + n * 16 + fq * 4;
                uint2 o; o.x = pk2(acc[m][n][0], acc[m][n][1]); o.y = pk2(acc[m][n][2], acc[m][n][3]);
                *(uint2*)(p.P + (size_t)row * NP + col) = o;
            }
        }
    }
}

__device__ void phaseD(const Params& p, float* sm, int bid, int nb) {
    const int tid = threadIdx.x;
    float* tw = sm;
    float* al = sm + 1024;
    for (int it = bid; it < M_TOT / 16; it += nb) {
        const int m0 = it * 16;
        for (int idx = tid; idx < 16 * 128; idx += NTHR) {
            const int tok = idx >> 7, j = idx & 127, col = C_WL + j, m = m0 + tok;
            int s, t; tok_info(m, s, t);
            const float cur = bf2f(p.P[(size_t)m * NP + col]);
            const float prev = t > 0 ? bf2f(p.P[(size_t)(m - 1) * NP + col]) : (s >= 8 ? p.st_shift[(size_t)(s - 8) * SHIFT_W + col] : 0.f);
            const float v = cur + p.mu_shift[col] * (prev - cur);
            if (j < 64) tw[tok * 64 + j] = tanhf(v); else al[tok * 64 + j - 64] = v;
        }
        __syncthreads();
        const int c = tid;
        float accw[16], acca[16];
#pragma unroll
        for (int i = 0; i < 16; ++i) { accw[i] = 0.f; acca[i] = 0.f; }
        for (int j4 = 0; j4 < 16; ++j4) {
            float wd[4], wi[4];
#pragma unroll
            for (int q = 0; q < 4; ++q) { wd[q] = p.w_decay2[(j4 * 4 + q) * 512 + c]; wi[q] = p.w_iclr2[(j4 * 4 + q) * 512 + c]; }
#pragma unroll
            for (int tok = 0; tok < 16; ++tok) {
                const float4 t4 = *(const float4*)(tw + tok * 64 + j4 * 4);
                const float4 a4 = *(const float4*)(al + tok * 64 + j4 * 4);
                accw[tok] += t4.x * wd[0] + t4.y * wd[1] + t4.z * wd[2] + t4.w * wd[3];
                acca[tok] += a4.x * wi[0] + a4.y * wi[1] + a4.z * wi[2] + a4.w * wi[3];
            }
        }
        const float w0c = p.w0[c], a0c = p.a0[c];
#pragma unroll
        for (int tok = 0; tok < 16; ++tok) {
            const int m = m0 + tok;
            const float sg = sigm(w0c + accw[tok]);
            const float omd = 1.f - __expf(-0.6065306597126334f * sg);
            const float av = sigm(a0c + acca[tok]);
            p.Omd[(size_t)m * 512 + c] = f2bf(omd);
            p.Aa[(size_t)m * 512 + c] = f2bf(av);
        }
        for (int tok = 0; tok < 16; ++tok) {
            const int m = m0 + tok;
            int s, t; tok_info(m, s, t);
            const int T = s < 8 ? 2048 : 8;
            if (t != T - 1) continue;
            float* osh = s < 8 ? p.out + O_PSHIFT + (size_t)s * SHIFT_W : p.out + O_SSHIFT + (size_t)(s - 8) * SHIFT_W;
            float* ocv = s < 8 ? p.out + O_PCONV + (size_t)s * 3072 : p.out + O_SCONV + (size_t)(s - 8) * 3072;
            for (int col = tid; col < SHIFT_W; col += NTHR) osh[col] = bf2f(p.P[(size_t)m * NP + col]);
            for (int idx = tid; idx < 3072; idx += NTHR) {
                const int r = idx >> 10, cc = idx & 1023;
                ocv[idx] = bf2f(p.P[(size_t)(m - 2 + r) * NP + C_QK + cc]);
            }
        }
        __syncthreads();
    }
}

__device__ void rwkv_item(const Params& p, int s, int h, int rg, float* sm) {
    float* s_kk = sm;
    float* s_d = sm + 1024;
    float* s_ka = sm + 2048;
    float* s_kp = sm + 3072;
    float* s_dr = sm + 4096;
    float* s_v = sm + 5120;
    float* s_c = sm + 6144;
    float* s_y = sm + 6176;
    const int tid = threadIdx.x, wid = tid >> 6, lane = tid & 63;
    const int T = s < 8 ? 2048 : 8;
    const int mbase = s < 8 ? s * 2048 : M_P + (s - 8) * 8;
    const int hj = h * 64 + lane;
    const int irow = rg * 16 + (wid & 3) * 4 + (lane >> 4);
    const int c4 = (lane & 15) * 4;
    float S0 = 0.f, S1 = 0.f, S2 = 0.f, S3 = 0.f;
    if (wid < 4 && s >= 8) {
        const float4 v = *(const float4*)(p.st_S + ((size_t)((s - 8) * 8 + h) * 64 + irow) * 64 + c4);
        S0 = v.x; S1 = v.y; S2 = v.z; S3 = v.w;
    }
    const float mu_r = p.mu_shift[C_R + hj], mu_k = p.mu_shift[C_K + hj], mu_v = p.mu_shift[C_V + hj];
    const float kkw = p.k_k[hj], kaw = p.k_a[hj];
    for (int t0 = 0; t0 < T; t0 += 16) {
        const int nT = (T - t0) < 16 ? (T - t0) : 16;
#pragma unroll
        for (int q = 0; q < 2; ++q) {
            const int tt = wid * 2 + q;
            if (tt < nT) {
                const int t = t0 + tt, m = mbase + t;
                const bf16_t* pr = p.P + (size_t)m * NP;
                float r = bf2f(pr[C_R + hj]), k = bf2f(pr[C_K + hj]), v = bf2f(pr[C_V + hj]);
                float rp, kp_, vp;
                if (t > 0) { rp = bf2f(pr[C_R + hj - NP]); kp_ = bf2f(pr[C_K + hj - NP]); vp = bf2f(pr[C_V + hj - NP]); }
                else if (s >= 8) { const float* st = p.st_shift + (size_t)(s - 8) * SHIFT_W; rp = st[C_R + hj]; kp_ = st[C_K + hj]; vp = st[C_V + hj]; }
                else { rp = 0.f; kp_ = 0.f; vp = 0.f; }
                r += mu_r * (rp - r); k += mu_k * (kp_ - k); v += mu_v * (vp - v);
                const float a = bf2f(p.Aa[(size_t)m * 512 + hj]);
                const float d = 1.f - bf2f(p.Omd[(size_t)m * 512 + hj]);
                const float kkr = k * kkw;
                const float nrm = sqrtf(wave_sum(kkr * kkr));
                const float kk = kkr / fmaxf(nrm, 1e-12f);
                const float ka = kk * a;
                const float kp = k * (1.f + (a - 1.f) * kaw);
                const float c1 = wave_sum(ka * r), c2 = wave_sum(kp * r);
                s_kk[tt * 64 + lane] = kk; s_d[tt * 64 + lane] = d; s_ka[tt * 64 + lane] = ka;
                s_kp[tt * 64 + lane] = kp; s_dr[tt * 64 + lane] = d * r; s_v[tt * 64 + lane] = v;
                if (lane == 0) { s_c[tt * 2] = c1; s_c[tt * 2 + 1] = c2; }
            }
        }
        __syncthreads();
        if (wid < 4) {
            for (int tt = 0; tt < nT; ++tt) {
                const float4 kk4 = *(const float4*)(s_kk + tt * 64 + c4);
                const float4 d4 = *(const float4*)(s_d + tt * 64 + c4);
                const float4 ka4 = *(const float4*)(s_ka + tt * 64 + c4);
                const float4 kp4 = *(const float4*)(s_kp + tt * 64 + c4);
                const float4 dr4 = *(const float4*)(s_dr + tt * 64 + c4);
                const float vi = s_v[tt * 64 + irow];
                const float c1 = s_c[tt * 2], c2 = s_c[tt * 2 + 1];
                float p1 = S0 * kk4.x + S1 * kk4.y + S2 * kk4.z + S3 * kk4.w;
                float p2 = S0 * dr4.x + S1 * dr4.y + S2 * dr4.z + S3 * dr4.w;
                p1 = row16_sum(p1); p2 = row16_sum(p2);
                const float y = p2 - p1 * c1 + vi * c2;
                S0 = S0 * d4.x - p1 * ka4.x + vi * kp4.x;
                S1 = S1 * d4.y - p1 * ka4.y + vi * kp4.y;
                S2 = S2 * d4.z - p1 * ka4.z + vi * kp4.z;
                S3 = S3 * d4.w - p1 * ka4.w + vi * kp4.w;
                if ((lane & 15) == 0) s_y[tt * 16 + wid * 4 + (lane >> 4)] = y;
            }
        }
        __syncthreads();
        if (tid < 256) {
            const int tt = tid >> 4, i = tid & 15;
            if (tt < nT) p.Yraw[(size_t)(mbase + t0 + tt) * 512 + h * 64 + rg * 16 + i] = f2bf(s_y[tt * 16 + i]);
        }
    }
    if (wid < 4) {
        float* o = (s < 8 ? p.out + O_PS + (size_t)s * 8 * 4096 : p.out + O_SS + (size_t)(s - 8) * 8 * 4096) + ((size_t)(h * 64 + irow)) * 64 + c4;
        float4 v; v.x = S0; v.y = S1; v.z = S2; v.w = S3;
        *(float4*)o = v;
    }
    __syncthreads();
}

__device__ void mlstm_item(const Params& p, int s, int h, float* sm) {
    float* sq = sm;
    float* sk = sm + 4160;
    float* sv = sm + 8320;
    float* sc = sm + 12480;
    float* sC = sm + 16640;
    float* sn = sm + 20800;
    float* sb = sn + 64;
    float* si = sn + 128;
    float* smt = sn + 192;
    float* swin = sn + 256;
    float* sden = sn + 320;
    float* sws = sn + 384;
    float* slf = sn + 448;
    float* smisc = sn + 512;
    const int tid = threadIdx.x, wid = tid >> 6, lane = tid & 63;
    const int T = s < 8 ? 2048 : 8, L = s < 8 ? 64 : 8, NC = T / L;
    const int mbase = s < 8 ? s * 2048 : M_P + (s - 8) * 8;
    for (int idx = tid; idx < 4096; idx += NTHR) {
        const int i = idx >> 6, j = idx & 63;
        sC[i * 65 + j] = s >= 8 ? p.st_C[(size_t)((s - 8) * 8 + h) * 4096 + idx] : 0.f;
    }
    if (tid < 64) sn[tid] = s >= 8 ? p.st_n[(size_t)((s - 8) * 8 + h) * 64 + tid] : 0.f;
    if (tid == 0) smisc[0] = s >= 8 ? p.st_m[(s - 8) * 8 + h] : 0.f;
    const float cwq[4] = {p.conv_w[0 * 1024 + h * 64 + lane], p.conv_w[1 * 1024 + h * 64 + lane], p.conv_w[2 * 1024 + h * 64 + lane], p.conv_w[3 * 1024 + h * 64 + lane]};
    const float cwk[4] = {p.conv_w[0 * 1024 + 512 + h * 64 + lane], p.conv_w[1 * 1024 + 512 + h * 64 + lane], p.conv_w[2 * 1024 + 512 + h * 64 + lane], p.conv_w[3 * 1024 + 512 + h * 64 + lane]};
    const float cbq = p.conv_b[h * 64 + lane], cbk = p.conv_b[512 + h * 64 + lane];
    const float gnw = p.gn_w[h * 64 + lane];
    const float bi = p.b_i[h], bfv = p.b_f[h];
    __syncthreads();
    for (int c = 0; c < NC; ++c) {
        const int t0 = c * L;
        for (int tt = wid; tt < L; tt += 8) {
            const int t = t0 + tt, m = mbase + t;
            float aq = cbq, ak = cbk;
#pragma unroll
            for (int j = 0; j < 4; ++j) {
                const int tau = t - 3 + j;
                float xq, xk;
                if (tau >= 0) {
                    const bf16_t* pr = p.P + (size_t)(mbase + tau) * NP + C_QK + h * 64 + lane;
                    xq = bf2f(pr[0]); xk = bf2f(pr[512]);
                } else if (s >= 8) {
                    const float* st = p.st_conv + ((size_t)(s - 8) * 3 + (3 + tau)) * 1024 + h * 64 + lane;
                    xq = st[0]; xk = st[512];
                } else { xq = 0.f; xk = 0.f; }
                aq += xq * cwq[j]; ak += xk * cwk[j];
            }
            sq[tt * 65 + lane] = silu(aq);
            sk[tt * 65 + lane] = silu(ak) * 0.125f;
            sv[tt * 65 + lane] = bf2f(p.P[(size_t)m * NP + C_VB + h * 64 + lane]);
        }
        if (tid < L) {
            const int m = mbase + t0 + tid;
            si[tid] = bf2f(p.P[(size_t)m * NP + C_IB + h]) + bi;
            const float f = bf2f(p.P[(size_t)m * NP + C_FB + h]) + bfv;
            slf[tid] = f > 0.f ? -log1pf(__expf(-f)) : f - log1pf(__expf(f));
        }
        __syncthreads();
        if (tid == 0) {
            const float mprev = smisc[0];
            float b = 0.f, run = mprev;
            for (int t = 0; t < L; ++t) {
                b += slf[t];
                run = fmaxf(run, si[t] - b);
                sb[t] = b; smt[t] = b + run; swin[t] = __expf(b + mprev - (b + run));
            }
            const float mnew = b + run;
            smisc[1] = mnew; smisc[2] = __expf(b + mprev - mnew);
            for (int t = 0; t < L; ++t) sws[t] = __expf(b - sb[t] + si[t] - mnew);
        }
        __syncthreads();
        for (int idx = tid; idx < L * L; idx += NTHR) {
            const int t = idx / L, u = idx % L;
            float v = 0.f;
            if (u <= t) {
                float dot = 0.f;
#pragma unroll 8
                for (int d = 0; d < 64; ++d) dot += sq[t * 65 + d] * sk[u * 65 + d];
                v = dot * __expf(sb[t] - sb[u] + si[u] - smt[t]);
            }
            sc[t * 65 + u] = v;
        }
        __syncthreads();
        if (tid < L) {
            float rs = 0.f, qn = 0.f;
            for (int u = 0; u < L; ++u) rs += sc[tid * 65 + u];
            for (int j = 0; j < 64; ++j) qn += sn[j] * sq[tid * 65 + j];
            const float den = rs + swin[tid] * qn;
            sden[tid] = fmaxf(fabsf(den), __expf(-smt[tid]));
        }
        __syncthreads();
        for (int tt = wid; tt < L; tt += 8) {
            float num = 0.f, inter = 0.f;
            for (int u = 0; u <= tt; ++u) num += sc[tt * 65 + u] * sv[u * 65 + lane];
#pragma unroll 8
            for (int j = 0; j < 64; ++j) inter += sC[lane * 65 + j] * sq[tt * 65 + j];
            const float hv = (num + swin[tt] * inter) / sden[tt];
            const float ms = wave_sum(hv * hv) * (1.f / 64.f);
            const float hn = hv * rsqrtf(ms + 1e-6f) * gnw;
            const int m = mbase + t0 + tt;
            const float ob = bf2f(p.P[(size_t)m * NP + C_OB + h * 64 + lane]);
            const float zb = bf2f(p.P[(size_t)m * NP + C_ZB + h * 64 + lane]);
            p.OutB[(size_t)m * 512 + h * 64 + lane] = f2bf(sigm(ob) * hn * silu(zb));
        }
        __syncthreads();
        {
            const float dec = smisc[2];
            const int j = lane;
#pragma unroll
            for (int ii = 0; ii < 8; ++ii) {
                const int i = wid + 8 * ii;
                float a = dec * sC[i * 65 + j];
                for (int u = 0; u < L; ++u) a += sws[u] * sv[u * 65 + i] * sk[u * 65 + j];
                sC[i * 65 + j] = a;
            }
            if (tid < 64) {
                float a = dec * sn[tid];
                for (int u = 0; u < L; ++u) a += sws[u] * sk[u * 65 + tid];
                sn[tid] = a;
            }
            if (tid == 0) smisc[0] = smisc[1];
        }
        __syncthreads();
    }
    {
        float* oC = s < 8 ? p.out + O_PC + (size_t)(s * 8 + h) * 4096 : p.out + O_SC + (size_t)((s - 8) * 8 + h) * 4096;
        float* on = s < 8 ? p.out + O_PN + (size_t)(s * 8 + h) * 64 : p.out + O_SN + (size_t)((s - 8) * 8 + h) * 64;
        float* om = s < 8 ? p.out + O_PM + (s * 8 + h) : p.out + O_SM + ((s - 8) * 8 + h);
        for (int idx = tid; idx < 4096; idx += NTHR) oC[idx] = sC[(idx >> 6) * 65 + (idx & 63)];
        if (tid < 64) on[tid] = sn[tid];
        if (tid == 0) om[0] = smisc[0];
    }
    __syncthreads();
}

__device__ void phaseE(const Params& p, float* sm, int bid, int nb) {
    constexpr int N_RP = 8 * 8 * 4, N_MP = 64, N_RS = 128 * 8 * 4, N_MS = 128 * 8;
    for (int it = bid; it < N_RP + N_MP + N_RS + N_MS; it += nb) {
        if (it < N_RP) { rwkv_item(p, it >> 5, (it >> 2) & 7, it & 3, sm); }
        else if (it < N_RP + N_MP) { const int i = it - N_RP; mlstm_item(p, i >> 3, i & 7, sm); }
        else if (it < N_RP + N_MP + N_RS) { const int i = it - N_RP - N_MP; rwkv_item(p, 8 + (i >> 5), (i >> 2) & 7, i & 3, sm); }
        else { const int i = it - N_RP - N_MP - N_RS; mlstm_item(p, 8 + (i >> 3), i & 7, sm); }
    }
}

__device__ void phaseF(const Params& p, int bid, int nb) {
    const int wid = threadIdx.x >> 6, lane = threadIdx.x & 63;
    for (int it = bid * 8 + wid; it < M_TOT * 8; it += nb * 8) {
        const int m = it >> 3, h = it & 7, hj = h * 64 + lane;
        int s, t; tok_info(m, s, t);
        const float y = bf2f(p.Yraw[(size_t)m * 512 + hj]);
        const float mean = wave_sum(y) * (1.f / 64.f);
        const float dy = y - mean;
        const float var = wave_sum(dy * dy) * (1.f / 64.f);
        float yn = dy * rsqrtf(var + 64e-5f) * p.ln_w[hj] + p.ln_b[hj];
        const bf16_t* pr = p.P + (size_t)m * NP;
        float r = bf2f(pr[C_R + hj]), k = bf2f(pr[C_K + hj]), v = bf2f(pr[C_V + hj]);
        float rp, kp_, vp;
        if (t > 0) { rp = bf2f(pr[C_R + hj - NP]); kp_ = bf2f(pr[C_K + hj - NP]); vp = bf2f(pr[C_V + hj - NP]); }
        else if (s >= 8) { const float* st = p.st_shift + (size_t)(s - 8) * SHIFT_W; rp = st[C_R + hj]; kp_ = st[C_K + hj]; vp = st[C_V + hj]; }
        else { rp = 0.f; kp_ = 0.f; vp = 0.f; }
        r += p.mu_shift[C_R + hj] * (rp - r); k += p.mu_shift[C_K + hj] * (kp_ - k); v += p.mu_shift[C_V + hj] * (vp - v);
        const float a = bf2f(p.Aa[(size_t)m * 512 + hj]);
        const float kp = k * (1.f + (a - 1.f) * p.k_a[hj]);
        const float bonus = wave_sum(r * kp * p.r_k[hj]);
        yn += bonus * v;
        const float z = bf2f(pr[C_ZA + hj]);
        p.Yraw[(size_t)m * 512 + hj] = f2bf(yn * silu(z));
    }
}

__device__ void phaseG(const Params& p, float* sm, int bid, int nb) {
    const int tid = threadIdx.x, wid = tid >> 6, lane = tid & 63, wr = wid >> 1, wc = wid & 1, fr = lane & 15, fq = lane >> 4;
    for (int it = bid; it < 136 * 8; it += nb) {
        const int mt = it >> 3, nt = it & 7;
        f32x4 acc[2][4], mg[2][4];
        acc_zero(acc);
        gemm_main(p.Yraw + (size_t)mt * 128 * 512, 512, p.WupaT + (size_t)nt * 128 * 512, 512, 512, acc, (bf16_t*)sm);
#pragma unroll
        for (int m = 0; m < 2; ++m) {
            const int row = mt * 128 + wr * 32 + m * 16 + fr;
#pragma unroll
            for (int n = 0; n < 4; ++n) {
                const int col = nt * 128 + wc * 64 + n * 16 + fq * 4;
                const uint2 g = *(const uint2*)(p.P + (size_t)row * NP + C_GLA + col);
                mg[m][n][0] = sigm(__uint_as_float(g.x << 16)) * acc[m][n][0];
                mg[m][n][1] = sigm(__uint_as_float(g.x & 0xFFFF0000u)) * acc[m][n][1];
                mg[m][n][2] = sigm(__uint_as_float(g.y << 16)) * acc[m][n][2];
                mg[m][n][3] = sigm(__uint_as_float(g.y & 0xFFFF0000u)) * acc[m][n][3];
            }
        }
        acc_zero(acc);
        gemm_main(p.OutB + (size_t)mt * 128 * 512, 512, p.WupbT + (size_t)nt * 128 * 512, 512, 512, acc, (bf16_t*)sm);
#pragma unroll
        for (int m = 0; m < 2; ++m) {
            const int row = mt * 128 + wr * 32 + m * 16 + fr;
#pragma unroll
            for (int n = 0; n < 4; ++n) {
                const int col = nt * 128 + wc * 64 + n * 16 + fq * 4;
                const uint2 g = *(const uint2*)(p.P + (size_t)row * NP + C_GLB + col);
                const float v0 = mg[m][n][0] + sigm(__uint_as_float(g.x << 16)) * acc[m][n][0];
                const float v1 = mg[m][n][1] + sigm(__uint_as_float(g.x & 0xFFFF0000u)) * acc[m][n][1];
                const float v2 = mg[m][n][2] + sigm(__uint_as_float(g.y << 16)) * acc[m][n][2];
                const float v3 = mg[m][n][3] + sigm(__uint_as_float(g.y & 0xFFFF0000u)) * acc[m][n][3];
                uint2 o; o.x = pk2(v0, v1); o.y = pk2(v2, v3);
                *(uint2*)(p.P + (size_t)row * NP + col) = o;
            }
        }
    }
}

__device__ void phaseH(const Params& p, float* sm, int bid, int nb) {
    const int tid = threadIdx.x, wid = tid >> 6, lane = tid & 63, wr = wid >> 1, wc = wid & 1, fr = lane & 15, fq = lane >> 4;
    for (int it = bid; it < 136 * 8; it += nb) {
        const int mt = it >> 3, nt = it & 7;
        f32x4 acc[2][4]; acc_zero(acc);
        gemm_main(p.P + (size_t)mt * 128 * NP, NP, p.WoutT + (size_t)nt * 128 * 1024, 1024, 1024, acc, (bf16_t*)sm);
#pragma unroll
        for (int m = 0; m < 2; ++m) {
            const int row = mt * 128 + wr * 32 + m * 16 + fr;
            int s, t; tok_info(row, s, t);
            const float* xr = xrow(p, row);
            const float* gt = p.mod + (size_t)s * 3072 + 2048;
#pragma unroll
            for (int n = 0; n < 4; ++n) {
                const int col = nt * 128 + wc * 64 + n * 16 + fq * 4;
                const float4 xv = *(const float4*)(xr + col);
                const float4 gv = *(const float4*)(gt + col);
                float4 o;
                o.x = xv.x + gv.x * acc[m][n][0]; o.y = xv.y + gv.y * acc[m][n][1];
                o.z = xv.z + gv.z * acc[m][n][2]; o.w = xv.w + gv.w * acc[m][n][3];
                *(float4*)(p.out + (size_t)row * 1024 + col) = o;
            }
        }
    }
}

__device__ void phaseI(const Params& p, int bid, int nb) {
    const int wid = threadIdx.x >> 6, lane = threadIdx.x & 63;
    for (int m = bid * 8 + wid; m < M_TOT; m += nb * 8) {
        float* yr = p.out + (size_t)m * 1024;
        float4 v[4]; float ss = 0.f;
#pragma unroll
        for (int i = 0; i < 4; ++i) {
            v[i] = *(const float4*)(yr + i * 256 + lane * 4);
            ss += v[i].x * v[i].x + v[i].y * v[i].y + v[i].z * v[i].z + v[i].w * v[i].w;
        }
        ss = wave_sum(ss);
        const float rstd = rsqrtf(ss * (1.f / 1024.f) + 1e-6f);
#pragma unroll
        for (int i = 0; i < 4; ++i) {
            const int c = i * 256 + lane * 4;
            const float4 g = *(const float4*)(p.g_final + c);
            float4 o; o.x = v[i].x * rstd * g.x; o.y = v[i].y * rstd * g.y; o.z = v[i].z * rstd * g.z; o.w = v[i].w * rstd * g.w;
            *(float4*)(yr + c) = o;
        }
    }
}

#if MK_MULTI
#define PHASE_KERNEL(NAME, CALL) __global__ void __launch_bounds__(NTHR) NAME(Params p) { __shared__ __attribute__((aligned(16))) float sm[SMEM_FLOATS]; const int bid = blockIdx.x, nb = gridDim.x; (void)sm; CALL; }
PHASE_KERNEL(kA, phaseA(p, sm, bid, nb))
PHASE_KERNEL(kB, phaseB(p, bid, nb))
PHASE_KERNEL(kC, phaseC(p, sm, bid, nb))
PHASE_KERNEL(kD, phaseD(p, sm, bid, nb))
PHASE_KERNEL(kE, phaseE(p, sm, bid, nb))
PHASE_KERNEL(kF, phaseF(p, bid, nb))
PHASE_KERNEL(kG, phaseG(p, sm, bid, nb))
PHASE_KERNEL(kH, phaseH(p, sm, bid, nb))
PHASE_KERNEL(kI, phaseI(p, bid, nb))
#else
__global__ void __launch_bounds__(NTHR) fwd_megakernel(Params p) {
    __shared__ __attribute__((aligned(16))) float sm[SMEM_FLOATS];
    cg::grid_group grid = cg::this_grid();
    const int bid = blockIdx.x, nb = gridDim.x;
    phaseA(p, sm, bid, nb); grid.sync();
    phaseB(p, bid, nb); grid.sync();
    phaseC(p, sm, bid, nb); grid.sync();
    phaseD(p, sm, bid, nb); grid.sync();
    phaseE(p, sm, bid, nb); grid.sync();
    phaseF(p, bid, nb); grid.sync();
    phaseG(p, sm, bid, nb); grid.sync();
    phaseH(p, sm, bid, nb); grid.sync();
    phaseI(p, bid, nb);
}
#endif

extern "C" void kernel_launch(void* const* d_in, const int* in_sizes, int n_in, void* d_out, int out_size, void* d_ws, size_t ws_size,
                              hipStream_t stream) {
    Params p{};
    const float* const* in = (const float* const*)d_in;
    p.x_p = in[0]; p.x_s = in[1]; p.c_p = in[2]; p.c_s = in[3];
    p.st_shift = in[4]; p.st_S = in[5]; p.st_conv = in[6]; p.st_C = in[7]; p.st_n = in[8]; p.st_m = in[9];
    p.g_norm = in[10]; p.w_ada = in[11]; p.b_ada = in[12]; p.w_in = in[13]; p.mu_shift = in[14]; p.w_decay2 = in[15];
    p.w0 = in[16]; p.w_iclr2 = in[17]; p.a0 = in[18]; p.k_k = in[19]; p.k_a = in[20]; p.r_k = in[21];
    p.ln_w = in[22]; p.ln_b = in[23]; p.conv_w = in[24]; p.conv_b = in[25]; p.b_i = in[26]; p.b_f = in[27];
    p.gn_w = in[28]; p.w_up_a = in[29]; p.w_up_b = in[30]; p.w_out = in[31]; p.g_final = in[32];
    p.out = (float*)d_out;
    char* ws = (char*)d_ws;
    size_t off = 0;
    p.P = (bf16_t*)(ws + off); off += (size_t)M_TOT * NP * 2;
    p.WinT = (bf16_t*)(ws + off); off += (size_t)NP * 1024 * 2;
    p.WupaT = (bf16_t*)(ws + off); off += (size_t)1024 * 512 * 2;
    p.WupbT = (bf16_t*)(ws + off); off += (size_t)1024 * 512 * 2;
    p.WoutT = (bf16_t*)(ws + off); off += (size_t)1024 * 1024 * 2;
    p.mod = (float*)(ws + off); off += (size_t)NSEQ * 3072 * 4;
    char* os = (char*)d_out;
    p.H = (bf16_t*)os;
    p.Yraw = (bf16_t*)os;
    p.OutB = (bf16_t*)(os + (size_t)M_TOT * 512 * 2);
    p.Omd = (bf16_t*)(os + (size_t)M_TOT * 1024 * 2);
    p.Aa = (bf16_t*)(os + (size_t)M_TOT * 1024 * 2 + (size_t)M_TOT * 512 * 2);
#if MK_MULTI
    const int G = 1024;
    kA<<<G, NTHR, 0, stream>>>(p);
    kB<<<G, NTHR, 0, stream>>>(p);
    kC<<<G, NTHR, 0, stream>>>(p);
    kD<<<G, NTHR, 0, stream>>>(p);
    kE<<<G, NTHR, 0, stream>>>(p);
    kF<<<G, NTHR, 0, stream>>>(p);
    kG<<<G, NTHR, 0, stream>>>(p);
    kH<<<G, NTHR, 0, stream>>>(p);
    kI<<<G, NTHR, 0, stream>>>(p);
#else
    static int grid_blocks = 0;
    if (!grid_blocks) {
        int dev = 0, cus = 0, per_cu = 0;
        hipGetDevice(&dev);
        hipDeviceGetAttribute(&cus, hipDeviceAttributeMultiprocessorCount, dev);
        hipOccupancyMaxActiveBlocksPerMultiprocessor(&per_cu, fwd_megakernel, NTHR, 0);
        if (per_cu > 1) per_cu = 1;
        grid_blocks = cus * per_cu;
    }
    void* args[] = {&p};
    hipError_t e = hipLaunchCooperativeKernel((void*)fwd_megakernel, dim3(grid_blocks), dim3(NTHR), args, 0, stream);
    if (e != hipSuccess) fprintf(stderr, "cooperative launch failed: %s (grid %d)\n", hipGetErrorString(e), grid_blocks);
#endif
}
```

```cpp
#include <hip/hip_runtime.h>
#include <hip/hip_cooperative_groups.h>
#include <cstdio>
namespace cg = cooperative_groups;

#ifndef MK_MULTI
#define MK_MULTI 0
#endif

typedef unsigned short bf16_t;
typedef short bf16x8 __attribute__((ext_vector_type(8)));
typedef float f32x4 __attribute__((ext_vector_type(4)));

constexpr int NTHR = 512;
constexpr int M_P = 16384, M_S = 1024, M_TOT = 17408;
constexpr int DM = 1024;
constexpr int NSEQ = 136;
constexpr int NP = 6912;
constexpr int N_IN = 6800;
constexpr int C_R = 0, C_K = 512, C_V = 1024, C_WL = 1536, C_AL = 1600, C_ZA = 1664, C_QK = 2176,
              C_VB = 3200, C_OB = 3712, C_IB = 4224, C_FB = 4232, C_ZB = 4240, C_GLA = 4752, C_GLB = 5776;
constexpr int SHIFT_W = 1664;

constexpr size_t O_Y = 0;
constexpr size_t O_PSHIFT = (size_t)M_TOT * DM;
constexpr size_t O_PS = O_PSHIFT + 8 * 1664;
constexpr size_t O_PCONV = O_PS + 8 * 8 * 4096;
constexpr size_t O_PC = O_PCONV + 8 * 3 * 1024;
constexpr size_t O_PN = O_PC + 8 * 8 * 4096;
constexpr size_t O_PM = O_PN + 8 * 8 * 64;
constexpr size_t O_SSHIFT = O_PM + 64;
constexpr size_t O_SS = O_SSHIFT + 128 * 1664;
constexpr size_t O_SCONV = O_SS + (size_t)128 * 8 * 4096;
constexpr size_t O_SC = O_SCONV + 128 * 3 * 1024;
constexpr size_t O_SN = O_SC + (size_t)128 * 8 * 4096;
constexpr size_t O_SM = O_SN + 128 * 8 * 64;
constexpr size_t O_END = O_SM + 1024;

struct Params {
    const float *x_p, *x_s, *c_p, *c_s;
    const float *st_shift, *st_S, *st_conv, *st_C, *st_n, *st_m;
    const float *g_norm, *w_ada, *b_ada, *w_in, *mu_shift, *w_decay2, *w0, *w_iclr2, *a0, *k_k, *k_a, *r_k,
        *ln_w, *ln_b, *conv_w, *conv_b, *b_i, *b_f, *gn_w, *w_up_a, *w_up_b, *w_out, *g_final;
    float* out;
    bf16_t *WinT, *WupaT, *WupbT, *WoutT;
    float* mod;
    bf16_t* P;
    bf16_t *H, *Yraw, *OutB, *Omd, *Aa;
    unsigned* ctr;
};

constexpr int SMEM_FLOATS = 21504;
__device__ __forceinline__ float bf2f(bf16_t v) { return __uint_as_float(((unsigned)v) << 16); }
__device__ __forceinline__ bf16_t f2bf(float f) { unsigned u = __float_as_uint(f); u += 0x7FFFu + ((u >> 16) & 1u); return (bf16_t)(u >> 16); }
__device__ __forceinline__ unsigned pk2(float lo, float hi) { return (unsigned)f2bf(lo) | ((unsigned)f2bf(hi) << 16); }
__device__ __forceinline__ float sigm(float x) { return 1.f / (1.f + __expf(-x)); }
__device__ __forceinline__ float silu(float x) { return x / (1.f + __expf(-x)); }
__device__ __forceinline__ float wave_sum(float v) {
#pragma unroll
    for (int o = 32; o; o >>= 1) v += __shfl_xor(v, o);
    return v;
}
template <int CTRL> __device__ __forceinline__ float dpp_mov(float v) {
    return __builtin_bit_cast(float, __builtin_amdgcn_update_dpp(0, __builtin_bit_cast(int, v), CTRL, 0xF, 0xF, true));
}
__device__ __forceinline__ float row16_sum(float v) {
    v += dpp_mov<0xB1>(v);
    v += dpp_mov<0x4E>(v);
    v += dpp_mov<0x141>(v);
    v += dpp_mov<0x140>(v);
    return v;
}
__device__ __forceinline__ void tok_info(int m, int& s, int& t) {
    if (m < M_P) { s = m >> 11; t = m & 2047; } else { int q = m - M_P; s = 8 + (q >> 3); t = q & 7; }
}
__device__ __forceinline__ const float* xrow(const Params& p, int m) {
    return m < M_P ? p.x_p + (size_t)m * DM : p.x_s + (size_t)(m - M_P) * DM;
}

__device__ void transpose_tile(const float* __restrict__ src, int Nsrc, bf16_t* __restrict__ dst, int K, int n0, int k0, float* tile) {
    const int tid = threadIdx.x;
    {
        const int nn = tid & 63, kk0 = tid >> 6;
        const int n = n0 + nn;
#pragma unroll
        for (int i = 0; i < 8; ++i) {
            const int kk = kk0 + 8 * i;
            tile[kk * 65 + nn] = (n < Nsrc) ? src[(size_t)(k0 + kk) * Nsrc + n] : 0.f;
        }
    }
    __syncthreads();
    {
        const int kk = tid & 63, nn0 = tid >> 6;
#pragma unroll
        for (int i = 0; i < 8; ++i) {
            const int nn = nn0 + 8 * i;
            dst[(size_t)(n0 + nn) * K + k0 + kk] = f2bf(tile[kk * 65 + nn]);
        }
    }
    __syncthreads();
}

__device__ void phaseA(const Params& p, float* sm, int bid, int nb) {
    const int tid = threadIdx.x;
    constexpr int T_IN = 108 * 16, T_UP = 16 * 8, T_OUT = 16 * 16;
    constexpr int T_ALL = T_IN + 2 * T_UP + T_OUT;
    constexpr int N_ADA = 48 * 17;
    if (bid == 0 && tid == 0) *p.ctr = 0u;
    for (int it = bid; it < T_ALL + N_ADA; it += nb) {
        if (it < T_IN) {
            transpose_tile(p.w_in, N_IN, p.WinT, 1024, (it / 16) * 64, (it % 16) * 64, sm);
        } else if (it < T_IN + T_UP) {
            const int i = it - T_IN;
            transpose_tile(p.w_up_a, 1024, p.WupaT, 512, (i / 8) * 64, (i % 8) * 64, sm);
        } else if (it < T_IN + 2 * T_UP) {
            const int i = it - T_IN - T_UP;
            transpose_tile(p.w_up_b, 1024, p.WupbT, 512, (i / 8) * 64, (i % 8) * 64, sm);
        } else if (it < T_ALL) {
            const int i = it - T_IN - 2 * T_UP;
            transpose_tile(p.w_out, 1024, p.WoutT, 1024, (i / 16) * 64, (i % 16) * 64, sm);
        } else {
            const int i = it - T_ALL;
            const int ct = i % 48, rgp = i / 48;
            float* sc = sm;
            float* red = sm + 8192;
            for (int idx = tid; idx < 8 * 1024; idx += NTHR) {
                const int sl = idx >> 10, k = idx & 1023, s = rgp * 8 + sl;
                const float c = s < 8 ? p.c_p[s * 1024 + k] : p.c_s[(s - 8) * 1024 + k];
                sc[idx] = silu(c);
            }
            __syncthreads();
            const int col = tid & 63, kq = tid >> 6;
            float acc[8];
#pragma unroll
            for (int s = 0; s < 8; ++s) acc[s] = 0.f;
            const float* wp = p.w_ada + (size_t)(kq * 128) * 3072 + ct * 64 + col;
            for (int k = 0; k < 128; ++k) {
                const float w = wp[(size_t)k * 3072];
#pragma unroll
                for (int s = 0; s < 8; ++s) acc[s] += sc[s * 1024 + kq * 128 + k] * w;
            }
#pragma unroll
            for (int s = 0; s < 8; ++s) red[(kq * 8 + s) * 64 + col] = acc[s];
            __syncthreads();
            {
                const int s = tid >> 6;
                float v = p.b_ada[ct * 64 + col];
#pragma unroll
                for (int q = 0; q < 8; ++q) v += red[(q * 8 + s) * 64 + col];
                p.mod[(size_t)(rgp * 8 + s) * 3072 + ct * 64 + col] = v;
            }
            __syncthreads();
        }
    }
}

__device__ void phaseB(const Params& p, int bid, int nb) {
    const int wid = threadIdx.x >> 6, lane = threadIdx.x & 63;
    for (int m = bid * 8 + wid; m < M_TOT; m += nb * 8) {
        const float* xr = xrow(p, m);
        int s, t; tok_info(m, s, t);
        const float* md = p.mod + (size_t)s * 3072;
        float4 v[4]; float ss = 0.f;
#pragma unroll
        for (int i = 0; i < 4; ++i) {
            v[i] = *(const float4*)(xr + i * 256 + lane * 4);
            ss += v[i].x * v[i].x + v[i].y * v[i].y + v[i].z * v[i].z + v[i].w * v[i].w;
        }
        ss = wave_sum(ss);
        const float rstd = rsqrtf(ss * (1.f / 1024.f) + 1e-6f);
#pragma unroll
        for (int i = 0; i < 4; ++i) {
            const int c = i * 256 + lane * 4;
            const float4 g = *(const float4*)(p.g_norm + c);
            const float4 sh = *(const float4*)(md + c);
            const float4 sl = *(const float4*)(md + 1024 + c);
            const float h0 = v[i].x * rstd * g.x * (1.f + sl.x) + sh.x;
            const float h1 = v[i].y * rstd * g.y * (1.f + sl.y) + sh.y;
            const float h2 = v[i].z * rstd * g.z * (1.f + sl.z) + sh.z;
            const float h3 = v[i].w * rstd * g.w * (1.f + sl.w) + sh.w;
            uint2 o; o.x = pk2(h0, h1); o.y = pk2(h2, h3);
            *(uint2*)(p.H + (size_t)m * 1024 + c) = o;
        }
    }
}

constexpr int LROW = 72;
constexpr int TBUF = 128 * LROW;
__device__ __forceinline__ void gemm_main(const bf16_t* __restrict__ A, int lda, const bf16_t* __restrict__ B, int ldb, int K,
                                          f32x4 (&acc)[2][4], bf16_t* smem) {
    const int tid = threadIdx.x, wid = tid >> 6, lane = tid & 63, wr = wid >> 1, wc = wid & 1, fr = lane & 15, fq = lane >> 4;
    bf16_t* sA = smem; bf16_t* sB = smem + 2 * TBUF;
    const int lr0 = tid >> 3, kc = tid & 7;
    const bf16_t* ga0 = A + (size_t)lr0 * lda + kc * 8; const bf16_t* ga1 = ga0 + (size_t)64 * lda;
    const bf16_t* gb0 = B + (size_t)lr0 * ldb + kc * 8; const bf16_t* gb1 = gb0 + (size_t)64 * ldb;
    const int so0 = lr0 * LROW + kc * 8, so1 = so0 + 64 * LROW;
    uint4 ra0 = *(const uint4*)ga0, ra1 = *(const uint4*)ga1, rb0 = *(const uint4*)gb0, rb1 = *(const uint4*)gb1;
    *(uint4*)(sA + so0) = ra0; *(uint4*)(sA + so1) = ra1; *(uint4*)(sB + so0) = rb0; *(uint4*)(sB + so1) = rb1;
    __syncthreads();
    const int nt = K >> 6;
    for (int t = 0; t < nt; ++t) {
        const int cur = t & 1;
        if (t + 1 < nt) {
            const int ko = (t + 1) * 64;
            ra0 = *(const uint4*)(ga0 + ko); ra1 = *(const uint4*)(ga1 + ko);
            rb0 = *(const uint4*)(gb0 + ko); rb1 = *(const uint4*)(gb1 + ko);
        }
        const bf16_t* cA = sA + cur * TBUF + (wr * 32 + fr) * LROW + fq * 8;
        const bf16_t* cB = sB + cur * TBUF + (wc * 64 + fr) * LROW + fq * 8;
#pragma unroll
        for (int ks = 0; ks < 2; ++ks) {
            bf16x8 a[2], b[4];
#pragma unroll
            for (int m = 0; m < 2; ++m) a[m] = *(const bf16x8*)(cA + m * 16 * LROW + ks * 32);
#pragma unroll
            for (int n = 0; n < 4; ++n) b[n] = *(const bf16x8*)(cB + n * 16 * LROW + ks * 32);
#pragma unroll
            for (int m = 0; m < 2; ++m)
#pragma unroll
                for (int n = 0; n < 4; ++n) acc[m][n] = __builtin_amdgcn_mfma_f32_16x16x32_bf16(b[n], a[m], acc[m][n], 0, 0, 0);
        }
        if (t + 1 < nt) {
            const int nx = (cur ^ 1) * TBUF;
            *(uint4*)(sA + nx + so0) = ra0; *(uint4*)(sA + nx + so1) = ra1;
            *(uint4*)(sB + nx + so0) = rb0; *(uint4*)(sB + nx + so1) = rb1;
        }
        __syncthreads();
    }
}
__device__ __forceinline__ void acc_zero(f32x4 (&acc)[2][4]) {
#pragma unroll
    for (int m = 0; m < 2; ++m)
#pragma unroll
        for (int n = 0; n < 4; ++n) acc[m][n] = (f32x4){0.f, 0.f, 0.f, 0.f};
}

__device__ void phaseC(const Params& p, float* sm, int bid, int nb) {
    const int tid = threadIdx.x, wid = tid >> 6, lane = tid & 63, wr = wid >> 1, wc = wid & 1, fr = lane & 15, fq = lane >> 4;
    constexpr int NMT = 136, NNT = 54, GRP = 8 * NNT;
    for (int it = bid; it < NMT * NNT; it += nb) {
        const int g = it / GRP, i = it % GRP;
        const int mt = g * 8 + (i & 7), nt = i >> 3;
        f32x4 acc[2][4]; acc_zero(acc);
        gemm_main(p.H + (size_t)mt * 128 * 1024, 1024, p.WinT + (size_t)nt * 128 * 1024, 1024, 1024, acc, (bf16_t*)sm);
#pragma unroll
        for (int m = 0; m < 2; ++m) {
            const int row = mt * 128 + wr * 32 + m * 16 + fr;
#pragma unroll
            for (int n = 0; n < 4; ++n) {
                const int col = nt * 128 + wc * 64 + n * 16 + fq * 4;
                uint2 o; o.x = pk2(acc[m][n][0], acc[m][n][1]); o.y = pk2(acc[m][n][2], acc[m][n][3]);
                *(uint2*)(p.P + (size_t)row * NP + col) = o;
            }
        }
    }
}

__device__ void phaseD(const Params& p, float* sm, int bid, int nb) {
    const int tid = threadIdx.x;
    float* tw = sm;
    float* al = sm + 1024;
    for (int it = bid; it < M_TOT / 16; it += nb) {
        const int m0 = it * 16;
        for (int idx = tid; idx < 16 * 128; idx += NTHR) {
            const int tok = idx >> 7, j = idx & 127, col = C_WL + j, m = m0 + tok;
            int s, t; tok_info(m, s, t);
            const float cur = bf2f(p.P[(size_t)m * NP + col]);
            const float prev = t > 0 ? bf2f(p.P[(size_t)(m - 1) * NP + col]) : (s >= 8 ? p.st_shift[(size_t)(s - 8) * SHIFT_W + col] : 0.f);
            const float v = cur + p.mu_shift[col] * (prev - cur);
            if (j < 64) tw[tok * 64 + j] = tanhf(v); else al[tok * 64 + j - 64] = v;
        }
        __syncthreads();
        const int c = tid;
        float accw[16], acca[16];
#pragma unroll
        for (int i = 0; i < 16; ++i) { accw[i] = 0.f; acca[i] = 0.f; }
        for (int j4 = 0; j4 < 16; ++j4) {
            float wd[4], wi[4];
#pragma unroll
            for (int q = 0; q < 4; ++q) { wd[q] = p.w_decay2[(j4 * 4 + q) * 512 + c]; wi[q] = p.w_iclr2[(j4 * 4 + q) * 512 + c]; }
#pragma unroll
            for (int tok = 0; tok < 16; ++tok) {
                const float4 t4 = *(const float4*)(tw + tok * 64 + j4 * 4);
                const float4 a4 = *(const float4*)(al + tok * 64 + j4 * 4);
                accw[tok] += t4.x * wd[0] + t4.y * wd[1] + t4.z * wd[2] + t4.w * wd[3];
                acca[tok] += a4.x * wi[0] + a4.y * wi[1] + a4.z * wi[2] + a4.w * wi[3];
            }
        }
        const float w0c = p.w0[c], a0c = p.a0[c];
#pragma unroll
        for (int tok = 0; tok < 16; ++tok) {
            const int m = m0 + tok;
            const float sg = sigm(w0c + accw[tok]);
            const float omd = 1.f - __expf(-0.6065306597126334f * sg);
            const float av = sigm(a0c + acca[tok]);
            p.Omd[(size_t)m * 512 + c] = f2bf(omd);
            p.Aa[(size_t)m * 512 + c] = f2bf(av);
        }
        for (int tok = 0; tok < 16; ++tok) {
            const int m = m0 + tok;
            int s, t; tok_info(m, s, t);
            const int T = s < 8 ? 2048 : 8;
            if (t != T - 1) continue;
            float* osh = s < 8 ? p.out + O_PSHIFT + (size_t)s * SHIFT_W : p.out + O_SSHIFT + (size_t)(s - 8) * SHIFT_W;
            float* ocv = s < 8 ? p.out + O_PCONV + (size_t)s * 3072 : p.out + O_SCONV + (size_t)(s - 8) * 3072;
            for (int col = tid; col < SHIFT_W; col += NTHR) osh[col] = bf2f(p.P[(size_t)m * NP + col]);
            for (int idx = tid; idx < 3072; idx += NTHR) {
                const int r = idx >> 10, cc = idx & 1023;
                ocv[idx] = bf2f(p.P[(size_t)(m - 2 + r) * NP + C_QK + cc]);
            }
        }
        __syncthreads();
    }
}

__device__ __forceinline__ float rdlane(float v, int l) { return __builtin_bit_cast(float, __builtin_amdgcn_readlane(__builtin_bit_cast(int, v), l)); }
__device__ __forceinline__ float wave_sum_fast(float v) {
    v = row16_sum(v);
    return (rdlane(v, 0) + rdlane(v, 16)) + (rdlane(v, 32) + rdlane(v, 48));
}
__device__ __forceinline__ float4 unpk4(uint2 u) {
    float4 f; f.x = __uint_as_float(u.x << 16); f.y = __uint_as_float(u.x & 0xFFFF0000u);
    f.z = __uint_as_float(u.y << 16); f.w = __uint_as_float(u.y & 0xFFFF0000u); return f;
}
__device__ void rwkv_item(const Params& p, int s, int h, int half, float* sm) {
    float* s_kk = sm;
    float* s_d = sm + 2048;
    float* s_ka = sm + 4096;
    float* s_kp = sm + 6144;
    float* s_dr = sm + 8192;
    float* s_v = sm + 10240;
    float* s_c = sm + 12288;
    float* s_y = sm + 12352;
    const int tid = threadIdx.x, wid = tid >> 6, lane = tid & 63;
    const int T = s < 8 ? 2048 : 8;
    const int mbase = s < 8 ? s * 2048 : M_P + (s - 8) * 8;
    const int lrow = wid * 4 + (lane >> 4);
    const int irow = half * 32 + lrow;
    const int c4 = (lane & 15) * 4;
    const int hc = h * 64 + c4;
    float S0 = 0.f, S1 = 0.f, S2 = 0.f, S3 = 0.f;
    if (s >= 8) {
        const float4 v = *(const float4*)(p.st_S + ((size_t)((s - 8) * 8 + h) * 64 + irow) * 64 + c4);
        S0 = v.x; S1 = v.y; S2 = v.z; S3 = v.w;
    }
    const float4 mu_r = *(const float4*)(p.mu_shift + C_R + hc), mu_k = *(const float4*)(p.mu_shift + C_K + hc), mu_v = *(const float4*)(p.mu_shift + C_V + hc);
    const float4 kkw = *(const float4*)(p.k_k + hc), kaw = *(const float4*)(p.k_a + hc);
    uint2 qr, qk, qv, qrp, qkp, qvp, qa, qo;
    qr = qk = qv = qrp = qkp = qvp = qa = qo = make_uint2(0u, 0u);
    auto prefetch = [&](int t0) {
        const int t = t0 + lrow;
        if (t < T) {
            const bf16_t* pr = p.P + (size_t)(mbase + t) * NP + hc;
            qr = *(const uint2*)(pr + C_R); qk = *(const uint2*)(pr + C_K); qv = *(const uint2*)(pr + C_V);
            if (t > 0) { qrp = *(const uint2*)(pr + C_R - NP); qkp = *(const uint2*)(pr + C_K - NP); qvp = *(const uint2*)(pr + C_V - NP); }
            qa = *(const uint2*)(p.Aa + (size_t)(mbase + t) * 512 + hc);
            qo = *(const uint2*)(p.Omd + (size_t)(mbase + t) * 512 + hc);
        }
    };
    prefetch(0);
    for (int t0 = 0; t0 < T; t0 += 32) {
        const int nT = (T - t0) < 32 ? (T - t0) : 32;
        if (lrow < nT) {
            const int t = t0 + lrow;
            float4 r = unpk4(qr), k = unpk4(qk), v = unpk4(qv), rp, kp_, vp;
            if (t > 0) { rp = unpk4(qrp); kp_ = unpk4(qkp); vp = unpk4(qvp); }
            else if (s >= 8) {
                const float* st = p.st_shift + (size_t)(s - 8) * SHIFT_W + hc;
                rp = *(const float4*)(st + C_R); kp_ = *(const float4*)(st + C_K); vp = *(const float4*)(st + C_V);
            } else { rp = make_float4(0.f, 0.f, 0.f, 0.f); kp_ = rp; vp = rp; }
            r.x += mu_r.x * (rp.x - r.x); r.y += mu_r.y * (rp.y - r.y); r.z += mu_r.z * (rp.z - r.z); r.w += mu_r.w * (rp.w - r.w);
            k.x += mu_k.x * (kp_.x - k.x); k.y += mu_k.y * (kp_.y - k.y); k.z += mu_k.z * (kp_.z - k.z); k.w += mu_k.w * (kp_.w - k.w);
            v.x += mu_v.x * (vp.x - v.x); v.y += mu_v.y * (vp.y - v.y); v.z += mu_v.z * (vp.z - v.z); v.w += mu_v.w * (vp.w - v.w);
            const float4 a = unpk4(qa), om = unpk4(qo);
            float4 kk; kk.x = k.x * kkw.x; kk.y = k.y * kkw.y; kk.z = k.z * kkw.z; kk.w = k.w * kkw.w;
            const float nrm = sqrtf(row16_sum(kk.x * kk.x + kk.y * kk.y + kk.z * kk.z + kk.w * kk.w));
            const float inv = 1.f / fmaxf(nrm, 1e-12f);
            kk.x *= inv; kk.y *= inv; kk.z *= inv; kk.w *= inv;
            float4 ka; ka.x = kk.x * a.x; ka.y = kk.y * a.y; ka.z = kk.z * a.z; ka.w = kk.w * a.w;
            float4 kp; kp.x = k.x * (1.f + (a.x - 1.f) * kaw.x); kp.y = k.y * (1.f + (a.y - 1.f) * kaw.y);
            kp.z = k.z * (1.f + (a.z - 1.f) * kaw.z); kp.w = k.w * (1.f + (a.w - 1.f) * kaw.w);
            float4 d; d.x = 1.f - om.x; d.y = 1.f - om.y; d.z = 1.f - om.z; d.w = 1.f - om.w;
            float4 dr; dr.x = d.x * r.x; dr.y = d.y * r.y; dr.z = d.z * r.z; dr.w = d.w * r.w;
            const float c1 = row16_sum(ka.x * r.x + ka.y * r.y + ka.z * r.z + ka.w * r.w);
            const float c2 = row16_sum(kp.x * r.x + kp.y * r.y + kp.z * r.z + kp.w * r.w);
            const int o = lrow * 64 + c4;
            *(float4*)(s_kk + o) = kk; *(float4*)(s_d + o) = d; *(float4*)(s_ka + o) = ka;
            *(float4*)(s_kp + o) = kp; *(float4*)(s_dr + o) = dr; *(float4*)(s_v + o) = v;
            if ((lane & 15) == 0) { s_c[lrow * 2] = c1; s_c[lrow * 2 + 1] = c2; }
        }
        __syncthreads();
        if (t0 + 32 < T) prefetch(t0 + 32);
        for (int tt = 0; tt < nT; ++tt) {
            const float4 kk4 = *(const float4*)(s_kk + tt * 64 + c4);
            const float4 dr4 = *(const float4*)(s_dr + tt * 64 + c4);
            const float4 d4 = *(const float4*)(s_d + tt * 64 + c4);
            const float4 ka4 = *(const float4*)(s_ka + tt * 64 + c4);
            const float4 kp4 = *(const float4*)(s_kp + tt * 64 + c4);
            const float vi = s_v[tt * 64 + irow];
            const float2 cc = *(const float2*)(s_c + tt * 2);
            float p1 = S0 * kk4.x + S1 * kk4.y + S2 * kk4.z + S3 * kk4.w;
            float p2 = S0 * dr4.x + S1 * dr4.y + S2 * dr4.z + S3 * dr4.w;
            p1 = row16_sum(p1); p2 = row16_sum(p2);
            const float y = p2 - p1 * cc.x + vi * cc.y;
            S0 = S0 * d4.x + vi * kp4.x - p1 * ka4.x;
            S1 = S1 * d4.y + vi * kp4.y - p1 * ka4.y;
            S2 = S2 * d4.z + vi * kp4.z - p1 * ka4.z;
            S3 = S3 * d4.w + vi * kp4.w - p1 * ka4.w;
            if ((lane & 15) == 0) s_y[tt * 32 + lrow] = y;
        }
        __syncthreads();
        for (int idx = tid; idx < nT * 32; idx += NTHR) {
            const int tt = idx >> 5, i = idx & 31;
            p.Yraw[(size_t)(mbase + t0 + tt) * 512 + h * 64 + half * 32 + i] = f2bf(s_y[idx]);
        }
    }
    {
        float* o = (s < 8 ? p.out + O_PS + (size_t)s * 8 * 4096 : p.out + O_SS + (size_t)(s - 8) * 8 * 4096) + ((size_t)(h * 64 + irow)) * 64 + c4;
        float4 v; v.x = S0; v.y = S1; v.z = S2; v.w = S3;
        *(float4*)o = v;
    }
    __syncthreads();
}

__device__ void mlstm_item(const Params& p, int s, int h, float* sm) {
    float* sq = sm;
    float* sk = sm + 4160;
    float* sv = sm + 8320;
    float* sc = sm + 12480;
    float* sC = sm + 16640;
    float* sn = sm + 20800;
    float* sb = sn + 64;
    float* si = sn + 128;
    float* smt = sn + 192;
    float* swin = sn + 256;
    float* sden = sn + 320;
    float* sws = sn + 384;
    float* slf = sn + 448;
    float* smisc = sn + 512;
    const int tid = threadIdx.x, wid = tid >> 6, lane = tid & 63;
    const int T = s < 8 ? 2048 : 8, L = s < 8 ? 64 : 8, NC = T / L;
    const int mbase = s < 8 ? s * 2048 : M_P + (s - 8) * 8;
    for (int idx = tid; idx < 4096; idx += NTHR) {
        const int i = idx >> 6, j = idx & 63;
        sC[i * 65 + j] = s >= 8 ? p.st_C[(size_t)((s - 8) * 8 + h) * 4096 + idx] : 0.f;
    }
    if (tid < 64) sn[tid] = s >= 8 ? p.st_n[(size_t)((s - 8) * 8 + h) * 64 + tid] : 0.f;
    if (tid == 0) smisc[0] = s >= 8 ? p.st_m[(s - 8) * 8 + h] : 0.f;
    const float cwq[4] = {p.conv_w[0 * 1024 + h * 64 + lane], p.conv_w[1 * 1024 + h * 64 + lane], p.conv_w[2 * 1024 + h * 64 + lane], p.conv_w[3 * 1024 + h * 64 + lane]};
    const float cwk[4] = {p.conv_w[0 * 1024 + 512 + h * 64 + lane], p.conv_w[1 * 1024 + 512 + h * 64 + lane], p.conv_w[2 * 1024 + 512 + h * 64 + lane], p.conv_w[3 * 1024 + 512 + h * 64 + lane]};
    const float cbq = p.conv_b[h * 64 + lane], cbk = p.conv_b[512 + h * 64 + lane];
    const float gnw = p.gn_w[h * 64 + lane];
    const float bi = p.b_i[h], bfv = p.b_f[h];
    __syncthreads();
    for (int c = 0; c < NC; ++c) {
        const int t0 = c * L;
        for (int tt = wid; tt < L; tt += 8) {
            const int t = t0 + tt, m = mbase + t;
            float aq = cbq, ak = cbk;
#pragma unroll
            for (int j = 0; j < 4; ++j) {
                const int tau = t - 3 + j;
                float xq, xk;
                if (tau >= 0) {
                    const bf16_t* pr = p.P + (size_t)(mbase + tau) * NP + C_QK + h * 64 + lane;
                    xq = bf2f(pr[0]); xk = bf2f(pr[512]);
                } else if (s >= 8) {
                    const float* st = p.st_conv + ((size_t)(s - 8) * 3 + (3 + tau)) * 1024 + h * 64 + lane;
                    xq = st[0]; xk = st[512];
                } else { xq = 0.f; xk = 0.f; }
                aq += xq * cwq[j]; ak += xk * cwk[j];
            }
            sq[tt * 65 + lane] = silu(aq);
            sk[tt * 65 + lane] = silu(ak) * 0.125f;
            sv[tt * 65 + lane] = bf2f(p.P[(size_t)m * NP + C_VB + h * 64 + lane]);
        }
        if (tid < L) {
            const int m = mbase + t0 + tid;
            si[tid] = bf2f(p.P[(size_t)m * NP + C_IB + h]) + bi;
            const float f = bf2f(p.P[(size_t)m * NP + C_FB + h]) + bfv;
            slf[tid] = f > 0.f ? -log1pf(__expf(-f)) : f - log1pf(__expf(f));
        }
        __syncthreads();
        if (tid == 0) {
            const float mprev = smisc[0];
            float b = 0.f, run = mprev;
            for (int t = 0; t < L; ++t) {
                b += slf[t];
                run = fmaxf(run, si[t] - b);
                sb[t] = b; smt[t] = b + run; swin[t] = __expf(b + mprev - (b + run));
            }
            const float mnew = b + run;
            smisc[1] = mnew; smisc[2] = __expf(b + mprev - mnew);
            for (int t = 0; t < L; ++t) sws[t] = __expf(b - sb[t] + si[t] - mnew);
        }
        __syncthreads();
        for (int idx = tid; idx < L * L; idx += NTHR) {
            const int t = idx / L, u = idx % L;
            float v = 0.f;
            if (u <= t) {
                float dot = 0.f;
#pragma unroll 8
                for (int d = 0; d < 64; ++d) dot += sq[t * 65 + d] * sk[u * 65 + d];
                v = dot * __expf(sb[t] - sb[u] + si[u] - smt[t]);
            }
            sc[t * 65 + u] = v;
        }
        __syncthreads();
        if (tid < L) {
            float rs = 0.f, qn = 0.f;
            for (int u = 0; u < L; ++u) rs += sc[tid * 65 + u];
            for (int j = 0; j < 64; ++j) qn += sn[j] * sq[tid * 65 + j];
            const float den = rs + swin[tid] * qn;
            sden[tid] = fmaxf(fabsf(den), __expf(-smt[tid]));
        }
        __syncthreads();
        for (int tt = wid; tt < L; tt += 8) {
            float num = 0.f, inter = 0.f;
            for (int u = 0; u <= tt; ++u) num += sc[tt * 65 + u] * sv[u * 65 + lane];
#pragma unroll 8
            for (int j = 0; j < 64; ++j) inter += sC[lane * 65 + j] * sq[tt * 65 + j];
            const float hv = (num + swin[tt] * inter) / sden[tt];
            const float ms = wave_sum(hv * hv) * (1.f / 64.f);
            const float hn = hv * rsqrtf(ms + 1e-6f) * gnw;
            const int m = mbase + t0 + tt;
            const float ob = bf2f(p.P[(size_t)m * NP + C_OB + h * 64 + lane]);
            const float zb = bf2f(p.P[(size_t)m * NP + C_ZB + h * 64 + lane]);
            p.OutB[(size_t)m * 512 + h * 64 + lane] = f2bf(sigm(ob) * hn * silu(zb));
        }
        __syncthreads();
        {
            const float dec = smisc[2];
            const int j = lane;
#pragma unroll
            for (int ii = 0; ii < 8; ++ii) {
                const int i = wid + 8 * ii;
                float a = dec * sC[i * 65 + j];
                for (int u = 0; u < L; ++u) a += sws[u] * sv[u * 65 + i] * sk[u * 65 + j];
                sC[i * 65 + j] = a;
            }
            if (tid < 64) {
                float a = dec * sn[tid];
                for (int u = 0; u < L; ++u) a += sws[u] * sk[u * 65 + tid];
                sn[tid] = a;
            }
            if (tid == 0) smisc[0] = smisc[1];
        }
        __syncthreads();
    }
    {
        float* oC = s < 8 ? p.out + O_PC + (size_t)(s * 8 + h) * 4096 : p.out + O_SC + (size_t)((s - 8) * 8 + h) * 4096;
        float* on = s < 8 ? p.out + O_PN + (size_t)(s * 8 + h) * 64 : p.out + O_SN + (size_t)((s - 8) * 8 + h) * 64;
        float* om = s < 8 ? p.out + O_PM + (s * 8 + h) : p.out + O_SM + ((s - 8) * 8 + h);
        for (int idx = tid; idx < 4096; idx += NTHR) oC[idx] = sC[(idx >> 6) * 65 + (idx & 63)];
        if (tid < 64) on[tid] = sn[tid];
        if (tid == 0) om[0] = smisc[0];
    }
    __syncthreads();
}

__device__ __forceinline__ bf16x8 ldfrag(const bf16_t* base, int row, int ks, int fq) { return *(const bf16x8*)(base + row * 72 + ks * 32 + fq * 8); }
__device__ __forceinline__ float sum8(float v) { v += dpp_mov<0xB1>(v); v += dpp_mov<0x4E>(v); v += dpp_mov<0x141>(v); return v; }
__device__ void mlstm_prompt(const Params& p, int s, int h, float* sm) {
    bf16_t* Qs = (bf16_t*)sm; bf16_t* Ks = Qs + 4608; bf16_t* VT = Ks + 4608; bf16_t* KwT = VT + 4608; bf16_t* Ps = KwT + 4608; bf16_t* Cb = Ps + 4608;
    float* hs = sm + 13824;
    float* sn = hs + 64 * 68;
    float* sg = sn + 64; float* srun = sn + 128; float* swin = sn + 192; float* sws = sn + 256; float* sden = sn + 320; float* sb = sn + 384;
    float* smisc = sn + 448;
    const int tid = threadIdx.x, wid = tid >> 6, lane = tid & 63, fr = lane & 15, fq = lane >> 4;
    const int tr = wid >> 1, tc0 = (wid & 1) * 2;
    const int mbase = s * 2048;
    f32x4 accC[2];
    accC[0] = (f32x4){0.f, 0.f, 0.f, 0.f}; accC[1] = accC[0];
    if (tid < 64) sn[tid] = 0.f;
    if (tid == 0) smisc[0] = 0.f;
    const int qc = h * 64 + lane;
    const float cwq0 = p.conv_w[qc], cwq1 = p.conv_w[1024 + qc], cwq2 = p.conv_w[2048 + qc], cwq3 = p.conv_w[3072 + qc];
    const float cwk0 = p.conv_w[512 + qc], cwk1 = p.conv_w[1536 + qc], cwk2 = p.conv_w[2560 + qc], cwk3 = p.conv_w[3584 + qc];
    const float cbq = p.conv_b[qc], cbk = p.conv_b[512 + qc];
    const float gnw = p.gn_w[qc];
    const float bi = p.b_i[h], bfv = p.b_f[h];
    __syncthreads();
    for (int c = 0; c < 32; ++c) {
        const int t0 = c * 64, mb = mbase + t0;
        if (wid == 0) {
            const bf16_t* pr = p.P + (size_t)(mb + lane) * NP;
            const float it = bf2f(pr[C_IB + h]) + bi;
            const float f = bf2f(pr[C_FB + h]) + bfv;
            float b = f > 0.f ? -log1pf(__expf(-f)) : f - log1pf(__expf(f));
#pragma unroll
            for (int o = 1; o < 64; o <<= 1) { const float v = __shfl_up(b, o); if (lane >= o) b += v; }
            const float g = it - b;
            float run = g;
#pragma unroll
            for (int o = 1; o < 64; o <<= 1) { const float v = __shfl_up(run, o); if (lane >= o) run = fmaxf(run, v); }
            const float mprev = smisc[0];
            run = fmaxf(run, mprev);
            const float runL = __shfl(run, 63), bL = __shfl(b, 63);
            sg[lane] = g; srun[lane] = run; sb[lane] = b; swin[lane] = __expf(mprev - run); sws[lane] = __expf(g - runL);
            if (lane == 0) { smisc[1] = bL + runL; smisc[2] = __expf(mprev - runL); }
        }
        __syncthreads();
        const float dec = smisc[2];
        float obv[8], zbv[8];
#pragma unroll
        for (int k8 = 0; k8 < 8; ++k8) {
            const int tt = wid + 8 * k8;
            const bf16_t* pr = p.P + (size_t)(mb + tt) * NP;
            obv[k8] = bf2f(pr[C_OB + qc]); zbv[k8] = bf2f(pr[C_ZB + qc]);
        }
#pragma unroll
        for (int k8 = 0; k8 < 8; ++k8) {
            const int tt = wid + 8 * k8, t = t0 + tt;
            const bf16_t* pr = p.P + (size_t)(mb + tt) * NP + C_QK + qc;
            float x3q = bf2f(pr[0]), x3k = bf2f(pr[512]);
            float x2q = 0.f, x2k = 0.f, x1q = 0.f, x1k = 0.f, x0q = 0.f, x0k = 0.f;
            if (t >= 1) { x2q = bf2f(pr[-NP]); x2k = bf2f(pr[512 - NP]); }
            if (t >= 2) { x1q = bf2f(pr[-2 * NP]); x1k = bf2f(pr[512 - 2 * NP]); }
            if (t >= 3) { x0q = bf2f(pr[-3 * NP]); x0k = bf2f(pr[512 - 3 * NP]); }
            const float q = silu(cbq + x0q * cwq0 + x1q * cwq1 + x2q * cwq2 + x3q * cwq3);
            const float k = silu(cbk + x0k * cwk0 + x1k * cwk1 + x2k * cwk2 + x3k * cwk3) * 0.125f;
            const float v = bf2f(p.P[(size_t)(mb + tt) * NP + C_VB + qc]);
            Qs[tt * 72 + lane] = f2bf(q);
            Ks[tt * 72 + lane] = f2bf(k);
            KwT[lane * 72 + tt] = f2bf(k * sws[tt]);
            VT[lane * 72 + tt] = f2bf(v);
        }
#pragma unroll
        for (int n = 0; n < 2; ++n) {
            uint2 o; o.x = pk2(accC[n][0], accC[n][1]); o.y = pk2(accC[n][2], accC[n][3]);
            *(uint2*)(Cb + (tr * 16 + fr) * 72 + (tc0 + n) * 16 + fq * 4) = o;
        }
        __syncthreads();
#pragma unroll
        for (int n = 0; n < 2; ++n) {
            const int ut = tc0 + n;
            f32x4 a = (f32x4){0.f, 0.f, 0.f, 0.f};
            if (ut <= tr) {
#pragma unroll
                for (int ks = 0; ks < 2; ++ks) a = __builtin_amdgcn_mfma_f32_16x16x32_bf16(ldfrag(Ks, ut * 16 + fr, ks, fq), ldfrag(Qs, tr * 16 + fr, ks, fq), a, 0, 0, 0);
            }
            const int t = tr * 16 + fr;
            const float rn = srun[t];
            float w[4];
#pragma unroll
            for (int r = 0; r < 4; ++r) {
                const int u = ut * 16 + fq * 4 + r;
                w[r] = (u <= t) ? a[r] * __expf(sg[u] - rn) : 0.f;
            }
            uint2 o; o.x = pk2(w[0], w[1]); o.y = pk2(w[2], w[3]);
            *(uint2*)(Ps + t * 72 + ut * 16 + fq * 4) = o;
        }
        __syncthreads();
        {
            const int t = tid >> 3, seg = tid & 7;
            const uint4 pv = *(const uint4*)(Ps + t * 72 + seg * 8);
            const uint4 qv = *(const uint4*)(Qs + t * 72 + seg * 8);
            const float4 pa = unpk4(make_uint2(pv.x, pv.y)), pb = unpk4(make_uint2(pv.z, pv.w));
            const float4 qa = unpk4(make_uint2(qv.x, qv.y)), qb = unpk4(make_uint2(qv.z, qv.w));
            const float4 na = *(const float4*)(sn + seg * 8), nb4 = *(const float4*)(sn + seg * 8 + 4);
            float rs = (pa.x + pa.y) + (pa.z + pa.w) + (pb.x + pb.y) + (pb.z + pb.w);
            float qn = qa.x * na.x + qa.y * na.y + qa.z * na.z + qa.w * na.w + qb.x * nb4.x + qb.y * nb4.y + qb.z * nb4.z + qb.w * nb4.w;
            rs = sum8(rs); qn = sum8(qn);
            if (seg == 0) sden[t] = fmaxf(fabsf(rs + swin[t] * qn), __expf(-(sb[t] + srun[t])));
        }
        f32x4 num[2], itr[2];
#pragma unroll
        for (int n = 0; n < 2; ++n) {
            const int it = tc0 + n;
            num[n] = (f32x4){0.f, 0.f, 0.f, 0.f}; itr[n] = num[n];
#pragma unroll
            for (int ks = 0; ks < 2; ++ks) {
                num[n] = __builtin_amdgcn_mfma_f32_16x16x32_bf16(ldfrag(VT, it * 16 + fr, ks, fq), ldfrag(Ps, tr * 16 + fr, ks, fq), num[n], 0, 0, 0);
                itr[n] = __builtin_amdgcn_mfma_f32_16x16x32_bf16(ldfrag(Cb, it * 16 + fr, ks, fq), ldfrag(Qs, tr * 16 + fr, ks, fq), itr[n], 0, 0, 0);
            }
        }
        __syncthreads();
        {
            const int t = tr * 16 + fr;
            const float rd = 1.f / sden[t], wn = swin[t];
#pragma unroll
            for (int n = 0; n < 2; ++n) {
                float4 o;
                o.x = (num[n][0] + wn * itr[n][0]) * rd; o.y = (num[n][1] + wn * itr[n][1]) * rd;
                o.z = (num[n][2] + wn * itr[n][2]) * rd; o.w = (num[n][3] + wn * itr[n][3]) * rd;
                *(float4*)(hs + t * 68 + (tc0 + n) * 16 + fq * 4) = o;
            }
        }
#pragma unroll
        for (int n = 0; n < 2; ++n) {
            accC[n][0] *= dec; accC[n][1] *= dec; accC[n][2] *= dec; accC[n][3] *= dec;
#pragma unroll
            for (int ks = 0; ks < 2; ++ks)
                accC[n] = __builtin_amdgcn_mfma_f32_16x16x32_bf16(ldfrag(KwT, (tc0 + n) * 16 + fr, ks, fq), ldfrag(VT, tr * 16 + fr, ks, fq), accC[n], 0, 0, 0);
        }
        {
            const int j = tid >> 3, seg = tid & 7;
            const uint4 kv = *(const uint4*)(KwT + j * 72 + seg * 8);
            const float4 ka = unpk4(make_uint2(kv.x, kv.y)), kb = unpk4(make_uint2(kv.z, kv.w));
            float sum = (ka.x + ka.y) + (ka.z + ka.w) + (kb.x + kb.y) + (kb.z + kb.w);
            sum = sum8(sum);
            if (seg == 0) sn[j] = dec * sn[j] + sum;
        }
        if (tid == 0) smisc[0] = smisc[1];
        __syncthreads();
#pragma unroll
        for (int k8 = 0; k8 < 8; ++k8) {
            const int tt = wid + 8 * k8;
            const float hv = hs[tt * 68 + lane];
            const float ms = wave_sum_fast(hv * hv) * (1.f / 64.f);
            const float hn = hv * rsqrtf(ms + 1e-6f) * gnw;
            p.OutB[(size_t)(mb + tt) * 512 + qc] = f2bf(sigm(obv[k8]) * hn * silu(zbv[k8]));
        }
    }
    {
        float* oC = p.out + O_PC + (size_t)(s * 8 + h) * 4096;
#pragma unroll
        for (int n = 0; n < 2; ++n) {
            float4 o; o.x = accC[n][0]; o.y = accC[n][1]; o.z = accC[n][2]; o.w = accC[n][3];
            *(float4*)(oC + (tr * 16 + fr) * 64 + (tc0 + n) * 16 + fq * 4) = o;
        }
        if (tid < 64) p.out[O_PN + (size_t)(s * 8 + h) * 64 + tid] = sn[tid];
        if (tid == 0) p.out[O_PM + s * 8 + h] = smisc[0];
    }
    __syncthreads();
}

__device__ void phaseE(const Params& p, float* sm, int bid, int nb) {
    constexpr int N_RP = 128, N_MP = 64, N_RS = 128 * 8 * 2, N_MS = 128 * 8;
    int* s_item = (int*)(sm + SMEM_FLOATS - 4);
    for (;;) {
        if (threadIdx.x == 0) *s_item = (int)atomicAdd(p.ctr, 1u);
        __syncthreads();
        const int it = *s_item;
        __syncthreads();
        if (it >= N_RP + N_MP + N_RS + N_MS) break;
        if (it < N_RP) { rwkv_item(p, it >> 4, (it >> 1) & 7, it & 1, sm); }
        else if (it < N_RP + N_MP) { const int i = it - N_RP; mlstm_prompt(p, i >> 3, i & 7, sm); }
        else if (it < N_RP + N_MP + N_RS) { const int i = it - N_RP - N_MP; rwkv_item(p, 8 + (i >> 4), (i >> 1) & 7, i & 1, sm); }
        else { const int i = it - N_RP - N_MP - N_RS; mlstm_item(p, 8 + (i >> 3), i & 7, sm); }
    }
}

__device__ void phaseF(const Params& p, int bid, int nb) {
    const int wid = threadIdx.x >> 6, lane = threadIdx.x & 63;
    for (int it = bid * 8 + wid; it < M_TOT * 8; it += nb * 8) {
        const int m = it >> 3, h = it & 7, hj = h * 64 + lane;
        int s, t; tok_info(m, s, t);
        const float y = bf2f(p.Yraw[(size_t)m * 512 + hj]);
        const float mean = wave_sum(y) * (1.f / 64.f);
        const float dy = y - mean;
        const float var = wave_sum(dy * dy) * (1.f / 64.f);
        float yn = dy * rsqrtf(var + 64e-5f) * p.ln_w[hj] + p.ln_b[hj];
        const bf16_t* pr = p.P + (size_t)m * NP;
        float r = bf2f(pr[C_R + hj]), k = bf2f(pr[C_K + hj]), v = bf2f(pr[C_V + hj]);
        float rp, kp_, vp;
        if (t > 0) { rp = bf2f(pr[C_R + hj - NP]); kp_ = bf2f(pr[C_K + hj - NP]); vp = bf2f(pr[C_V + hj - NP]); }
        else if (s >= 8) { const float* st = p.st_shift + (size_t)(s - 8) * SHIFT_W; rp = st[C_R + hj]; kp_ = st[C_K + hj]; vp = st[C_V + hj]; }
        else { rp = 0.f; kp_ = 0.f; vp = 0.f; }
        r += p.mu_shift[C_R + hj] * (rp - r); k += p.mu_shift[C_K + hj] * (kp_ - k); v += p.mu_shift[C_V + hj] * (vp - v);
        const float a = bf2f(p.Aa[(size_t)m * 512 + hj]);
        const float kp = k * (1.f + (a - 1.f) * p.k_a[hj]);
        const float bonus = wave_sum(r * kp * p.r_k[hj]);
        yn += bonus * v;
        const float z = bf2f(pr[C_ZA + hj]);
        p.Yraw[(size_t)m * 512 + hj] = f2bf(yn * silu(z));
    }
}

__device__ void phaseG(const Params& p, float* sm, int bid, int nb) {
    const int tid = threadIdx.x, wid = tid >> 6, lane = tid & 63, wr = wid >> 1, wc = wid & 1, fr = lane & 15, fq = lane >> 4;
    for (int it = bid; it < 136 * 8; it += nb) {
        const int mt = it >> 3, nt = it & 7;
        f32x4 acc[2][4], mg[2][4];
        acc_zero(acc);
        gemm_main(p.Yraw + (size_t)mt * 128 * 512, 512, p.WupaT + (size_t)nt * 128 * 512, 512, 512, acc, (bf16_t*)sm);
#pragma unroll
        for (int m = 0; m < 2; ++m) {
            const int row = mt * 128 + wr * 32 + m * 16 + fr;
#pragma unroll
            for (int n = 0; n < 4; ++n) {
                const int col = nt * 128 + wc * 64 + n * 16 + fq * 4;
                const uint2 g = *(const uint2*)(p.P + (size_t)row * NP + C_GLA + col);
                mg[m][n][0] = sigm(__uint_as_float(g.x << 16)) * acc[m][n][0];
                mg[m][n][1] = sigm(__uint_as_float(g.x & 0xFFFF0000u)) * acc[m][n][1];
                mg[m][n][2] = sigm(__uint_as_float(g.y << 16)) * acc[m][n][2];
                mg[m][n][3] = sigm(__uint_as_float(g.y & 0xFFFF0000u)) * acc[m][n][3];
            }
        }
        acc_zero(acc);
        gemm_main(p.OutB + (size_t)mt * 128 * 512, 512, p.WupbT + (size_t)nt * 128 * 512, 512, 512, acc, (bf16_t*)sm);
#pragma unroll
        for (int m = 0; m < 2; ++m) {
            const int row = mt * 128 + wr * 32 + m * 16 + fr;
#pragma unroll
            for (int n = 0; n < 4; ++n) {
                const int col = nt * 128 + wc * 64 + n * 16 + fq * 4;
                const uint2 g = *(const uint2*)(p.P + (size_t)row * NP + C_GLB + col);
                const float v0 = mg[m][n][0] + sigm(__uint_as_float(g.x << 16)) * acc[m][n][0];
                const float v1 = mg[m][n][1] + sigm(__uint_as_float(g.x & 0xFFFF0000u)) * acc[m][n][1];
                const float v2 = mg[m][n][2] + sigm(__uint_as_float(g.y << 16)) * acc[m][n][2];
                const float v3 = mg[m][n][3] + sigm(__uint_as_float(g.y & 0xFFFF0000u)) * acc[m][n][3];
                uint2 o; o.x = pk2(v0, v1); o.y = pk2(v2, v3);
                *(uint2*)(p.P + (size_t)row * NP + col) = o;
            }
        }
    }
}

__device__ void phaseH(const Params& p, float* sm, int bid, int nb) {
    const int tid = threadIdx.x, wid = tid >> 6, lane = tid & 63, wr = wid >> 1, wc = wid & 1, fr = lane & 15, fq = lane >> 4;
    for (int it = bid; it < 136 * 8; it += nb) {
        const int mt = it >> 3, nt = it & 7;
        f32x4 acc[2][4]; acc_zero(acc);
        gemm_main(p.P + (size_t)mt * 128 * NP, NP, p.WoutT + (size_t)nt * 128 * 1024, 1024, 1024, acc, (bf16_t*)sm);
#pragma unroll
        for (int m = 0; m < 2; ++m) {
            const int row = mt * 128 + wr * 32 + m * 16 + fr;
            int s, t; tok_info(row, s, t);
            const float* xr = xrow(p, row);
            const float* gt = p.mod + (size_t)s * 3072 + 2048;
#pragma unroll
            for (int n = 0; n < 4; ++n) {
                const int col = nt * 128 + wc * 64 + n * 16 + fq * 4;
                const float4 xv = *(const float4*)(xr + col);
                const float4 gv = *(const float4*)(gt + col);
                float4 o;
                o.x = xv.x + gv.x * acc[m][n][0]; o.y = xv.y + gv.y * acc[m][n][1];
                o.z = xv.z + gv.z * acc[m][n][2]; o.w = xv.w + gv.w * acc[m][n][3];
                *(float4*)(p.out + (size_t)row * 1024 + col) = o;
            }
        }
    }
}

__device__ void phaseI(const Params& p, int bid, int nb) {
    const int wid = threadIdx.x >> 6, lane = threadIdx.x & 63;
    for (int m = bid * 8 + wid; m < M_TOT; m += nb * 8) {
        float* yr = p.out + (size_t)m * 1024;
        float4 v[4]; float ss = 0.f;
#pragma unroll
        for (int i = 0; i < 4; ++i) {
            v[i] = *(const float4*)(yr + i * 256 + lane * 4);
            ss += v[i].x * v[i].x + v[i].y * v[i].y + v[i].z * v[i].z + v[i].w * v[i].w;
        }
        ss = wave_sum(ss);
        const float rstd = rsqrtf(ss * (1.f / 1024.f) + 1e-6f);
#pragma unroll
        for (int i = 0; i < 4; ++i) {
            const int c = i * 256 + lane * 4;
            const float4 g = *(const float4*)(p.g_final + c);
            float4 o; o.x = v[i].x * rstd * g.x; o.y = v[i].y * rstd * g.y; o.z = v[i].z * rstd * g.z; o.w = v[i].w * rstd * g.w;
            *(float4*)(yr + c) = o;
        }
    }
}

#if MK_MULTI
#define PHASE_KERNEL(NAME, CALL) __global__ void __launch_bounds__(NTHR) NAME(Params p) { __shared__ __attribute__((aligned(16))) float sm[SMEM_FLOATS]; const int bid = blockIdx.x, nb = gridDim.x; (void)sm; CALL; }
PHASE_KERNEL(kA, phaseA(p, sm, bid, nb))
PHASE_KERNEL(kB, phaseB(p, bid, nb))
PHASE_KERNEL(kC, phaseC(p, sm, bid, nb))
PHASE_KERNEL(kD, phaseD(p, sm, bid, nb))
PHASE_KERNEL(kE, phaseE(p, sm, bid, nb))
PHASE_KERNEL(kF, phaseF(p, bid, nb))
PHASE_KERNEL(kG, phaseG(p, sm, bid, nb))
PHASE_KERNEL(kH, phaseH(p, sm, bid, nb))
PHASE_KERNEL(kI, phaseI(p, bid, nb))
#else
__global__ void __launch_bounds__(NTHR) fwd_megakernel(Params p) {
    __shared__ __attribute__((aligned(16))) float sm[SMEM_FLOATS];
    cg::grid_group grid = cg::this_grid();
    const int bid = blockIdx.x, nb = gridDim.x;
    phaseA(p, sm, bid, nb); grid.sync();
    phaseB(p, bid, nb); grid.sync();
    phaseC(p, sm, bid, nb); grid.sync();
    phaseD(p, sm, bid, nb); grid.sync();
    phaseE(p, sm, bid, nb); grid.sync();
    phaseF(p, bid, nb); grid.sync();
    phaseG(p, sm, bid, nb); grid.sync();
    phaseH(p, sm, bid, nb); grid.sync();
    phaseI(p, bid, nb);
}
#endif

extern "C" void kernel_launch(void* const* d_in, const int* in_sizes, int n_in, void* d_out, int out_size, void* d_ws, size_t ws_size,
                              hipStream_t stream) {
    Params p{};
    const float* const* in = (const float* const*)d_in;
    p.x_p = in[0]; p.x_s = in[1]; p.c_p = in[2]; p.c_s = in[3];
    p.st_shift = in[4]; p.st_S = in[5]; p.st_conv = in[6]; p.st_C = in[7]; p.st_n = in[8]; p.st_m = in[9];
    p.g_norm = in[10]; p.w_ada = in[11]; p.b_ada = in[12]; p.w_in = in[13]; p.mu_shift = in[14]; p.w_decay2 = in[15];
    p.w0 = in[16]; p.w_iclr2 = in[17]; p.a0 = in[18]; p.k_k = in[19]; p.k_a = in[20]; p.r_k = in[21];
    p.ln_w = in[22]; p.ln_b = in[23]; p.conv_w = in[24]; p.conv_b = in[25]; p.b_i = in[26]; p.b_f = in[27];
    p.gn_w = in[28]; p.w_up_a = in[29]; p.w_up_b = in[30]; p.w_out = in[31]; p.g_final = in[32];
    p.out = (float*)d_out;
    char* ws = (char*)d_ws;
    size_t off = 0;
    p.P = (bf16_t*)(ws + off); off += (size_t)M_TOT * NP * 2;
    p.WinT = (bf16_t*)(ws + off); off += (size_t)NP * 1024 * 2;
    p.WupaT = (bf16_t*)(ws + off); off += (size_t)1024 * 512 * 2;
    p.WupbT = (bf16_t*)(ws + off); off += (size_t)1024 * 512 * 2;
    p.WoutT = (bf16_t*)(ws + off); off += (size_t)1024 * 1024 * 2;
    p.mod = (float*)(ws + off); off += (size_t)NSEQ * 3072 * 4;
    p.ctr = (unsigned*)(ws + off); off += 256;
    char* os = (char*)d_out;
    p.H = (bf16_t*)os;
    p.Yraw = (bf16_t*)os;
    p.OutB = (bf16_t*)(os + (size_t)M_TOT * 512 * 2);
    p.Omd = (bf16_t*)(os + (size_t)M_TOT * 1024 * 2);
    p.Aa = (bf16_t*)(os + (size_t)M_TOT * 1024 * 2 + (size_t)M_TOT * 512 * 2);
#if MK_MULTI
    const int G = 1024;
    kA<<<G, NTHR, 0, stream>>>(p);
    kB<<<G, NTHR, 0, stream>>>(p);
    kC<<<G, NTHR, 0, stream>>>(p);
    kD<<<G, NTHR, 0, stream>>>(p);
    kE<<<G, NTHR, 0, stream>>>(p);
    kF<<<G, NTHR, 0, stream>>>(p);
    kG<<<G, NTHR, 0, stream>>>(p);
    kH<<<G, NTHR, 0, stream>>>(p);
    kI<<<G, NTHR, 0, stream>>>(p);
#else
    static int grid_blocks = 0;
    if (!grid_blocks) {
        int dev = 0, cus = 0, per_cu = 0;
        hipGetDevice(&dev);
        hipDeviceGetAttribute(&cus, hipDeviceAttributeMultiprocessorCount, dev);
        hipOccupancyMaxActiveBlocksPerMultiprocessor(&per_cu, fwd_megakernel, NTHR, 0);
        if (per_cu > 1) per_cu = 1;
        grid_blocks = cus * per_cu;
    }
    void* args[] = {&p};
    hipError_t e = hipLaunchCooperativeKernel((void*)fwd_megakernel, dim3(grid_blocks), dim3(NTHR), args, 0, stream);
    if (e != hipSuccess) fprintf(stderr, "cooperative launch failed: %s (grid %d)\n", hipGetErrorString(e), grid_blocks);
#endif
}
```

```cpp
#include <hip/hip_runtime.h>
#include <hip/hip_cooperative_groups.h>
#include <cstdio>
namespace cg = cooperative_groups;

#ifndef MK_MULTI
#define MK_MULTI 0
#endif

typedef unsigned short bf16_t;
typedef short bf16x8 __attribute__((ext_vector_type(8)));
typedef float f32x4 __attribute__((ext_vector_type(4)));

constexpr int NTHR = 512;
constexpr int M_P = 16384, M_S = 1024, M_TOT = 17408;
constexpr int DM = 1024;
constexpr int NSEQ = 136;
constexpr int NP = 6912;
constexpr int N_IN = 6800;
constexpr int C_R = 0, C_K = 512, C_V = 1024, C_WL = 1536, C_AL = 1600, C_ZA = 1664, C_QK = 2176,
              C_VB = 3200, C_OB = 3712, C_IB = 4224, C_FB = 4232, C_ZB = 4240, C_GLA = 4752, C_GLB = 5776;
constexpr int SHIFT_W = 1664;

constexpr size_t O_Y = 0;
constexpr size_t O_PSHIFT = (size_t)M_TOT * DM;
constexpr size_t O_PS = O_PSHIFT + 8 * 1664;
constexpr size_t O_PCONV = O_PS + 8 * 8 * 4096;
constexpr size_t O_PC = O_PCONV + 8 * 3 * 1024;
constexpr size_t O_PN = O_PC + 8 * 8 * 4096;
constexpr size_t O_PM = O_PN + 8 * 8 * 64;
constexpr size_t O_SSHIFT = O_PM + 64;
constexpr size_t O_SS = O_SSHIFT + 128 * 1664;
constexpr size_t O_SCONV = O_SS + (size_t)128 * 8 * 4096;
constexpr size_t O_SC = O_SCONV + 128 * 3 * 1024;
constexpr size_t O_SN = O_SC + (size_t)128 * 8 * 4096;
constexpr size_t O_SM = O_SN + 128 * 8 * 64;
constexpr size_t O_END = O_SM + 1024;

struct Params {
    const float *x_p, *x_s, *c_p, *c_s;
    const float *st_shift, *st_S, *st_conv, *st_C, *st_n, *st_m;
    const float *g_norm, *w_ada, *b_ada, *w_in, *mu_shift, *w_decay2, *w0, *w_iclr2, *a0, *k_k, *k_a, *r_k,
        *ln_w, *ln_b, *conv_w, *conv_b, *b_i, *b_f, *gn_w, *w_up_a, *w_up_b, *w_out, *g_final;
    float* out;
    bf16_t *WinT, *WupaT, *WupbT, *WoutT;
    float* mod;
    bf16_t* P;
    bf16_t *H, *Yraw, *OutB, *Omd, *Aa, *OutA;
    unsigned* ctr;
    unsigned* bar;
};

constexpr int SMEM_FLOATS = 32768 + 64;
__device__ __forceinline__ int otid() { int t = (int)__builtin_amdgcn_workitem_id_x(); asm volatile("" : "+v"(t)); return t; }
__device__ __forceinline__ void lds_barrier() { asm volatile("s_waitcnt lgkmcnt(0)" ::: "memory"); __builtin_amdgcn_s_barrier(); asm volatile("" ::: "memory"); }
__device__ __forceinline__ float bf2f(bf16_t v) { return __uint_as_float(((unsigned)v) << 16); }
__device__ __forceinline__ bf16_t f2bf(float f) { unsigned u = __float_as_uint(f); u += 0x7FFFu + ((u >> 16) & 1u); return (bf16_t)(u >> 16); }
__device__ __forceinline__ unsigned pk2(float lo, float hi) { return (unsigned)f2bf(lo) | ((unsigned)f2bf(hi) << 16); }
__device__ __forceinline__ float sigm(float x) { return __builtin_amdgcn_rcpf(1.f + __expf(-x)); }
__device__ __forceinline__ float silu(float x) { return x * __builtin_amdgcn_rcpf(1.f + __expf(-x)); }
__device__ __forceinline__ float wave_sum(float v) {
#pragma unroll
    for (int o = 32; o; o >>= 1) v += __shfl_xor(v, o);
    return v;
}
template <int CTRL> __device__ __forceinline__ float dpp_mov(float v) {
    return __builtin_bit_cast(float, __builtin_amdgcn_update_dpp(0, __builtin_bit_cast(int, v), CTRL, 0xF, 0xF, true));
}
__device__ __forceinline__ float row16_sum(float v) {
    v += dpp_mov<0xB1>(v);
    v += dpp_mov<0x4E>(v);
    v += dpp_mov<0x141>(v);
    v += dpp_mov<0x140>(v);
    return v;
}
__device__ __forceinline__ void tok_info(int m, int& s, int& t) {
    if (m < M_P) { s = m >> 11; t = m & 2047; } else { int q = m - M_P; s = 8 + (q >> 3); t = q & 7; }
}
__device__ __forceinline__ const float* xrow(const Params& p, int m) {
    return m < M_P ? p.x_p + (size_t)m * DM : p.x_s + (size_t)(m - M_P) * DM;
}

__device__ __forceinline__ void tr8(const float* __restrict__ src, int Nsrc, bf16_t* __restrict__ dst, int K, int n, int kg) {
    float v[8];
    if (n < Nsrc) {
        const float* sp = src + (size_t)(kg * 8) * Nsrc + n;
#pragma unroll
        for (int i = 0; i < 8; ++i) v[i] = sp[(size_t)i * Nsrc];
    } else {
#pragma unroll
        for (int i = 0; i < 8; ++i) v[i] = 0.f;
    }
    uint4 o; o.x = pk2(v[0], v[1]); o.y = pk2(v[2], v[3]); o.z = pk2(v[4], v[5]); o.w = pk2(v[6], v[7]);
    *(uint4*)(dst + (size_t)n * K + kg * 8) = o;
}
__device__ void phaseA(const Params& p, float* sm, int bid, int nb) {
    const int tid = otid();
    if (bid == 0 && tid == 0) *p.ctr = 0u;
    constexpr int N_ADA = 48 * 17;
    for (int i = bid; i < N_ADA; i += nb) {
        const int ct = i % 48, rgp = i / 48;
        float* sc = sm;
        float* red = sm + 8192;
        for (int idx = tid; idx < 8 * 1024; idx += NTHR) {
            const int sl = idx >> 10, k = idx & 1023, s = rgp * 8 + sl;
            const float c = s < 8 ? p.c_p[s * 1024 + k] : p.c_s[(s - 8) * 1024 + k];
            sc[idx] = silu(c);
        }
        __syncthreads();
        const int col = tid & 63, kq = tid >> 6;
        float acc[8];
#pragma unroll
        for (int s = 0; s < 8; ++s) acc[s] = 0.f;
        const float* wp = p.w_ada + (size_t)(kq * 128) * 3072 + ct * 64 + col;
#pragma unroll 8
        for (int k = 0; k < 128; ++k) {
            const float w = wp[(size_t)k * 3072];
#pragma unroll
            for (int s = 0; s < 8; ++s) acc[s] += sc[s * 1024 + kq * 128 + k] * w;
        }
#pragma unroll
        for (int s = 0; s < 8; ++s) red[(kq * 8 + s) * 64 + col] = acc[s];
        __syncthreads();
        {
            const int s = tid >> 6;
            float v = p.b_ada[ct * 64 + col];
#pragma unroll
            for (int q = 0; q < 8; ++q) v += red[(q * 8 + s) * 64 + col];
            p.mod[(size_t)(rgp * 8 + s) * 3072 + ct * 64 + col] = v;
        }
        __syncthreads();
    }
    constexpr int W_IN = NP * 128, W_UP = 1024 * 64, W_OUT = 1024 * 128;
    const int gt = bid * NTHR + tid, gs = nb * NTHR;
    for (int w = gt; w < W_IN; w += gs) tr8(p.w_in, N_IN, p.WinT, 1024, w % NP, w / NP);
    for (int w = gt; w < W_UP; w += gs) { tr8(p.w_up_a, 1024, p.WupaT, 512, w & 1023, w >> 10); tr8(p.w_up_b, 1024, p.WupbT, 512, w & 1023, w >> 10); }
    for (int w = gt; w < W_OUT; w += gs) tr8(p.w_out, 1024, p.WoutT, 1024, w & 1023, w >> 10);
}

__device__ __forceinline__ void normrow_load(const float* xr, int lane, float4 (&v)[4]) {
#pragma unroll
    for (int i = 0; i < 4; ++i) v[i] = *(const float4*)(xr + i * 256 + lane * 4);
}
__device__ __forceinline__ float sumsq4(const float4 (&v)[4]) {
    float ss = 0.f;
#pragma unroll
    for (int i = 0; i < 4; ++i) ss += v[i].x * v[i].x + v[i].y * v[i].y + v[i].z * v[i].z + v[i].w * v[i].w;
    return ss;
}
__device__ __forceinline__ void hrow_store(const Params& p, int m, int lane, const float4 (&v)[4], float rstd) {
    int s, t; tok_info(m, s, t);
    const float* md = p.mod + (size_t)s * 3072;
#pragma unroll
    for (int i = 0; i < 4; ++i) {
        const int c = i * 256 + lane * 4;
        const float4 g = *(const float4*)(p.g_norm + c);
        const float4 sh = *(const float4*)(md + c);
        const float4 sl = *(const float4*)(md + 1024 + c);
        const float h0 = v[i].x * rstd * g.x * (1.f + sl.x) + sh.x;
        const float h1 = v[i].y * rstd * g.y * (1.f + sl.y) + sh.y;
        const float h2 = v[i].z * rstd * g.z * (1.f + sl.z) + sh.z;
        const float h3 = v[i].w * rstd * g.w * (1.f + sl.w) + sh.w;
        uint2 o; o.x = pk2(h0, h1); o.y = pk2(h2, h3);
        *(uint2*)(p.H + (size_t)m * 1024 + c) = o;
    }
}
__device__ void phaseB(const Params& p, int bid, int nb) {
    const int wid = otid() >> 6, lane = otid() & 63;
    const int stride = nb * 8;
    for (int m = bid * 8 + wid; m < M_TOT; m += 2 * stride) {
        const int m2 = m + stride;
        const bool has2 = m2 < M_TOT;
        float4 va[4], vb[4];
        normrow_load(xrow(p, m), lane, va);
        normrow_load(xrow(p, has2 ? m2 : m), lane, vb);
        const float ra = rsqrtf(wave_sum(sumsq4(va)) * (1.f / 1024.f) + 1e-6f);
        const float rb = rsqrtf(wave_sum(sumsq4(vb)) * (1.f / 1024.f) + 1e-6f);
        hrow_store(p, m, lane, va, ra);
        if (has2) hrow_store(p, m2, lane, vb, rb);
    }
}

__device__ void phaseD(const Params& p, float* sm, int bid, int nb) {
    const int tid = otid();
    float* tw = sm;
    float* al = sm + 1024;
    const int c = tid;
    float wd[64], wi[64];
#pragma unroll
    for (int j = 0; j < 64; ++j) { wd[j] = p.w_decay2[j * 512 + c]; wi[j] = p.w_iclr2[j * 512 + c]; }
    const float w0c = p.w0[c], a0c = p.a0[c];
    for (int it = bid; it < M_TOT / 16; it += nb) {
        const int m0 = it * 16;
        for (int idx = tid; idx < 16 * 128; idx += NTHR) {
            const int tok = idx >> 7, j = idx & 127, col = C_WL + j, m = m0 + tok;
            int s, t; tok_info(m, s, t);
            const float cur = bf2f(p.P[(size_t)m * NP + col]);
            const float prev = t > 0 ? bf2f(p.P[(size_t)(m - 1) * NP + col]) : (s >= 8 ? p.st_shift[(size_t)(s - 8) * SHIFT_W + col] : 0.f);
            const float v = cur + p.mu_shift[col] * (prev - cur);
            if (j < 64) tw[tok * 64 + j] = tanhf(v); else al[tok * 64 + j - 64] = v;
        }
        __syncthreads();
#pragma unroll 2
        for (int tok = 0; tok < 16; ++tok) {
            float aw = 0.f, aa = 0.f;
#pragma unroll
            for (int j4 = 0; j4 < 16; ++j4) {
                const float4 t4 = *(const float4*)(tw + tok * 64 + j4 * 4);
                const float4 a4 = *(const float4*)(al + tok * 64 + j4 * 4);
                aw += t4.x * wd[j4 * 4] + t4.y * wd[j4 * 4 + 1] + t4.z * wd[j4 * 4 + 2] + t4.w * wd[j4 * 4 + 3];
                aa += a4.x * wi[j4 * 4] + a4.y * wi[j4 * 4 + 1] + a4.z * wi[j4 * 4 + 2] + a4.w * wi[j4 * 4 + 3];
            }
            const int m = m0 + tok;
            const float sg = sigm(w0c + aw);
            p.Omd[(size_t)m * 512 + c] = f2bf(1.f - __expf(-0.6065306597126334f * sg));
            p.Aa[(size_t)m * 512 + c] = f2bf(sigm(a0c + aa));
        }
        for (int tok = 0; tok < 16; ++tok) {
            const int m = m0 + tok;
            int s, t; tok_info(m, s, t);
            const int T = s < 8 ? 2048 : 8;
            if (t != T - 1) continue;
            float* osh = s < 8 ? p.out + O_PSHIFT + (size_t)s * SHIFT_W : p.out + O_SSHIFT + (size_t)(s - 8) * SHIFT_W;
            float* ocv = s < 8 ? p.out + O_PCONV + (size_t)s * 3072 : p.out + O_SCONV + (size_t)(s - 8) * 3072;
            for (int col = tid; col < SHIFT_W; col += NTHR) osh[col] = bf2f(p.P[(size_t)m * NP + col]);
            for (int idx = tid; idx < 3072; idx += NTHR) {
                const int r = idx >> 10, cc = idx & 1023;
                ocv[idx] = bf2f(p.P[(size_t)(m - 2 + r) * NP + C_QK + cc]);
            }
        }
        __syncthreads();
    }
}

__device__ __forceinline__ float rdlane(float v, int l) { return __builtin_bit_cast(float, __builtin_amdgcn_readlane(__builtin_bit_cast(int, v), l)); }
__device__ __forceinline__ float wave_sum_fast(float v) {
    v = row16_sum(v);
    return (rdlane(v, 0) + rdlane(v, 16)) + (rdlane(v, 32) + rdlane(v, 48));
}
__device__ __forceinline__ float4 unpk4(uint2 u) {
    float4 f; f.x = __uint_as_float(u.x << 16); f.y = __uint_as_float(u.x & 0xFFFF0000u);
    f.z = __uint_as_float(u.y << 16); f.w = __uint_as_float(u.y & 0xFFFF0000u); return f;
}
__device__ void rwkv_item(const Params& p, int s, int h, int third, float* sm) {
    constexpr int BUF = 15680;
    constexpr int VC_OFF = 10368, Y_OFF = 13632, NCH = 64;
    const int tid = otid(), wid = tid >> 6, lane = tid & 63;
    const int mbase = s * 2048;
    const int r0 = third * 21 + (third > 0 ? 1 : 0), nr = third == 0 ? 22 : 21;
    if (wid >= 6) {
        const int pw = wid - 6, g = lane >> 4;
        const int c4 = (lane & 15) * 4, hc = h * 64 + c4;
        const int l128 = pw * 64 + lane;
        const float4 mu_r = *(const float4*)(p.mu_shift + C_R + hc), mu_k = *(const float4*)(p.mu_shift + C_K + hc), mu_v = *(const float4*)(p.mu_shift + C_V + hc);
        const float4 kkw = *(const float4*)(p.k_k + hc), kaw = *(const float4*)(p.k_a + hc);
        uint2 R[4][8];
        auto fetch = [&](int pass, uint2 (&q)[8]) {
            const int t = (pass >> 2) * 32 + (pass & 3) * 8 + pw * 4 + g;
            const bf16_t* pr = p.P + (size_t)(mbase + t) * NP + hc;
            const bf16_t* pp = t > 0 ? pr - NP : pr;
            q[0] = *(const uint2*)(pr + C_R); q[1] = *(const uint2*)(pr + C_K); q[2] = *(const uint2*)(pr + C_V);
            q[3] = *(const uint2*)(pp + C_R); q[4] = *(const uint2*)(pp + C_K); q[5] = *(const uint2*)(pp + C_V);
            q[6] = *(const uint2*)(p.Aa + (size_t)(mbase + t) * 512 + hc);
            q[7] = *(const uint2*)(p.Omd + (size_t)(mbase + t) * 512 + hc);
        };
        auto step = [&](int pass, uint2 (&q)[8]) {
            const uint2 cr = q[0], ck = q[1], cv = q[2], crp = q[3], ckp = q[4], cvp = q[5], ca = q[6], co = q[7];
            if (pass + 4 < NCH * 4) fetch(pass + 4, q);
            const int tok = (pass & 3) * 8 + pw * 4 + g, t = (pass >> 2) * 32 + tok;
            float* B = sm + ((pass >> 2) & 1) * BUF;
            float4 r = unpk4(cr), k = unpk4(ck), v = unpk4(cv), rp, kp_, vp;
            if (t > 0) { rp = unpk4(crp); kp_ = unpk4(ckp); vp = unpk4(cvp); }
            else { rp = make_float4(0.f, 0.f, 0.f, 0.f); kp_ = rp; vp = rp; }
            r.x += mu_r.x * (rp.x - r.x); r.y += mu_r.y * (rp.y - r.y); r.z += mu_r.z * (rp.z - r.z); r.w += mu_r.w * (rp.w - r.w);
            k.x += mu_k.x * (kp_.x - k.x); k.y += mu_k.y * (kp_.y - k.y); k.z += mu_k.z * (kp_.z - k.z); k.w += mu_k.w * (kp_.w - k.w);
            v.x += mu_v.x * (vp.x - v.x); v.y += mu_v.y * (vp.y - v.y); v.z += mu_v.z * (vp.z - v.z); v.w += mu_v.w * (vp.w - v.w);
            const float4 a = unpk4(ca), om = unpk4(co);
            float4 kk; kk.x = k.x * kkw.x; kk.y = k.y * kkw.y; kk.z = k.z * kkw.z; kk.w = k.w * kkw.w;
            const float nrm = sqrtf(row16_sum(kk.x * kk.x + kk.y * kk.y + kk.z * kk.z + kk.w * kk.w));
            const float inv = __builtin_amdgcn_rcpf(fmaxf(nrm, 1e-12f));
            kk.x *= inv; kk.y *= inv; kk.z *= inv; kk.w *= inv;
            float4 ka; ka.x = kk.x * a.x; ka.y = kk.y * a.y; ka.z = kk.z * a.z; ka.w = kk.w * a.w;
            float4 kp; kp.x = k.x * (1.f + (a.x - 1.f) * kaw.x); kp.y = k.y * (1.f + (a.y - 1.f) * kaw.y);
            kp.z = k.z * (1.f + (a.z - 1.f) * kaw.z); kp.w = k.w * (1.f + (a.w - 1.f) * kaw.w);
            float4 d; d.x = 1.f - om.x; d.y = 1.f - om.y; d.z = 1.f - om.z; d.w = 1.f - om.w;
            float4 dr; dr.x = d.x * r.x; dr.y = d.y * r.y; dr.z = d.z * r.z; dr.w = d.w * r.w;
            const float c1 = row16_sum(ka.x * r.x + ka.y * r.y + ka.z * r.z + ka.w * r.w);
            const float c2 = row16_sum(kp.x * r.x + kp.y * r.y + kp.z * r.z + kp.w * r.w);
            const int o = tok * 64 + c4;
            *(float4*)(B + o) = kk; *(float4*)(B + 2048 + o) = d; *(float4*)(B + 4096 + o) = ka;
            *(float4*)(B + 6144 + o) = kp; *(float4*)(B + 8192 + o) = dr;
            float4* vc = (float4*)(B + VC_OFF) + tok * 24;
            const int l0 = c4 - r0;
            if (l0 >= 0 && l0 < nr) vc[l0] = make_float4(v.x, c1, c2, 0.f);
            if (l0 + 1 >= 0 && l0 + 1 < nr) vc[l0 + 1] = make_float4(v.y, c1, c2, 0.f);
            if (l0 + 2 >= 0 && l0 + 2 < nr) vc[l0 + 2] = make_float4(v.z, c1, c2, 0.f);
            if (l0 + 3 >= 0 && l0 + 3 < nr) vc[l0 + 3] = make_float4(v.w, c1, c2, 0.f);
        };
        auto flush = [&](int c) {
            const float* Y = sm + (c & 1) * BUF + Y_OFF;
            const int tt = l128 >> 2, part = l128 & 3;
            bf16_t* dst = p.Yraw + (size_t)(mbase + c * 32 + tt) * 512 + h * 64 + r0;
#pragma unroll
            for (int k = 0; k < 6; ++k) { const int i = part + 4 * k; if (i < nr) dst[i] = f2bf(Y[tt * 64 + i]); }
        };
#pragma unroll
        for (int q = 0; q < 4; ++q) fetch(q, R[q]);
#pragma unroll
        for (int q = 0; q < 4; ++q) step(q, R[q]);
        lds_barrier();
#pragma unroll 1
        for (int c = 0; c < NCH; ++c) {
            if (c > 0) flush(c - 1);
            if (c + 1 < NCH) {
#pragma unroll
                for (int q = 0; q < 4; ++q) step((c + 1) * 4 + q, R[q]);
            }
            lds_barrier();
        }
        flush(NCH - 1);
    } else {
        const int lrow = wid * 4 + (lane >> 4);
        const int irow = r0 + (lrow < nr ? lrow : nr - 1);
        const int c4 = (lane & 15) * 4;
        const int yslot = ((lane & 15) == 0 && lrow < nr) ? lrow : 32 + (lane & 31);
        float S0 = 0.f, S1 = 0.f, S2 = 0.f, S3 = 0.f;
        lds_barrier();
#pragma unroll 1
        for (int c = 0; c < NCH; ++c) {
            const float* B = sm + (c & 1) * BUF;
            const float* bp = B + c4;
            const float4* vp4 = (const float4*)(B + VC_OFF) + (irow - r0);
            float4 kk4 = *(const float4*)(bp), d4 = *(const float4*)(bp + 2048), ka4 = *(const float4*)(bp + 4096);
            float4 kp4 = *(const float4*)(bp + 6144), dr4 = *(const float4*)(bp + 8192), vc = vp4[0];
            float4 kkB = *(const float4*)(bp + 64), dB = *(const float4*)(bp + 64 + 2048), kaB = *(const float4*)(bp + 64 + 4096);
            float4 kpB = *(const float4*)(bp + 64 + 6144), drB = *(const float4*)(bp + 64 + 8192), vcB = vp4[24];
            float* yp = sm + (c & 1) * BUF + Y_OFF + yslot;
#pragma unroll 8
            for (int tt = 0; tt < 32; ++tt) {
                const float* nb_ = bp + (tt + 2) * 64;
                const float4 nkk = *(const float4*)(nb_), nd = *(const float4*)(nb_ + 2048), nka = *(const float4*)(nb_ + 4096);
                const float4 nkp = *(const float4*)(nb_ + 6144), ndr = *(const float4*)(nb_ + 8192), nvc = vp4[(tt + 2) * 24];
                __builtin_amdgcn_sched_barrier(0);
                float p1 = S0 * kk4.x + S1 * kk4.y + S2 * kk4.z + S3 * kk4.w;
                float p2 = S0 * dr4.x + S1 * dr4.y + S2 * dr4.z + S3 * dr4.w;
                const float vi = vc.x;
                const float u0 = S0 * d4.x + vi * kp4.x, u1 = S1 * d4.y + vi * kp4.y, u2 = S2 * d4.z + vi * kp4.z, u3 = S3 * d4.w + vi * kp4.w;
                float z = p2 - vc.y * p1;
                p1 = row16_sum(p1);
                z = row16_sum(z);
                S0 = u0 - p1 * ka4.x; S1 = u1 - p1 * ka4.y; S2 = u2 - p1 * ka4.z; S3 = u3 - p1 * ka4.w;
                yp[tt * 64] = z + vi * vc.z;
                kk4 = kkB; d4 = dB; ka4 = kaB; kp4 = kpB; dr4 = drB; vc = vcB;
                kkB = nkk; dB = nd; kaB = nka; kpB = nkp; drB = ndr; vcB = nvc;
                __builtin_amdgcn_sched_barrier(0);
            }
            lds_barrier();
        }
        if (lrow < nr) {
            float* o = p.out + O_PS + (size_t)s * 8 * 4096 + ((size_t)(h * 64 + irow)) * 64 + c4;
            float4 v; v.x = S0; v.y = S1; v.z = S2; v.w = S3;
            *(float4*)o = v;
        }
    }
    __syncthreads();
}

__device__ void mlstm_item(const Params& p, int s, int h, float* sm) {
    float* sq = sm;
    float* sk = sm + 4160;
    float* sv = sm + 8320;
    float* sc = sm + 12480;
    float* sC = sm + 16640;
    float* sn = sm + 20800;
    float* sb = sn + 64;
    float* si = sn + 128;
    float* smt = sn + 192;
    float* swin = sn + 256;
    float* sden = sn + 320;
    float* sws = sn + 384;
    float* slf = sn + 448;
    float* smisc = sn + 512;
    const int tid = otid(), wid = tid >> 6, lane = tid & 63;
    const int T = s < 8 ? 2048 : 8, L = s < 8 ? 64 : 8, NC = T / L;
    const int mbase = s < 8 ? s * 2048 : M_P + (s - 8) * 8;
    for (int idx = tid; idx < 4096; idx += NTHR) {
        const int i = idx >> 6, j = idx & 63;
        sC[i * 65 + j] = s >= 8 ? p.st_C[(size_t)((s - 8) * 8 + h) * 4096 + idx] : 0.f;
    }
    if (tid < 64) sn[tid] = s >= 8 ? p.st_n[(size_t)((s - 8) * 8 + h) * 64 + tid] : 0.f;
    if (tid == 0) smisc[0] = s >= 8 ? p.st_m[(s - 8) * 8 + h] : 0.f;
    const float cwq[4] = {p.conv_w[0 * 1024 + h * 64 + lane], p.conv_w[1 * 1024 + h * 64 + lane], p.conv_w[2 * 1024 + h * 64 + lane], p.conv_w[3 * 1024 + h * 64 + lane]};
    const float cwk[4] = {p.conv_w[0 * 1024 + 512 + h * 64 + lane], p.conv_w[1 * 1024 + 512 + h * 64 + lane], p.conv_w[2 * 1024 + 512 + h * 64 + lane], p.conv_w[3 * 1024 + 512 + h * 64 + lane]};
    const float cbq = p.conv_b[h * 64 + lane], cbk = p.conv_b[512 + h * 64 + lane];
    const float gnw = p.gn_w[h * 64 + lane];
    const float bi = p.b_i[h], bfv = p.b_f[h];
    __syncthreads();
    for (int c = 0; c < NC; ++c) {
        const int t0 = c * L;
        for (int tt = wid; tt < L; tt += 8) {
            const int t = t0 + tt, m = mbase + t;
            float aq = cbq, ak = cbk;
#pragma unroll
            for (int j = 0; j < 4; ++j) {
                const int tau = t - 3 + j;
                float xq, xk;
                if (tau >= 0) {
                    const bf16_t* pr = p.P + (size_t)(mbase + tau) * NP + C_QK + h * 64 + lane;
                    xq = bf2f(pr[0]); xk = bf2f(pr[512]);
                } else if (s >= 8) {
                    const float* st = p.st_conv + ((size_t)(s - 8) * 3 + (3 + tau)) * 1024 + h * 64 + lane;
                    xq = st[0]; xk = st[512];
                } else { xq = 0.f; xk = 0.f; }
                aq += xq * cwq[j]; ak += xk * cwk[j];
            }
            sq[tt * 65 + lane] = silu(aq);
            sk[tt * 65 + lane] = silu(ak) * 0.125f;
            sv[tt * 65 + lane] = bf2f(p.P[(size_t)m * NP + C_VB + h * 64 + lane]);
        }
        if (tid < L) {
            const int m = mbase + t0 + tid;
            si[tid] = bf2f(p.P[(size_t)m * NP + C_IB + h]) + bi;
            const float f = bf2f(p.P[(size_t)m * NP + C_FB + h]) + bfv;
            slf[tid] = f > 0.f ? -log1pf(__expf(-f)) : f - log1pf(__expf(f));
        }
        __syncthreads();
        if (tid == 0) {
            const float mprev = smisc[0];
            float b = 0.f, run = mprev;
            for (int t = 0; t < L; ++t) {
                b += slf[t];
                run = fmaxf(run, si[t] - b);
                sb[t] = b; smt[t] = b + run; swin[t] = __expf(b + mprev - (b + run));
            }
            const float mnew = b + run;
            smisc[1] = mnew; smisc[2] = __expf(b + mprev - mnew);
            for (int t = 0; t < L; ++t) sws[t] = __expf(b - sb[t] + si[t] - mnew);
        }
        __syncthreads();
        for (int idx = tid; idx < L * L; idx += NTHR) {
            const int t = idx / L, u = idx % L;
            float v = 0.f;
            if (u <= t) {
                float dot = 0.f;
#pragma unroll 8
                for (int d = 0; d < 64; ++d) dot += sq[t * 65 + d] * sk[u * 65 + d];
                v = dot * __expf(sb[t] - sb[u] + si[u] - smt[t]);
            }
            sc[t * 65 + u] = v;
        }
        __syncthreads();
        if (tid < L) {
            float rs = 0.f, qn = 0.f;
            for (int u = 0; u < L; ++u) rs += sc[tid * 65 + u];
            for (int j = 0; j < 64; ++j) qn += sn[j] * sq[tid * 65 + j];
            const float den = rs + swin[tid] * qn;
            sden[tid] = fmaxf(fabsf(den), __expf(-smt[tid]));
        }
        __syncthreads();
        for (int tt = wid; tt < L; tt += 8) {
            float num = 0.f, inter = 0.f;
            for (int u = 0; u <= tt; ++u) num += sc[tt * 65 + u] * sv[u * 65 + lane];
#pragma unroll 8
            for (int j = 0; j < 64; ++j) inter += sC[lane * 65 + j] * sq[tt * 65 + j];
            const float hv = (num + swin[tt] * inter) / sden[tt];
            const float ms = wave_sum(hv * hv) * (1.f / 64.f);
            const float hn = hv * rsqrtf(ms + 1e-6f) * gnw;
            const int m = mbase + t0 + tt;
            const float ob = bf2f(p.P[(size_t)m * NP + C_OB + h * 64 + lane]);
            const float zb = bf2f(p.P[(size_t)m * NP + C_ZB + h * 64 + lane]);
            p.OutB[(size_t)m * 512 + h * 64 + lane] = f2bf(sigm(ob) * hn * silu(zb));
        }
        __syncthreads();
        {
            const float dec = smisc[2];
            const int j = lane;
#pragma unroll
            for (int ii = 0; ii < 8; ++ii) {
                const int i = wid + 8 * ii;
                float a = dec * sC[i * 65 + j];
                for (int u = 0; u < L; ++u) a += sws[u] * sv[u * 65 + i] * sk[u * 65 + j];
                sC[i * 65 + j] = a;
            }
            if (tid < 64) {
                float a = dec * sn[tid];
                for (int u = 0; u < L; ++u) a += sws[u] * sk[u * 65 + tid];
                sn[tid] = a;
            }
            if (tid == 0) smisc[0] = smisc[1];
        }
        __syncthreads();
    }
    {
        float* oC = s < 8 ? p.out + O_PC + (size_t)(s * 8 + h) * 4096 : p.out + O_SC + (size_t)((s - 8) * 8 + h) * 4096;
        float* on = s < 8 ? p.out + O_PN + (size_t)(s * 8 + h) * 64 : p.out + O_SN + (size_t)((s - 8) * 8 + h) * 64;
        float* om = s < 8 ? p.out + O_PM + (s * 8 + h) : p.out + O_SM + ((s - 8) * 8 + h);
        for (int idx = tid; idx < 4096; idx += NTHR) oC[idx] = sC[(idx >> 6) * 65 + (idx & 63)];
        if (tid < 64) on[tid] = sn[tid];
        if (tid == 0) om[0] = smisc[0];
    }
    __syncthreads();
}

__device__ __forceinline__ bf16x8 ldfrag(const bf16_t* base, int row, int ks, int fq) { return *(const bf16x8*)(base + row * 72 + ks * 32 + fq * 8); }
__device__ __forceinline__ float sum8(float v) { v += dpp_mov<0xB1>(v); v += dpp_mov<0x4E>(v); v += dpp_mov<0x141>(v); return v; }
__device__ void mlstm_prompt(const Params& p, int s, int h, float* sm) {
    bf16_t* Qs = (bf16_t*)sm; bf16_t* Ks = Qs + 4608; bf16_t* VT = Ks + 4608; bf16_t* KwT = VT + 4608; bf16_t* Ps = KwT + 4608; bf16_t* Cb = Ps + 4608;
    float* hs = sm + 13824;
    float* sn = hs + 64 * 68;
    float* sden = sn + 64;
    float* gv = sn + 128;
    float* Gg = sn + 128 + 768;
    float* Gl = Gg + 2048;
    float* Gb = Gl + 2048;
    const int tid = otid(), wid = tid >> 6, lane = tid & 63, fr = lane & 15, fq = lane >> 4;
    const int tr = wid >> 1, tc0 = (wid & 1) * 2;
    const int mbase = s * 2048;
    const int qc = h * 64 + lane;
    f32x4 accC[2];
    accC[0] = (f32x4){0.f, 0.f, 0.f, 0.f}; accC[1] = accC[0];
    if (tid < 64) sn[tid] = 0.f;
    {
        const float bi = p.b_i[h], bfv = p.b_f[h];
        for (int cc = wid; cc < 32; cc += 8) {
            const bf16_t* pr = p.P + (size_t)(mbase + cc * 64 + lane) * NP;
            const float it = bf2f(pr[C_IB + h]) + bi;
            const float f = bf2f(pr[C_FB + h]) + bfv;
            float b = f > 0.f ? -log1pf(__expf(-f)) : f - log1pf(__expf(f));
#pragma unroll
            for (int o = 1; o < 64; o <<= 1) { const float v = __shfl_up(b, o); if (lane >= o) b += v; }
            const float g = it - b;
            float run = g;
#pragma unroll
            for (int o = 1; o < 64; o <<= 1) { const float v = __shfl_up(run, o); if (lane >= o) run = fmaxf(run, v); }
            Gg[cc * 64 + lane] = g; Gl[cc * 64 + lane] = run; Gb[cc * 64 + lane] = b;
        }
    }
    const float cwq0 = p.conv_w[qc], cwq1 = p.conv_w[1024 + qc], cwq2 = p.conv_w[2048 + qc], cwq3 = p.conv_w[3072 + qc];
    const float cwk0 = p.conv_w[512 + qc], cwk1 = p.conv_w[1536 + qc], cwk2 = p.conv_w[2560 + qc], cwk3 = p.conv_w[3584 + qc];
    const float cbq = p.conv_b[qc], cbk = p.conv_b[512 + qc];
    const float gnw = p.gn_w[qc];
    unsigned xqr[11], xkr[11], vvr[8];
    auto load_raw = [&](int c) {
        const int tb = c * 64 + wid * 8 - 3;
#pragma unroll
        for (int r = 0; r < 11; ++r) {
            const int t = tb + r, tc = t < 0 ? 0 : t;
            const bf16_t* pr = p.P + (size_t)(mbase + tc) * NP + C_QK + qc;
            xqr[r] = pr[0]; xkr[r] = pr[512];
        }
#pragma unroll
        for (int k = 0; k < 8; ++k) vvr[k] = p.P[(size_t)(mbase + tb + 3 + k) * NP + C_VB + qc];
    };
    auto gates = [&](int c, float mprev) {
        float* v = gv + (c & 1) * 384;
        const float g = Gg[c * 64 + lane], b = Gb[c * 64 + lane];
        const float run = fmaxf(Gl[c * 64 + lane], mprev), runL = fmaxf(Gl[c * 64 + 63], mprev), bL = Gb[c * 64 + 63];
        v[lane] = g; v[64 + lane] = run; v[128 + lane] = __expf(mprev - run); v[192 + lane] = __expf(g - runL); v[256 + lane] = b;
        if (lane == 0) { v[320] = bL + runL; v[321] = __expf(mprev - runL); }
    };
    load_raw(0);
    __syncthreads();
    if (wid == 0) gates(0, 0.f);
    __syncthreads();
    for (int c = 0; c < 32; ++c) {
        const int t0 = c * 64, mb = mbase + t0;
        const float* sg = gv + (c & 1) * 384; const float* srun = sg + 64; const float* swin = sg + 128; const float* sws = sg + 192; const float* sb = sg + 256;
        const float dec = sg[321];
        {
            float kw[8], xq[11], xk[11], vv[8];
            const bool head = (c == 0 && wid == 0);
#pragma unroll
            for (int r = 0; r < 11; ++r) {
                const bool z = head && r < 3;
                xq[r] = z ? 0.f : __uint_as_float(xqr[r] << 16); xk[r] = z ? 0.f : __uint_as_float(xkr[r] << 16);
            }
#pragma unroll
            for (int k = 0; k < 8; ++k) vv[k] = __uint_as_float(vvr[k] << 16);
#pragma unroll
            for (int k = 0; k < 8; ++k) {
                const int tt = wid * 8 + k;
                const float q = silu(cbq + xq[k] * cwq0 + xq[k + 1] * cwq1 + xq[k + 2] * cwq2 + xq[k + 3] * cwq3);
                const float kk = silu(cbk + xk[k] * cwk0 + xk[k + 1] * cwk1 + xk[k + 2] * cwk2 + xk[k + 3] * cwk3) * 0.125f;
                Qs[tt * 72 + lane] = f2bf(q);
                Ks[tt * 72 + lane] = f2bf(kk);
                kw[k] = kk * sws[tt];
            }
            uint4 o; o.x = pk2(kw[0], kw[1]); o.y = pk2(kw[2], kw[3]); o.z = pk2(kw[4], kw[5]); o.w = pk2(kw[6], kw[7]);
            *(uint4*)(KwT + lane * 72 + wid * 8) = o;
            o.x = pk2(vv[0], vv[1]); o.y = pk2(vv[2], vv[3]); o.z = pk2(vv[4], vv[5]); o.w = pk2(vv[6], vv[7]);
            *(uint4*)(VT + lane * 72 + wid * 8) = o;
        }
#pragma unroll
        for (int n = 0; n < 2; ++n) {
            uint2 o; o.x = pk2(accC[n][0], accC[n][1]); o.y = pk2(accC[n][2], accC[n][3]);
            *(uint2*)(Cb + (tr * 16 + fr) * 72 + (tc0 + n) * 16 + fq * 4) = o;
        }
        if (c + 1 < 32) load_raw(c + 1);
        lds_barrier();
        unsigned obr[8], zbr[8];
#pragma unroll
        for (int k = 0; k < 8; ++k) {
            const bf16_t* pr = p.P + (size_t)(mb + wid * 8 + k) * NP;
            obr[k] = pr[C_OB + qc]; zbr[k] = pr[C_ZB + qc];
        }
#pragma unroll
        for (int n = 0; n < 2; ++n) {
            const int ut = tc0 + n;
            f32x4 a = (f32x4){0.f, 0.f, 0.f, 0.f};
            if (ut <= tr) {
#pragma unroll
                for (int ks = 0; ks < 2; ++ks) a = __builtin_amdgcn_mfma_f32_16x16x32_bf16(ldfrag(Ks, ut * 16 + fr, ks, fq), ldfrag(Qs, tr * 16 + fr, ks, fq), a, 0, 0, 0);
            }
            const int t = tr * 16 + fr;
            const float rn = srun[t];
            float w[4];
#pragma unroll
            for (int r = 0; r < 4; ++r) {
                const int u = ut * 16 + fq * 4 + r;
                w[r] = (u <= t) ? a[r] * __expf(sg[u] - rn) : 0.f;
            }
            uint2 o; o.x = pk2(w[0], w[1]); o.y = pk2(w[2], w[3]);
            *(uint2*)(Ps + t * 72 + ut * 16 + fq * 4) = o;
        }
        lds_barrier();
        {
            const int t = tid >> 3, seg = tid & 7;
            const uint4 pv = *(const uint4*)(Ps + t * 72 + seg * 8);
            const uint4 qv = *(const uint4*)(Qs + t * 72 + seg * 8);
            const float4 pa = unpk4(make_uint2(pv.x, pv.y)), pb = unpk4(make_uint2(pv.z, pv.w));
            const float4 qa = unpk4(make_uint2(qv.x, qv.y)), qb = unpk4(make_uint2(qv.z, qv.w));
            const float4 na = *(const float4*)(sn + seg * 8), nb4 = *(const float4*)(sn + seg * 8 + 4);
            float rs = (pa.x + pa.y) + (pa.z + pa.w) + (pb.x + pb.y) + (pb.z + pb.w);
            float qn = qa.x * na.x + qa.y * na.y + qa.z * na.z + qa.w * na.w + qb.x * nb4.x + qb.y * nb4.y + qb.z * nb4.z + qb.w * nb4.w;
            rs = sum8(rs); qn = sum8(qn);
            if (seg == 0) sden[t] = fmaxf(fabsf(rs + swin[t] * qn), __expf(-(sb[t] + srun[t])));
        }
        f32x4 num[2], itr[2];
#pragma unroll
        for (int n = 0; n < 2; ++n) {
            const int it = tc0 + n;
            num[n] = (f32x4){0.f, 0.f, 0.f, 0.f}; itr[n] = num[n];
#pragma unroll
            for (int ks = 0; ks < 2; ++ks) {
                num[n] = __builtin_amdgcn_mfma_f32_16x16x32_bf16(ldfrag(VT, it * 16 + fr, ks, fq), ldfrag(Ps, tr * 16 + fr, ks, fq), num[n], 0, 0, 0);
                itr[n] = __builtin_amdgcn_mfma_f32_16x16x32_bf16(ldfrag(Cb, it * 16 + fr, ks, fq), ldfrag(Qs, tr * 16 + fr, ks, fq), itr[n], 0, 0, 0);
            }
        }
        lds_barrier();
        {
            const int t = tr * 16 + fr;
            const float rd = 1.f / sden[t], wn = swin[t];
#pragma unroll
            for (int n = 0; n < 2; ++n) {
                float4 o;
                o.x = (num[n][0] + wn * itr[n][0]) * rd; o.y = (num[n][1] + wn * itr[n][1]) * rd;
                o.z = (num[n][2] + wn * itr[n][2]) * rd; o.w = (num[n][3] + wn * itr[n][3]) * rd;
                *(float4*)(hs + t * 68 + (tc0 + n) * 16 + fq * 4) = o;
            }
        }
#pragma unroll
        for (int n = 0; n < 2; ++n) {
            accC[n][0] *= dec; accC[n][1] *= dec; accC[n][2] *= dec; accC[n][3] *= dec;
#pragma unroll
            for (int ks = 0; ks < 2; ++ks)
                accC[n] = __builtin_amdgcn_mfma_f32_16x16x32_bf16(ldfrag(KwT, (tc0 + n) * 16 + fr, ks, fq), ldfrag(VT, tr * 16 + fr, ks, fq), accC[n], 0, 0, 0);
        }
        {
            const int j = tid >> 3, seg = tid & 7;
            const uint4 kv = *(const uint4*)(KwT + j * 72 + seg * 8);
            const float4 ka = unpk4(make_uint2(kv.x, kv.y)), kb = unpk4(make_uint2(kv.z, kv.w));
            float sum = (ka.x + ka.y) + (ka.z + ka.w) + (kb.x + kb.y) + (kb.z + kb.w);
            sum = sum8(sum);
            if (seg == 0) sn[j] = dec * sn[j] + sum;
        }
        if (wid == 0 && c + 1 < 32) gates(c + 1, sg[320]);
        lds_barrier();
#pragma unroll
        for (int k = 0; k < 8; ++k) {
            const int tt = wid * 8 + k;
            const float hv = hs[tt * 68 + lane];
            const float ms = wave_sum_fast(hv * hv) * (1.f / 64.f);
            const float hn = hv * rsqrtf(ms + 1e-6f) * gnw;
            p.P[(size_t)(mb + tt) * NP + C_OB + qc] = f2bf(sigm(__uint_as_float(obr[k] << 16)) * hn * silu(__uint_as_float(zbr[k] << 16)));
        }
    }
    {
        float* oC = p.out + O_PC + (size_t)(s * 8 + h) * 4096;
#pragma unroll
        for (int n = 0; n < 2; ++n) {
            float4 o; o.x = accC[n][0]; o.y = accC[n][1]; o.z = accC[n][2]; o.w = accC[n][3];
            *(float4*)(oC + (tr * 16 + fr) * 64 + (tc0 + n) * 16 + fq * 4) = o;
        }
        if (tid < 64) p.out[O_PN + (size_t)(s * 8 + h) * 64 + tid] = sn[tid];
        if (tid == 0) p.out[O_PM + s * 8 + h] = gv[384 + 320];
    }
    __syncthreads();
}

__device__ __forceinline__ void wave_lds_fence() { __builtin_amdgcn_fence(__ATOMIC_RELEASE, "wavefront"); __builtin_amdgcn_wave_barrier(); __builtin_amdgcn_fence(__ATOMIC_ACQUIRE, "wavefront"); }
__device__ void rwkv_sample_wave(const Params& p, int sb, int h, float* wsm) {
    const int lane = otid() & 63;
    const int hj = h * 64 + lane;
    const int m0 = M_P + sb * 8;
    {
        float rr[8], kr[8], vr[8], ar[8], dd[8];
#pragma unroll
        for (int t = 0; t < 8; ++t) {
            const bf16_t* pr = p.P + (size_t)(m0 + t) * NP;
            rr[t] = bf2f(pr[C_R + hj]); kr[t] = bf2f(pr[C_K + hj]); vr[t] = bf2f(pr[C_V + hj]);
            ar[t] = bf2f(p.Aa[(size_t)(m0 + t) * 512 + hj]); dd[t] = 1.f - bf2f(p.Omd[(size_t)(m0 + t) * 512 + hj]);
        }
        const float* st = p.st_shift + (size_t)sb * SHIFT_W;
        float rp = st[C_R + hj], kp_ = st[C_K + hj], vp = st[C_V + hj];
        const float mu_r = p.mu_shift[C_R + hj], mu_k = p.mu_shift[C_K + hj], mu_v = p.mu_shift[C_V + hj];
        const float kkw = p.k_k[hj], kaw = p.k_a[hj];
#pragma unroll
        for (int t = 0; t < 8; ++t) {
            const float r = rr[t] + mu_r * (rp - rr[t]), k = kr[t] + mu_k * (kp_ - kr[t]), v = vr[t] + mu_v * (vp - vr[t]);
            rp = rr[t]; kp_ = kr[t]; vp = vr[t];
            const float a = ar[t], d = dd[t];
            float kk = k * kkw;
            const float nrm = sqrtf(wave_sum_fast(kk * kk));
            kk = kk / fmaxf(nrm, 1e-12f);
            const float ka = kk * a, kp = k * (1.f + (a - 1.f) * kaw);
            const float c1 = wave_sum_fast(ka * r), c2 = wave_sum_fast(kp * r);
            float* w = wsm + t * 400;
            w[lane] = kk; w[64 + lane] = d; w[128 + lane] = ka; w[192 + lane] = kp; w[256 + lane] = d * r; w[320 + lane] = v;
            if (lane == 0) { w[384] = c1; w[385] = c2; }
        }
    }
    float S[64];
    {
        const float* srow = p.st_S + ((size_t)(sb * 8 + h) * 64 + lane) * 64;
#pragma unroll
        for (int q = 0; q < 16; ++q) { const float4 v = *(const float4*)(srow + q * 4); S[4 * q] = v.x; S[4 * q + 1] = v.y; S[4 * q + 2] = v.z; S[4 * q + 3] = v.w; }
    }
    wave_lds_fence();
#pragma unroll 1
    for (int t = 0; t < 8; ++t) {
        const float* w = wsm + t * 400;
        float p1 = 0.f, p2 = 0.f;
#pragma unroll
        for (int q = 0; q < 16; ++q) {
            const float4 k4 = *(const float4*)(w + q * 4), r4 = *(const float4*)(w + 256 + q * 4);
            p1 += S[4 * q] * k4.x + S[4 * q + 1] * k4.y + S[4 * q + 2] * k4.z + S[4 * q + 3] * k4.w;
            p2 += S[4 * q] * r4.x + S[4 * q + 1] * r4.y + S[4 * q + 2] * r4.z + S[4 * q + 3] * r4.w;
        }
        const float vi = w[320 + lane];
        const float y = p2 - p1 * w[384] + vi * w[385];
#pragma unroll
        for (int q = 0; q < 16; ++q) {
            const float4 d4 = *(const float4*)(w + 64 + q * 4), a4 = *(const float4*)(w + 128 + q * 4), k4 = *(const float4*)(w + 192 + q * 4);
            S[4 * q] = S[4 * q] * d4.x + vi * k4.x - p1 * a4.x;
            S[4 * q + 1] = S[4 * q + 1] * d4.y + vi * k4.y - p1 * a4.y;
            S[4 * q + 2] = S[4 * q + 2] * d4.z + vi * k4.z - p1 * a4.z;
            S[4 * q + 3] = S[4 * q + 3] * d4.w + vi * k4.w - p1 * a4.w;
        }
        p.Yraw[(size_t)(m0 + t) * 512 + hj] = f2bf(y);
    }
    {
        float* o = p.out + O_SS + ((size_t)(sb * 8 + h) * 64 + lane) * 64;
#pragma unroll
        for (int q = 0; q < 16; ++q) { float4 v; v.x = S[4 * q]; v.y = S[4 * q + 1]; v.z = S[4 * q + 2]; v.w = S[4 * q + 3]; *(float4*)(o + q * 4) = v; }
    }
    wave_lds_fence();
}

__device__ void mlstm_sample_wave(const Params& p, int sb, int h, float* wsm) {
    const int lane = otid() & 63;
    const int qc = h * 64 + lane;
    const int m0 = M_P + sb * 8;
    float gi = 0.f, gl = 0.f;
    {
        float xq[11], xk[11];
#pragma unroll
        for (int r = 0; r < 3; ++r) { const float* st = p.st_conv + ((size_t)sb * 3 + r) * 1024 + qc; xq[r] = st[0]; xk[r] = st[512]; }
#pragma unroll
        for (int t = 0; t < 8; ++t) { const bf16_t* pr = p.P + (size_t)(m0 + t) * NP + C_QK + qc; xq[3 + t] = bf2f(pr[0]); xk[3 + t] = bf2f(pr[512]); }
#pragma unroll
        for (int t = 0; t < 8; ++t) {
            const bf16_t* pr = p.P + (size_t)(m0 + t) * NP;
            wsm[1024 + t * 64 + lane] = bf2f(pr[C_VB + qc]); wsm[1536 + t * 64 + lane] = bf2f(pr[C_OB + qc]); wsm[2048 + t * 64 + lane] = bf2f(pr[C_ZB + qc]);
        }
        if (lane < 8) {
            const bf16_t* pr = p.P + (size_t)(m0 + lane) * NP;
            gi = bf2f(pr[C_IB + h]) + p.b_i[h];
            const float f = bf2f(pr[C_FB + h]) + p.b_f[h];
            gl = f > 0.f ? -log1pf(__expf(-f)) : f - log1pf(__expf(f));
        }
        const float cwq0 = p.conv_w[qc], cwq1 = p.conv_w[1024 + qc], cwq2 = p.conv_w[2048 + qc], cwq3 = p.conv_w[3072 + qc];
        const float cwk0 = p.conv_w[512 + qc], cwk1 = p.conv_w[1536 + qc], cwk2 = p.conv_w[2560 + qc], cwk3 = p.conv_w[3584 + qc];
        const float cbq = p.conv_b[qc], cbk = p.conv_b[512 + qc];
#pragma unroll
        for (int t = 0; t < 8; ++t) {
            wsm[t * 64 + lane] = silu(cbq + xq[t] * cwq0 + xq[t + 1] * cwq1 + xq[t + 2] * cwq2 + xq[t + 3] * cwq3);
            wsm[512 + t * 64 + lane] = silu(cbk + xk[t] * cwk0 + xk[t + 1] * cwk1 + xk[t + 2] * cwk2 + xk[t + 3] * cwk3) * 0.125f;
        }
    }
    const float gnw = p.gn_w[qc];
    float C[64];
    {
        const float* crow = p.st_C + ((size_t)(sb * 8 + h) * 64 + lane) * 64;
#pragma unroll
        for (int q = 0; q < 16; ++q) { const float4 v = *(const float4*)(crow + q * 4); C[4 * q] = v.x; C[4 * q + 1] = v.y; C[4 * q + 2] = v.z; C[4 * q + 3] = v.w; }
    }
    float nl = p.st_n[(size_t)(sb * 8 + h) * 64 + lane];
    float m = p.st_m[sb * 8 + h];
    wave_lds_fence();
#pragma unroll 1
    for (int t = 0; t < 8; ++t) {
        const float it = rdlane(gi, t), lf = rdlane(gl, t);
        const float mt = fmaxf(lf + m, it);
        const float fdec = __expf(lf + m - mt), iw = __expf(it - mt);
        m = mt;
        const float ql = wsm[t * 64 + lane], kl = wsm[512 + t * 64 + lane];
        nl = fdec * nl + iw * kl;
        const float den = wave_sum_fast(nl * ql);
        const float ai = iw * wsm[1024 + t * 64 + lane];
        float num = 0.f;
#pragma unroll
        for (int q = 0; q < 16; ++q) {
            const float4 k4 = *(const float4*)(wsm + 512 + t * 64 + q * 4), q4 = *(const float4*)(wsm + t * 64 + q * 4);
            C[4 * q] = fdec * C[4 * q] + ai * k4.x; C[4 * q + 1] = fdec * C[4 * q + 1] + ai * k4.y;
            C[4 * q + 2] = fdec * C[4 * q + 2] + ai * k4.z; C[4 * q + 3] = fdec * C[4 * q + 3] + ai * k4.w;
            num += C[4 * q] * q4.x + C[4 * q + 1] * q4.y + C[4 * q + 2] * q4.z + C[4 * q + 3] * q4.w;
        }
        const float hv = num / fmaxf(fabsf(den), __expf(-mt));
        const float ms = wave_sum_fast(hv * hv) * (1.f / 64.f);
        p.P[(size_t)(m0 + t) * NP + C_OB + qc] = f2bf(sigm(wsm[1536 + t * 64 + lane]) * hv * rsqrtf(ms + 1e-6f) * gnw * silu(wsm[2048 + t * 64 + lane]));
    }
    {
        float* o = p.out + O_SC + ((size_t)(sb * 8 + h) * 64 + lane) * 64;
#pragma unroll
        for (int q = 0; q < 16; ++q) { float4 v; v.x = C[4 * q]; v.y = C[4 * q + 1]; v.z = C[4 * q + 2]; v.w = C[4 * q + 3]; *(float4*)(o + q * 4) = v; }
        p.out[O_SN + (size_t)(sb * 8 + h) * 64 + lane] = nl;
        if (lane == 0) p.out[O_SM + sb * 8 + h] = m;
    }
    wave_lds_fence();
}

__device__ void gemm1_unit(const Params& p, float* sm, int j);
__device__ void phaseE(const Params& p, float* sm, int bid, int nb) {
    constexpr int N_RP = 192, N_MP = 64, N_RS = 128, N_MS = 128, N_GU = 68 * 27 - 7 * 256;
    int* s_item = (int*)(sm + 32768);
    for (;;) {
        if (otid() == 0) *s_item = (int)atomicAdd(p.ctr, 1u);
        __syncthreads();
        const int it = *s_item;
        __syncthreads();
        if (it >= N_RP + N_MP + N_RS + N_MS + N_GU) break;
        if (it < N_RP) { rwkv_item(p, it / 24, (it / 3) & 7, it % 3, sm); }
        else if (it < N_RP + N_MP) { const int i = it - N_RP; mlstm_prompt(p, i >> 3, i & 7, sm); }
        else if (it < N_RP + N_MP + N_RS) { const int wid = otid() >> 6; const int i = (it - N_RP - N_MP) * 8 + wid; rwkv_sample_wave(p, i >> 3, i & 7, sm + wid * 3328); }
        else if (it < N_RP + N_MP + N_RS + N_MS) { const int wid = otid() >> 6; const int i = (it - N_RP - N_MP - N_RS) * 8 + wid; mlstm_sample_wave(p, i >> 3, i & 7, sm + wid * 3328); }
        else { gemm1_unit(p, sm, it - N_RP - N_MP - N_RS - N_MS); }
    }
}

__device__ void phaseF(const Params& p, int bid, int nb) {
    const int wid = otid() >> 6, lane = otid() & 63;
    const int c8 = lane * 8;
    float lnw[8], lnb[8], mur[8], muk[8], muv[8], kaw[8], rkw[8];
#pragma unroll
    for (int i = 0; i < 8; ++i) {
        lnw[i] = p.ln_w[c8 + i]; lnb[i] = p.ln_b[c8 + i]; mur[i] = p.mu_shift[C_R + c8 + i]; muk[i] = p.mu_shift[C_K + c8 + i];
        muv[i] = p.mu_shift[C_V + c8 + i]; kaw[i] = p.k_a[c8 + i]; rkw[i] = p.r_k[c8 + i];
    }
    auto un8 = [](const uint4 u, float* o) {
        o[0] = __uint_as_float(u.x << 16); o[1] = __uint_as_float(u.x & 0xFFFF0000u); o[2] = __uint_as_float(u.y << 16); o[3] = __uint_as_float(u.y & 0xFFFF0000u);
        o[4] = __uint_as_float(u.z << 16); o[5] = __uint_as_float(u.z & 0xFFFF0000u); o[6] = __uint_as_float(u.w << 16); o[7] = __uint_as_float(u.w & 0xFFFF0000u);
    };
    for (int m = bid * 8 + wid; m < M_TOT; m += nb * 8) {
        int s, t; tok_info(m, s, t);
        const bf16_t* pr = p.P + (size_t)m * NP + c8;
        const uint4 uy = *(const uint4*)(p.Yraw + (size_t)m * 512 + c8);
        const uint4 ur = *(const uint4*)(pr + C_R), uk = *(const uint4*)(pr + C_K), uv = *(const uint4*)(pr + C_V), uz = *(const uint4*)(pr + C_ZA);
        const uint4 ua = *(const uint4*)(p.Aa + (size_t)m * 512 + c8);
        float y[8], r[8], k[8], v[8], z[8], a[8], rp[8], kp_[8], vp[8];
        if (t > 0) {
            const uint4 urp = *(const uint4*)(pr + C_R - NP), ukp = *(const uint4*)(pr + C_K - NP), uvp = *(const uint4*)(pr + C_V - NP);
            un8(urp, rp); un8(ukp, kp_); un8(uvp, vp);
        } else if (s >= 8) {
            const float* st = p.st_shift + (size_t)(s - 8) * SHIFT_W + c8;
#pragma unroll
            for (int i = 0; i < 8; ++i) { rp[i] = st[C_R + i]; kp_[i] = st[C_K + i]; vp[i] = st[C_V + i]; }
        } else {
#pragma unroll
            for (int i = 0; i < 8; ++i) { rp[i] = 0.f; kp_[i] = 0.f; vp[i] = 0.f; }
        }
        un8(uy, y); un8(ur, r); un8(uk, k); un8(uv, v); un8(uz, z); un8(ua, a);
        float sy = 0.f;
#pragma unroll
        for (int i = 0; i < 8; ++i) sy += y[i];
        const float mean = sum8(sy) * (1.f / 64.f);
        float sv = 0.f, sbn = 0.f;
#pragma unroll
        for (int i = 0; i < 8; ++i) {
            y[i] -= mean; sv += y[i] * y[i];
            r[i] += mur[i] * (rp[i] - r[i]); k[i] += muk[i] * (kp_[i] - k[i]); v[i] += muv[i] * (vp[i] - v[i]);
            sbn += r[i] * (k[i] * (1.f + (a[i] - 1.f) * kaw[i])) * rkw[i];
        }
        const float rstd = rsqrtf(sum8(sv) * (1.f / 64.f) + 64e-5f);
        const float bonus = sum8(sbn);
        float o[8];
#pragma unroll
        for (int i = 0; i < 8; ++i) o[i] = (y[i] * rstd * lnw[i] + lnb[i] + bonus * v[i]) * silu(z[i]);
        uint4 ou; ou.x = pk2(o[0], o[1]); ou.y = pk2(o[2], o[3]); ou.z = pk2(o[4], o[5]); ou.w = pk2(o[6], o[7]);
        *(uint4*)(p.OutA + (size_t)m * 512 + c8) = ou;
    }
}

__device__ __forceinline__ void yrow_store(const Params& p, float* yr, int lane, const float4 (&v)[4], float rstd) {
#pragma unroll
    for (int i = 0; i < 4; ++i) {
        const int c = i * 256 + lane * 4;
        const float4 g = *(const float4*)(p.g_final + c);
        float4 o; o.x = v[i].x * rstd * g.x; o.y = v[i].y * rstd * g.y; o.z = v[i].z * rstd * g.z; o.w = v[i].w * rstd * g.w;
        *(float4*)(yr + c) = o;
    }
}
__device__ void phaseI(const Params& p, int bid, int nb) {
    const int wid = otid() >> 6, lane = otid() & 63;
    const int stride = nb * 8;
    for (int m = bid * 8 + wid; m < M_TOT; m += 2 * stride) {
        const int m2 = m + stride;
        const bool has2 = m2 < M_TOT;
        float* ya = p.out + (size_t)m * 1024;
        float* yb = p.out + (size_t)(has2 ? m2 : m) * 1024;
        float4 va[4], vb[4];
        normrow_load(ya, lane, va);
        normrow_load(yb, lane, vb);
        const float ra = rsqrtf(wave_sum(sumsq4(va)) * (1.f / 1024.f) + 1e-6f);
        const float rb = rsqrtf(wave_sum(sumsq4(vb)) * (1.f / 1024.f) + 1e-6f);
        yrow_store(p, ya, lane, va, ra);
        if (has2) yrow_store(p, yb, lane, vb, rb);
    }
}

namespace pg8 {
#define PG8_LAS __attribute__((address_space(3)))
typedef unsigned short bf16_t;
typedef short bf16x8 __attribute__((ext_vector_type(8)));
typedef float f32x4 __attribute__((ext_vector_type(4)));
typedef unsigned u32x4 __attribute__((ext_vector_type(4)));
constexpr int BM = 256, BK = 64, HALF = 128, HTB = HALF * BK * 2  , STAGE_BYTES = 8 * HTB, NXCD = 8, WGM = 8;

__host__ __device__ __forceinline__ int lds_byte(int r, int c) { const int st = (r >> 4) * 2 + (c >> 5), rr = r & 15, cc = c & 31, ob = rr * 64 + cc * 2; return st * 1024 + (ob ^ (((ob >> 9) & 1) << 5)); }
__host__ __device__ __forceinline__ void stage_rc(int b, int& R, int& C) { const int st = b / 1024, sb = b % 1024, swz = sb ^ (((sb >> 9) & 1) << 5); R = (st >> 1) * 16 + swz / 64; C = (st & 1) * 32 + (swz % 64) / 2; }
__host__ __device__ __forceinline__ int perm32(int rho) { const int n = rho >> 4, i = rho & 15; return 8 * (i >> 2) + 4 * n + (i & 3); }

struct Unit { int pm, pn; };
struct Gemm { const bf16_t* A; const bf16_t* Bt; int M, N, K, lda, ldb; };

struct StaticOrder {
    int nM, nN, nwg, G, c;
    __host__ __device__ void init(int M, int N, int G_, int c_) { nM = M / BM; nN = N / BM; nwg = nM * nN; G = G_; c = c_; }
    __host__ __device__ bool next(int i, Unit& u) const {
        const long L = (long)i * G + c; if (L >= nwg) return false;
        int wgid = (int)L; { const int q = nwg / NXCD, r = nwg % NXCD, xcd = wgid % NXCD, off = wgid / NXCD; wgid = (xcd < r ? xcd * (q + 1) : r * (q + 1) + (xcd - r) * q) + off; }
        const int nig = WGM * nN, gid = wgid / nig, fm = gid * WGM, gsz = (nM - fm) < WGM ? (nM - fm) : WGM;
        u.pm = fm + ((wgid % nig) % gsz); u.pn = (wgid % nig) / gsz; return true;
    }
    __device__ __forceinline__ void a_ready(const Unit&) const {}
    __device__ __forceinline__ void done(const Unit&) const {}
};
template <class Epi, class Sched, bool STAMP = false>
__device__ __forceinline__ void gemm_phase(PG8_LAS unsigned char* lds, const Gemm g, const Sched& S, const Epi& E, unsigned long long* stamps) {
    const int tid = otid(), wid = __builtin_amdgcn_readfirstlane(tid >> 6), lane = tid & 63, wr = wid >> 2, wc = wid & 3, fr = lane & 15, fq = lane >> 4;
    const int K = g.K, nt = K / BK;
    int ts_lo = 0, ts_hi = 0, nts = 0; const unsigned long long rt_entry = STAMP ? (unsigned long long)wall_clock64() : 0ull;
#define PG8_STAMP() do { if (STAMP && wid == 0 && nts < 64) { const unsigned long long _c = (unsigned long long)clock64(); \
        ts_lo = (lane == nts) ? (int)(unsigned)_c : ts_lo; ts_hi = (lane == nts) ? (int)(unsigned)(_c >> 32) : ts_hi; ++nts; } } while (0)
    PG8_STAMP();
    unsigned voffA[2], voffB[2];
#pragma unroll
    for (int i = 0; i < 2; ++i) { int R, C; stage_rc(tid * 16 + i * 8192, R, C); const int Rb = Epi::PERM ? ((R & ~31) + perm32(R & 31)) : R;
        voffA[i] = (unsigned)(R * g.lda + C) * 2u; voffB[i] = (unsigned)(Rb * g.ldb + C) * 2u; }
    const size_t kstep = (size_t)(BK * 2);
    const size_t hstepA = (size_t)HALF * g.lda * 2, hstepB = (size_t)HALF * g.ldb * 2;
    const size_t tstepA = 2 * hstepA, tstepB = 2 * hstepB;
    const unsigned ldsw = (unsigned)wid * 1024u;
    const int aoff = lds_byte(wr * 64 + fr, fq * 8), boff = lds_byte(wc * 32 + fr, fq * 8);
#define PG8_SA(b, h) (((b) * 2 + (h)) * HTB)
#define PG8_SB(b, h) ((4 + (b) * 2 + (h)) * HTB)
#define PG8_STAGE(bufoff, gbase, voff) do { _Pragma("unroll") for (int _i = 0; _i < 2; ++_i) \
        __builtin_amdgcn_global_load_lds((const unsigned*)((const char*)(gbase) + (voff)[_i]), (PG8_LAS unsigned*)(lds + (bufoff) + ldsw + _i * 8192), 16, 0, 0); } while (0)
#define PG8_LDA(dst, b, h) do { _Pragma("unroll") for (int m = 0; m < 4; ++m) _Pragma("unroll") for (int k = 0; k < 2; ++k) dst[m][k] = *(const PG8_LAS bf16x8*)(lds + PG8_SA(b, h) + aoff + m * 2048 + k * 1024); } while (0)
#define PG8_LDB(dst, b, h) do { _Pragma("unroll") for (int n = 0; n < 2; ++n) _Pragma("unroll") for (int k = 0; k < 2; ++k) dst[n][k] = *(const PG8_LAS bf16x8*)(lds + PG8_SB(b, h) + boff + n * 2048 + k * 1024); } while (0)
#define PG8_MMA(ai, bj, At, Bt) do { __builtin_amdgcn_s_setprio(1); _Pragma("unroll") for (int m = 0; m < 4; ++m) _Pragma("unroll") for (int n = 0; n < 2; ++n) _Pragma("unroll") for (int k = 0; k < 2; ++k) \
        acc[ai][bj][m][n] = __builtin_amdgcn_mfma_f32_16x16x32_bf16(Bt[n][k], At[m][k], acc[ai][bj][m][n], 0, 0, 0); __builtin_amdgcn_s_setprio(0); } while (0)
#define PG8_WAIT_V(n) asm volatile("s_waitcnt vmcnt(" #n ")" ::: "memory")
#define PG8_WAIT_L(n) asm volatile("s_waitcnt lgkmcnt(" #n ")" ::: "memory")
#define PG8_BAR __builtin_amdgcn_s_barrier()
#define PG8_SCHED __builtin_amdgcn_sched_barrier(0)
    Unit cur, nxt; int ui = 0;
    if (!S.next(0, cur)) return;
    f32x4 acc[2][2][4][2];
#pragma unroll
    for (int a = 0; a < 2; ++a)
#pragma unroll
        for (int b = 0; b < 2; ++b)
#pragma unroll
            for (int m = 0; m < 4; ++m)
#pragma unroll
                for (int n = 0; n < 2; ++n) acc[a][b][m][n] = (f32x4){0.f, 0.f, 0.f, 0.f};
    bf16x8 At[4][2], B0[2][2], B1[2][2];
    const char* cA = (const char*)g.A + (size_t)cur.pm * tstepA; const char* cB = (const char*)g.Bt + (size_t)cur.pn * tstepB;
    S.a_ready(cur);
    PG8_STAGE(PG8_SB(0, 0), cB, voffB); PG8_STAGE(PG8_SA(0, 0), cA, voffA); PG8_STAGE(PG8_SB(0, 1), cB + hstepB, voffB); PG8_STAGE(PG8_SA(0, 1), cA + hstepA, voffA);
    if (wr == 1) PG8_BAR;
    PG8_WAIT_V(4); PG8_BAR;
    PG8_STAGE(PG8_SB(1, 0), cB + kstep, voffB); PG8_STAGE(PG8_SA(1, 0), cA + kstep, voffA); PG8_STAGE(PG8_SB(1, 1), cB + hstepB + kstep, voffB);
    PG8_WAIT_V(6); PG8_BAR;
    PG8_STAMP();
    for (;;) {
        const bool has_next = S.next(ui + 1, nxt);
        const char* nA = has_next ? (const char*)g.A + (size_t)nxt.pm * tstepA : cA; const char* nB = has_next ? (const char*)g.Bt + (size_t)nxt.pn * tstepB : cB;
        for (int t = 0; t < nt; t += 2) {
            const bool last = (t == nt - 2);
            const char* a1 = cA + (size_t)(t + 1) * kstep;
            const char* a2 = last ? nA : cA + (size_t)(t + 2) * kstep; const char* b2 = last ? nB : cB + (size_t)(t + 2) * kstep;
            const char* a3 = a2 + kstep; const char* b3 = b2 + kstep;
            if (last && has_next) S.a_ready(nxt);
            PG8_LDB(B0, 0, 0); PG8_SCHED; PG8_LDA(At, 0, 0); PG8_STAGE(PG8_SA(1, 1), a1 + hstepA, voffA);
            PG8_WAIT_L(8); PG8_BAR; PG8_WAIT_L(0); PG8_MMA(0, 0, At, B0); PG8_BAR; PG8_SCHED;
            PG8_LDB(B1, 0, 1); PG8_STAGE(PG8_SB(0, 0), b2, voffB);
            PG8_BAR; PG8_WAIT_L(0); PG8_MMA(0, 1, At, B1); PG8_BAR;
            PG8_LDA(At, 0, 1); PG8_STAGE(PG8_SA(0, 0), a2, voffA);
            PG8_BAR; PG8_WAIT_L(0); PG8_MMA(1, 0, At, B0); PG8_BAR; PG8_SCHED;
            PG8_STAGE(PG8_SB(0, 1), b2 + hstepB, voffB);
            PG8_WAIT_V(6); PG8_BAR; PG8_MMA(1, 1, At, B1); PG8_BAR;
            PG8_LDB(B0, 1, 0); PG8_SCHED; PG8_LDA(At, 1, 0); PG8_STAGE(PG8_SA(0, 1), a2 + hstepA, voffA);
            PG8_WAIT_L(8); PG8_BAR; PG8_WAIT_L(0); PG8_MMA(0, 0, At, B0); PG8_BAR; PG8_SCHED;
            PG8_LDB(B1, 1, 1); PG8_STAGE(PG8_SB(1, 0), b3, voffB);
            PG8_BAR; PG8_WAIT_L(0); PG8_MMA(0, 1, At, B1); PG8_BAR;
            PG8_LDA(At, 1, 1); PG8_STAGE(PG8_SA(1, 0), a3, voffA);
            PG8_BAR; PG8_WAIT_L(0); PG8_MMA(1, 0, At, B0); PG8_BAR; PG8_SCHED;
            PG8_STAGE(PG8_SB(1, 1), b3 + hstepB, voffB);
            PG8_WAIT_V(6); PG8_BAR; PG8_MMA(1, 1, At, B1); PG8_BAR;
        }
        PG8_STAMP();
        if constexpr (!Epi::AFTER_DRAIN) { E(acc, cur, wr, wc, fr, fq); S.done(cur); }
        PG8_STAMP();
        if (!has_next) break;
#pragma unroll
        for (int a = 0; a < 2; ++a)
#pragma unroll
            for (int b = 0; b < 2; ++b)
#pragma unroll
                for (int m = 0; m < 4; ++m)
#pragma unroll
                    for (int n = 0; n < 2; ++n) acc[a][b][m][n] = (f32x4){0.f, 0.f, 0.f, 0.f};
        cur = nxt; cA = nA; cB = nB; ++ui;
    }
    PG8_WAIT_V(0);
    if (wr == 0) PG8_BAR;
    PG8_BAR;
    if constexpr (Epi::AFTER_DRAIN) { E.fused(acc, cur, wr, wc, fr, fq, lds, wid, lane); S.done(cur); }
    PG8_STAMP();
    if (STAMP && wid == 0) { stamps[lane] = lane < nts ? (((unsigned long long)(unsigned)ts_hi << 32) | (unsigned)ts_lo) : 0ull;
        if (lane == 62) stamps[62] = rt_entry; if (lane == 63) stamps[63] = (unsigned long long)wall_clock64(); }
#undef PG8_STAMP
#undef PG8_SA
#undef PG8_SB
#undef PG8_STAGE
#undef PG8_LDA
#undef PG8_LDB
#undef PG8_MMA
#undef PG8_WAIT_V
#undef PG8_WAIT_L
#undef PG8_BAR
#undef PG8_SCHED
}
}

struct EpiP {
    static constexpr bool PERM = true, AFTER_DRAIN = false;
    bf16_t* O; int ldc;
    __device__ __forceinline__ void operator()(const f32x4 (&acc)[2][2][4][2], const pg8::Unit& u, int wr, int wc, int fr, int fq) const {
        const int row0 = u.pm * 256 + wr * 64 + fr, col0 = u.pn * 256 + wc * 32 + 8 * fq;
#pragma unroll
        for (int ai = 0; ai < 2; ++ai)
#pragma unroll
            for (int m = 0; m < 4; ++m) {
                bf16_t* rowp = O + (size_t)(row0 + ai * 128 + m * 16) * ldc + col0;
#pragma unroll
                for (int bj = 0; bj < 2; ++bj) {
                    const f32x4 v0 = acc[ai][bj][m][0], v1 = acc[ai][bj][m][1];
                    uint4 o; o.x = pk2(v0[0], v0[1]); o.y = pk2(v0[2], v0[3]); o.z = pk2(v1[0], v1[1]); o.w = pk2(v1[2], v1[3]);
                    *(uint4*)(rowp + bj * 128) = o;
                }
            }
    }
};
template <int SECOND> struct EpiMerge {
    static constexpr bool PERM = true, AFTER_DRAIN = false;
    bf16_t* P; int gcol;
    __device__ __forceinline__ void operator()(const f32x4 (&acc)[2][2][4][2], const pg8::Unit& u, int wr, int wc, int fr, int fq) const {
        const int row0 = u.pm * 256 + wr * 64 + fr, col0 = u.pn * 256 + wc * 32 + 8 * fq;
#pragma unroll
        for (int ai = 0; ai < 2; ++ai)
#pragma unroll
            for (int m = 0; m < 4; ++m) {
                bf16_t* rowp = P + (size_t)(row0 + ai * 128 + m * 16) * NP + col0;
#pragma unroll
                for (int bj = 0; bj < 2; ++bj) {
                    const f32x4 v0 = acc[ai][bj][m][0], v1 = acc[ai][bj][m][1];
                    const uint4 g = *(const uint4*)(rowp + gcol + bj * 128);
                    const float4 ga = unpk4(make_uint2(g.x, g.y)), gb = unpk4(make_uint2(g.z, g.w));
                    float r[8] = {sigm(ga.x) * v0[0], sigm(ga.y) * v0[1], sigm(ga.z) * v0[2], sigm(ga.w) * v0[3],
                                  sigm(gb.x) * v1[0], sigm(gb.y) * v1[1], sigm(gb.z) * v1[2], sigm(gb.w) * v1[3]};
                    if (SECOND) {
                        const uint4 pv = *(const uint4*)(rowp + bj * 128);
                        const float4 pa = unpk4(make_uint2(pv.x, pv.y)), pb = unpk4(make_uint2(pv.z, pv.w));
                        r[0] += pa.x; r[1] += pa.y; r[2] += pa.z; r[3] += pa.w; r[4] += pb.x; r[5] += pb.y; r[6] += pb.z; r[7] += pb.w;
                    }
                    uint4 o; o.x = pk2(r[0], r[1]); o.y = pk2(r[2], r[3]); o.z = pk2(r[4], r[5]); o.w = pk2(r[6], r[7]);
                    *(uint4*)(rowp + bj * 128) = o;
                }
            }
    }
};
struct EpiOut {
    static constexpr bool PERM = false, AFTER_DRAIN = false;
    const Params* pp;
    __device__ __forceinline__ void operator()(const f32x4 (&acc)[2][2][4][2], const pg8::Unit& u, int wr, int wc, int fr, int fq) const {
        const Params& p = *pp;
        const int row0 = u.pm * 256 + wr * 64 + fr, col0 = u.pn * 256 + wc * 32 + 4 * fq;
#pragma unroll
        for (int ai = 0; ai < 2; ++ai)
#pragma unroll
            for (int m = 0; m < 4; ++m) {
                const int row = row0 + ai * 128 + m * 16;
                int s, t; tok_info(row, s, t);
                const float* xr = xrow(p, row) + col0;
                const float* gt = p.mod + (size_t)s * 3072 + 2048 + col0;
                float* orow = p.out + (size_t)row * 1024 + col0;
#pragma unroll
                for (int bj = 0; bj < 2; ++bj)
#pragma unroll
                    for (int n = 0; n < 2; ++n) {
                        const int co = bj * 128 + n * 16;
                        const float4 xv = *(const float4*)(xr + co), gv = *(const float4*)(gt + co);
                        const f32x4 a = acc[ai][bj][m][n];
                        float4 o; o.x = xv.x + gv.x * a[0]; o.y = xv.y + gv.y * a[1]; o.z = xv.z + gv.z * a[2]; o.w = xv.w + gv.w * a[3];
                        *(float4*)(orow + co) = o;
                    }
            }
    }
};
template <class Epi> __device__ __forceinline__ void run_gemm(float* sm, const bf16_t* A, int lda, const bf16_t* Bt, int ldb, int M, int N, int K, const Epi& E, int bid, int nb) {
    pg8::Gemm g; g.A = A; g.Bt = Bt; g.M = M; g.N = N; g.K = K; g.lda = lda; g.ldb = ldb;
    pg8::StaticOrder S; S.init(M, N, nb, bid);
    pg8::gemm_phase<Epi, pg8::StaticOrder, false>((PG8_LAS unsigned char*)sm, g, S, E, nullptr);
}
constexpr int C_MAIN = 68 * 25, C_UNITS = 7 * 256, E_GEMM_UNITS = 68 * 27 - C_UNITS;
struct OrderC {
    pg8::StaticOrder so;
    __device__ void init(int G, int c) { so.init(M_TOT, 25 * 256, G, c); }
    __device__ bool next(int i, pg8::Unit& u) const {
        const long L = (long)i * so.G + so.c;
        if (L < C_MAIN) { so.next(i, u); return true; }
        if (L >= C_UNITS) return false;
        const int j = (int)(L - C_MAIN);
        if (j < 58) { u.pn = 25; u.pm = j < 34 ? j : j + 10; } else { u.pn = 26; u.pm = j - 58; }
        return true;
    }
    __device__ __forceinline__ void a_ready(const pg8::Unit&) const {}
    __device__ __forceinline__ void done(const pg8::Unit&) const {}
};
struct OneUnit {
    int pm, pn;
    __device__ bool next(int i, pg8::Unit& u) const { if (i) return false; u.pm = pm; u.pn = pn; return true; }
    __device__ __forceinline__ void a_ready(const pg8::Unit&) const {}
    __device__ __forceinline__ void done(const pg8::Unit&) const {}
};
__device__ void phaseC(const Params& p, float* sm, int bid, int nb) {
    EpiP E; E.O = p.P; E.ldc = NP;
    pg8::Gemm g; g.A = p.H; g.Bt = p.WinT; g.M = M_TOT; g.N = NP; g.K = 1024; g.lda = 1024; g.ldb = 1024;
    OrderC S; S.init(nb, bid);
    pg8::gemm_phase<EpiP, OrderC, false>((PG8_LAS unsigned char*)sm, g, S, E, nullptr);
}
__device__ void gemm1_unit(const Params& p, float* sm, int j) {
    EpiP E; E.O = p.P; E.ldc = NP;
    pg8::Gemm g; g.A = p.H; g.Bt = p.WinT; g.M = M_TOT; g.N = NP; g.K = 1024; g.lda = 1024; g.ldb = 1024;
    OneUnit S;
    if (j < 34) { S.pm = 34 + j; S.pn = 26; } else { S.pm = j; S.pn = 25; }
    pg8::gemm_phase<EpiP, OneUnit, false>((PG8_LAS unsigned char*)sm, g, S, E, nullptr);
}
__device__ void phaseG(const Params& p, float* sm, int bid, int nb) {
    EpiMerge<0> E0; E0.P = p.P; E0.gcol = C_GLA;
    run_gemm(sm, p.OutA, 512, p.WupaT, 512, M_TOT, 1024, 512, E0, bid, nb);
    __syncthreads();
    EpiMerge<1> E1; E1.P = p.P; E1.gcol = C_GLB;
    run_gemm(sm, p.P + C_OB, NP, p.WupbT, 512, M_TOT, 1024, 512, E1, bid, nb);
}
__device__ void phaseH(const Params& p, float* sm, int bid, int nb) {
    EpiOut E; E.pp = &p;
    run_gemm(sm, p.P, NP, p.WoutT, 1024, M_TOT, 1024, 1024, E, bid, nb);
}

#define XB_TMO      128
#define XB_XCNT(j)  (256  + 64 * (j))
#define XB_XSUB(j)  (1280 + 64 * (j))
#define XB_XGEN(j)  (2304 + 64 * (j))
#define XB_TOP      3328
#define XB_TOPGEN   3392
#define XCD_BAR_WORDS 3456
#define XB_SPIN_CAP (1u << 18)
#define LAS __attribute__((address_space(3)))

__device__ __forceinline__ unsigned xb_ld(unsigned* p)              { return __hip_atomic_load(p, __ATOMIC_RELAXED, __HIP_MEMORY_SCOPE_AGENT); }
__device__ __forceinline__ unsigned xb_add(unsigned* p, unsigned v) { return __hip_atomic_fetch_add(p, v, __ATOMIC_RELAXED, __HIP_MEMORY_SCOPE_AGENT); }
__device__ __forceinline__ unsigned xb_xcc_id() { return (unsigned)__builtin_amdgcn_s_getreg((3 << 11) | 20) & 0xFu; }
#define XB_SPIN(cond, bar) do { unsigned _sp = 0; while (cond) { __builtin_amdgcn_s_sleep(1); \
    if ((++_sp & 255u) == 0u) { if (xb_ld(&(bar)[XB_TMO])) break; if (_sp > XB_SPIN_CAP) { atomicAdd(&(bar)[XB_TMO], 1u); break; } } } } while (0)

struct XcdBarrier {
    unsigned* bar; unsigned x;
    volatile LAS unsigned* st;
};

__device__ __forceinline__ XcdBarrier xcd_barrier_post(unsigned* bar, volatile LAS unsigned* st) {
    XcdBarrier b; b.bar = bar; b.x = xb_xcc_id(); b.st = st;
    if (threadIdx.x == 0) (void)xb_add(&bar[XB_XCNT(b.x)], 1u);
    return b;
}
__device__ __forceinline__ void xcd_barrier_complete(unsigned* bar, unsigned x, unsigned& nloc, unsigned& nx) {
    const unsigned G = gridDim.x * gridDim.y * gridDim.z;
    unsigned sum, cnt, mine, sp = 0u;
    for (;;) {
        sum = 0u; cnt = 0u; mine = 0u;
#pragma unroll
        for (unsigned j = 0; j < 16; ++j) { const unsigned c = xb_ld(&bar[XB_XCNT(j)]); sum += c; cnt += (c > 0u) ? 1u : 0u; mine = (j == x) ? c : mine; }
        if (sum == G) break;
        __builtin_amdgcn_s_sleep(1);
        if ((++sp & 255u) == 0u) { if (xb_ld(&bar[XB_TMO])) break; if (sp > XB_SPIN_CAP) { atomicAdd(&bar[XB_TMO], 1u); break; } }
    }
    nloc = mine > 0u ? mine : 1u; nx = cnt > 0u ? cnt : 1u;
}

__device__ __forceinline__ void xcd_barrier(const XcdBarrier& b) {
    asm volatile("s_waitcnt vmcnt(0)" ::: "memory");
    __syncthreads();
    if (threadIdx.x == 0) {
        unsigned* bar = b.bar;
        __builtin_amdgcn_s_waitcnt(0);
        unsigned nloc = b.st[0], nx = b.st[1];
        if (nloc == 0u) { xcd_barrier_complete(bar, b.x, nloc, nx); b.st[0] = nloc; b.st[1] = nx; }
        const unsigned old = xb_add(&bar[XB_XSUB(b.x)], 1u);
        const unsigned gen = old / nloc;
        if (old + 1u == (gen + 1u) * nloc) {
            __builtin_amdgcn_fence(__ATOMIC_RELEASE, "agent");
            asm volatile("s_waitcnt vmcnt(0)" ::: "memory");
            const unsigned og = xb_add(&bar[XB_TOP], 1u);
            const unsigned tg = og / nx;
            if (og + 1u == (tg + 1u) * nx) xb_add(&bar[XB_TOPGEN], 1u);
            else XB_SPIN(xb_ld(&bar[XB_TOPGEN]) == tg, bar);
            __builtin_amdgcn_fence(__ATOMIC_ACQUIRE, "agent");
            xb_add(&bar[XB_XGEN(b.x)], 1u);
            asm volatile("s_waitcnt vmcnt(0)" ::: "memory");
        } else {
            XB_SPIN(xb_ld(&bar[XB_XGEN(b.x)]) == gen, bar);
            __builtin_amdgcn_fence(__ATOMIC_ACQUIRE, "agent");
            asm volatile("s_waitcnt vmcnt(0)" ::: "memory");
        }
    }
    __syncthreads();
}


#if MK_MULTI
#define PHASE_KERNEL(NAME, CALL) __global__ void __launch_bounds__(NTHR) NAME(Params p) { __shared__ __attribute__((aligned(16))) float sm[SMEM_FLOATS]; const int bid = blockIdx.x, nb = gridDim.x; (void)sm; CALL; }
PHASE_KERNEL(kA, phaseA(p, sm, bid, nb))
PHASE_KERNEL(kB, phaseB(p, bid, nb))
PHASE_KERNEL(kC, phaseC(p, sm, bid, nb))
PHASE_KERNEL(kD, phaseD(p, sm, bid, nb))
PHASE_KERNEL(kE, phaseE(p, sm, bid, nb))
PHASE_KERNEL(kF, phaseF(p, bid, nb))
PHASE_KERNEL(kG, phaseG(p, sm, bid, nb))
PHASE_KERNEL(kH, phaseH(p, sm, bid, nb))
PHASE_KERNEL(kI, phaseI(p, bid, nb))
#else
__global__ void __launch_bounds__(NTHR) fwd_megakernel(Params p) {
    __shared__ __attribute__((aligned(16))) float sm[SMEM_FLOATS];
    __shared__ uint4 xb_words;
    cg::grid_group grid = cg::this_grid();
    const int bid = blockIdx.x, nb = gridDim.x;
    if (threadIdx.x == 0) xb_words = make_uint4(0u, 0u, 0u, 0u);
    __syncthreads();
    XcdBarrier xb = xcd_barrier_post(p.bar, (volatile LAS unsigned*)&xb_words);
    phaseA(p, sm, bid, nb); grid.sync();
    phaseB(p, bid, nb); xcd_barrier(xb);
    phaseC(p, sm, bid, nb); xcd_barrier(xb);
    phaseD(p, sm, bid, nb); xcd_barrier(xb);
    phaseE(p, sm, bid, nb); xcd_barrier(xb);
    phaseF(p, bid, nb); xcd_barrier(xb);
    phaseG(p, sm, bid, nb); xcd_barrier(xb);
    phaseH(p, sm, bid, nb); xcd_barrier(xb);
    phaseI(p, bid, nb);
}
#endif

extern "C" void kernel_launch(void* const* d_in, const int* in_sizes, int n_in, void* d_out, int out_size, void* d_ws, size_t ws_size,
                              hipStream_t stream) {
    Params p{};
    const float* const* in = (const float* const*)d_in;
    p.x_p = in[0]; p.x_s = in[1]; p.c_p = in[2]; p.c_s = in[3];
    p.st_shift = in[4]; p.st_S = in[5]; p.st_conv = in[6]; p.st_C = in[7]; p.st_n = in[8]; p.st_m = in[9];
    p.g_norm = in[10]; p.w_ada = in[11]; p.b_ada = in[12]; p.w_in = in[13]; p.mu_shift = in[14]; p.w_decay2 = in[15];
    p.w0 = in[16]; p.w_iclr2 = in[17]; p.a0 = in[18]; p.k_k = in[19]; p.k_a = in[20]; p.r_k = in[21];
    p.ln_w = in[22]; p.ln_b = in[23]; p.conv_w = in[24]; p.conv_b = in[25]; p.b_i = in[26]; p.b_f = in[27];
    p.gn_w = in[28]; p.w_up_a = in[29]; p.w_up_b = in[30]; p.w_out = in[31]; p.g_final = in[32];
    p.out = (float*)d_out;
    char* ws = (char*)d_ws;
    size_t off = 0;
    p.P = (bf16_t*)(ws + off); off += (size_t)M_TOT * NP * 2;
    p.WinT = (bf16_t*)(ws + off); off += (size_t)NP * 1024 * 2;
    p.WupaT = (bf16_t*)(ws + off); off += (size_t)1024 * 512 * 2;
    p.WupbT = (bf16_t*)(ws + off); off += (size_t)1024 * 512 * 2;
    p.WoutT = (bf16_t*)(ws + off); off += (size_t)1024 * 1024 * 2;
    p.mod = (float*)(ws + off); off += (size_t)NSEQ * 3072 * 4;
    p.ctr = (unsigned*)(ws + off); off += 256;
    p.bar = (unsigned*)(ws + off); off += (size_t)XCD_BAR_WORDS * 4;
    char* os = (char*)d_out;
    p.H = (bf16_t*)os;
    p.Yraw = (bf16_t*)os;
    p.OutB = (bf16_t*)(os + (size_t)M_TOT * 512 * 2);
    p.Omd = (bf16_t*)(os + (size_t)M_TOT * 1024 * 2);
    p.Aa = (bf16_t*)(os + (size_t)M_TOT * 1024 * 2 + (size_t)M_TOT * 512 * 2);
    p.OutA = p.Omd;
#if MK_MULTI
    const int G = 1024;
    kA<<<G, NTHR, 0, stream>>>(p);
    kB<<<G, NTHR, 0, stream>>>(p);
    kC<<<G, NTHR, 0, stream>>>(p);
    kD<<<G, NTHR, 0, stream>>>(p);
    kE<<<G, NTHR, 0, stream>>>(p);
    kF<<<G, NTHR, 0, stream>>>(p);
    kG<<<G, NTHR, 0, stream>>>(p);
    kH<<<G, NTHR, 0, stream>>>(p);
    kI<<<G, NTHR, 0, stream>>>(p);
#else
    static int grid_blocks = 0;
    if (!grid_blocks) {
        int dev = 0, cus = 0, per_cu = 0;
        hipGetDevice(&dev);
        hipDeviceGetAttribute(&cus, hipDeviceAttributeMultiprocessorCount, dev);
        hipOccupancyMaxActiveBlocksPerMultiprocessor(&per_cu, fwd_megakernel, NTHR, 0);
        if (per_cu > 1) per_cu = 1;
        grid_blocks = cus * per_cu;
    }
    (void)hipMemsetAsync(p.ctr, 0, 256 + (size_t)XCD_BAR_WORDS * 4, stream);
    void* args[] = {&p};
    hipError_t e = hipLaunchCooperativeKernel((void*)fwd_megakernel, dim3(grid_blocks), dim3(NTHR), args, 0, stream);
    if (e != hipSuccess) fprintf(stderr, "cooperative launch failed: %s (grid %d)\n", hipGetErrorString(e), grid_blocks);
#endif
}
```

```cpp
#include <hip/hip_runtime.h>
#include <hip/hip_cooperative_groups.h>
#include <cstdio>
namespace cg = cooperative_groups;

#ifndef MK_MULTI
#define MK_MULTI 0
#endif

typedef unsigned short bf16_t;
typedef short bf16x8 __attribute__((ext_vector_type(8)));
typedef float f32x4 __attribute__((ext_vector_type(4)));

constexpr int NTHR = 512;
constexpr int M_P = 16384, M_S = 1024, M_TOT = 17408;
constexpr int DM = 1024;
constexpr int NSEQ = 136;
constexpr int NP = 6912;
constexpr int N_IN = 6800;
constexpr int C_R = 0, C_K = 512, C_V = 1024, C_WL = 1536, C_AL = 1600, C_ZA = 1664, C_QK = 2176,
              C_VB = 3200, C_OB = 3712, C_IB = 4224, C_FB = 4232, C_ZB = 4240, C_GLA = 4752, C_GLB = 5776;
constexpr int SHIFT_W = 1664;

constexpr size_t O_Y = 0;
constexpr size_t O_PSHIFT = (size_t)M_TOT * DM;
constexpr size_t O_PS = O_PSHIFT + 8 * 1664;
constexpr size_t O_PCONV = O_PS + 8 * 8 * 4096;
constexpr size_t O_PC = O_PCONV + 8 * 3 * 1024;
constexpr size_t O_PN = O_PC + 8 * 8 * 4096;
constexpr size_t O_PM = O_PN + 8 * 8 * 64;
constexpr size_t O_SSHIFT = O_PM + 64;
constexpr size_t O_SS = O_SSHIFT + 128 * 1664;
constexpr size_t O_SCONV = O_SS + (size_t)128 * 8 * 4096;
constexpr size_t O_SC = O_SCONV + 128 * 3 * 1024;
constexpr size_t O_SN = O_SC + (size_t)128 * 8 * 4096;
constexpr size_t O_SM = O_SN + 128 * 8 * 64;
constexpr size_t O_END = O_SM + 1024;

struct Params {
    const float *x_p, *x_s, *c_p, *c_s;
    const float *st_shift, *st_S, *st_conv, *st_C, *st_n, *st_m;
    const float *g_norm, *w_ada, *b_ada, *w_in, *mu_shift, *w_decay2, *w0, *w_iclr2, *a0, *k_k, *k_a, *r_k,
        *ln_w, *ln_b, *conv_w, *conv_b, *b_i, *b_f, *gn_w, *w_up_a, *w_up_b, *w_out, *g_final;
    float* out;
    bf16_t *WinT, *WupaT, *WupbT, *WoutT;
    float* mod;
    bf16_t* P;
    bf16_t *H, *Yraw, *OutB, *Omd, *Aa, *OutA;
    unsigned* ctr;
    unsigned* bar;
};

constexpr int SMEM_FLOATS = 32768 + 64;
__device__ __forceinline__ int otid() { int t = (int)__builtin_amdgcn_workitem_id_x(); asm volatile("" : "+v"(t)); return t; }
__device__ __forceinline__ void lds_barrier() { asm volatile("s_waitcnt lgkmcnt(0)" ::: "memory"); __builtin_amdgcn_s_barrier(); asm volatile("" ::: "memory"); }
__device__ __forceinline__ float bf2f(bf16_t v) { return __uint_as_float(((unsigned)v) << 16); }
__device__ __forceinline__ bf16_t f2bf(float f) { unsigned u = __float_as_uint(f); u += 0x7FFFu + ((u >> 16) & 1u); return (bf16_t)(u >> 16); }
__device__ __forceinline__ unsigned pk2(float lo, float hi) { return (unsigned)f2bf(lo) | ((unsigned)f2bf(hi) << 16); }
__device__ __forceinline__ float sigm(float x) { return __builtin_amdgcn_rcpf(1.f + __expf(-x)); }
__device__ __forceinline__ float silu(float x) { return x * __builtin_amdgcn_rcpf(1.f + __expf(-x)); }
__device__ __forceinline__ float wave_sum(float v) {
#pragma unroll
    for (int o = 32; o; o >>= 1) v += __shfl_xor(v, o);
    return v;
}
template <int CTRL> __device__ __forceinline__ float dpp_mov(float v) {
    return __builtin_bit_cast(float, __builtin_amdgcn_update_dpp(0, __builtin_bit_cast(int, v), CTRL, 0xF, 0xF, true));
}
__device__ __forceinline__ float row16_sum(float v) {
    v += dpp_mov<0xB1>(v);
    v += dpp_mov<0x4E>(v);
    v += dpp_mov<0x141>(v);
    v += dpp_mov<0x140>(v);
    return v;
}
__device__ __forceinline__ void tok_info(int m, int& s, int& t) {
    if (m < M_P) { s = m >> 11; t = m & 2047; } else { int q = m - M_P; s = 8 + (q >> 3); t = q & 7; }
}
__device__ __forceinline__ const float* xrow(const Params& p, int m) {
    return m < M_P ? p.x_p + (size_t)m * DM : p.x_s + (size_t)(m - M_P) * DM;
}

__device__ __forceinline__ void tr8(const float* __restrict__ src, int Nsrc, bf16_t* __restrict__ dst, int K, int n, int kg) {
    float v[8];
    if (n < Nsrc) {
        const float* sp = src + (size_t)(kg * 8) * Nsrc + n;
#pragma unroll
        for (int i = 0; i < 8; ++i) v[i] = sp[(size_t)i * Nsrc];
    } else {
#pragma unroll
        for (int i = 0; i < 8; ++i) v[i] = 0.f;
    }
    uint4 o; o.x = pk2(v[0], v[1]); o.y = pk2(v[2], v[3]); o.z = pk2(v[4], v[5]); o.w = pk2(v[6], v[7]);
    *(uint4*)(dst + (size_t)n * K + kg * 8) = o;
}
__device__ void phaseA(const Params& p, float* sm, int bid, int nb) {
    const int tid = otid();
    if (bid == 0 && tid == 0) *p.ctr = 0u;
    constexpr int N_ADA = 48 * 17;
    for (int i = bid; i < N_ADA; i += nb) {
        const int ct = i % 48, rgp = i / 48;
        float* sc = sm;
        float* red = sm + 8192;
        {
            float cv[16];
#pragma unroll
            for (int q = 0; q < 16; ++q) {
                const int idx = tid + q * NTHR, sl = idx >> 10, k = idx & 1023, s = rgp * 8 + sl;
                const float* src = s < 8 ? p.c_p + s * 1024 : p.c_s + (s - 8) * 1024;
                cv[q] = src[k];
            }
#pragma unroll
            for (int q = 0; q < 16; ++q) sc[tid + q * NTHR] = silu(cv[q]);
        }
        __syncthreads();
        const int col = tid & 63, kq = tid >> 6;
        float acc[8];
#pragma unroll
        for (int s = 0; s < 8; ++s) acc[s] = 0.f;
        const float* wp = p.w_ada + (size_t)(kq * 128) * 3072 + ct * 64 + col;
#pragma unroll 4
        for (int k4 = 0; k4 < 32; ++k4) {
            const float w0 = wp[(size_t)(k4 * 4) * 3072], w1 = wp[(size_t)(k4 * 4 + 1) * 3072], w2 = wp[(size_t)(k4 * 4 + 2) * 3072], w3 = wp[(size_t)(k4 * 4 + 3) * 3072];
#pragma unroll
            for (int s = 0; s < 8; ++s) {
                const float4 c = *(const float4*)(sc + s * 1024 + kq * 128 + k4 * 4);
                acc[s] += c.x * w0 + c.y * w1 + c.z * w2 + c.w * w3;
            }
        }
#pragma unroll
        for (int s = 0; s < 8; ++s) red[(kq * 8 + s) * 64 + col] = acc[s];
        __syncthreads();
        {
            const int s = tid >> 6;
            float v = p.b_ada[ct * 64 + col];
#pragma unroll
            for (int q = 0; q < 8; ++q) v += red[(q * 8 + s) * 64 + col];
            p.mod[(size_t)(rgp * 8 + s) * 3072 + ct * 64 + col] = v;
        }
        __syncthreads();
    }
    constexpr int W_IN = NP * 128, W_UP = 1024 * 64, W_OUT = 1024 * 128;
    const int gt = bid * NTHR + tid, gs = nb * NTHR;
    for (int w = gt; w < W_IN; w += gs) tr8(p.w_in, N_IN, p.WinT, 1024, w % NP, w / NP);
    for (int w = gt; w < W_UP; w += gs) { tr8(p.w_up_a, 1024, p.WupaT, 512, w & 1023, w >> 10); tr8(p.w_up_b, 1024, p.WupbT, 512, w & 1023, w >> 10); }
    for (int w = gt; w < W_OUT; w += gs) tr8(p.w_out, 1024, p.WoutT, 1024, w & 1023, w >> 10);
}

__device__ __forceinline__ void normrow_load(const float* xr, int lane, float4 (&v)[4]) {
#pragma unroll
    for (int i = 0; i < 4; ++i) v[i] = *(const float4*)(xr + i * 256 + lane * 4);
}
__device__ __forceinline__ float sumsq4(const float4 (&v)[4]) {
    float ss = 0.f;
#pragma unroll
    for (int i = 0; i < 4; ++i) ss += v[i].x * v[i].x + v[i].y * v[i].y + v[i].z * v[i].z + v[i].w * v[i].w;
    return ss;
}
__device__ __forceinline__ void hrow_store(const Params& p, int m, int lane, const float4 (&v)[4], float rstd) {
    int s, t; tok_info(m, s, t);
    const float* md = p.mod + (size_t)s * 3072;
#pragma unroll
    for (int i = 0; i < 4; ++i) {
        const int c = i * 256 + lane * 4;
        const float4 g = *(const float4*)(p.g_norm + c);
        const float4 sh = *(const float4*)(md + c);
        const float4 sl = *(const float4*)(md + 1024 + c);
        const float h0 = v[i].x * rstd * g.x * (1.f + sl.x) + sh.x;
        const float h1 = v[i].y * rstd * g.y * (1.f + sl.y) + sh.y;
        const float h2 = v[i].z * rstd * g.z * (1.f + sl.z) + sh.z;
        const float h3 = v[i].w * rstd * g.w * (1.f + sl.w) + sh.w;
        uint2 o; o.x = pk2(h0, h1); o.y = pk2(h2, h3);
        *(uint2*)(p.H + (size_t)m * 1024 + c) = o;
    }
}
__device__ void phaseB(const Params& p, int bid, int nb) {
    const int wid = otid() >> 6, lane = otid() & 63;
    const int stride = nb * 8;
    for (int m = bid * 8 + wid; m < M_TOT; m += 2 * stride) {
        const int m2 = m + stride;
        const bool has2 = m2 < M_TOT;
        float4 va[4], vb[4];
        normrow_load(xrow(p, m), lane, va);
        normrow_load(xrow(p, has2 ? m2 : m), lane, vb);
        const float ra = rsqrtf(wave_sum(sumsq4(va)) * (1.f / 1024.f) + 1e-6f);
        const float rb = rsqrtf(wave_sum(sumsq4(vb)) * (1.f / 1024.f) + 1e-6f);
        hrow_store(p, m, lane, va, ra);
        if (has2) hrow_store(p, m2, lane, vb, rb);
    }
}

__device__ void phaseD(const Params& p, float* sm, int bid, int nb) {
    const int tid = otid();
    float* tw = sm;
    float* al = sm + 1024;
    const int c = tid;
    float wd[64], wi[64];
#pragma unroll
    for (int j = 0; j < 64; ++j) { wd[j] = p.w_decay2[j * 512 + c]; wi[j] = p.w_iclr2[j * 512 + c]; }
    const float w0c = p.w0[c], a0c = p.a0[c];
    for (int it = bid; it < M_TOT / 16; it += nb) {
        const int m0 = it * 16;
        {
            unsigned cu[4], pv[4]; float st[4];
#pragma unroll
            for (int q = 0; q < 4; ++q) {
                const int idx = tid + q * NTHR, tok = idx >> 7, j = idx & 127, col = C_WL + j, m = m0 + tok;
                int s, t; tok_info(m, s, t);
                cu[q] = p.P[(size_t)m * NP + col];
                pv[q] = p.P[(size_t)(t > 0 ? m - 1 : m) * NP + col];
                st[q] = p.st_shift[(size_t)(s >= 8 ? s - 8 : 0) * SHIFT_W + col];
            }
#pragma unroll
            for (int q = 0; q < 4; ++q) {
                const int idx = tid + q * NTHR, tok = idx >> 7, j = idx & 127, col = C_WL + j, m = m0 + tok;
                int s, t; tok_info(m, s, t);
                const float cur = __uint_as_float(cu[q] << 16);
                const float prev = t > 0 ? __uint_as_float(pv[q] << 16) : (s >= 8 ? st[q] : 0.f);
                const float v = cur + p.mu_shift[col] * (prev - cur);
                if (j < 64) tw[tok * 64 + j] = tanhf(v); else al[tok * 64 + j - 64] = v;
            }
        }
        __syncthreads();
#pragma unroll 2
        for (int tok = 0; tok < 16; ++tok) {
            float aw = 0.f, aa = 0.f;
#pragma unroll
            for (int j4 = 0; j4 < 16; ++j4) {
                const float4 t4 = *(const float4*)(tw + tok * 64 + j4 * 4);
                const float4 a4 = *(const float4*)(al + tok * 64 + j4 * 4);
                aw += t4.x * wd[j4 * 4] + t4.y * wd[j4 * 4 + 1] + t4.z * wd[j4 * 4 + 2] + t4.w * wd[j4 * 4 + 3];
                aa += a4.x * wi[j4 * 4] + a4.y * wi[j4 * 4 + 1] + a4.z * wi[j4 * 4 + 2] + a4.w * wi[j4 * 4 + 3];
            }
            const int m = m0 + tok;
            const float sg = sigm(w0c + aw);
            p.Omd[(size_t)m * 512 + c] = f2bf(1.f - __expf(-0.6065306597126334f * sg));
            p.Aa[(size_t)m * 512 + c] = f2bf(sigm(a0c + aa));
        }
        for (int tok = 0; tok < 16; ++tok) {
            const int m = m0 + tok;
            int s, t; tok_info(m, s, t);
            const int T = s < 8 ? 2048 : 8;
            if (t != T - 1) continue;
            float* osh = s < 8 ? p.out + O_PSHIFT + (size_t)s * SHIFT_W : p.out + O_SSHIFT + (size_t)(s - 8) * SHIFT_W;
            float* ocv = s < 8 ? p.out + O_PCONV + (size_t)s * 3072 : p.out + O_SCONV + (size_t)(s - 8) * 3072;
            for (int col = tid; col < SHIFT_W; col += NTHR) osh[col] = bf2f(p.P[(size_t)m * NP + col]);
            for (int idx = tid; idx < 3072; idx += NTHR) {
                const int r = idx >> 10, cc = idx & 1023;
                ocv[idx] = bf2f(p.P[(size_t)(m - 2 + r) * NP + C_QK + cc]);
            }
        }
        __syncthreads();
    }
}

__device__ __forceinline__ float rdlane(float v, int l) { return __builtin_bit_cast(float, __builtin_amdgcn_readlane(__builtin_bit_cast(int, v), l)); }
__device__ __forceinline__ float wave_sum_fast(float v) {
    v = row16_sum(v);
    return (rdlane(v, 0) + rdlane(v, 16)) + (rdlane(v, 32) + rdlane(v, 48));
}
__device__ __forceinline__ float4 unpk4(uint2 u) {
    float4 f; f.x = __uint_as_float(u.x << 16); f.y = __uint_as_float(u.x & 0xFFFF0000u);
    f.z = __uint_as_float(u.y << 16); f.w = __uint_as_float(u.y & 0xFFFF0000u); return f;
}
__device__ void rwkv_item(const Params& p, int s, int h, int third, float* sm) {
    constexpr int BUF = 15680;
    constexpr int VC_OFF = 10368, Y_OFF = 13632, NCH = 64;
    const int tid = otid(), wid = tid >> 6, lane = tid & 63;
    const int mbase = s * 2048;
    const int r0 = third * 21 + (third > 0 ? 1 : 0), nr = third == 0 ? 22 : 21;
    if (wid >= 6) {
        const int pw = wid - 6, g = lane >> 4;
        const int c4 = (lane & 15) * 4, hc = h * 64 + c4;
        const int l128 = pw * 64 + lane;
        const float4 mu_r = *(const float4*)(p.mu_shift + C_R + hc), mu_k = *(const float4*)(p.mu_shift + C_K + hc), mu_v = *(const float4*)(p.mu_shift + C_V + hc);
        const float4 kkw = *(const float4*)(p.k_k + hc), kaw = *(const float4*)(p.k_a + hc);
        uint2 R[4][8];
        auto fetch = [&](int pass, uint2 (&q)[8]) {
            const int t = (pass >> 2) * 32 + (pass & 3) * 8 + pw * 4 + g;
            const bf16_t* pr = p.P + (size_t)(mbase + t) * NP + hc;
            const bf16_t* pp = t > 0 ? pr - NP : pr;
            q[0] = *(const uint2*)(pr + C_R); q[1] = *(const uint2*)(pr + C_K); q[2] = *(const uint2*)(pr + C_V);
            q[3] = *(const uint2*)(pp + C_R); q[4] = *(const uint2*)(pp + C_K); q[5] = *(const uint2*)(pp + C_V);
            q[6] = *(const uint2*)(p.Aa + (size_t)(mbase + t) * 512 + hc);
            q[7] = *(const uint2*)(p.Omd + (size_t)(mbase + t) * 512 + hc);
        };
        auto step = [&](int pass, uint2 (&q)[8]) {
            const uint2 cr = q[0], ck = q[1], cv = q[2], crp = q[3], ckp = q[4], cvp = q[5], ca = q[6], co = q[7];
            if (pass + 4 < NCH * 4) fetch(pass + 4, q);
            const int tok = (pass & 3) * 8 + pw * 4 + g, t = (pass >> 2) * 32 + tok;
            float* B = sm + ((pass >> 2) & 1) * BUF;
            float4 r = unpk4(cr), k = unpk4(ck), v = unpk4(cv), rp, kp_, vp;
            if (t > 0) { rp = unpk4(crp); kp_ = unpk4(ckp); vp = unpk4(cvp); }
            else { rp = make_float4(0.f, 0.f, 0.f, 0.f); kp_ = rp; vp = rp; }
            r.x += mu_r.x * (rp.x - r.x); r.y += mu_r.y * (rp.y - r.y); r.z += mu_r.z * (rp.z - r.z); r.w += mu_r.w * (rp.w - r.w);
            k.x += mu_k.x * (kp_.x - k.x); k.y += mu_k.y * (kp_.y - k.y); k.z += mu_k.z * (kp_.z - k.z); k.w += mu_k.w * (kp_.w - k.w);
            v.x += mu_v.x * (vp.x - v.x); v.y += mu_v.y * (vp.y - v.y); v.z += mu_v.z * (vp.z - v.z); v.w += mu_v.w * (vp.w - v.w);
            const float4 a = unpk4(ca), om = unpk4(co);
            float4 kk; kk.x = k.x * kkw.x; kk.y = k.y * kkw.y; kk.z = k.z * kkw.z; kk.w = k.w * kkw.w;
            const float nrm = sqrtf(row16_sum(kk.x * kk.x + kk.y * kk.y + kk.z * kk.z + kk.w * kk.w));
            const float inv = __builtin_amdgcn_rcpf(fmaxf(nrm, 1e-12f));
            kk.x *= inv; kk.y *= inv; kk.z *= inv; kk.w *= inv;
            float4 ka; ka.x = kk.x * a.x; ka.y = kk.y * a.y; ka.z = kk.z * a.z; ka.w = kk.w * a.w;
            float4 kp; kp.x = k.x * (1.f + (a.x - 1.f) * kaw.x); kp.y = k.y * (1.f + (a.y - 1.f) * kaw.y);
            kp.z = k.z * (1.f + (a.z - 1.f) * kaw.z); kp.w = k.w * (1.f + (a.w - 1.f) * kaw.w);
            float4 d; d.x = 1.f - om.x; d.y = 1.f - om.y; d.z = 1.f - om.z; d.w = 1.f - om.w;
            float4 dr; dr.x = d.x * r.x; dr.y = d.y * r.y; dr.z = d.z * r.z; dr.w = d.w * r.w;
            const float c1 = row16_sum(ka.x * r.x + ka.y * r.y + ka.z * r.z + ka.w * r.w);
            const float c2 = row16_sum(kp.x * r.x + kp.y * r.y + kp.z * r.z + kp.w * r.w);
            const int o = tok * 64 + c4;
            *(float4*)(B + o) = kk; *(float4*)(B + 2048 + o) = d; *(float4*)(B + 4096 + o) = ka;
            *(float4*)(B + 6144 + o) = kp; *(float4*)(B + 8192 + o) = dr;
            float4* vc = (float4*)(B + VC_OFF) + tok * 24;
            const int l0 = c4 - r0;
            if (l0 >= 0 && l0 < nr) vc[l0] = make_float4(v.x, c1, c2, 0.f);
            if (l0 + 1 >= 0 && l0 + 1 < nr) vc[l0 + 1] = make_float4(v.y, c1, c2, 0.f);
            if (l0 + 2 >= 0 && l0 + 2 < nr) vc[l0 + 2] = make_float4(v.z, c1, c2, 0.f);
            if (l0 + 3 >= 0 && l0 + 3 < nr) vc[l0 + 3] = make_float4(v.w, c1, c2, 0.f);
        };
        auto flush = [&](int c) {
            const float* Y = sm + (c & 1) * BUF + Y_OFF;
            const int tt = l128 >> 2, part = l128 & 3;
            bf16_t* dst = p.Yraw + (size_t)(mbase + c * 32 + tt) * 512 + h * 64 + r0;
#pragma unroll
            for (int k = 0; k < 6; ++k) { const int i = part + 4 * k; if (i < nr) dst[i] = f2bf(Y[tt * 64 + i]); }
        };
#pragma unroll
        for (int q = 0; q < 4; ++q) fetch(q, R[q]);
#pragma unroll
        for (int q = 0; q < 4; ++q) step(q, R[q]);
        lds_barrier();
#pragma unroll 1
        for (int c = 0; c < NCH; ++c) {
            if (c > 0) flush(c - 1);
            if (c + 1 < NCH) {
#pragma unroll
                for (int q = 0; q < 4; ++q) step((c + 1) * 4 + q, R[q]);
            }
            lds_barrier();
        }
        flush(NCH - 1);
    } else {
        const int lrow = wid * 4 + (lane >> 4);
        const int irow = r0 + (lrow < nr ? lrow : nr - 1);
        const int c4 = (lane & 15) * 4;
        const int yslot = ((lane & 15) == 0 && lrow < nr) ? lrow : 32 + (lane & 31);
        float S0 = 0.f, S1 = 0.f, S2 = 0.f, S3 = 0.f;
        lds_barrier();
#pragma unroll 1
        for (int c = 0; c < NCH; ++c) {
            const float* B = sm + (c & 1) * BUF;
            const float* bp = B + c4;
            const float4* vp4 = (const float4*)(B + VC_OFF) + (irow - r0);
            float4 kk4 = *(const float4*)(bp), d4 = *(const float4*)(bp + 2048), ka4 = *(const float4*)(bp + 4096);
            float4 kp4 = *(const float4*)(bp + 6144), dr4 = *(const float4*)(bp + 8192), vc = vp4[0];
            float4 kkB = *(const float4*)(bp + 64), dB = *(const float4*)(bp + 64 + 2048), kaB = *(const float4*)(bp + 64 + 4096);
            float4 kpB = *(const float4*)(bp + 64 + 6144), drB = *(const float4*)(bp + 64 + 8192), vcB = vp4[24];
            float* yp = sm + (c & 1) * BUF + Y_OFF + yslot;
#pragma unroll 8
            for (int tt = 0; tt < 32; ++tt) {
                const float* nb_ = bp + (tt + 2) * 64;
                const float4 nkk = *(const float4*)(nb_), nd = *(const float4*)(nb_ + 2048), nka = *(const float4*)(nb_ + 4096);
                const float4 nkp = *(const float4*)(nb_ + 6144), ndr = *(const float4*)(nb_ + 8192), nvc = vp4[(tt + 2) * 24];
                __builtin_amdgcn_sched_barrier(0);
                float p1 = S0 * kk4.x + S1 * kk4.y + S2 * kk4.z + S3 * kk4.w;
                float p2 = S0 * dr4.x + S1 * dr4.y + S2 * dr4.z + S3 * dr4.w;
                const float vi = vc.x;
                const float u0 = S0 * d4.x + vi * kp4.x, u1 = S1 * d4.y + vi * kp4.y, u2 = S2 * d4.z + vi * kp4.z, u3 = S3 * d4.w + vi * kp4.w;
                float z = p2 - vc.y * p1;
                p1 = row16_sum(p1);
                z = row16_sum(z);
                S0 = u0 - p1 * ka4.x; S1 = u1 - p1 * ka4.y; S2 = u2 - p1 * ka4.z; S3 = u3 - p1 * ka4.w;
                yp[tt * 64] = z + vi * vc.z;
                kk4 = kkB; d4 = dB; ka4 = kaB; kp4 = kpB; dr4 = drB; vc = vcB;
                kkB = nkk; dB = nd; kaB = nka; kpB = nkp; drB = ndr; vcB = nvc;
                __builtin_amdgcn_sched_barrier(0);
            }
            lds_barrier();
        }
        if (lrow < nr) {
            float* o = p.out + O_PS + (size_t)s * 8 * 4096 + ((size_t)(h * 64 + irow)) * 64 + c4;
            float4 v; v.x = S0; v.y = S1; v.z = S2; v.w = S3;
            *(float4*)o = v;
        }
    }
    __syncthreads();
}

__device__ void mlstm_item(const Params& p, int s, int h, float* sm) {
    float* sq = sm;
    float* sk = sm + 4160;
    float* sv = sm + 8320;
    float* sc = sm + 12480;
    float* sC = sm + 16640;
    float* sn = sm + 20800;
    float* sb = sn + 64;
    float* si = sn + 128;
    float* smt = sn + 192;
    float* swin = sn + 256;
    float* sden = sn + 320;
    float* sws = sn + 384;
    float* slf = sn + 448;
    float* smisc = sn + 512;
    const int tid = otid(), wid = tid >> 6, lane = tid & 63;
    const int T = s < 8 ? 2048 : 8, L = s < 8 ? 64 : 8, NC = T / L;
    const int mbase = s < 8 ? s * 2048 : M_P + (s - 8) * 8;
    for (int idx = tid; idx < 4096; idx += NTHR) {
        const int i = idx >> 6, j = idx & 63;
        sC[i * 65 + j] = s >= 8 ? p.st_C[(size_t)((s - 8) * 8 + h) * 4096 + idx] : 0.f;
    }
    if (tid < 64) sn[tid] = s >= 8 ? p.st_n[(size_t)((s - 8) * 8 + h) * 64 + tid] : 0.f;
    if (tid == 0) smisc[0] = s >= 8 ? p.st_m[(s - 8) * 8 + h] : 0.f;
    const float cwq[4] = {p.conv_w[0 * 1024 + h * 64 + lane], p.conv_w[1 * 1024 + h * 64 + lane], p.conv_w[2 * 1024 + h * 64 + lane], p.conv_w[3 * 1024 + h * 64 + lane]};
    const float cwk[4] = {p.conv_w[0 * 1024 + 512 + h * 64 + lane], p.conv_w[1 * 1024 + 512 + h * 64 + lane], p.conv_w[2 * 1024 + 512 + h * 64 + lane], p.conv_w[3 * 1024 + 512 + h * 64 + lane]};
    const float cbq = p.conv_b[h * 64 + lane], cbk = p.conv_b[512 + h * 64 + lane];
    const float gnw = p.gn_w[h * 64 + lane];
    const float bi = p.b_i[h], bfv = p.b_f[h];
    __syncthreads();
    for (int c = 0; c < NC; ++c) {
        const int t0 = c * L;
        for (int tt = wid; tt < L; tt += 8) {
            const int t = t0 + tt, m = mbase + t;
            float aq = cbq, ak = cbk;
#pragma unroll
            for (int j = 0; j < 4; ++j) {
                const int tau = t - 3 + j;
                float xq, xk;
                if (tau >= 0) {
                    const bf16_t* pr = p.P + (size_t)(mbase + tau) * NP + C_QK + h * 64 + lane;
                    xq = bf2f(pr[0]); xk = bf2f(pr[512]);
                } else if (s >= 8) {
                    const float* st = p.st_conv + ((size_t)(s - 8) * 3 + (3 + tau)) * 1024 + h * 64 + lane;
                    xq = st[0]; xk = st[512];
                } else { xq = 0.f; xk = 0.f; }
                aq += xq * cwq[j]; ak += xk * cwk[j];
            }
            sq[tt * 65 + lane] = silu(aq);
            sk[tt * 65 + lane] = silu(ak) * 0.125f;
            sv[tt * 65 + lane] = bf2f(p.P[(size_t)m * NP + C_VB + h * 64 + lane]);
        }
        if (tid < L) {
            const int m = mbase + t0 + tid;
            si[tid] = bf2f(p.P[(size_t)m * NP + C_IB + h]) + bi;
            const float f = bf2f(p.P[(size_t)m * NP + C_FB + h]) + bfv;
            slf[tid] = f > 0.f ? -log1pf(__expf(-f)) : f - log1pf(__expf(f));
        }
        __syncthreads();
        if (tid == 0) {
            const float mprev = smisc[0];
            float b = 0.f, run = mprev;
            for (int t = 0; t < L; ++t) {
                b += slf[t];
                run = fmaxf(run, si[t] - b);
                sb[t] = b; smt[t] = b + run; swin[t] = __expf(b + mprev - (b + run));
            }
            const float mnew = b + run;
            smisc[1] = mnew; smisc[2] = __expf(b + mprev - mnew);
            for (int t = 0; t < L; ++t) sws[t] = __expf(b - sb[t] + si[t] - mnew);
        }
        __syncthreads();
        for (int idx = tid; idx < L * L; idx += NTHR) {
            const int t = idx / L, u = idx % L;
            float v = 0.f;
            if (u <= t) {
                float dot = 0.f;
#pragma unroll 8
                for (int d = 0; d < 64; ++d) dot += sq[t * 65 + d] * sk[u * 65 + d];
                v = dot * __expf(sb[t] - sb[u] + si[u] - smt[t]);
            }
            sc[t * 65 + u] = v;
        }
        __syncthreads();
        if (tid < L) {
            float rs = 0.f, qn = 0.f;
            for (int u = 0; u < L; ++u) rs += sc[tid * 65 + u];
            for (int j = 0; j < 64; ++j) qn += sn[j] * sq[tid * 65 + j];
            const float den = rs + swin[tid] * qn;
            sden[tid] = fmaxf(fabsf(den), __expf(-smt[tid]));
        }
        __syncthreads();
        for (int tt = wid; tt < L; tt += 8) {
            float num = 0.f, inter = 0.f;
            for (int u = 0; u <= tt; ++u) num += sc[tt * 65 + u] * sv[u * 65 + lane];
#pragma unroll 8
            for (int j = 0; j < 64; ++j) inter += sC[lane * 65 + j] * sq[tt * 65 + j];
            const float hv = (num + swin[tt] * inter) / sden[tt];
            const float ms = wave_sum(hv * hv) * (1.f / 64.f);
            const float hn = hv * rsqrtf(ms + 1e-6f) * gnw;
            const int m = mbase + t0 + tt;
            const float ob = bf2f(p.P[(size_t)m * NP + C_OB + h * 64 + lane]);
            const float zb = bf2f(p.P[(size_t)m * NP + C_ZB + h * 64 + lane]);
            p.OutB[(size_t)m * 512 + h * 64 + lane] = f2bf(sigm(ob) * hn * silu(zb));
        }
        __syncthreads();
        {
            const float dec = smisc[2];
            const int j = lane;
#pragma unroll
            for (int ii = 0; ii < 8; ++ii) {
                const int i = wid + 8 * ii;
                float a = dec * sC[i * 65 + j];
                for (int u = 0; u < L; ++u) a += sws[u] * sv[u * 65 + i] * sk[u * 65 + j];
                sC[i * 65 + j] = a;
            }
            if (tid < 64) {
                float a = dec * sn[tid];
                for (int u = 0; u < L; ++u) a += sws[u] * sk[u * 65 + tid];
                sn[tid] = a;
            }
            if (tid == 0) smisc[0] = smisc[1];
        }
        __syncthreads();
    }
    {
        float* oC = s < 8 ? p.out + O_PC + (size_t)(s * 8 + h) * 4096 : p.out + O_SC + (size_t)((s - 8) * 8 + h) * 4096;
        float* on = s < 8 ? p.out + O_PN + (size_t)(s * 8 + h) * 64 : p.out + O_SN + (size_t)((s - 8) * 8 + h) * 64;
        float* om = s < 8 ? p.out + O_PM + (s * 8 + h) : p.out + O_SM + ((s - 8) * 8 + h);
        for (int idx = tid; idx < 4096; idx += NTHR) oC[idx] = sC[(idx >> 6) * 65 + (idx & 63)];
        if (tid < 64) on[tid] = sn[tid];
        if (tid == 0) om[0] = smisc[0];
    }
    __syncthreads();
}

__device__ __forceinline__ bf16x8 ldfrag(const bf16_t* base, int row, int ks, int fq) { return *(const bf16x8*)(base + row * 72 + ks * 32 + fq * 8); }
__device__ __forceinline__ float sum8(float v) { v += dpp_mov<0xB1>(v); v += dpp_mov<0x4E>(v); v += dpp_mov<0x141>(v); return v; }
__device__ void mlstm_prompt(const Params& p, int s, int h, float* sm) {
    bf16_t* Qs = (bf16_t*)sm; bf16_t* Ks = Qs + 4608; bf16_t* VT = Ks + 4608; bf16_t* KwT = VT + 4608; bf16_t* Ps = KwT + 4608; bf16_t* Cb = Ps + 4608;
    float* hs = sm + 13824;
    float* sn = hs + 64 * 68;
    float* sden = sn + 64;
    float* gv = sn + 128;
    float* Gg = sn + 128 + 768;
    float* Gl = Gg + 2048;
    float* Gb = Gl + 2048;
    const int tid = otid(), wid = tid >> 6, lane = tid & 63, fr = lane & 15, fq = lane >> 4;
    const int tr = wid >> 1, tc0 = (wid & 1) * 2;
    const int mbase = s * 2048;
    const int qc = h * 64 + lane;
    f32x4 accC[2];
    accC[0] = (f32x4){0.f, 0.f, 0.f, 0.f}; accC[1] = accC[0];
    if (tid < 64) sn[tid] = 0.f;
    {
        const float bi = p.b_i[h], bfv = p.b_f[h];
        for (int cc = wid; cc < 32; cc += 8) {
            const bf16_t* pr = p.P + (size_t)(mbase + cc * 64 + lane) * NP;
            const float it = bf2f(pr[C_IB + h]) + bi;
            const float f = bf2f(pr[C_FB + h]) + bfv;
            float b = f > 0.f ? -log1pf(__expf(-f)) : f - log1pf(__expf(f));
#pragma unroll
            for (int o = 1; o < 64; o <<= 1) { const float v = __shfl_up(b, o); if (lane >= o) b += v; }
            const float g = it - b;
            float run = g;
#pragma unroll
            for (int o = 1; o < 64; o <<= 1) { const float v = __shfl_up(run, o); if (lane >= o) run = fmaxf(run, v); }
            Gg[cc * 64 + lane] = g; Gl[cc * 64 + lane] = run; Gb[cc * 64 + lane] = b;
        }
    }
    const float cwq0 = p.conv_w[qc], cwq1 = p.conv_w[1024 + qc], cwq2 = p.conv_w[2048 + qc], cwq3 = p.conv_w[3072 + qc];
    const float cwk0 = p.conv_w[512 + qc], cwk1 = p.conv_w[1536 + qc], cwk2 = p.conv_w[2560 + qc], cwk3 = p.conv_w[3584 + qc];
    const float cbq = p.conv_b[qc], cbk = p.conv_b[512 + qc];
    const float gnw = p.gn_w[qc];
    unsigned xqr[11], xkr[11], vvr[8];
    auto load_raw = [&](int c) {
        const int tb = c * 64 + wid * 8 - 3;
#pragma unroll
        for (int r = 0; r < 11; ++r) {
            const int t = tb + r, tc = t < 0 ? 0 : t;
            const bf16_t* pr = p.P + (size_t)(mbase + tc) * NP + C_QK + qc;
            xqr[r] = pr[0]; xkr[r] = pr[512];
        }
#pragma unroll
        for (int k = 0; k < 8; ++k) vvr[k] = p.P[(size_t)(mbase + tb + 3 + k) * NP + C_VB + qc];
    };
    auto gates = [&](int c, float mprev) {
        float* v = gv + (c & 1) * 384;
        const float g = Gg[c * 64 + lane], b = Gb[c * 64 + lane];
        const float run = fmaxf(Gl[c * 64 + lane], mprev), runL = fmaxf(Gl[c * 64 + 63], mprev), bL = Gb[c * 64 + 63];
        v[lane] = g; v[64 + lane] = run; v[128 + lane] = __expf(mprev - run); v[192 + lane] = __expf(g - runL); v[256 + lane] = b;
        if (lane == 0) { v[320] = bL + runL; v[321] = __expf(mprev - runL); }
    };
    load_raw(0);
    __syncthreads();
    if (wid == 0) gates(0, 0.f);
    __syncthreads();
    for (int c = 0; c < 32; ++c) {
        const int t0 = c * 64, mb = mbase + t0;
        const float* sg = gv + (c & 1) * 384; const float* srun = sg + 64; const float* swin = sg + 128; const float* sws = sg + 192; const float* sb = sg + 256;
        const float dec = sg[321];
        {
            float kw[8], xq[11], xk[11], vv[8];
            const bool head = (c == 0 && wid == 0);
#pragma unroll
            for (int r = 0; r < 11; ++r) {
                const bool z = head && r < 3;
                xq[r] = z ? 0.f : __uint_as_float(xqr[r] << 16); xk[r] = z ? 0.f : __uint_as_float(xkr[r] << 16);
            }
#pragma unroll
            for (int k = 0; k < 8; ++k) vv[k] = __uint_as_float(vvr[k] << 16);
#pragma unroll
            for (int k = 0; k < 8; ++k) {
                const int tt = wid * 8 + k;
                const float q = silu(cbq + xq[k] * cwq0 + xq[k + 1] * cwq1 + xq[k + 2] * cwq2 + xq[k + 3] * cwq3);
                const float kk = silu(cbk + xk[k] * cwk0 + xk[k + 1] * cwk1 + xk[k + 2] * cwk2 + xk[k + 3] * cwk3) * 0.125f;
                Qs[tt * 72 + lane] = f2bf(q);
                Ks[tt * 72 + lane] = f2bf(kk);
                kw[k] = kk * sws[tt];
            }
            uint4 o; o.x = pk2(kw[0], kw[1]); o.y = pk2(kw[2], kw[3]); o.z = pk2(kw[4], kw[5]); o.w = pk2(kw[6], kw[7]);
            *(uint4*)(KwT + lane * 72 + wid * 8) = o;
            o.x = pk2(vv[0], vv[1]); o.y = pk2(vv[2], vv[3]); o.z = pk2(vv[4], vv[5]); o.w = pk2(vv[6], vv[7]);
            *(uint4*)(VT + lane * 72 + wid * 8) = o;
        }
#pragma unroll
        for (int n = 0; n < 2; ++n) {
            uint2 o; o.x = pk2(accC[n][0], accC[n][1]); o.y = pk2(accC[n][2], accC[n][3]);
            *(uint2*)(Cb + (tr * 16 + fr) * 72 + (tc0 + n) * 16 + fq * 4) = o;
        }
        if (c + 1 < 32) load_raw(c + 1);
        lds_barrier();
        unsigned obr[8], zbr[8];
#pragma unroll
        for (int k = 0; k < 8; ++k) {
            const bf16_t* pr = p.P + (size_t)(mb + wid * 8 + k) * NP;
            obr[k] = pr[C_OB + qc]; zbr[k] = pr[C_ZB + qc];
        }
#pragma unroll
        for (int n = 0; n < 2; ++n) {
            const int ut = tc0 + n;
            f32x4 a = (f32x4){0.f, 0.f, 0.f, 0.f};
            if (ut <= tr) {
#pragma unroll
                for (int ks = 0; ks < 2; ++ks) a = __builtin_amdgcn_mfma_f32_16x16x32_bf16(ldfrag(Ks, ut * 16 + fr, ks, fq), ldfrag(Qs, tr * 16 + fr, ks, fq), a, 0, 0, 0);
            }
            const int t = tr * 16 + fr;
            const float rn = srun[t];
            float w[4];
#pragma unroll
            for (int r = 0; r < 4; ++r) {
                const int u = ut * 16 + fq * 4 + r;
                w[r] = (u <= t) ? a[r] * __expf(sg[u] - rn) : 0.f;
            }
            uint2 o; o.x = pk2(w[0], w[1]); o.y = pk2(w[2], w[3]);
            *(uint2*)(Ps + t * 72 + ut * 16 + fq * 4) = o;
        }
        lds_barrier();
        {
            const int t = tid >> 3, seg = tid & 7;
            const uint4 pv = *(const uint4*)(Ps + t * 72 + seg * 8);
            const uint4 qv = *(const uint4*)(Qs + t * 72 + seg * 8);
            const float4 pa = unpk4(make_uint2(pv.x, pv.y)), pb = unpk4(make_uint2(pv.z, pv.w));
            const float4 qa = unpk4(make_uint2(qv.x, qv.y)), qb = unpk4(make_uint2(qv.z, qv.w));
            const float4 na = *(const float4*)(sn + seg * 8), nb4 = *(const float4*)(sn + seg * 8 + 4);
            float rs = (pa.x + pa.y) + (pa.z + pa.w) + (pb.x + pb.y) + (pb.z + pb.w);
            float qn = qa.x * na.x + qa.y * na.y + qa.z * na.z + qa.w * na.w + qb.x * nb4.x + qb.y * nb4.y + qb.z * nb4.z + qb.w * nb4.w;
            rs = sum8(rs); qn = sum8(qn);
            if (seg == 0) sden[t] = fmaxf(fabsf(rs + swin[t] * qn), __expf(-(sb[t] + srun[t])));
        }
        f32x4 num[2], itr[2];
#pragma unroll
        for (int n = 0; n < 2; ++n) {
            const int it = tc0 + n;
            num[n] = (f32x4){0.f, 0.f, 0.f, 0.f}; itr[n] = num[n];
#pragma unroll
            for (int ks = 0; ks < 2; ++ks) {
                num[n] = __builtin_amdgcn_mfma_f32_16x16x32_bf16(ldfrag(VT, it * 16 + fr, ks, fq), ldfrag(Ps, tr * 16 + fr, ks, fq), num[n], 0, 0, 0);
                itr[n] = __builtin_amdgcn_mfma_f32_16x16x32_bf16(ldfrag(Cb, it * 16 + fr, ks, fq), ldfrag(Qs, tr * 16 + fr, ks, fq), itr[n], 0, 0, 0);
            }
        }
        lds_barrier();
        {
            const int t = tr * 16 + fr;
            const float rd = 1.f / sden[t], wn = swin[t];
#pragma unroll
            for (int n = 0; n < 2; ++n) {
                float4 o;
                o.x = (num[n][0] + wn * itr[n][0]) * rd; o.y = (num[n][1] + wn * itr[n][1]) * rd;
                o.z = (num[n][2] + wn * itr[n][2]) * rd; o.w = (num[n][3] + wn * itr[n][3]) * rd;
                *(float4*)(hs + t * 68 + (tc0 + n) * 16 + fq * 4) = o;
            }
        }
#pragma unroll
        for (int n = 0; n < 2; ++n) {
            accC[n][0] *= dec; accC[n][1] *= dec; accC[n][2] *= dec; accC[n][3] *= dec;
#pragma unroll
            for (int ks = 0; ks < 2; ++ks)
                accC[n] = __builtin_amdgcn_mfma_f32_16x16x32_bf16(ldfrag(KwT, (tc0 + n) * 16 + fr, ks, fq), ldfrag(VT, tr * 16 + fr, ks, fq), accC[n], 0, 0, 0);
        }
        {
            const int j = tid >> 3, seg = tid & 7;
            const uint4 kv = *(const uint4*)(KwT + j * 72 + seg * 8);
            const float4 ka = unpk4(make_uint2(kv.x, kv.y)), kb = unpk4(make_uint2(kv.z, kv.w));
            float sum = (ka.x + ka.y) + (ka.z + ka.w) + (kb.x + kb.y) + (kb.z + kb.w);
            sum = sum8(sum);
            if (seg == 0) sn[j] = dec * sn[j] + sum;
        }
        if (wid == 0 && c + 1 < 32) gates(c + 1, sg[320]);
        lds_barrier();
#pragma unroll
        for (int k = 0; k < 8; ++k) {
            const int tt = wid * 8 + k;
            const float hv = hs[tt * 68 + lane];
            const float ms = wave_sum_fast(hv * hv) * (1.f / 64.f);
            const float hn = hv * rsqrtf(ms + 1e-6f) * gnw;
            p.OutB[(size_t)(mb + tt) * 512 + qc] = f2bf(sigm(__uint_as_float(obr[k] << 16)) * hn * silu(__uint_as_float(zbr[k] << 16)));
        }
    }
    {
        float* oC = p.out + O_PC + (size_t)(s * 8 + h) * 4096;
#pragma unroll
        for (int n = 0; n < 2; ++n) {
            float4 o; o.x = accC[n][0]; o.y = accC[n][1]; o.z = accC[n][2]; o.w = accC[n][3];
            *(float4*)(oC + (tr * 16 + fr) * 64 + (tc0 + n) * 16 + fq * 4) = o;
        }
        if (tid < 64) p.out[O_PN + (size_t)(s * 8 + h) * 64 + tid] = sn[tid];
        if (tid == 0) p.out[O_PM + s * 8 + h] = gv[384 + 320];
    }
    __syncthreads();
}

__device__ __forceinline__ void wave_lds_fence() { __builtin_amdgcn_fence(__ATOMIC_RELEASE, "wavefront"); __builtin_amdgcn_wave_barrier(); __builtin_amdgcn_fence(__ATOMIC_ACQUIRE, "wavefront"); }
__device__ void rwkv_sample_wave(const Params& p, int sb, int h, float* wsm) {
    const int lane = otid() & 63;
    const int hj = h * 64 + lane;
    const int m0 = M_P + sb * 8;
    {
        float rr[8], kr[8], vr[8], ar[8], dd[8];
#pragma unroll
        for (int t = 0; t < 8; ++t) {
            const bf16_t* pr = p.P + (size_t)(m0 + t) * NP;
            rr[t] = bf2f(pr[C_R + hj]); kr[t] = bf2f(pr[C_K + hj]); vr[t] = bf2f(pr[C_V + hj]);
            ar[t] = bf2f(p.Aa[(size_t)(m0 + t) * 512 + hj]); dd[t] = 1.f - bf2f(p.Omd[(size_t)(m0 + t) * 512 + hj]);
        }
        const float* st = p.st_shift + (size_t)sb * SHIFT_W;
        float rp = st[C_R + hj], kp_ = st[C_K + hj], vp = st[C_V + hj];
        const float mu_r = p.mu_shift[C_R + hj], mu_k = p.mu_shift[C_K + hj], mu_v = p.mu_shift[C_V + hj];
        const float kkw = p.k_k[hj], kaw = p.k_a[hj];
#pragma unroll
        for (int t = 0; t < 8; ++t) {
            const float r = rr[t] + mu_r * (rp - rr[t]), k = kr[t] + mu_k * (kp_ - kr[t]), v = vr[t] + mu_v * (vp - vr[t]);
            rp = rr[t]; kp_ = kr[t]; vp = vr[t];
            const float a = ar[t], d = dd[t];
            float kk = k * kkw;
            const float nrm = sqrtf(wave_sum_fast(kk * kk));
            kk = kk / fmaxf(nrm, 1e-12f);
            const float ka = kk * a, kp = k * (1.f + (a - 1.f) * kaw);
            const float c1 = wave_sum_fast(ka * r), c2 = wave_sum_fast(kp * r);
            float* w = wsm + t * 400;
            w[lane] = kk; w[64 + lane] = d; w[128 + lane] = ka; w[192 + lane] = kp; w[256 + lane] = d * r; w[320 + lane] = v;
            if (lane == 0) { w[384] = c1; w[385] = c2; }
        }
    }
    float S[64];
    {
        const float* srow = p.st_S + ((size_t)(sb * 8 + h) * 64 + lane) * 64;
#pragma unroll
        for (int q = 0; q < 16; ++q) { const float4 v = *(const float4*)(srow + q * 4); S[4 * q] = v.x; S[4 * q + 1] = v.y; S[4 * q + 2] = v.z; S[4 * q + 3] = v.w; }
    }
    wave_lds_fence();
#pragma unroll 1
    for (int t = 0; t < 8; ++t) {
        const float* w = wsm + t * 400;
        float p1 = 0.f, p2 = 0.f;
#pragma unroll
        for (int q = 0; q < 16; ++q) {
            const float4 k4 = *(const float4*)(w + q * 4), r4 = *(const float4*)(w + 256 + q * 4);
            p1 += S[4 * q] * k4.x + S[4 * q + 1] * k4.y + S[4 * q + 2] * k4.z + S[4 * q + 3] * k4.w;
            p2 += S[4 * q] * r4.x + S[4 * q + 1] * r4.y + S[4 * q + 2] * r4.z + S[4 * q + 3] * r4.w;
        }
        const float vi = w[320 + lane];
        const float y = p2 - p1 * w[384] + vi * w[385];
#pragma unroll
        for (int q = 0; q < 16; ++q) {
            const float4 d4 = *(const float4*)(w + 64 + q * 4), a4 = *(const float4*)(w + 128 + q * 4), k4 = *(const float4*)(w + 192 + q * 4);
            S[4 * q] = S[4 * q] * d4.x + vi * k4.x - p1 * a4.x;
            S[4 * q + 1] = S[4 * q + 1] * d4.y + vi * k4.y - p1 * a4.y;
            S[4 * q + 2] = S[4 * q + 2] * d4.z + vi * k4.z - p1 * a4.z;
            S[4 * q + 3] = S[4 * q + 3] * d4.w + vi * k4.w - p1 * a4.w;
        }
        p.Yraw[(size_t)(m0 + t) * 512 + hj] = f2bf(y);
    }
    {
        float* o = p.out + O_SS + ((size_t)(sb * 8 + h) * 64 + lane) * 64;
#pragma unroll
        for (int q = 0; q < 16; ++q) { float4 v; v.x = S[4 * q]; v.y = S[4 * q + 1]; v.z = S[4 * q + 2]; v.w = S[4 * q + 3]; *(float4*)(o + q * 4) = v; }
    }
    wave_lds_fence();
}

__device__ void mlstm_sample_wave(const Params& p, int sb, int h, float* wsm) {
    const int lane = otid() & 63;
    const int qc = h * 64 + lane;
    const int m0 = M_P + sb * 8;
    float gi = 0.f, gl = 0.f;
    {
        float xq[11], xk[11];
#pragma unroll
        for (int r = 0; r < 3; ++r) { const float* st = p.st_conv + ((size_t)sb * 3 + r) * 1024 + qc; xq[r] = st[0]; xk[r] = st[512]; }
#pragma unroll
        for (int t = 0; t < 8; ++t) { const bf16_t* pr = p.P + (size_t)(m0 + t) * NP + C_QK + qc; xq[3 + t] = bf2f(pr[0]); xk[3 + t] = bf2f(pr[512]); }
#pragma unroll
        for (int t = 0; t < 8; ++t) {
            const bf16_t* pr = p.P + (size_t)(m0 + t) * NP;
            wsm[1024 + t * 64 + lane] = bf2f(pr[C_VB + qc]); wsm[1536 + t * 64 + lane] = bf2f(pr[C_OB + qc]); wsm[2048 + t * 64 + lane] = bf2f(pr[C_ZB + qc]);
        }
        if (lane < 8) {
            const bf16_t* pr = p.P + (size_t)(m0 + lane) * NP;
            gi = bf2f(pr[C_IB + h]) + p.b_i[h];
            const float f = bf2f(pr[C_FB + h]) + p.b_f[h];
            gl = f > 0.f ? -log1pf(__expf(-f)) : f - log1pf(__expf(f));
        }
        const float cwq0 = p.conv_w[qc], cwq1 = p.conv_w[1024 + qc], cwq2 = p.conv_w[2048 + qc], cwq3 = p.conv_w[3072 + qc];
        const float cwk0 = p.conv_w[512 + qc], cwk1 = p.conv_w[1536 + qc], cwk2 = p.conv_w[2560 + qc], cwk3 = p.conv_w[3584 + qc];
        const float cbq = p.conv_b[qc], cbk = p.conv_b[512 + qc];
#pragma unroll
        for (int t = 0; t < 8; ++t) {
            wsm[t * 64 + lane] = silu(cbq + xq[t] * cwq0 + xq[t + 1] * cwq1 + xq[t + 2] * cwq2 + xq[t + 3] * cwq3);
            wsm[512 + t * 64 + lane] = silu(cbk + xk[t] * cwk0 + xk[t + 1] * cwk1 + xk[t + 2] * cwk2 + xk[t + 3] * cwk3) * 0.125f;
        }
    }
    const float gnw = p.gn_w[qc];
    float C[64];
    {
        const float* crow = p.st_C + ((size_t)(sb * 8 + h) * 64 + lane) * 64;
#pragma unroll
        for (int q = 0; q < 16; ++q) { const float4 v = *(const float4*)(crow + q * 4); C[4 * q] = v.x; C[4 * q + 1] = v.y; C[4 * q + 2] = v.z; C[4 * q + 3] = v.w; }
    }
    float nl = p.st_n[(size_t)(sb * 8 + h) * 64 + lane];
    float m = p.st_m[sb * 8 + h];
    wave_lds_fence();
#pragma unroll 1
    for (int t = 0; t < 8; ++t) {
        const float it = rdlane(gi, t), lf = rdlane(gl, t);
        const float mt = fmaxf(lf + m, it);
        const float fdec = __expf(lf + m - mt), iw = __expf(it - mt);
        m = mt;
        const float ql = wsm[t * 64 + lane], kl = wsm[512 + t * 64 + lane];
        nl = fdec * nl + iw * kl;
        const float den = wave_sum_fast(nl * ql);
        const float ai = iw * wsm[1024 + t * 64 + lane];
        float num = 0.f;
#pragma unroll
        for (int q = 0; q < 16; ++q) {
            const float4 k4 = *(const float4*)(wsm + 512 + t * 64 + q * 4), q4 = *(const float4*)(wsm + t * 64 + q * 4);
            C[4 * q] = fdec * C[4 * q] + ai * k4.x; C[4 * q + 1] = fdec * C[4 * q + 1] + ai * k4.y;
            C[4 * q + 2] = fdec * C[4 * q + 2] + ai * k4.z; C[4 * q + 3] = fdec * C[4 * q + 3] + ai * k4.w;
            num += C[4 * q] * q4.x + C[4 * q + 1] * q4.y + C[4 * q + 2] * q4.z + C[4 * q + 3] * q4.w;
        }
        const float hv = num / fmaxf(fabsf(den), __expf(-mt));
        const float ms = wave_sum_fast(hv * hv) * (1.f / 64.f);
        p.OutB[(size_t)(m0 + t) * 512 + qc] = f2bf(sigm(wsm[1536 + t * 64 + lane]) * hv * rsqrtf(ms + 1e-6f) * gnw * silu(wsm[2048 + t * 64 + lane]));
    }
    {
        float* o = p.out + O_SC + ((size_t)(sb * 8 + h) * 64 + lane) * 64;
#pragma unroll
        for (int q = 0; q < 16; ++q) { float4 v; v.x = C[4 * q]; v.y = C[4 * q + 1]; v.z = C[4 * q + 2]; v.w = C[4 * q + 3]; *(float4*)(o + q * 4) = v; }
        p.out[O_SN + (size_t)(sb * 8 + h) * 64 + lane] = nl;
        if (lane == 0) p.out[O_SM + sb * 8 + h] = m;
    }
    wave_lds_fence();
}

__device__ void phaseE(const Params& p, float* sm, int bid, int nb) {
    constexpr int N_RP = 192, N_MP = 64, N_RS = 128, N_MS = 128;
    int* s_item = (int*)(sm + 32768);
    for (;;) {
        if (otid() == 0) *s_item = (int)atomicAdd(p.ctr, 1u);
        __syncthreads();
        const int it = *s_item;
        __syncthreads();
        if (it >= N_RP + N_MP + N_RS + N_MS) break;
        if (it < N_RP) { rwkv_item(p, it / 24, (it / 3) & 7, it % 3, sm); }
        else if (it < N_RP + N_MP) { const int i = it - N_RP; mlstm_prompt(p, i >> 3, i & 7, sm); }
        else if (it < N_RP + N_MP + N_RS) { const int wid = otid() >> 6; const int i = (it - N_RP - N_MP) * 8 + wid; rwkv_sample_wave(p, i >> 3, i & 7, sm + wid * 3328); }
        else if (it < N_RP + N_MP + N_RS + N_MS) { const int wid = otid() >> 6; const int i = (it - N_RP - N_MP - N_RS) * 8 + wid; mlstm_sample_wave(p, i >> 3, i & 7, sm + wid * 3328); }
    }
}

__device__ void phaseF(const Params& p, int bid, int nb) {
    const int wid = otid() >> 6, lane = otid() & 63;
    const int c8 = lane * 8;
    float lnw[8], lnb[8], mur[8], muk[8], muv[8], kaw[8], rkw[8];
#pragma unroll
    for (int i = 0; i < 8; ++i) {
        lnw[i] = p.ln_w[c8 + i]; lnb[i] = p.ln_b[c8 + i]; mur[i] = p.mu_shift[C_R + c8 + i]; muk[i] = p.mu_shift[C_K + c8 + i];
        muv[i] = p.mu_shift[C_V + c8 + i]; kaw[i] = p.k_a[c8 + i]; rkw[i] = p.r_k[c8 + i];
    }
    auto un8 = [](const uint4 u, float* o) {
        o[0] = __uint_as_float(u.x << 16); o[1] = __uint_as_float(u.x & 0xFFFF0000u); o[2] = __uint_as_float(u.y << 16); o[3] = __uint_as_float(u.y & 0xFFFF0000u);
        o[4] = __uint_as_float(u.z << 16); o[5] = __uint_as_float(u.z & 0xFFFF0000u); o[6] = __uint_as_float(u.w << 16); o[7] = __uint_as_float(u.w & 0xFFFF0000u);
    };
    for (int m = bid * 8 + wid; m < M_TOT; m += nb * 8) {
        int s, t; tok_info(m, s, t);
        const bf16_t* pr = p.P + (size_t)m * NP + c8;
        const uint4 uy = *(const uint4*)(p.Yraw + (size_t)m * 512 + c8);
        const uint4 ur = *(const uint4*)(pr + C_R), uk = *(const uint4*)(pr + C_K), uv = *(const uint4*)(pr + C_V), uz = *(const uint4*)(pr + C_ZA);
        const uint4 ua = *(const uint4*)(p.Aa + (size_t)m * 512 + c8);
        float y[8], r[8], k[8], v[8], z[8], a[8], rp[8], kp_[8], vp[8];
        if (t > 0) {
            const uint4 urp = *(const uint4*)(pr + C_R - NP), ukp = *(const uint4*)(pr + C_K - NP), uvp = *(const uint4*)(pr + C_V - NP);
            un8(urp, rp); un8(ukp, kp_); un8(uvp, vp);
        } else if (s >= 8) {
            const float* st = p.st_shift + (size_t)(s - 8) * SHIFT_W + c8;
#pragma unroll
            for (int i = 0; i < 8; ++i) { rp[i] = st[C_R + i]; kp_[i] = st[C_K + i]; vp[i] = st[C_V + i]; }
        } else {
#pragma unroll
            for (int i = 0; i < 8; ++i) { rp[i] = 0.f; kp_[i] = 0.f; vp[i] = 0.f; }
        }
        un8(uy, y); un8(ur, r); un8(uk, k); un8(uv, v); un8(uz, z); un8(ua, a);
        float sy = 0.f;
#pragma unroll
        for (int i = 0; i < 8; ++i) sy += y[i];
        const float mean = sum8(sy) * (1.f / 64.f);
        float sv = 0.f, sbn = 0.f;
#pragma unroll
        for (int i = 0; i < 8; ++i) {
            y[i] -= mean; sv += y[i] * y[i];
            r[i] += mur[i] * (rp[i] - r[i]); k[i] += muk[i] * (kp_[i] - k[i]); v[i] += muv[i] * (vp[i] - v[i]);
            sbn += r[i] * (k[i] * (1.f + (a[i] - 1.f) * kaw[i])) * rkw[i];
        }
        const float rstd = rsqrtf(sum8(sv) * (1.f / 64.f) + 64e-5f);
        const float bonus = sum8(sbn);
        float o[8];
#pragma unroll
        for (int i = 0; i < 8; ++i) o[i] = (y[i] * rstd * lnw[i] + lnb[i] + bonus * v[i]) * silu(z[i]);
        uint4 ou; ou.x = pk2(o[0], o[1]); ou.y = pk2(o[2], o[3]); ou.z = pk2(o[4], o[5]); ou.w = pk2(o[6], o[7]);
        *(uint4*)(p.OutA + (size_t)m * 512 + c8) = ou;
    }
}

__device__ __forceinline__ void yrow_store(const Params& p, float* yr, int lane, const float4 (&v)[4], float rstd) {
#pragma unroll
    for (int i = 0; i < 4; ++i) {
        const int c = i * 256 + lane * 4;
        const float4 g = *(const float4*)(p.g_final + c);
        float4 o; o.x = v[i].x * rstd * g.x; o.y = v[i].y * rstd * g.y; o.z = v[i].z * rstd * g.z; o.w = v[i].w * rstd * g.w;
        *(float4*)(yr + c) = o;
    }
}
__device__ void phaseI(const Params& p, int bid, int nb) {
    const int wid = otid() >> 6, lane = otid() & 63;
    const int stride = nb * 8;
    for (int m = bid * 8 + wid; m < M_TOT; m += 2 * stride) {
        const int m2 = m + stride;
        const bool has2 = m2 < M_TOT;
        float* ya = p.out + (size_t)m * 1024;
        float* yb = p.out + (size_t)(has2 ? m2 : m) * 1024;
        float4 va[4], vb[4];
        normrow_load(ya, lane, va);
        normrow_load(yb, lane, vb);
        const float ra = rsqrtf(wave_sum(sumsq4(va)) * (1.f / 1024.f) + 1e-6f);
        const float rb = rsqrtf(wave_sum(sumsq4(vb)) * (1.f / 1024.f) + 1e-6f);
        yrow_store(p, ya, lane, va, ra);
        if (has2) yrow_store(p, yb, lane, vb, rb);
    }
}

namespace pg8 {
#define PG8_LAS __attribute__((address_space(3)))
typedef unsigned short bf16_t;
typedef short bf16x8 __attribute__((ext_vector_type(8)));
typedef float f32x4 __attribute__((ext_vector_type(4)));
typedef unsigned u32x4 __attribute__((ext_vector_type(4)));
constexpr int BM = 256, BK = 64, HALF = 128, HTB = HALF * BK * 2  , STAGE_BYTES = 8 * HTB, NXCD = 8, WGM = 8;

__host__ __device__ __forceinline__ int lds_byte(int r, int c) { const int st = (r >> 4) * 2 + (c >> 5), rr = r & 15, cc = c & 31, ob = rr * 64 + cc * 2; return st * 1024 + (ob ^ (((ob >> 9) & 1) << 5)); }
__host__ __device__ __forceinline__ void stage_rc(int b, int& R, int& C) { const int st = b / 1024, sb = b % 1024, swz = sb ^ (((sb >> 9) & 1) << 5); R = (st >> 1) * 16 + swz / 64; C = (st & 1) * 32 + (swz % 64) / 2; }
__host__ __device__ __forceinline__ int perm32(int rho) { const int n = rho >> 4, i = rho & 15; return 8 * (i >> 2) + 4 * n + (i & 3); }

struct Unit { int pm, pn; };
struct Gemm { const bf16_t* A; const bf16_t* Bt; int M, N, K, lda, ldb; };

struct StaticOrder {
    int nM, nN, nwg, G, c;
    __host__ __device__ void init(int M, int N, int G_, int c_) { nM = M / BM; nN = N / BM; nwg = nM * nN; G = G_; c = c_; }
    __host__ __device__ bool next(int i, Unit& u) const {
        const long L = (long)i * G + c; if (L >= nwg) return false;
        int wgid = (int)L; { const int q = nwg / NXCD, r = nwg % NXCD, xcd = wgid % NXCD, off = wgid / NXCD; wgid = (xcd < r ? xcd * (q + 1) : r * (q + 1) + (xcd - r) * q) + off; }
        const int nig = WGM * nN, gid = wgid / nig, fm = gid * WGM, gsz = (nM - fm) < WGM ? (nM - fm) : WGM;
        u.pm = fm + ((wgid % nig) % gsz); u.pn = (wgid % nig) / gsz; return true;
    }
    __device__ __forceinline__ void a_ready(const Unit&) const {}
    __device__ __forceinline__ void done(const Unit&) const {}
};
template <class Epi, class Sched, bool STAMP = false>
__device__ __forceinline__ void gemm_phase(PG8_LAS unsigned char* lds, const Gemm g, const Sched& S, const Epi& E, unsigned long long* stamps) {
    const int tid = otid(), wid = __builtin_amdgcn_readfirstlane(tid >> 6), lane = tid & 63, wr = wid >> 2, wc = wid & 3, fr = lane & 15, fq = lane >> 4;
    const int K = g.K, nt = K / BK;
    int ts_lo = 0, ts_hi = 0, nts = 0; const unsigned long long rt_entry = STAMP ? (unsigned long long)wall_clock64() : 0ull;
#define PG8_STAMP() do { if (STAMP && wid == 0 && nts < 64) { const unsigned long long _c = (unsigned long long)clock64(); \
        ts_lo = (lane == nts) ? (int)(unsigned)_c : ts_lo; ts_hi = (lane == nts) ? (int)(unsigned)(_c >> 32) : ts_hi; ++nts; } } while (0)
    PG8_STAMP();
    unsigned voffA[2], voffB[2];
#pragma unroll
    for (int i = 0; i < 2; ++i) { int R, C; stage_rc(tid * 16 + i * 8192, R, C); const int Rb = Epi::PERM ? ((R & ~31) + perm32(R & 31)) : R;
        voffA[i] = (unsigned)(R * g.lda + C) * 2u; voffB[i] = (unsigned)(Rb * g.ldb + C) * 2u; }
    const size_t kstep = (size_t)(BK * 2);
    const size_t hstepA = (size_t)HALF * g.lda * 2, hstepB = (size_t)HALF * g.ldb * 2;
    const size_t tstepA = 2 * hstepA, tstepB = 2 * hstepB;
    const unsigned ldsw = (unsigned)wid * 1024u;
    const int aoff = lds_byte(wr * 64 + fr, fq * 8), boff = lds_byte(wc * 32 + fr, fq * 8);
#define PG8_SA(b, h) (((b) * 2 + (h)) * HTB)
#define PG8_SB(b, h) ((4 + (b) * 2 + (h)) * HTB)
#define PG8_STAGE(bufoff, gbase, voff) do { _Pragma("unroll") for (int _i = 0; _i < 2; ++_i) \
        __builtin_amdgcn_global_load_lds((const unsigned*)((const char*)(gbase) + (voff)[_i]), (PG8_LAS unsigned*)(lds + (bufoff) + ldsw + _i * 8192), 16, 0, 0); } while (0)
#define PG8_LDA(dst, b, h) do { _Pragma("unroll") for (int m = 0; m < 4; ++m) _Pragma("unroll") for (int k = 0; k < 2; ++k) dst[m][k] = *(const PG8_LAS bf16x8*)(lds + PG8_SA(b, h) + aoff + m * 2048 + k * 1024); } while (0)
#define PG8_LDB(dst, b, h) do { _Pragma("unroll") for (int n = 0; n < 2; ++n) _Pragma("unroll") for (int k = 0; k < 2; ++k) dst[n][k] = *(const PG8_LAS bf16x8*)(lds + PG8_SB(b, h) + boff + n * 2048 + k * 1024); } while (0)
#define PG8_MMA(ai, bj, At, Bt) do { __builtin_amdgcn_s_setprio(1); _Pragma("unroll") for (int m = 0; m < 4; ++m) _Pragma("unroll") for (int n = 0; n < 2; ++n) _Pragma("unroll") for (int k = 0; k < 2; ++k) \
        acc[ai][bj][m][n] = __builtin_amdgcn_mfma_f32_16x16x32_bf16(Bt[n][k], At[m][k], acc[ai][bj][m][n], 0, 0, 0); __builtin_amdgcn_s_setprio(0); } while (0)
#define PG8_WAIT_V(n) asm volatile("s_waitcnt vmcnt(" #n ")" ::: "memory")
#define PG8_WAIT_L(n) asm volatile("s_waitcnt lgkmcnt(" #n ")" ::: "memory")
#define PG8_BAR __builtin_amdgcn_s_barrier()
#define PG8_SCHED __builtin_amdgcn_sched_barrier(0)
    Unit cur, nxt; int ui = 0;
    if (!S.next(0, cur)) return;
    f32x4 acc[2][2][4][2];
#pragma unroll
    for (int a = 0; a < 2; ++a)
#pragma unroll
        for (int b = 0; b < 2; ++b)
#pragma unroll
            for (int m = 0; m < 4; ++m)
#pragma unroll
                for (int n = 0; n < 2; ++n) acc[a][b][m][n] = (f32x4){0.f, 0.f, 0.f, 0.f};
    bf16x8 At[4][2], B0[2][2], B1[2][2];
    const char* cA = (const char*)g.A + (size_t)cur.pm * tstepA; const char* cB = (const char*)g.Bt + (size_t)cur.pn * tstepB;
    S.a_ready(cur);
    PG8_STAGE(PG8_SB(0, 0), cB, voffB); PG8_STAGE(PG8_SA(0, 0), cA, voffA); PG8_STAGE(PG8_SB(0, 1), cB + hstepB, voffB); PG8_STAGE(PG8_SA(0, 1), cA + hstepA, voffA);
    if (wr == 1) PG8_BAR;
    PG8_WAIT_V(4); PG8_BAR;
    PG8_STAGE(PG8_SB(1, 0), cB + kstep, voffB); PG8_STAGE(PG8_SA(1, 0), cA + kstep, voffA); PG8_STAGE(PG8_SB(1, 1), cB + hstepB + kstep, voffB);
    PG8_WAIT_V(6); PG8_BAR;
    PG8_STAMP();
    for (;;) {
        const bool has_next = S.next(ui + 1, nxt);
        const char* nA = has_next ? (const char*)g.A + (size_t)nxt.pm * tstepA : cA; const char* nB = has_next ? (const char*)g.Bt + (size_t)nxt.pn * tstepB : cB;
        for (int t = 0; t < nt; t += 2) {
            const bool last = (t == nt - 2);
            const char* a1 = cA + (size_t)(t + 1) * kstep;
            const char* a2 = last ? nA : cA + (size_t)(t + 2) * kstep; const char* b2 = last ? nB : cB + (size_t)(t + 2) * kstep;
            const char* a3 = a2 + kstep; const char* b3 = b2 + kstep;
            if (last && has_next) S.a_ready(nxt);
            PG8_LDB(B0, 0, 0); PG8_SCHED; PG8_LDA(At, 0, 0); PG8_STAGE(PG8_SA(1, 1), a1 + hstepA, voffA);
            PG8_WAIT_L(8); PG8_BAR; PG8_WAIT_L(0); PG8_MMA(0, 0, At, B0); PG8_BAR; PG8_SCHED;
            PG8_LDB(B1, 0, 1); PG8_STAGE(PG8_SB(0, 0), b2, voffB);
            PG8_BAR; PG8_WAIT_L(0); PG8_MMA(0, 1, At, B1); PG8_BAR;
            PG8_LDA(At, 0, 1); PG8_STAGE(PG8_SA(0, 0), a2, voffA);
            PG8_BAR; PG8_WAIT_L(0); PG8_MMA(1, 0, At, B0); PG8_BAR; PG8_SCHED;
            PG8_STAGE(PG8_SB(0, 1), b2 + hstepB, voffB);
            PG8_WAIT_V(6); PG8_BAR; PG8_MMA(1, 1, At, B1); PG8_BAR;
            PG8_LDB(B0, 1, 0); PG8_SCHED; PG8_LDA(At, 1, 0); PG8_STAGE(PG8_SA(0, 1), a2 + hstepA, voffA);
            PG8_WAIT_L(8); PG8_BAR; PG8_WAIT_L(0); PG8_MMA(0, 0, At, B0); PG8_BAR; PG8_SCHED;
            PG8_LDB(B1, 1, 1); PG8_STAGE(PG8_SB(1, 0), b3, voffB);
            PG8_BAR; PG8_WAIT_L(0); PG8_MMA(0, 1, At, B1); PG8_BAR;
            PG8_LDA(At, 1, 1); PG8_STAGE(PG8_SA(1, 0), a3, voffA);
            PG8_BAR; PG8_WAIT_L(0); PG8_MMA(1, 0, At, B0); PG8_BAR; PG8_SCHED;
            PG8_STAGE(PG8_SB(1, 1), b3 + hstepB, voffB);
            PG8_WAIT_V(6); PG8_BAR; PG8_MMA(1, 1, At, B1); PG8_BAR;
        }
        PG8_STAMP();
        if constexpr (!Epi::AFTER_DRAIN) { E(acc, cur, wr, wc, fr, fq); S.done(cur); }
        PG8_STAMP();
        if (!has_next) break;
#pragma unroll
        for (int a = 0; a < 2; ++a)
#pragma unroll
            for (int b = 0; b < 2; ++b)
#pragma unroll
                for (int m = 0; m < 4; ++m)
#pragma unroll
                    for (int n = 0; n < 2; ++n) acc[a][b][m][n] = (f32x4){0.f, 0.f, 0.f, 0.f};
        cur = nxt; cA = nA; cB = nB; ++ui;
    }
    PG8_WAIT_V(0);
    if (wr == 0) PG8_BAR;
    PG8_BAR;
    if constexpr (Epi::AFTER_DRAIN) { E.fused(acc, cur, wr, wc, fr, fq, lds, wid, lane); S.done(cur); }
    PG8_STAMP();
    if (STAMP && wid == 0) { stamps[lane] = lane < nts ? (((unsigned long long)(unsigned)ts_hi << 32) | (unsigned)ts_lo) : 0ull;
        if (lane == 62) stamps[62] = rt_entry; if (lane == 63) stamps[63] = (unsigned long long)wall_clock64(); }
#undef PG8_STAMP
#undef PG8_SA
#undef PG8_SB
#undef PG8_STAGE
#undef PG8_LDA
#undef PG8_LDB
#undef PG8_MMA
#undef PG8_WAIT_V
#undef PG8_WAIT_L
#undef PG8_BAR
#undef PG8_SCHED
}
}

struct EpiP {
    static constexpr bool PERM = true, AFTER_DRAIN = false;
    bf16_t* O; int ldc;
    __device__ __forceinline__ void operator()(const f32x4 (&acc)[2][2][4][2], const pg8::Unit& u, int wr, int wc, int fr, int fq) const {
        const int row0 = u.pm * 256 + wr * 64 + fr, col0 = u.pn * 256 + wc * 32 + 8 * fq;
#pragma unroll
        for (int ai = 0; ai < 2; ++ai)
#pragma unroll
            for (int m = 0; m < 4; ++m) {
                bf16_t* rowp = O + (size_t)(row0 + ai * 128 + m * 16) * ldc + col0;
#pragma unroll
                for (int bj = 0; bj < 2; ++bj) {
                    const f32x4 v0 = acc[ai][bj][m][0], v1 = acc[ai][bj][m][1];
                    uint4 o; o.x = pk2(v0[0], v0[1]); o.y = pk2(v0[2], v0[3]); o.z = pk2(v1[0], v1[1]); o.w = pk2(v1[2], v1[3]);
                    *(uint4*)(rowp + bj * 128) = o;
                }
            }
    }
};
template <int SECOND> struct EpiMerge {
    static constexpr bool PERM = true, AFTER_DRAIN = false;
    bf16_t* P; int gcol;
    __device__ __forceinline__ void operator()(const f32x4 (&acc)[2][2][4][2], const pg8::Unit& u, int wr, int wc, int fr, int fq) const {
        const int row0 = u.pm * 256 + wr * 64 + fr, col0 = u.pn * 256 + wc * 32 + 8 * fq;
#pragma unroll
        for (int ai = 0; ai < 2; ++ai)
#pragma unroll
            for (int m = 0; m < 4; ++m) {
                bf16_t* rowp = P + (size_t)(row0 + ai * 128 + m * 16) * NP + col0;
#pragma unroll
                for (int bj = 0; bj < 2; ++bj) {
                    const f32x4 v0 = acc[ai][bj][m][0], v1 = acc[ai][bj][m][1];
                    const uint4 g = *(const uint4*)(rowp + gcol + bj * 128);
                    const float4 ga = unpk4(make_uint2(g.x, g.y)), gb = unpk4(make_uint2(g.z, g.w));
                    float r[8] = {sigm(ga.x) * v0[0], sigm(ga.y) * v0[1], sigm(ga.z) * v0[2], sigm(ga.w) * v0[3],
                                  sigm(gb.x) * v1[0], sigm(gb.y) * v1[1], sigm(gb.z) * v1[2], sigm(gb.w) * v1[3]};
                    if (SECOND) {
                        const uint4 pv = *(const uint4*)(rowp + bj * 128);
                        const float4 pa = unpk4(make_uint2(pv.x, pv.y)), pb = unpk4(make_uint2(pv.z, pv.w));
                        r[0] += pa.x; r[1] += pa.y; r[2] += pa.z; r[3] += pa.w; r[4] += pb.x; r[5] += pb.y; r[6] += pb.z; r[7] += pb.w;
                    }
                    uint4 o; o.x = pk2(r[0], r[1]); o.y = pk2(r[2], r[3]); o.z = pk2(r[4], r[5]); o.w = pk2(r[6], r[7]);
                    *(uint4*)(rowp + bj * 128) = o;
                }
            }
    }
};
struct EpiOut {
    static constexpr bool PERM = false, AFTER_DRAIN = false;
    const Params* pp;
    __device__ __forceinline__ void operator()(const f32x4 (&acc)[2][2][4][2], const pg8::Unit& u, int wr, int wc, int fr, int fq) const {
        const Params& p = *pp;
        const int row0 = u.pm * 256 + wr * 64 + fr, col0 = u.pn * 256 + wc * 32 + 4 * fq;
#pragma unroll
        for (int ai = 0; ai < 2; ++ai)
#pragma unroll
            for (int m = 0; m < 4; ++m) {
                const int row = row0 + ai * 128 + m * 16;
                int s, t; tok_info(row, s, t);
                const float* xr = xrow(p, row) + col0;
                const float* gt = p.mod + (size_t)s * 3072 + 2048 + col0;
                float* orow = p.out + (size_t)row * 1024 + col0;
#pragma unroll
                for (int bj = 0; bj < 2; ++bj)
#pragma unroll
                    for (int n = 0; n < 2; ++n) {
                        const int co = bj * 128 + n * 16;
                        const float4 xv = *(const float4*)(xr + co), gv = *(const float4*)(gt + co);
                        const f32x4 a = acc[ai][bj][m][n];
                        float4 o; o.x = xv.x + gv.x * a[0]; o.y = xv.y + gv.y * a[1]; o.z = xv.z + gv.z * a[2]; o.w = xv.w + gv.w * a[3];
                        *(float4*)(orow + co) = o;
                    }
            }
    }
};
template <class Epi> __device__ __forceinline__ void run_gemm(float* sm, const bf16_t* A, int lda, const bf16_t* Bt, int ldb, int M, int N, int K, const Epi& E, int bid, int nb) {
    pg8::Gemm g; g.A = A; g.Bt = Bt; g.M = M; g.N = N; g.K = K; g.lda = lda; g.ldb = ldb;
    pg8::StaticOrder S; S.init(M, N, nb, bid);
    pg8::gemm_phase<Epi, pg8::StaticOrder, false>((PG8_LAS unsigned char*)sm, g, S, E, nullptr);
}
__device__ void phaseC(const Params& p, float* sm, int bid, int nb) {
    EpiP E; E.O = p.P; E.ldc = NP;
    run_gemm(sm, p.H, 1024, p.WinT, 1024, M_TOT, NP, 1024, E, bid, nb);
}
__device__ void phaseG(const Params& p, float* sm, int bid, int nb) {
    EpiMerge<0> E0; E0.P = p.P; E0.gcol = C_GLA;
    run_gemm(sm, p.OutA, 512, p.WupaT, 512, M_TOT, 1024, 512, E0, bid, nb);
    __syncthreads();
    EpiMerge<1> E1; E1.P = p.P; E1.gcol = C_GLB;
    run_gemm(sm, p.OutB, 512, p.WupbT, 512, M_TOT, 1024, 512, E1, bid, nb);
}
__device__ void phaseH(const Params& p, float* sm, int bid, int nb) {
    EpiOut E; E.pp = &p;
    run_gemm(sm, p.P, NP, p.WoutT, 1024, M_TOT, 1024, 1024, E, bid, nb);
}

#define XB_TMO      128
#define XB_XCNT(j)  (256  + 64 * (j))
#define XB_XSUB(j)  (1280 + 64 * (j))
#define XB_XGEN(j)  (2304 + 64 * (j))
#define XB_TOP      3328
#define XB_TOPGEN   3392
#define XCD_BAR_WORDS 3456
#define XB_SPIN_CAP (1u << 18)
#define LAS __attribute__((address_space(3)))

__device__ __forceinline__ unsigned xb_ld(unsigned* p)              { return __hip_atomic_load(p, __ATOMIC_RELAXED, __HIP_MEMORY_SCOPE_AGENT); }
__device__ __forceinline__ unsigned xb_add(unsigned* p, unsigned v) { return __hip_atomic_fetch_add(p, v, __ATOMIC_RELAXED, __HIP_MEMORY_SCOPE_AGENT); }
__device__ __forceinline__ unsigned xb_xcc_id() { return (unsigned)__builtin_amdgcn_s_getreg((3 << 11) | 20) & 0xFu; }
#define XB_SPIN(cond, bar) do { unsigned _sp = 0; while (cond) { __builtin_amdgcn_s_sleep(1); \
    if ((++_sp & 255u) == 0u) { if (xb_ld(&(bar)[XB_TMO])) break; if (_sp > XB_SPIN_CAP) { atomicAdd(&(bar)[XB_TMO], 1u); break; } } } } while (0)

struct XcdBarrier {
    unsigned* bar; unsigned x;
    volatile LAS unsigned* st;
};

__device__ __forceinline__ XcdBarrier xcd_barrier_post(unsigned* bar, volatile LAS unsigned* st) {
    XcdBarrier b; b.bar = bar; b.x = xb_xcc_id(); b.st = st;
    if (threadIdx.x == 0) (void)xb_add(&bar[XB_XCNT(b.x)], 1u);
    return b;
}
__device__ __forceinline__ void xcd_barrier_complete(unsigned* bar, unsigned x, unsigned& nloc, unsigned& nx) {
    const unsigned G = gridDim.x * gridDim.y * gridDim.z;
    unsigned sum, cnt, mine, sp = 0u;
    for (;;) {
        sum = 0u; cnt = 0u; mine = 0u;
#pragma unroll
        for (unsigned j = 0; j < 16; ++j) { const unsigned c = xb_ld(&bar[XB_XCNT(j)]); sum += c; cnt += (c > 0u) ? 1u : 0u; mine = (j == x) ? c : mine; }
        if (sum == G) break;
        __builtin_amdgcn_s_sleep(1);
        if ((++sp & 255u) == 0u) { if (xb_ld(&bar[XB_TMO])) break; if (sp > XB_SPIN_CAP) { atomicAdd(&bar[XB_TMO], 1u); break; } }
    }
    nloc = mine > 0u ? mine : 1u; nx = cnt > 0u ? cnt : 1u;
}

__device__ __forceinline__ void xcd_barrier(const XcdBarrier& b) {
    asm volatile("s_waitcnt vmcnt(0)" ::: "memory");
    __syncthreads();
    if (threadIdx.x == 0) {
        unsigned* bar = b.bar;
        __builtin_amdgcn_s_waitcnt(0);
        unsigned nloc = b.st[0], nx = b.st[1];
        if (nloc == 0u) { xcd_barrier_complete(bar, b.x, nloc, nx); b.st[0] = nloc; b.st[1] = nx; }
        const unsigned old = xb_add(&bar[XB_XSUB(b.x)], 1u);
        const unsigned gen = old / nloc;
        if (old + 1u == (gen + 1u) * nloc) {
            __builtin_amdgcn_fence(__ATOMIC_RELEASE, "agent");
            asm volatile("s_waitcnt vmcnt(0)" ::: "memory");
            const unsigned og = xb_add(&bar[XB_TOP], 1u);
            const unsigned tg = og / nx;
            if (og + 1u == (tg + 1u) * nx) xb_add(&bar[XB_TOPGEN], 1u);
            else XB_SPIN(xb_ld(&bar[XB_TOPGEN]) == tg, bar);
            __builtin_amdgcn_fence(__ATOMIC_ACQUIRE, "agent");
            xb_add(&bar[XB_XGEN(b.x)], 1u);
            asm volatile("s_waitcnt vmcnt(0)" ::: "memory");
        } else {
            XB_SPIN(xb_ld(&bar[XB_XGEN(b.x)]) == gen, bar);
            __builtin_amdgcn_fence(__ATOMIC_ACQUIRE, "agent");
            asm volatile("s_waitcnt vmcnt(0)" ::: "memory");
        }
    }
    __syncthreads();
}


#if MK_MULTI
#define PHASE_KERNEL(NAME, CALL) __global__ void __launch_bounds__(NTHR) NAME(Params p) { __shared__ __attribute__((aligned(16))) float sm[SMEM_FLOATS]; const int bid = blockIdx.x, nb = gridDim.x; (void)sm; CALL; }
PHASE_KERNEL(kA, phaseA(p, sm, bid, nb))
PHASE_KERNEL(kB, phaseB(p, bid, nb))
PHASE_KERNEL(kC, phaseC(p, sm, bid, nb))
PHASE_KERNEL(kD, phaseD(p, sm, bid, nb))
PHASE_KERNEL(kE, phaseE(p, sm, bid, nb))
PHASE_KERNEL(kF, phaseF(p, bid, nb))
PHASE_KERNEL(kG, phaseG(p, sm, bid, nb))
PHASE_KERNEL(kH, phaseH(p, sm, bid, nb))
PHASE_KERNEL(kI, phaseI(p, bid, nb))
#else
__global__ void __launch_bounds__(NTHR) fwd_megakernel(Params p) {
    __shared__ __attribute__((aligned(16))) float sm[SMEM_FLOATS];
    __shared__ uint4 xb_words;
    cg::grid_group grid = cg::this_grid();
    const int bid = blockIdx.x, nb = gridDim.x;
    if (threadIdx.x == 0) xb_words = make_uint4(0u, 0u, 0u, 0u);
    __syncthreads();
    XcdBarrier xb = xcd_barrier_post(p.bar, (volatile LAS unsigned*)&xb_words);
    phaseA(p, sm, bid, nb); grid.sync();
    phaseB(p, bid, nb); xcd_barrier(xb);
    phaseC(p, sm, bid, nb); xcd_barrier(xb);
    phaseD(p, sm, bid, nb); xcd_barrier(xb);
    phaseE(p, sm, bid, nb); xcd_barrier(xb);
    phaseF(p, bid, nb); xcd_barrier(xb);
    phaseG(p, sm, bid, nb); xcd_barrier(xb);
    phaseH(p, sm, bid, nb); xcd_barrier(xb);
    phaseI(p, bid, nb);
}
#endif

extern "C" void kernel_launch(void* const* d_in, const int* in_sizes, int n_in, void* d_out, int out_size, void* d_ws, size_t ws_size,
                              hipStream_t stream) {
    Params p{};
    const float* const* in = (const float* const*)d_in;
    p.x_p = in[0]; p.x_s = in[1]; p.c_p = in[2]; p.c_s = in[3];
    p.st_shift = in[4]; p.st_S = in[5]; p.st_conv = in[6]; p.st_C = in[7]; p.st_n = in[8]; p.st_m = in[9];
    p.g_norm = in[10]; p.w_ada = in[11]; p.b_ada = in[12]; p.w_in = in[13]; p.mu_shift = in[14]; p.w_decay2 = in[15];
    p.w0 = in[16]; p.w_iclr2 = in[17]; p.a0 = in[18]; p.k_k = in[19]; p.k_a = in[20]; p.r_k = in[21];
    p.ln_w = in[22]; p.ln_b = in[23]; p.conv_w = in[24]; p.conv_b = in[25]; p.b_i = in[26]; p.b_f = in[27];
    p.gn_w = in[28]; p.w_up_a = in[29]; p.w_up_b = in[30]; p.w_out = in[31]; p.g_final = in[32];
    p.out = (float*)d_out;
    char* ws = (char*)d_ws;
    size_t off = 0;
    p.P = (bf16_t*)(ws + off); off += (size_t)M_TOT * NP * 2;
    p.WinT = (bf16_t*)(ws + off); off += (size_t)NP * 1024 * 2;
    p.WupaT = (bf16_t*)(ws + off); off += (size_t)1024 * 512 * 2;
    p.WupbT = (bf16_t*)(ws + off); off += (size_t)1024 * 512 * 2;
    p.WoutT = (bf16_t*)(ws + off); off += (size_t)1024 * 1024 * 2;
    p.mod = (float*)(ws + off); off += (size_t)NSEQ * 3072 * 4;
    p.ctr = (unsigned*)(ws + off); off += 256;
    p.bar = (unsigned*)(ws + off); off += (size_t)XCD_BAR_WORDS * 4;
    char* os = (char*)d_out;
    p.H = (bf16_t*)os;
    p.Yraw = (bf16_t*)os;
    p.OutB = (bf16_t*)(os + (size_t)M_TOT * 512 * 2);
    p.Omd = (bf16_t*)(os + (size_t)M_TOT * 1024 * 2);
    p.Aa = (bf16_t*)(os + (size_t)M_TOT * 1024 * 2 + (size_t)M_TOT * 512 * 2);
    p.OutA = p.Omd;
#if MK_MULTI
    const int G = 1024;
    kA<<<G, NTHR, 0, stream>>>(p);
    kB<<<G, NTHR, 0, stream>>>(p);
    kC<<<G, NTHR, 0, stream>>>(p);
    kD<<<G, NTHR, 0, stream>>>(p);
    kE<<<G, NTHR, 0, stream>>>(p);
    kF<<<G, NTHR, 0, stream>>>(p);
    kG<<<G, NTHR, 0, stream>>>(p);
    kH<<<G, NTHR, 0, stream>>>(p);
    kI<<<G, NTHR, 0, stream>>>(p);
#else
    static int grid_blocks = 0;
    if (!grid_blocks) {
        int dev = 0, cus = 0, per_cu = 0;
        hipGetDevice(&dev);
        hipDeviceGetAttribute(&cus, hipDeviceAttributeMultiprocessorCount, dev);
        hipOccupancyMaxActiveBlocksPerMultiprocessor(&per_cu, fwd_megakernel, NTHR, 0);
        if (per_cu > 1) per_cu = 1;
        grid_blocks = cus * per_cu;
    }
    (void)hipMemsetAsync(p.ctr, 0, 256 + (size_t)XCD_BAR_WORDS * 4, stream);
    void* args[] = {&p};
    hipError_t e = hipLaunchCooperativeKernel((void*)fwd_megakernel, dim3(grid_blocks), dim3(NTHR), args, 0, stream);
    if (e != hipSuccess) fprintf(stderr, "cooperative launch failed: %s (grid %d)\n", hipGetErrorString(e), grid_blocks);
#endif
}
```

```cpp
#include <hip/hip_runtime.h>
#include <hip/hip_cooperative_groups.h>
#include <cstdio>
namespace cg = cooperative_groups;

#ifndef MK_MULTI
#define MK_MULTI 0
#endif

typedef unsigned short bf16_t;
typedef short bf16x8 __attribute__((ext_vector_type(8)));
typedef float f32x4 __attribute__((ext_vector_type(4)));

constexpr int NTHR = 512;
constexpr int M_P = 16384, M_S = 1024, M_TOT = 17408;
constexpr int DM = 1024;
constexpr int NSEQ = 136;
constexpr int NP = 6912;
constexpr int N_IN = 6800;
constexpr int C_R = 0, C_K = 512, C_V = 1024, C_WL = 1536, C_AL = 1600, C_ZA = 1664, C_QK = 2176,
              C_VB = 3200, C_OB = 3712, C_IB = 4224, C_FB = 4232, C_ZB = 4240, C_GLA = 4752, C_GLB = 5776;
constexpr int SHIFT_W = 1664;

constexpr size_t O_Y = 0;
constexpr size_t O_PSHIFT = (size_t)M_TOT * DM;
constexpr size_t O_PS = O_PSHIFT + 8 * 1664;
constexpr size_t O_PCONV = O_PS + 8 * 8 * 4096;
constexpr size_t O_PC = O_PCONV + 8 * 3 * 1024;
constexpr size_t O_PN = O_PC + 8 * 8 * 4096;
constexpr size_t O_PM = O_PN + 8 * 8 * 64;
constexpr size_t O_SSHIFT = O_PM + 64;
constexpr size_t O_SS = O_SSHIFT + 128 * 1664;
constexpr size_t O_SCONV = O_SS + (size_t)128 * 8 * 4096;
constexpr size_t O_SC = O_SCONV + 128 * 3 * 1024;
constexpr size_t O_SN = O_SC + (size_t)128 * 8 * 4096;
constexpr size_t O_SM = O_SN + 128 * 8 * 64;
constexpr size_t O_END = O_SM + 1024;

struct Params {
    const float *x_p, *x_s, *c_p, *c_s;
    const float *st_shift, *st_S, *st_conv, *st_C, *st_n, *st_m;
    const float *g_norm, *w_ada, *b_ada, *w_in, *mu_shift, *w_decay2, *w0, *w_iclr2, *a0, *k_k, *k_a, *r_k,
        *ln_w, *ln_b, *conv_w, *conv_b, *b_i, *b_f, *gn_w, *w_up_a, *w_up_b, *w_out, *g_final;
    float* out;
    bf16_t *WinT, *WupaT, *WupbT, *WoutT;
    float* mod;
    bf16_t* P;
    bf16_t *H, *Yraw, *OutB, *Omd, *Aa, *OutA;
    unsigned* ctr;
    unsigned* bar;
};

constexpr int SMEM_FLOATS = 32768 + 64;
__device__ __forceinline__ int otid() { int t = (int)__builtin_amdgcn_workitem_id_x(); asm volatile("" : "+v"(t)); return t; }
__device__ __forceinline__ void lds_barrier() { asm volatile("s_waitcnt lgkmcnt(0)" ::: "memory"); __builtin_amdgcn_s_barrier(); asm volatile("" ::: "memory"); }
__device__ __forceinline__ float bf2f(bf16_t v) { return __uint_as_float(((unsigned)v) << 16); }
__device__ __forceinline__ bf16_t f2bf(float f) { unsigned u = __float_as_uint(f); u += 0x7FFFu + ((u >> 16) & 1u); return (bf16_t)(u >> 16); }
__device__ __forceinline__ unsigned pk2(float lo, float hi) { return (unsigned)f2bf(lo) | ((unsigned)f2bf(hi) << 16); }
__device__ __forceinline__ float sigm(float x) { return __builtin_amdgcn_rcpf(1.f + __expf(-x)); }
__device__ __forceinline__ float silu(float x) { return x * __builtin_amdgcn_rcpf(1.f + __expf(-x)); }
__device__ __forceinline__ float wave_sum(float v) {
#pragma unroll
    for (int o = 32; o; o >>= 1) v += __shfl_xor(v, o);
    return v;
}
template <int CTRL> __device__ __forceinline__ float dpp_mov(float v) {
    return __builtin_bit_cast(float, __builtin_amdgcn_update_dpp(0, __builtin_bit_cast(int, v), CTRL, 0xF, 0xF, true));
}
__device__ __forceinline__ float row16_sum(float v) {
    v += dpp_mov<0xB1>(v);
    v += dpp_mov<0x4E>(v);
    v += dpp_mov<0x141>(v);
    v += dpp_mov<0x140>(v);
    return v;
}
__device__ __forceinline__ void tok_info(int m, int& s, int& t) {
    if (m < M_P) { s = m >> 11; t = m & 2047; } else { int q = m - M_P; s = 8 + (q >> 3); t = q & 7; }
}
__device__ __forceinline__ const float* xrow(const Params& p, int m) {
    return m < M_P ? p.x_p + (size_t)m * DM : p.x_s + (size_t)(m - M_P) * DM;
}

__device__ __forceinline__ void tr8(const float* __restrict__ src, int Nsrc, bf16_t* __restrict__ dst, int K, int n, int kg) {
    float v[8];
    if (n < Nsrc) {
        const float* sp = src + (size_t)(kg * 8) * Nsrc + n;
#pragma unroll
        for (int i = 0; i < 8; ++i) v[i] = sp[(size_t)i * Nsrc];
    } else {
#pragma unroll
        for (int i = 0; i < 8; ++i) v[i] = 0.f;
    }
    uint4 o; o.x = pk2(v[0], v[1]); o.y = pk2(v[2], v[3]); o.z = pk2(v[4], v[5]); o.w = pk2(v[6], v[7]);
    *(uint4*)(dst + (size_t)n * K + kg * 8) = o;
}
__device__ void phaseA(const Params& p, float* sm, int bid, int nb) {
    const int tid = otid();
    if (bid == 0 && tid == 0) *p.ctr = 0u;
    constexpr int N_ADA = 48 * 17;
    for (int i = bid; i < N_ADA; i += nb) {
        const int ct = i % 48, rgp = i / 48;
        float* sc = sm;
        float* red = sm + 8192;
        {
            float cv[16];
#pragma unroll
            for (int q = 0; q < 16; ++q) {
                const int idx = tid + q * NTHR, sl = idx >> 10, k = idx & 1023, s = rgp * 8 + sl;
                const float* src = s < 8 ? p.c_p + s * 1024 : p.c_s + (s - 8) * 1024;
                cv[q] = src[k];
            }
#pragma unroll
            for (int q = 0; q < 16; ++q) sc[tid + q * NTHR] = silu(cv[q]);
        }
        __syncthreads();
        const int col = tid & 63, kq = tid >> 6;
        float acc[8];
#pragma unroll
        for (int s = 0; s < 8; ++s) acc[s] = 0.f;
        const float* wp = p.w_ada + (size_t)(kq * 128) * 3072 + ct * 64 + col;
#pragma unroll 4
        for (int k4 = 0; k4 < 32; ++k4) {
            const float w0 = wp[(size_t)(k4 * 4) * 3072], w1 = wp[(size_t)(k4 * 4 + 1) * 3072], w2 = wp[(size_t)(k4 * 4 + 2) * 3072], w3 = wp[(size_t)(k4 * 4 + 3) * 3072];
#pragma unroll
            for (int s = 0; s < 8; ++s) {
                const float4 c = *(const float4*)(sc + s * 1024 + kq * 128 + k4 * 4);
                acc[s] += c.x * w0 + c.y * w1 + c.z * w2 + c.w * w3;
            }
        }
#pragma unroll
        for (int s = 0; s < 8; ++s) red[(kq * 8 + s) * 64 + col] = acc[s];
        __syncthreads();
        {
            const int s = tid >> 6;
            float v = p.b_ada[ct * 64 + col];
#pragma unroll
            for (int q = 0; q < 8; ++q) v += red[(q * 8 + s) * 64 + col];
            p.mod[(size_t)(rgp * 8 + s) * 3072 + ct * 64 + col] = v;
        }
        __syncthreads();
    }
    constexpr int W_IN = NP * 128, W_UP = 1024 * 64, W_OUT = 1024 * 128;
    const int gt = bid * NTHR + tid, gs = nb * NTHR;
    for (int w = gt; w < W_IN; w += gs) tr8(p.w_in, N_IN, p.WinT, 1024, w % NP, w / NP);
    for (int w = gt; w < W_UP; w += gs) { tr8(p.w_up_a, 1024, p.WupaT, 512, w & 1023, w >> 10); tr8(p.w_up_b, 1024, p.WupbT, 512, w & 1023, w >> 10); }
    for (int w = gt; w < W_OUT; w += gs) tr8(p.w_out, 1024, p.WoutT, 1024, w & 1023, w >> 10);
}

__device__ __forceinline__ void normrow_load(const float* xr, int lane, float4 (&v)[4]) {
#pragma unroll
    for (int i = 0; i < 4; ++i) v[i] = *(const float4*)(xr + i * 256 + lane * 4);
}
__device__ __forceinline__ float sumsq4(const float4 (&v)[4]) {
    float ss = 0.f;
#pragma unroll
    for (int i = 0; i < 4; ++i) ss += v[i].x * v[i].x + v[i].y * v[i].y + v[i].z * v[i].z + v[i].w * v[i].w;
    return ss;
}
__device__ __forceinline__ void hrow_store(const Params& p, int m, int lane, const float4 (&v)[4], float rstd) {
    int s, t; tok_info(m, s, t);
    const float* md = p.mod + (size_t)s * 3072;
#pragma unroll
    for (int i = 0; i < 4; ++i) {
        const int c = i * 256 + lane * 4;
        const float4 g = *(const float4*)(p.g_norm + c);
        const float4 sh = *(const float4*)(md + c);
        const float4 sl = *(const float4*)(md + 1024 + c);
        const float h0 = v[i].x * rstd * g.x * (1.f + sl.x) + sh.x;
        const float h1 = v[i].y * rstd * g.y * (1.f + sl.y) + sh.y;
        const float h2 = v[i].z * rstd * g.z * (1.f + sl.z) + sh.z;
        const float h3 = v[i].w * rstd * g.w * (1.f + sl.w) + sh.w;
        uint2 o; o.x = pk2(h0, h1); o.y = pk2(h2, h3);
        *(uint2*)(p.H + (size_t)m * 1024 + c) = o;
    }
}
__device__ void phaseB(const Params& p, int bid, int nb) {
    const int wid = otid() >> 6, lane = otid() & 63;
    const int stride = nb * 8;
    for (int m = bid * 8 + wid; m < M_TOT; m += 2 * stride) {
        const int m2 = m + stride;
        const bool has2 = m2 < M_TOT;
        float4 va[4], vb[4];
        normrow_load(xrow(p, m), lane, va);
        normrow_load(xrow(p, has2 ? m2 : m), lane, vb);
        const float ra = rsqrtf(wave_sum(sumsq4(va)) * (1.f / 1024.f) + 1e-6f);
        const float rb = rsqrtf(wave_sum(sumsq4(vb)) * (1.f / 1024.f) + 1e-6f);
        hrow_store(p, m, lane, va, ra);
        if (has2) hrow_store(p, m2, lane, vb, rb);
    }
}

typedef unsigned u32x4v __attribute__((ext_vector_type(4)));
__device__ __forceinline__ bf16x8 pack8(const float (&v)[8]) {
    u32x4v t; t[0] = pk2(v[0], v[1]); t[1] = pk2(v[2], v[3]); t[2] = pk2(v[4], v[5]); t[3] = pk2(v[6], v[7]);
    return __builtin_bit_cast(bf16x8, t);
}
__device__ void phaseD(const Params& p, float* sm, int bid, int nb) {
    const int tid = otid(), wid = tid >> 6, lane = tid & 63, fr = lane & 15, fq = lane >> 4;
    bf16_t* twb = (bf16_t*)sm;
    bf16_t* alb = twb + 16 * 72;
    bf16x8 Bd[4][2], Bi[4][2];
#pragma unroll
    for (int ct = 0; ct < 4; ++ct)
#pragma unroll
        for (int ks = 0; ks < 2; ++ks) {
            const int n = wid * 64 + ct * 16 + fr, k0 = ks * 32 + fq * 8;
            float vd[8], vi[8];
#pragma unroll
            for (int j = 0; j < 8; ++j) { vd[j] = p.w_decay2[(k0 + j) * 512 + n]; vi[j] = p.w_iclr2[(k0 + j) * 512 + n]; }
            Bd[ct][ks] = pack8(vd); Bi[ct][ks] = pack8(vi);
        }
    float w0r[16], a0r[16];
#pragma unroll
    for (int q = 0; q < 16; ++q) { const int col = wid * 64 + (q >> 2) * 16 + fq * 4 + (q & 3); w0r[q] = p.w0[col]; a0r[q] = p.a0[col]; }
    for (int it = bid; it < M_TOT / 16; it += nb) {
        const int m0 = it * 16;
        {
            unsigned cu[4], pv[4]; float st[4];
#pragma unroll
            for (int q = 0; q < 4; ++q) {
                const int idx = tid + q * NTHR, tok = idx >> 7, j = idx & 127, col = C_WL + j, m = m0 + tok;
                int s, t; tok_info(m, s, t);
                cu[q] = p.P[(size_t)m * NP + col];
                pv[q] = p.P[(size_t)(t > 0 ? m - 1 : m) * NP + col];
                st[q] = p.st_shift[(size_t)(s >= 8 ? s - 8 : 0) * SHIFT_W + col];
            }
#pragma unroll
            for (int q = 0; q < 4; ++q) {
                const int idx = tid + q * NTHR, tok = idx >> 7, j = idx & 127, col = C_WL + j, m = m0 + tok;
                int s, t; tok_info(m, s, t);
                const float cur = __uint_as_float(cu[q] << 16);
                const float prev = t > 0 ? __uint_as_float(pv[q] << 16) : (s >= 8 ? st[q] : 0.f);
                const float v = cur + p.mu_shift[col] * (prev - cur);
                if (j < 64) twb[tok * 72 + j] = f2bf(tanhf(v)); else alb[tok * 72 + j - 64] = f2bf(v);
            }
        }
        __syncthreads();
        {
            const bf16x8 at0 = *(const bf16x8*)(twb + fr * 72 + fq * 8), at1 = *(const bf16x8*)(twb + fr * 72 + 32 + fq * 8);
            const bf16x8 aa0 = *(const bf16x8*)(alb + fr * 72 + fq * 8), aa1 = *(const bf16x8*)(alb + fr * 72 + 32 + fq * 8);
            const size_t mrow = (size_t)(m0 + fr) * 512 + wid * 64 + fq * 4;
#pragma unroll
            for (int ct = 0; ct < 4; ++ct) {
                f32x4 cw = (f32x4){0.f, 0.f, 0.f, 0.f}, ca = cw;
                cw = __builtin_amdgcn_mfma_f32_16x16x32_bf16(Bd[ct][0], at0, cw, 0, 0, 0);
                cw = __builtin_amdgcn_mfma_f32_16x16x32_bf16(Bd[ct][1], at1, cw, 0, 0, 0);
                ca = __builtin_amdgcn_mfma_f32_16x16x32_bf16(Bi[ct][0], aa0, ca, 0, 0, 0);
                ca = __builtin_amdgcn_mfma_f32_16x16x32_bf16(Bi[ct][1], aa1, ca, 0, 0, 0);
                float o[4], a[4];
#pragma unroll
                for (int r = 0; r < 4; ++r) {
                    const float sg = sigm(w0r[ct * 4 + r] + cw[r]);
                    o[r] = 1.f - __expf(-0.6065306597126334f * sg);
                    a[r] = sigm(a0r[ct * 4 + r] + ca[r]);
                }
                uint2 uo, ua; uo.x = pk2(o[0], o[1]); uo.y = pk2(o[2], o[3]); ua.x = pk2(a[0], a[1]); ua.y = pk2(a[2], a[3]);
                *(uint2*)(p.Omd + mrow + ct * 16) = uo;
                *(uint2*)(p.Aa + mrow + ct * 16) = ua;
            }
        }
        for (int tok = 0; tok < 16; ++tok) {
            const int m = m0 + tok;
            int s, t; tok_info(m, s, t);
            const int T = s < 8 ? 2048 : 8;
            if (t != T - 1) continue;
            float* osh = s < 8 ? p.out + O_PSHIFT + (size_t)s * SHIFT_W : p.out + O_SSHIFT + (size_t)(s - 8) * SHIFT_W;
            float* ocv = s < 8 ? p.out + O_PCONV + (size_t)s * 3072 : p.out + O_SCONV + (size_t)(s - 8) * 3072;
            for (int col = tid; col < SHIFT_W; col += NTHR) osh[col] = bf2f(p.P[(size_t)m * NP + col]);
            for (int idx = tid; idx < 3072; idx += NTHR) {
                const int r = idx >> 10, cc = idx & 1023;
                ocv[idx] = bf2f(p.P[(size_t)(m - 2 + r) * NP + C_QK + cc]);
            }
        }
        __syncthreads();
    }
}

__device__ __forceinline__ float rdlane(float v, int l) { return __builtin_bit_cast(float, __builtin_amdgcn_readlane(__builtin_bit_cast(int, v), l)); }
__device__ __forceinline__ float wave_sum_fast(float v) {
    v = row16_sum(v);
    return (rdlane(v, 0) + rdlane(v, 16)) + (rdlane(v, 32) + rdlane(v, 48));
}
__device__ __forceinline__ float4 unpk4(uint2 u) {
    float4 f; f.x = __uint_as_float(u.x << 16); f.y = __uint_as_float(u.x & 0xFFFF0000u);
    f.z = __uint_as_float(u.y << 16); f.w = __uint_as_float(u.y & 0xFFFF0000u); return f;
}
__device__ void rwkv_item(const Params& p, int s, int h, int third, float* sm) {
    constexpr int BUF = 15680;
    constexpr int VC_OFF = 10368, Y_OFF = 13632, NCH = 64;
    const int tid = otid(), wid = tid >> 6, lane = tid & 63;
    const int mbase = s * 2048;
    const int r0 = third * 21 + (third > 0 ? 1 : 0), nr = third == 0 ? 22 : 21;
    if (wid >= 6) {
        const int pw = wid - 6, g = lane >> 4;
        const int c4 = (lane & 15) * 4, hc = h * 64 + c4;
        const int l128 = pw * 64 + lane;
        const float4 mu_r = *(const float4*)(p.mu_shift + C_R + hc), mu_k = *(const float4*)(p.mu_shift + C_K + hc), mu_v = *(const float4*)(p.mu_shift + C_V + hc);
        const float4 kkw = *(const float4*)(p.k_k + hc), kaw = *(const float4*)(p.k_a + hc);
        uint2 R[4][8];
        auto fetch = [&](int pass, uint2 (&q)[8]) {
            const int t = (pass >> 2) * 32 + (pass & 3) * 8 + pw * 4 + g;
            const bf16_t* pr = p.P + (size_t)(mbase + t) * NP + hc;
            const bf16_t* pp = t > 0 ? pr - NP : pr;
            q[0] = *(const uint2*)(pr + C_R); q[1] = *(const uint2*)(pr + C_K); q[2] = *(const uint2*)(pr + C_V);
            q[3] = *(const uint2*)(pp + C_R); q[4] = *(const uint2*)(pp + C_K); q[5] = *(const uint2*)(pp + C_V);
            q[6] = *(const uint2*)(p.Aa + (size_t)(mbase + t) * 512 + hc);
            q[7] = *(const uint2*)(p.Omd + (size_t)(mbase + t) * 512 + hc);
        };
        auto step = [&](int pass, uint2 (&q)[8]) {
            const uint2 cr = q[0], ck = q[1], cv = q[2], crp = q[3], ckp = q[4], cvp = q[5], ca = q[6], co = q[7];
            if (pass + 4 < NCH * 4) fetch(pass + 4, q);
            const int tok = (pass & 3) * 8 + pw * 4 + g, t = (pass >> 2) * 32 + tok;
            float* B = sm + ((pass >> 2) & 1) * BUF;
            float4 r = unpk4(cr), k = unpk4(ck), v = unpk4(cv), rp, kp_, vp;
            if (t > 0) { rp = unpk4(crp); kp_ = unpk4(ckp); vp = unpk4(cvp); }
            else { rp = make_float4(0.f, 0.f, 0.f, 0.f); kp_ = rp; vp = rp; }
            r.x += mu_r.x * (rp.x - r.x); r.y += mu_r.y * (rp.y - r.y); r.z += mu_r.z * (rp.z - r.z); r.w += mu_r.w * (rp.w - r.w);
            k.x += mu_k.x * (kp_.x - k.x); k.y += mu_k.y * (kp_.y - k.y); k.z += mu_k.z * (kp_.z - k.z); k.w += mu_k.w * (kp_.w - k.w);
            v.x += mu_v.x * (vp.x - v.x); v.y += mu_v.y * (vp.y - v.y); v.z += mu_v.z * (vp.z - v.z); v.w += mu_v.w * (vp.w - v.w);
            const float4 a = unpk4(ca), om = unpk4(co);
            float4 kk; kk.x = k.x * kkw.x; kk.y = k.y * kkw.y; kk.z = k.z * kkw.z; kk.w = k.w * kkw.w;
            const float nrm = sqrtf(row16_sum(kk.x * kk.x + kk.y * kk.y + kk.z * kk.z + kk.w * kk.w));
            const float inv = __builtin_amdgcn_rcpf(fmaxf(nrm, 1e-12f));
            kk.x *= inv; kk.y *= inv; kk.z *= inv; kk.w *= inv;
            float4 ka; ka.x = kk.x * a.x; ka.y = kk.y * a.y; ka.z = kk.z * a.z; ka.w = kk.w * a.w;
            float4 kp; kp.x = k.x * (1.f + (a.x - 1.f) * kaw.x); kp.y = k.y * (1.f + (a.y - 1.f) * kaw.y);
            kp.z = k.z * (1.f + (a.z - 1.f) * kaw.z); kp.w = k.w * (1.f + (a.w - 1.f) * kaw.w);
            float4 d; d.x = 1.f - om.x; d.y = 1.f - om.y; d.z = 1.f - om.z; d.w = 1.f - om.w;
            float4 dr; dr.x = d.x * r.x; dr.y = d.y * r.y; dr.z = d.z * r.z; dr.w = d.w * r.w;
            const float c1 = row16_sum(ka.x * r.x + ka.y * r.y + ka.z * r.z + ka.w * r.w);
            const float c2 = row16_sum(kp.x * r.x + kp.y * r.y + kp.z * r.z + kp.w * r.w);
            const int o = tok * 64 + c4;
            *(float4*)(B + o) = kk; *(float4*)(B + 2048 + o) = d; *(float4*)(B + 4096 + o) = ka;
            *(float4*)(B + 6144 + o) = kp; *(float4*)(B + 8192 + o) = dr;
            float4* vc = (float4*)(B + VC_OFF) + tok * 24;
            const int l0 = c4 - r0;
            if (l0 >= 0 && l0 < nr) vc[l0] = make_float4(v.x, c1, c2, 0.f);
            if (l0 + 1 >= 0 && l0 + 1 < nr) vc[l0 + 1] = make_float4(v.y, c1, c2, 0.f);
            if (l0 + 2 >= 0 && l0 + 2 < nr) vc[l0 + 2] = make_float4(v.z, c1, c2, 0.f);
            if (l0 + 3 >= 0 && l0 + 3 < nr) vc[l0 + 3] = make_float4(v.w, c1, c2, 0.f);
        };
        auto flush = [&](int c) {
            const float* Y = sm + (c & 1) * BUF + Y_OFF;
            const int tt = l128 >> 2, part = l128 & 3;
            bf16_t* dst = p.Yraw + (size_t)(mbase + c * 32 + tt) * 512 + h * 64 + r0;
#pragma unroll
            for (int k = 0; k < 6; ++k) { const int i = part + 4 * k; if (i < nr) dst[i] = f2bf(Y[tt * 64 + i]); }
        };
#pragma unroll
        for (int q = 0; q < 4; ++q) fetch(q, R[q]);
#pragma unroll
        for (int q = 0; q < 4; ++q) step(q, R[q]);
        lds_barrier();
#pragma unroll 1
        for (int c = 0; c < NCH; ++c) {
            if (c > 0) flush(c - 1);
            if (c + 1 < NCH) {
#pragma unroll
                for (int q = 0; q < 4; ++q) step((c + 1) * 4 + q, R[q]);
            }
            lds_barrier();
        }
        flush(NCH - 1);
    } else {
        const int lrow = wid * 4 + (lane >> 4);
        const int irow = r0 + (lrow < nr ? lrow : nr - 1);
        const int c4 = (lane & 15) * 4;
        const int yslot = ((lane & 15) == 0 && lrow < nr) ? lrow : 32 + (lane & 31);
        float S0 = 0.f, S1 = 0.f, S2 = 0.f, S3 = 0.f;
        lds_barrier();
#pragma unroll 1
        for (int c = 0; c < NCH; ++c) {
            const float* B = sm + (c & 1) * BUF;
            const float* bp = B + c4;
            const float4* vp4 = (const float4*)(B + VC_OFF) + (irow - r0);
            float4 kk4 = *(const float4*)(bp), d4 = *(const float4*)(bp + 2048), ka4 = *(const float4*)(bp + 4096);
            float4 kp4 = *(const float4*)(bp + 6144), dr4 = *(const float4*)(bp + 8192), vc = vp4[0];
            float4 kkB = *(const float4*)(bp + 64), dB = *(const float4*)(bp + 64 + 2048), kaB = *(const float4*)(bp + 64 + 4096);
            float4 kpB = *(const float4*)(bp + 64 + 6144), drB = *(const float4*)(bp + 64 + 8192), vcB = vp4[24];
            float* yp = sm + (c & 1) * BUF + Y_OFF + yslot;
#pragma unroll 8
            for (int tt = 0; tt < 32; ++tt) {
                const float* nb_ = bp + (tt + 2) * 64;
                const float4 nkk = *(const float4*)(nb_), nd = *(const float4*)(nb_ + 2048), nka = *(const float4*)(nb_ + 4096);
                const float4 nkp = *(const float4*)(nb_ + 6144), ndr = *(const float4*)(nb_ + 8192), nvc = vp4[(tt + 2) * 24];
                __builtin_amdgcn_sched_barrier(0);
                float p1 = S0 * kk4.x + S1 * kk4.y + S2 * kk4.z + S3 * kk4.w;
                float p2 = S0 * dr4.x + S1 * dr4.y + S2 * dr4.z + S3 * dr4.w;
                const float vi = vc.x;
                const float u0 = S0 * d4.x + vi * kp4.x, u1 = S1 * d4.y + vi * kp4.y, u2 = S2 * d4.z + vi * kp4.z, u3 = S3 * d4.w + vi * kp4.w;
                float z = p2 - vc.y * p1;
                p1 = row16_sum(p1);
                z = row16_sum(z);
                S0 = u0 - p1 * ka4.x; S1 = u1 - p1 * ka4.y; S2 = u2 - p1 * ka4.z; S3 = u3 - p1 * ka4.w;
                yp[tt * 64] = z + vi * vc.z;
                kk4 = kkB; d4 = dB; ka4 = kaB; kp4 = kpB; dr4 = drB; vc = vcB;
                kkB = nkk; dB = nd; kaB = nka; kpB = nkp; drB = ndr; vcB = nvc;
                __builtin_amdgcn_sched_barrier(0);
            }
            lds_barrier();
        }
        if (lrow < nr) {
            float* o = p.out + O_PS + (size_t)s * 8 * 4096 + ((size_t)(h * 64 + irow)) * 64 + c4;
            float4 v; v.x = S0; v.y = S1; v.z = S2; v.w = S3;
            *(float4*)o = v;
        }
    }
    __syncthreads();
}

__device__ void mlstm_item(const Params& p, int s, int h, float* sm) {
    float* sq = sm;
    float* sk = sm + 4160;
    float* sv = sm + 8320;
    float* sc = sm + 12480;
    float* sC = sm + 16640;
    float* sn = sm + 20800;
    float* sb = sn + 64;
    float* si = sn + 128;
    float* smt = sn + 192;
    float* swin = sn + 256;
    float* sden = sn + 320;
    float* sws = sn + 384;
    float* slf = sn + 448;
    float* smisc = sn + 512;
    const int tid = otid(), wid = tid >> 6, lane = tid & 63;
    const int T = s < 8 ? 2048 : 8, L = s < 8 ? 64 : 8, NC = T / L;
    const int mbase = s < 8 ? s * 2048 : M_P + (s - 8) * 8;
    for (int idx = tid; idx < 4096; idx += NTHR) {
        const int i = idx >> 6, j = idx & 63;
        sC[i * 65 + j] = s >= 8 ? p.st_C[(size_t)((s - 8) * 8 + h) * 4096 + idx] : 0.f;
    }
    if (tid < 64) sn[tid] = s >= 8 ? p.st_n[(size_t)((s - 8) * 8 + h) * 64 + tid] : 0.f;
    if (tid == 0) smisc[0] = s >= 8 ? p.st_m[(s - 8) * 8 + h] : 0.f;
    const float cwq[4] = {p.conv_w[0 * 1024 + h * 64 + lane], p.conv_w[1 * 1024 + h * 64 + lane], p.conv_w[2 * 1024 + h * 64 + lane], p.conv_w[3 * 1024 + h * 64 + lane]};
    const float cwk[4] = {p.conv_w[0 * 1024 + 512 + h * 64 + lane], p.conv_w[1 * 1024 + 512 + h * 64 + lane], p.conv_w[2 * 1024 + 512 + h * 64 + lane], p.conv_w[3 * 1024 + 512 + h * 64 + lane]};
    const float cbq = p.conv_b[h * 64 + lane], cbk = p.conv_b[512 + h * 64 + lane];
    const float gnw = p.gn_w[h * 64 + lane];
    const float bi = p.b_i[h], bfv = p.b_f[h];
    __syncthreads();
    for (int c = 0; c < NC; ++c) {
        const int t0 = c * L;
        for (int tt = wid; tt < L; tt += 8) {
            const int t = t0 + tt, m = mbase + t;
            float aq = cbq, ak = cbk;
#pragma unroll
            for (int j = 0; j < 4; ++j) {
                const int tau = t - 3 + j;
                float xq, xk;
                if (tau >= 0) {
                    const bf16_t* pr = p.P + (size_t)(mbase + tau) * NP + C_QK + h * 64 + lane;
                    xq = bf2f(pr[0]); xk = bf2f(pr[512]);
                } else if (s >= 8) {
                    const float* st = p.st_conv + ((size_t)(s - 8) * 3 + (3 + tau)) * 1024 + h * 64 + lane;
                    xq = st[0]; xk = st[512];
                } else { xq = 0.f; xk = 0.f; }
                aq += xq * cwq[j]; ak += xk * cwk[j];
            }
            sq[tt * 65 + lane] = silu(aq);
            sk[tt * 65 + lane] = silu(ak) * 0.125f;
            sv[tt * 65 + lane] = bf2f(p.P[(size_t)m * NP + C_VB + h * 64 + lane]);
        }
        if (tid < L) {
            const int m = mbase + t0 + tid;
            si[tid] = bf2f(p.P[(size_t)m * NP + C_IB + h]) + bi;
            const float f = bf2f(p.P[(size_t)m * NP + C_FB + h]) + bfv;
            slf[tid] = f > 0.f ? -log1pf(__expf(-f)) : f - log1pf(__expf(f));
        }
        __syncthreads();
        if (tid == 0) {
            const float mprev = smisc[0];
            float b = 0.f, run = mprev;
            for (int t = 0; t < L; ++t) {
                b += slf[t];
                run = fmaxf(run, si[t] - b);
                sb[t] = b; smt[t] = b + run; swin[t] = __expf(b + mprev - (b + run));
            }
            const float mnew = b + run;
            smisc[1] = mnew; smisc[2] = __expf(b + mprev - mnew);
            for (int t = 0; t < L; ++t) sws[t] = __expf(b - sb[t] + si[t] - mnew);
        }
        __syncthreads();
        for (int idx = tid; idx < L * L; idx += NTHR) {
            const int t = idx / L, u = idx % L;
            float v = 0.f;
            if (u <= t) {
                float dot = 0.f;
#pragma unroll 8
                for (int d = 0; d < 64; ++d) dot += sq[t * 65 + d] * sk[u * 65 + d];
                v = dot * __expf(sb[t] - sb[u] + si[u] - smt[t]);
            }
            sc[t * 65 + u] = v;
        }
        __syncthreads();
        if (tid < L) {
            float rs = 0.f, qn = 0.f;
            for (int u = 0; u < L; ++u) rs += sc[tid * 65 + u];
            for (int j = 0; j < 64; ++j) qn += sn[j] * sq[tid * 65 + j];
            const float den = rs + swin[tid] * qn;
            sden[tid] = fmaxf(fabsf(den), __expf(-smt[tid]));
        }
        __syncthreads();
        for (int tt = wid; tt < L; tt += 8) {
            float num = 0.f, inter = 0.f;
            for (int u = 0; u <= tt; ++u) num += sc[tt * 65 + u] * sv[u * 65 + lane];
#pragma unroll 8
            for (int j = 0; j < 64; ++j) inter += sC[lane * 65 + j] * sq[tt * 65 + j];
            const float hv = (num + swin[tt] * inter) / sden[tt];
            const float ms = wave_sum(hv * hv) * (1.f / 64.f);
            const float hn = hv * rsqrtf(ms + 1e-6f) * gnw;
            const int m = mbase + t0 + tt;
            const float ob = bf2f(p.P[(size_t)m * NP + C_OB + h * 64 + lane]);
            const float zb = bf2f(p.P[(size_t)m * NP + C_ZB + h * 64 + lane]);
            p.OutB[(size_t)m * 512 + h * 64 + lane] = f2bf(sigm(ob) * hn * silu(zb));
        }
        __syncthreads();
        {
            const float dec = smisc[2];
            const int j = lane;
#pragma unroll
            for (int ii = 0; ii < 8; ++ii) {
                const int i = wid + 8 * ii;
                float a = dec * sC[i * 65 + j];
                for (int u = 0; u < L; ++u) a += sws[u] * sv[u * 65 + i] * sk[u * 65 + j];
                sC[i * 65 + j] = a;
            }
            if (tid < 64) {
                float a = dec * sn[tid];
                for (int u = 0; u < L; ++u) a += sws[u] * sk[u * 65 + tid];
                sn[tid] = a;
            }
            if (tid == 0) smisc[0] = smisc[1];
        }
        __syncthreads();
    }
    {
        float* oC = s < 8 ? p.out + O_PC + (size_t)(s * 8 + h) * 4096 : p.out + O_SC + (size_t)((s - 8) * 8 + h) * 4096;
        float* on = s < 8 ? p.out + O_PN + (size_t)(s * 8 + h) * 64 : p.out + O_SN + (size_t)((s - 8) * 8 + h) * 64;
        float* om = s < 8 ? p.out + O_PM + (s * 8 + h) : p.out + O_SM + ((s - 8) * 8 + h);
        for (int idx = tid; idx < 4096; idx += NTHR) oC[idx] = sC[(idx >> 6) * 65 + (idx & 63)];
        if (tid < 64) on[tid] = sn[tid];
        if (tid == 0) om[0] = smisc[0];
    }
    __syncthreads();
}

__device__ __forceinline__ bf16x8 ldfrag(const bf16_t* base, int row, int ks, int fq) { return *(const bf16x8*)(base + row * 72 + ks * 32 + fq * 8); }
__device__ __forceinline__ float sum8(float v) { v += dpp_mov<0xB1>(v); v += dpp_mov<0x4E>(v); v += dpp_mov<0x141>(v); return v; }
__device__ void mlstm_prompt(const Params& p, int s, int h, float* sm) {
    bf16_t* Qs = (bf16_t*)sm; bf16_t* Ks = Qs + 4608; bf16_t* VT = Ks + 4608; bf16_t* KwT = VT + 4608; bf16_t* Ps = KwT + 4608; bf16_t* Cb = Ps + 4608;
    float* hs = sm + 13824;
    float* sn = hs + 64 * 68;
    float* sden = sn + 64;
    float* gv = sn + 128;
    float* Gg = sn + 128 + 768;
    float* Gl = Gg + 2048;
    float* Gb = Gl + 2048;
    const int tid = otid(), wid = tid >> 6, lane = tid & 63, fr = lane & 15, fq = lane >> 4;
    const int tr = wid >> 1, tc0 = (wid & 1) * 2;
    const int mbase = s * 2048;
    const int qc = h * 64 + lane;
    f32x4 accC[2];
    accC[0] = (f32x4){0.f, 0.f, 0.f, 0.f}; accC[1] = accC[0];
    if (tid < 64) sn[tid] = 0.f;
    {
        const float bi = p.b_i[h], bfv = p.b_f[h];
        for (int cc = wid; cc < 32; cc += 8) {
            const bf16_t* pr = p.P + (size_t)(mbase + cc * 64 + lane) * NP;
            const float it = bf2f(pr[C_IB + h]) + bi;
            const float f = bf2f(pr[C_FB + h]) + bfv;
            float b = f > 0.f ? -log1pf(__expf(-f)) : f - log1pf(__expf(f));
#pragma unroll
            for (int o = 1; o < 64; o <<= 1) { const float v = __shfl_up(b, o); if (lane >= o) b += v; }
            const float g = it - b;
            float run = g;
#pragma unroll
            for (int o = 1; o < 64; o <<= 1) { const float v = __shfl_up(run, o); if (lane >= o) run = fmaxf(run, v); }
            Gg[cc * 64 + lane] = g; Gl[cc * 64 + lane] = run; Gb[cc * 64 + lane] = b;
        }
    }
    const float cwq0 = p.conv_w[qc], cwq1 = p.conv_w[1024 + qc], cwq2 = p.conv_w[2048 + qc], cwq3 = p.conv_w[3072 + qc];
    const float cwk0 = p.conv_w[512 + qc], cwk1 = p.conv_w[1536 + qc], cwk2 = p.conv_w[2560 + qc], cwk3 = p.conv_w[3584 + qc];
    const float cbq = p.conv_b[qc], cbk = p.conv_b[512 + qc];
    const float gnw = p.gn_w[qc];
    unsigned xqr[11], xkr[11], vvr[8];
    auto load_raw = [&](int c) {
        const int tb = c * 64 + wid * 8 - 3;
#pragma unroll
        for (int r = 0; r < 11; ++r) {
            const int t = tb + r, tc = t < 0 ? 0 : t;
            const bf16_t* pr = p.P + (size_t)(mbase + tc) * NP + C_QK + qc;
            xqr[r] = pr[0]; xkr[r] = pr[512];
        }
#pragma unroll
        for (int k = 0; k < 8; ++k) vvr[k] = p.P[(size_t)(mbase + tb + 3 + k) * NP + C_VB + qc];
    };
    auto gates = [&](int c, float mprev) {
        float* v = gv + (c & 1) * 384;
        const float g = Gg[c * 64 + lane], b = Gb[c * 64 + lane];
        const float run = fmaxf(Gl[c * 64 + lane], mprev), runL = fmaxf(Gl[c * 64 + 63], mprev), bL = Gb[c * 64 + 63];
        v[lane] = g; v[64 + lane] = run; v[128 + lane] = __expf(mprev - run); v[192 + lane] = __expf(g - runL); v[256 + lane] = b;
        if (lane == 0) { v[320] = bL + runL; v[321] = __expf(mprev - runL); }
    };
    load_raw(0);
    __syncthreads();
    if (wid == 0) gates(0, 0.f);
    __syncthreads();
    for (int c = 0; c < 32; ++c) {
        const int t0 = c * 64, mb = mbase + t0;
        const float* sg = gv + (c & 1) * 384; const float* srun = sg + 64; const float* swin = sg + 128; const float* sws = sg + 192; const float* sb = sg + 256;
        const float dec = sg[321];
        {
            float kw[8], xq[11], xk[11], vv[8];
            const bool head = (c == 0 && wid == 0);
#pragma unroll
            for (int r = 0; r < 11; ++r) {
                const bool z = head && r < 3;
                xq[r] = z ? 0.f : __uint_as_float(xqr[r] << 16); xk[r] = z ? 0.f : __uint_as_float(xkr[r] << 16);
            }
#pragma unroll
            for (int k = 0; k < 8; ++k) vv[k] = __uint_as_float(vvr[k] << 16);
#pragma unroll
            for (int k = 0; k < 8; ++k) {
                const int tt = wid * 8 + k;
                const float q = silu(cbq + xq[k] * cwq0 + xq[k + 1] * cwq1 + xq[k + 2] * cwq2 + xq[k + 3] * cwq3);
                const float kk = silu(cbk + xk[k] * cwk0 + xk[k + 1] * cwk1 + xk[k + 2] * cwk2 + xk[k + 3] * cwk3) * 0.125f;
                Qs[tt * 72 + lane] = f2bf(q);
                Ks[tt * 72 + lane] = f2bf(kk);
                kw[k] = kk * sws[tt];
            }
            uint4 o; o.x = pk2(kw[0], kw[1]); o.y = pk2(kw[2], kw[3]); o.z = pk2(kw[4], kw[5]); o.w = pk2(kw[6], kw[7]);
            *(uint4*)(KwT + lane * 72 + wid * 8) = o;
            o.x = pk2(vv[0], vv[1]); o.y = pk2(vv[2], vv[3]); o.z = pk2(vv[4], vv[5]); o.w = pk2(vv[6], vv[7]);
            *(uint4*)(VT + lane * 72 + wid * 8) = o;
        }
#pragma unroll
        for (int n = 0; n < 2; ++n) {
            uint2 o; o.x = pk2(accC[n][0], accC[n][1]); o.y = pk2(accC[n][2], accC[n][3]);
            *(uint2*)(Cb + (tr * 16 + fr) * 72 + (tc0 + n) * 16 + fq * 4) = o;
        }
        if (c + 1 < 32) load_raw(c + 1);
        lds_barrier();
        unsigned obr[8], zbr[8];
#pragma unroll
        for (int k = 0; k < 8; ++k) {
            const bf16_t* pr = p.P + (size_t)(mb + wid * 8 + k) * NP;
            obr[k] = pr[C_OB + qc]; zbr[k] = pr[C_ZB + qc];
        }
#pragma unroll
        for (int n = 0; n < 2; ++n) {
            const int ut = tc0 + n;
            f32x4 a = (f32x4){0.f, 0.f, 0.f, 0.f};
            if (ut <= tr) {
#pragma unroll
                for (int ks = 0; ks < 2; ++ks) a = __builtin_amdgcn_mfma_f32_16x16x32_bf16(ldfrag(Ks, ut * 16 + fr, ks, fq), ldfrag(Qs, tr * 16 + fr, ks, fq), a, 0, 0, 0);
            }
            const int t = tr * 16 + fr;
            const float rn = srun[t];
            float w[4];
#pragma unroll
            for (int r = 0; r < 4; ++r) {
                const int u = ut * 16 + fq * 4 + r;
                w[r] = (u <= t) ? a[r] * __expf(sg[u] - rn) : 0.f;
            }
            uint2 o; o.x = pk2(w[0], w[1]); o.y = pk2(w[2], w[3]);
            *(uint2*)(Ps + t * 72 + ut * 16 + fq * 4) = o;
        }
        lds_barrier();
        {
            const int t = tid >> 3, seg = tid & 7;
            const uint4 pv = *(const uint4*)(Ps + t * 72 + seg * 8);
            const uint4 qv = *(const uint4*)(Qs + t * 72 + seg * 8);
            const float4 pa = unpk4(make_uint2(pv.x, pv.y)), pb = unpk4(make_uint2(pv.z, pv.w));
            const float4 qa = unpk4(make_uint2(qv.x, qv.y)), qb = unpk4(make_uint2(qv.z, qv.w));
            const float4 na = *(const float4*)(sn + seg * 8), nb4 = *(const float4*)(sn + seg * 8 + 4);
            float rs = (pa.x + pa.y) + (pa.z + pa.w) + (pb.x + pb.y) + (pb.z + pb.w);
            float qn = qa.x * na.x + qa.y * na.y + qa.z * na.z + qa.w * na.w + qb.x * nb4.x + qb.y * nb4.y + qb.z * nb4.z + qb.w * nb4.w;
            rs = sum8(rs); qn = sum8(qn);
            if (seg == 0) sden[t] = fmaxf(fabsf(rs + swin[t] * qn), __expf(-(sb[t] + srun[t])));
        }
        f32x4 num[2], itr[2];
#pragma unroll
        for (int n = 0; n < 2; ++n) {
            const int it = tc0 + n;
            num[n] = (f32x4){0.f, 0.f, 0.f, 0.f}; itr[n] = num[n];
#pragma unroll
            for (int ks = 0; ks < 2; ++ks) {
                num[n] = __builtin_amdgcn_mfma_f32_16x16x32_bf16(ldfrag(VT, it * 16 + fr, ks, fq), ldfrag(Ps, tr * 16 + fr, ks, fq), num[n], 0, 0, 0);
                itr[n] = __builtin_amdgcn_mfma_f32_16x16x32_bf16(ldfrag(Cb, it * 16 + fr, ks, fq), ldfrag(Qs, tr * 16 + fr, ks, fq), itr[n], 0, 0, 0);
            }
        }
        lds_barrier();
        {
            const int t = tr * 16 + fr;
            const float rd = 1.f / sden[t], wn = swin[t];
#pragma unroll
            for (int n = 0; n < 2; ++n) {
                float4 o;
                o.x = (num[n][0] + wn * itr[n][0]) * rd; o.y = (num[n][1] + wn * itr[n][1]) * rd;
                o.z = (num[n][2] + wn * itr[n][2]) * rd; o.w = (num[n][3] + wn * itr[n][3]) * rd;
                *(float4*)(hs + t * 68 + (tc0 + n) * 16 + fq * 4) = o;
            }
        }
#pragma unroll
        for (int n = 0; n < 2; ++n) {
            accC[n][0] *= dec; accC[n][1] *= dec; accC[n][2] *= dec; accC[n][3] *= dec;
#pragma unroll
            for (int ks = 0; ks < 2; ++ks)
                accC[n] = __builtin_amdgcn_mfma_f32_16x16x32_bf16(ldfrag(KwT, (tc0 + n) * 16 + fr, ks, fq), ldfrag(VT, tr * 16 + fr, ks, fq), accC[n], 0, 0, 0);
        }
        {
            const int j = tid >> 3, seg = tid & 7;
            const uint4 kv = *(const uint4*)(KwT + j * 72 + seg * 8);
            const float4 ka = unpk4(make_uint2(kv.x, kv.y)), kb = unpk4(make_uint2(kv.z, kv.w));
            float sum = (ka.x + ka.y) + (ka.z + ka.w) + (kb.x + kb.y) + (kb.z + kb.w);
            sum = sum8(sum);
            if (seg == 0) sn[j] = dec * sn[j] + sum;
        }
        if (wid == 0 && c + 1 < 32) gates(c + 1, sg[320]);
        lds_barrier();
#pragma unroll
        for (int k = 0; k < 8; ++k) {
            const int tt = wid * 8 + k;
            const float hv = hs[tt * 68 + lane];
            const float ms = wave_sum_fast(hv * hv) * (1.f / 64.f);
            const float hn = hv * rsqrtf(ms + 1e-6f) * gnw;
            p.OutB[(size_t)(mb + tt) * 512 + qc] = f2bf(sigm(__uint_as_float(obr[k] << 16)) * hn * silu(__uint_as_float(zbr[k] << 16)));
        }
    }
    {
        float* oC = p.out + O_PC + (size_t)(s * 8 + h) * 4096;
#pragma unroll
        for (int n = 0; n < 2; ++n) {
            float4 o; o.x = accC[n][0]; o.y = accC[n][1]; o.z = accC[n][2]; o.w = accC[n][3];
            *(float4*)(oC + (tr * 16 + fr) * 64 + (tc0 + n) * 16 + fq * 4) = o;
        }
        if (tid < 64) p.out[O_PN + (size_t)(s * 8 + h) * 64 + tid] = sn[tid];
        if (tid == 0) p.out[O_PM + s * 8 + h] = gv[384 + 320];
    }
    __syncthreads();
}

__device__ __forceinline__ void wave_lds_fence() { __builtin_amdgcn_fence(__ATOMIC_RELEASE, "wavefront"); __builtin_amdgcn_wave_barrier(); __builtin_amdgcn_fence(__ATOMIC_ACQUIRE, "wavefront"); }
__device__ void rwkv_sample_wave(const Params& p, int sb, int h, float* wsm) {
    const int lane = otid() & 63;
    const int hj = h * 64 + lane;
    const int m0 = M_P + sb * 8;
    {
        float rr[8], kr[8], vr[8], ar[8], dd[8];
#pragma unroll
        for (int t = 0; t < 8; ++t) {
            const bf16_t* pr = p.P + (size_t)(m0 + t) * NP;
            rr[t] = bf2f(pr[C_R + hj]); kr[t] = bf2f(pr[C_K + hj]); vr[t] = bf2f(pr[C_V + hj]);
            ar[t] = bf2f(p.Aa[(size_t)(m0 + t) * 512 + hj]); dd[t] = 1.f - bf2f(p.Omd[(size_t)(m0 + t) * 512 + hj]);
        }
        const float* st = p.st_shift + (size_t)sb * SHIFT_W;
        float rp = st[C_R + hj], kp_ = st[C_K + hj], vp = st[C_V + hj];
        const float mu_r = p.mu_shift[C_R + hj], mu_k = p.mu_shift[C_K + hj], mu_v = p.mu_shift[C_V + hj];
        const float kkw = p.k_k[hj], kaw = p.k_a[hj];
#pragma unroll
        for (int t = 0; t < 8; ++t) {
            const float r = rr[t] + mu_r * (rp - rr[t]), k = kr[t] + mu_k * (kp_ - kr[t]), v = vr[t] + mu_v * (vp - vr[t]);
            rp = rr[t]; kp_ = kr[t]; vp = vr[t];
            const float a = ar[t], d = dd[t];
            float kk = k * kkw;
            const float nrm = sqrtf(wave_sum_fast(kk * kk));
            kk = kk / fmaxf(nrm, 1e-12f);
            const float ka = kk * a, kp = k * (1.f + (a - 1.f) * kaw);
            const float c1 = wave_sum_fast(ka * r), c2 = wave_sum_fast(kp * r);
            float* w = wsm + t * 400;
            w[lane] = kk; w[64 + lane] = d; w[128 + lane] = ka; w[192 + lane] = kp; w[256 + lane] = d * r; w[320 + lane] = v;
            if (lane == 0) { w[384] = c1; w[385] = c2; }
        }
    }
    float S[64];
    {
        const float* srow = p.st_S + ((size_t)(sb * 8 + h) * 64 + lane) * 64;
#pragma unroll
        for (int q = 0; q < 16; ++q) { const float4 v = *(const float4*)(srow + q * 4); S[4 * q] = v.x; S[4 * q + 1] = v.y; S[4 * q + 2] = v.z; S[4 * q + 3] = v.w; }
    }
    wave_lds_fence();
#pragma unroll 1
    for (int t = 0; t < 8; ++t) {
        const float* w = wsm + t * 400;
        float p1 = 0.f, p2 = 0.f;
#pragma unroll
        for (int q = 0; q < 16; ++q) {
            const float4 k4 = *(const float4*)(w + q * 4), r4 = *(const float4*)(w + 256 + q * 4);
            p1 += S[4 * q] * k4.x + S[4 * q + 1] * k4.y + S[4 * q + 2] * k4.z + S[4 * q + 3] * k4.w;
            p2 += S[4 * q] * r4.x + S[4 * q + 1] * r4.y + S[4 * q + 2] * r4.z + S[4 * q + 3] * r4.w;
        }
        const float vi = w[320 + lane];
        const float y = p2 - p1 * w[384] + vi * w[385];
#pragma unroll
        for (int q = 0; q < 16; ++q) {
            const float4 d4 = *(const float4*)(w + 64 + q * 4), a4 = *(const float4*)(w + 128 + q * 4), k4 = *(const float4*)(w + 192 + q * 4);
            S[4 * q] = S[4 * q] * d4.x + vi * k4.x - p1 * a4.x;
            S[4 * q + 1] = S[4 * q + 1] * d4.y + vi * k4.y - p1 * a4.y;
            S[4 * q + 2] = S[4 * q + 2] * d4.z + vi * k4.z - p1 * a4.z;
            S[4 * q + 3] = S[4 * q + 3] * d4.w + vi * k4.w - p1 * a4.w;
        }
        p.Yraw[(size_t)(m0 + t) * 512 + hj] = f2bf(y);
    }
    {
        float* o = p.out + O_SS + ((size_t)(sb * 8 + h) * 64 + lane) * 64;
#pragma unroll
        for (int q = 0; q < 16; ++q) { float4 v; v.x = S[4 * q]; v.y = S[4 * q + 1]; v.z = S[4 * q + 2]; v.w = S[4 * q + 3]; *(float4*)(o + q * 4) = v; }
    }
    wave_lds_fence();
}

__device__ void mlstm_sample_wave(const Params& p, int sb, int h, float* wsm) {
    const int lane = otid() & 63;
    const int qc = h * 64 + lane;
    const int m0 = M_P + sb * 8;
    float gi = 0.f, gl = 0.f;
    {
        float xq[11], xk[11];
#pragma unroll
        for (int r = 0; r < 3; ++r) { const float* st = p.st_conv + ((size_t)sb * 3 + r) * 1024 + qc; xq[r] = st[0]; xk[r] = st[512]; }
#pragma unroll
        for (int t = 0; t < 8; ++t) { const bf16_t* pr = p.P + (size_t)(m0 + t) * NP + C_QK + qc; xq[3 + t] = bf2f(pr[0]); xk[3 + t] = bf2f(pr[512]); }
#pragma unroll
        for (int t = 0; t < 8; ++t) {
            const bf16_t* pr = p.P + (size_t)(m0 + t) * NP;
            wsm[1024 + t * 64 + lane] = bf2f(pr[C_VB + qc]); wsm[1536 + t * 64 + lane] = bf2f(pr[C_OB + qc]); wsm[2048 + t * 64 + lane] = bf2f(pr[C_ZB + qc]);
        }
        if (lane < 8) {
            const bf16_t* pr = p.P + (size_t)(m0 + lane) * NP;
            gi = bf2f(pr[C_IB + h]) + p.b_i[h];
            const float f = bf2f(pr[C_FB + h]) + p.b_f[h];
            gl = f > 0.f ? -log1pf(__expf(-f)) : f - log1pf(__expf(f));
        }
        const float cwq0 = p.conv_w[qc], cwq1 = p.conv_w[1024 + qc], cwq2 = p.conv_w[2048 + qc], cwq3 = p.conv_w[3072 + qc];
        const float cwk0 = p.conv_w[512 + qc], cwk1 = p.conv_w[1536 + qc], cwk2 = p.conv_w[2560 + qc], cwk3 = p.conv_w[3584 + qc];
        const float cbq = p.conv_b[qc], cbk = p.conv_b[512 + qc];
#pragma unroll
        for (int t = 0; t < 8; ++t) {
            wsm[t * 64 + lane] = silu(cbq + xq[t] * cwq0 + xq[t + 1] * cwq1 + xq[t + 2] * cwq2 + xq[t + 3] * cwq3);
            wsm[512 + t * 64 + lane] = silu(cbk + xk[t] * cwk0 + xk[t + 1] * cwk1 + xk[t + 2] * cwk2 + xk[t + 3] * cwk3) * 0.125f;
        }
    }
    const float gnw = p.gn_w[qc];
    float C[64];
    {
        const float* crow = p.st_C + ((size_t)(sb * 8 + h) * 64 + lane) * 64;
#pragma unroll
        for (int q = 0; q < 16; ++q) { const float4 v = *(const float4*)(crow + q * 4); C[4 * q] = v.x; C[4 * q + 1] = v.y; C[4 * q + 2] = v.z; C[4 * q + 3] = v.w; }
    }
    float nl = p.st_n[(size_t)(sb * 8 + h) * 64 + lane];
    float m = p.st_m[sb * 8 + h];
    wave_lds_fence();
#pragma unroll 1
    for (int t = 0; t < 8; ++t) {
        const float it = rdlane(gi, t), lf = rdlane(gl, t);
        const float mt = fmaxf(lf + m, it);
        const float fdec = __expf(lf + m - mt), iw = __expf(it - mt);
        m = mt;
        const float ql = wsm[t * 64 + lane], kl = wsm[512 + t * 64 + lane];
        nl = fdec * nl + iw * kl;
        const float den = wave_sum_fast(nl * ql);
        const float ai = iw * wsm[1024 + t * 64 + lane];
        float num = 0.f;
#pragma unroll
        for (int q = 0; q < 16; ++q) {
            const float4 k4 = *(const float4*)(wsm + 512 + t * 64 + q * 4), q4 = *(const float4*)(wsm + t * 64 + q * 4);
            C[4 * q] = fdec * C[4 * q] + ai * k4.x; C[4 * q + 1] = fdec * C[4 * q + 1] + ai * k4.y;
            C[4 * q + 2] = fdec * C[4 * q + 2] + ai * k4.z; C[4 * q + 3] = fdec * C[4 * q + 3] + ai * k4.w;
            num += C[4 * q] * q4.x + C[4 * q + 1] * q4.y + C[4 * q + 2] * q4.z + C[4 * q + 3] * q4.w;
        }
        const float hv = num / fmaxf(fabsf(den), __expf(-mt));
        const float ms = wave_sum_fast(hv * hv) * (1.f / 64.f);
        p.OutB[(size_t)(m0 + t) * 512 + qc] = f2bf(sigm(wsm[1536 + t * 64 + lane]) * hv * rsqrtf(ms + 1e-6f) * gnw * silu(wsm[2048 + t * 64 + lane]));
    }
    {
        float* o = p.out + O_SC + ((size_t)(sb * 8 + h) * 64 + lane) * 64;
#pragma unroll
        for (int q = 0; q < 16; ++q) { float4 v; v.x = C[4 * q]; v.y = C[4 * q + 1]; v.z = C[4 * q + 2]; v.w = C[4 * q + 3]; *(float4*)(o + q * 4) = v; }
        p.out[O_SN + (size_t)(sb * 8 + h) * 64 + lane] = nl;
        if (lane == 0) p.out[O_SM + sb * 8 + h] = m;
    }
    wave_lds_fence();
}

__device__ void phaseE(const Params& p, float* sm, int bid, int nb) {
    constexpr int N_RP = 192, N_MP = 64, N_RS = 128, N_MS = 128;
    int* s_item = (int*)(sm + 32768);
    for (;;) {
        if (otid() == 0) *s_item = (int)atomicAdd(p.ctr, 1u);
        __syncthreads();
        const int it = *s_item;
        __syncthreads();
        if (it >= N_RP + N_MP + N_RS + N_MS) break;
        if (it < N_RP) { rwkv_item(p, it / 24, (it / 3) & 7, it % 3, sm); }
        else if (it < N_RP + N_MP) { const int i = it - N_RP; mlstm_prompt(p, i >> 3, i & 7, sm); }
        else if (it < N_RP + N_MP + N_RS) { const int wid = otid() >> 6; const int i = (it - N_RP - N_MP) * 8 + wid; rwkv_sample_wave(p, i >> 3, i & 7, sm + wid * 3328); }
        else if (it < N_RP + N_MP + N_RS + N_MS) { const int wid = otid() >> 6; const int i = (it - N_RP - N_MP - N_RS) * 8 + wid; mlstm_sample_wave(p, i >> 3, i & 7, sm + wid * 3328); }
    }
}

__device__ void phaseF(const Params& p, int bid, int nb) {
    const int wid = otid() >> 6, lane = otid() & 63;
    const int c8 = lane * 8;
    float lnw[8], lnb[8], mur[8], muk[8], muv[8], kaw[8], rkw[8];
#pragma unroll
    for (int i = 0; i < 8; ++i) {
        lnw[i] = p.ln_w[c8 + i]; lnb[i] = p.ln_b[c8 + i]; mur[i] = p.mu_shift[C_R + c8 + i]; muk[i] = p.mu_shift[C_K + c8 + i];
        muv[i] = p.mu_shift[C_V + c8 + i]; kaw[i] = p.k_a[c8 + i]; rkw[i] = p.r_k[c8 + i];
    }
    auto un8 = [](const uint4 u, float* o) {
        o[0] = __uint_as_float(u.x << 16); o[1] = __uint_as_float(u.x & 0xFFFF0000u); o[2] = __uint_as_float(u.y << 16); o[3] = __uint_as_float(u.y & 0xFFFF0000u);
        o[4] = __uint_as_float(u.z << 16); o[5] = __uint_as_float(u.z & 0xFFFF0000u); o[6] = __uint_as_float(u.w << 16); o[7] = __uint_as_float(u.w & 0xFFFF0000u);
    };
    for (int m = bid * 8 + wid; m < M_TOT; m += nb * 8) {
        int s, t; tok_info(m, s, t);
        const bf16_t* pr = p.P + (size_t)m * NP + c8;
        const uint4 uy = *(const uint4*)(p.Yraw + (size_t)m * 512 + c8);
        const uint4 ur = *(const uint4*)(pr + C_R), uk = *(const uint4*)(pr + C_K), uv = *(const uint4*)(pr + C_V), uz = *(const uint4*)(pr + C_ZA);
        const uint4 ua = *(const uint4*)(p.Aa + (size_t)m * 512 + c8);
        float y[8], r[8], k[8], v[8], z[8], a[8], rp[8], kp_[8], vp[8];
        if (t > 0) {
            const uint4 urp = *(const uint4*)(pr + C_R - NP), ukp = *(const uint4*)(pr + C_K - NP), uvp = *(const uint4*)(pr + C_V - NP);
            un8(urp, rp); un8(ukp, kp_); un8(uvp, vp);
        } else if (s >= 8) {
            const float* st = p.st_shift + (size_t)(s - 8) * SHIFT_W + c8;
#pragma unroll
            for (int i = 0; i < 8; ++i) { rp[i] = st[C_R + i]; kp_[i] = st[C_K + i]; vp[i] = st[C_V + i]; }
        } else {
#pragma unroll
            for (int i = 0; i < 8; ++i) { rp[i] = 0.f; kp_[i] = 0.f; vp[i] = 0.f; }
        }
        un8(uy, y); un8(ur, r); un8(uk, k); un8(uv, v); un8(uz, z); un8(ua, a);
        float sy = 0.f;
#pragma unroll
        for (int i = 0; i < 8; ++i) sy += y[i];
        const float mean = sum8(sy) * (1.f / 64.f);
        float sv = 0.f, sbn = 0.f;
#pragma unroll
        for (int i = 0; i < 8; ++i) {
            y[i] -= mean; sv += y[i] * y[i];
            r[i] += mur[i] * (rp[i] - r[i]); k[i] += muk[i] * (kp_[i] - k[i]); v[i] += muv[i] * (vp[i] - v[i]);
            sbn += r[i] * (k[i] * (1.f + (a[i] - 1.f) * kaw[i])) * rkw[i];
        }
        const float rstd = rsqrtf(sum8(sv) * (1.f / 64.f) + 64e-5f);
        const float bonus = sum8(sbn);
        float o[8];
#pragma unroll
        for (int i = 0; i < 8; ++i) o[i] = (y[i] * rstd * lnw[i] + lnb[i] + bonus * v[i]) * silu(z[i]);
        uint4 ou; ou.x = pk2(o[0], o[1]); ou.y = pk2(o[2], o[3]); ou.z = pk2(o[4], o[5]); ou.w = pk2(o[6], o[7]);
        *(uint4*)(p.OutA + (size_t)m * 512 + c8) = ou;
    }
}

__device__ __forceinline__ void yrow_store(const Params& p, float* yr, int lane, const float4 (&v)[4], float rstd) {
#pragma unroll
    for (int i = 0; i < 4; ++i) {
        const int c = i * 256 + lane * 4;
        const float4 g = *(const float4*)(p.g_final + c);
        float4 o; o.x = v[i].x * rstd * g.x; o.y = v[i].y * rstd * g.y; o.z = v[i].z * rstd * g.z; o.w = v[i].w * rstd * g.w;
        *(float4*)(yr + c) = o;
    }
}
__device__ void phaseI(const Params& p, int bid, int nb) {
    const int wid = otid() >> 6, lane = otid() & 63;
    const int stride = nb * 8;
    for (int m = bid * 8 + wid; m < M_TOT; m += 2 * stride) {
        const int m2 = m + stride;
        const bool has2 = m2 < M_TOT;
        float* ya = p.out + (size_t)m * 1024;
        float* yb = p.out + (size_t)(has2 ? m2 : m) * 1024;
        float4 va[4], vb[4];
        normrow_load(ya, lane, va);
        normrow_load(yb, lane, vb);
        const float ra = rsqrtf(wave_sum(sumsq4(va)) * (1.f / 1024.f) + 1e-6f);
        const float rb = rsqrtf(wave_sum(sumsq4(vb)) * (1.f / 1024.f) + 1e-6f);
        yrow_store(p, ya, lane, va, ra);
        if (has2) yrow_store(p, yb, lane, vb, rb);
    }
}

namespace pg8 {
#define PG8_LAS __attribute__((address_space(3)))
typedef unsigned short bf16_t;
typedef short bf16x8 __attribute__((ext_vector_type(8)));
typedef float f32x4 __attribute__((ext_vector_type(4)));
typedef unsigned u32x4 __attribute__((ext_vector_type(4)));
constexpr int BM = 256, BK = 64, HALF = 128, HTB = HALF * BK * 2  , STAGE_BYTES = 8 * HTB, NXCD = 8, WGM = 8;

__host__ __device__ __forceinline__ int lds_byte(int r, int c) { const int st = (r >> 4) * 2 + (c >> 5), rr = r & 15, cc = c & 31, ob = rr * 64 + cc * 2; return st * 1024 + (ob ^ (((ob >> 9) & 1) << 5)); }
__host__ __device__ __forceinline__ void stage_rc(int b, int& R, int& C) { const int st = b / 1024, sb = b % 1024, swz = sb ^ (((sb >> 9) & 1) << 5); R = (st >> 1) * 16 + swz / 64; C = (st & 1) * 32 + (swz % 64) / 2; }
__host__ __device__ __forceinline__ int perm32(int rho) { const int n = rho >> 4, i = rho & 15; return 8 * (i >> 2) + 4 * n + (i & 3); }

struct Unit { int pm, pn; };
struct Gemm { const bf16_t* A; const bf16_t* Bt; int M, N, K, lda, ldb; };

struct StaticOrder {
    int nM, nN, nwg, G, c;
    __host__ __device__ void init(int M, int N, int G_, int c_) { nM = M / BM; nN = N / BM; nwg = nM * nN; G = G_; c = c_; }
    __host__ __device__ bool next(int i, Unit& u) const {
        const long L = (long)i * G + c; if (L >= nwg) return false;
        int wgid = (int)L; { const int q = nwg / NXCD, r = nwg % NXCD, xcd = wgid % NXCD, off = wgid / NXCD; wgid = (xcd < r ? xcd * (q + 1) : r * (q + 1) + (xcd - r) * q) + off; }
        const int nig = WGM * nN, gid = wgid / nig, fm = gid * WGM, gsz = (nM - fm) < WGM ? (nM - fm) : WGM;
        u.pm = fm + ((wgid % nig) % gsz); u.pn = (wgid % nig) / gsz; return true;
    }
    __device__ __forceinline__ void a_ready(const Unit&) const {}
    __device__ __forceinline__ void done(const Unit&) const {}
};
template <class Epi, class Sched, bool STAMP = false>
__device__ __forceinline__ void gemm_phase(PG8_LAS unsigned char* lds, const Gemm g, const Sched& S, const Epi& E, unsigned long long* stamps) {
    const int tid = otid(), wid = __builtin_amdgcn_readfirstlane(tid >> 6), lane = tid & 63, wr = wid >> 2, wc = wid & 3, fr = lane & 15, fq = lane >> 4;
    const int K = g.K, nt = K / BK;
    int ts_lo = 0, ts_hi = 0, nts = 0; const unsigned long long rt_entry = STAMP ? (unsigned long long)wall_clock64() : 0ull;
#define PG8_STAMP() do { if (STAMP && wid == 0 && nts < 64) { const unsigned long long _c = (unsigned long long)clock64(); \
        ts_lo = (lane == nts) ? (int)(unsigned)_c : ts_lo; ts_hi = (lane == nts) ? (int)(unsigned)(_c >> 32) : ts_hi; ++nts; } } while (0)
    PG8_STAMP();
    unsigned voffA[2], voffB[2];
#pragma unroll
    for (int i = 0; i < 2; ++i) { int R, C; stage_rc(tid * 16 + i * 8192, R, C); const int Rb = Epi::PERM ? ((R & ~31) + perm32(R & 31)) : R;
        voffA[i] = (unsigned)(R * g.lda + C) * 2u; voffB[i] = (unsigned)(Rb * g.ldb + C) * 2u; }
    const size_t kstep = (size_t)(BK * 2);
    const size_t hstepA = (size_t)HALF * g.lda * 2, hstepB = (size_t)HALF * g.ldb * 2;
    const size_t tstepA = 2 * hstepA, tstepB = 2 * hstepB;
    const unsigned ldsw = (unsigned)wid * 1024u;
    const int aoff = lds_byte(wr * 64 + fr, fq * 8), boff = lds_byte(wc * 32 + fr, fq * 8);
#define PG8_SA(b, h) (((b) * 2 + (h)) * HTB)
#define PG8_SB(b, h) ((4 + (b) * 2 + (h)) * HTB)
#define PG8_STAGE(bufoff, gbase, voff) do { _Pragma("unroll") for (int _i = 0; _i < 2; ++_i) \
        __builtin_amdgcn_global_load_lds((const unsigned*)((const char*)(gbase) + (voff)[_i]), (PG8_LAS unsigned*)(lds + (bufoff) + ldsw + _i * 8192), 16, 0, 0); } while (0)
#define PG8_LDA(dst, b, h) do { _Pragma("unroll") for (int m = 0; m < 4; ++m) _Pragma("unroll") for (int k = 0; k < 2; ++k) dst[m][k] = *(const PG8_LAS bf16x8*)(lds + PG8_SA(b, h) + aoff + m * 2048 + k * 1024); } while (0)
#define PG8_LDB(dst, b, h) do { _Pragma("unroll") for (int n = 0; n < 2; ++n) _Pragma("unroll") for (int k = 0; k < 2; ++k) dst[n][k] = *(const PG8_LAS bf16x8*)(lds + PG8_SB(b, h) + boff + n * 2048 + k * 1024); } while (0)
#define PG8_MMA(ai, bj, At, Bt) do { __builtin_amdgcn_s_setprio(1); _Pragma("unroll") for (int m = 0; m < 4; ++m) _Pragma("unroll") for (int n = 0; n < 2; ++n) _Pragma("unroll") for (int k = 0; k < 2; ++k) \
        acc[ai][bj][m][n] = __builtin_amdgcn_mfma_f32_16x16x32_bf16(Bt[n][k], At[m][k], acc[ai][bj][m][n], 0, 0, 0); __builtin_amdgcn_s_setprio(0); } while (0)
#define PG8_WAIT_V(n) asm volatile("s_waitcnt vmcnt(" #n ")" ::: "memory")
#define PG8_WAIT_L(n) asm volatile("s_waitcnt lgkmcnt(" #n ")" ::: "memory")
#define PG8_BAR __builtin_amdgcn_s_barrier()
#define PG8_SCHED __builtin_amdgcn_sched_barrier(0)
    Unit cur, nxt; int ui = 0;
    if (!S.next(0, cur)) return;
    f32x4 acc[2][2][4][2];
#pragma unroll
    for (int a = 0; a < 2; ++a)
#pragma unroll
        for (int b = 0; b < 2; ++b)
#pragma unroll
            for (int m = 0; m < 4; ++m)
#pragma unroll
                for (int n = 0; n < 2; ++n) acc[a][b][m][n] = (f32x4){0.f, 0.f, 0.f, 0.f};
    bf16x8 At[4][2], B0[2][2], B1[2][2];
    const char* cA = (const char*)g.A + (size_t)cur.pm * tstepA; const char* cB = (const char*)g.Bt + (size_t)cur.pn * tstepB;
    S.a_ready(cur);
    PG8_STAGE(PG8_SB(0, 0), cB, voffB); PG8_STAGE(PG8_SA(0, 0), cA, voffA); PG8_STAGE(PG8_SB(0, 1), cB + hstepB, voffB); PG8_STAGE(PG8_SA(0, 1), cA + hstepA, voffA);
    if (wr == 1) PG8_BAR;
    PG8_WAIT_V(4); PG8_BAR;
    PG8_STAGE(PG8_SB(1, 0), cB + kstep, voffB); PG8_STAGE(PG8_SA(1, 0), cA + kstep, voffA); PG8_STAGE(PG8_SB(1, 1), cB + hstepB + kstep, voffB);
    PG8_WAIT_V(6); PG8_BAR;
    PG8_STAMP();
    for (;;) {
        const bool has_next = S.next(ui + 1, nxt);
        const char* nA = has_next ? (const char*)g.A + (size_t)nxt.pm * tstepA : cA; const char* nB = has_next ? (const char*)g.Bt + (size_t)nxt.pn * tstepB : cB;
        for (int t = 0; t < nt; t += 2) {
            const bool last = (t == nt - 2);
            const char* a1 = cA + (size_t)(t + 1) * kstep;
            const char* a2 = last ? nA : cA + (size_t)(t + 2) * kstep; const char* b2 = last ? nB : cB + (size_t)(t + 2) * kstep;
            const char* a3 = a2 + kstep; const char* b3 = b2 + kstep;
            if (last && has_next) S.a_ready(nxt);
            PG8_LDB(B0, 0, 0); PG8_SCHED; PG8_LDA(At, 0, 0); PG8_STAGE(PG8_SA(1, 1), a1 + hstepA, voffA);
            PG8_WAIT_L(8); PG8_BAR; PG8_WAIT_L(0); PG8_MMA(0, 0, At, B0); PG8_BAR; PG8_SCHED;
            PG8_LDB(B1, 0, 1); PG8_STAGE(PG8_SB(0, 0), b2, voffB);
            PG8_BAR; PG8_WAIT_L(0); PG8_MMA(0, 1, At, B1); PG8_BAR;
            PG8_LDA(At, 0, 1); PG8_STAGE(PG8_SA(0, 0), a2, voffA);
            PG8_BAR; PG8_WAIT_L(0); PG8_MMA(1, 0, At, B0); PG8_BAR; PG8_SCHED;
            PG8_STAGE(PG8_SB(0, 1), b2 + hstepB, voffB);
            PG8_WAIT_V(6); PG8_BAR; PG8_MMA(1, 1, At, B1); PG8_BAR;
            PG8_LDB(B0, 1, 0); PG8_SCHED; PG8_LDA(At, 1, 0); PG8_STAGE(PG8_SA(0, 1), a2 + hstepA, voffA);
            PG8_WAIT_L(8); PG8_BAR; PG8_WAIT_L(0); PG8_MMA(0, 0, At, B0); PG8_BAR; PG8_SCHED;
            PG8_LDB(B1, 1, 1); PG8_STAGE(PG8_SB(1, 0), b3, voffB);
            PG8_BAR; PG8_WAIT_L(0); PG8_MMA(0, 1, At, B1); PG8_BAR;
            PG8_LDA(At, 1, 1); PG8_STAGE(PG8_SA(1, 0), a3, voffA);
            PG8_BAR; PG8_WAIT_L(0); PG8_MMA(1, 0, At, B0); PG8_BAR; PG8_SCHED;
            PG8_STAGE(PG8_SB(1, 1), b3 + hstepB, voffB);
            PG8_WAIT_V(6); PG8_BAR; PG8_MMA(1, 1, At, B1); PG8_BAR;
        }
        PG8_STAMP();
        if constexpr (!Epi::AFTER_DRAIN) { E(acc, cur, wr, wc, fr, fq); S.done(cur); }
        PG8_STAMP();
        if (!has_next) break;
#pragma unroll
        for (int a = 0; a < 2; ++a)
#pragma unroll
            for (int b = 0; b < 2; ++b)
#pragma unroll
                for (int m = 0; m < 4; ++m)
#pragma unroll
                    for (int n = 0; n < 2; ++n) acc[a][b][m][n] = (f32x4){0.f, 0.f, 0.f, 0.f};
        cur = nxt; cA = nA; cB = nB; ++ui;
    }
    PG8_WAIT_V(0);
    if (wr == 0) PG8_BAR;
    PG8_BAR;
    if constexpr (Epi::AFTER_DRAIN) { E.fused(acc, cur, wr, wc, fr, fq, lds, wid, lane); S.done(cur); }
    PG8_STAMP();
    if (STAMP && wid == 0) { stamps[lane] = lane < nts ? (((unsigned long long)(unsigned)ts_hi << 32) | (unsigned)ts_lo) : 0ull;
        if (lane == 62) stamps[62] = rt_entry; if (lane == 63) stamps[63] = (unsigned long long)wall_clock64(); }
#undef PG8_STAMP
#undef PG8_SA
#undef PG8_SB
#undef PG8_STAGE
#undef PG8_LDA
#undef PG8_LDB
#undef PG8_MMA
#undef PG8_WAIT_V
#undef PG8_WAIT_L
#undef PG8_BAR
#undef PG8_SCHED
}
}

struct EpiP {
    static constexpr bool PERM = true, AFTER_DRAIN = false;
    bf16_t* O; int ldc;
    __device__ __forceinline__ void operator()(const f32x4 (&acc)[2][2][4][2], const pg8::Unit& u, int wr, int wc, int fr, int fq) const {
        const int row0 = u.pm * 256 + wr * 64 + fr, col0 = u.pn * 256 + wc * 32 + 8 * fq;
#pragma unroll
        for (int ai = 0; ai < 2; ++ai)
#pragma unroll
            for (int m = 0; m < 4; ++m) {
                bf16_t* rowp = O + (size_t)(row0 + ai * 128 + m * 16) * ldc + col0;
#pragma unroll
                for (int bj = 0; bj < 2; ++bj) {
                    const f32x4 v0 = acc[ai][bj][m][0], v1 = acc[ai][bj][m][1];
                    uint4 o; o.x = pk2(v0[0], v0[1]); o.y = pk2(v0[2], v0[3]); o.z = pk2(v1[0], v1[1]); o.w = pk2(v1[2], v1[3]);
                    *(uint4*)(rowp + bj * 128) = o;
                }
            }
    }
};
template <int SECOND> struct EpiMerge {
    static constexpr bool PERM = true, AFTER_DRAIN = false;
    bf16_t* P; int gcol;
    __device__ __forceinline__ void operator()(const f32x4 (&acc)[2][2][4][2], const pg8::Unit& u, int wr, int wc, int fr, int fq) const {
        const int row0 = u.pm * 256 + wr * 64 + fr, col0 = u.pn * 256 + wc * 32 + 8 * fq;
#pragma unroll
        for (int ai = 0; ai < 2; ++ai)
#pragma unroll
            for (int m = 0; m < 4; ++m) {
                bf16_t* rowp = P + (size_t)(row0 + ai * 128 + m * 16) * NP + col0;
#pragma unroll
                for (int bj = 0; bj < 2; ++bj) {
                    const f32x4 v0 = acc[ai][bj][m][0], v1 = acc[ai][bj][m][1];
                    const uint4 g = *(const uint4*)(rowp + gcol + bj * 128);
                    const float4 ga = unpk4(make_uint2(g.x, g.y)), gb = unpk4(make_uint2(g.z, g.w));
                    float r[8] = {sigm(ga.x) * v0[0], sigm(ga.y) * v0[1], sigm(ga.z) * v0[2], sigm(ga.w) * v0[3],
                                  sigm(gb.x) * v1[0], sigm(gb.y) * v1[1], sigm(gb.z) * v1[2], sigm(gb.w) * v1[3]};
                    if (SECOND) {
                        const uint4 pv = *(const uint4*)(rowp + bj * 128);
                        const float4 pa = unpk4(make_uint2(pv.x, pv.y)), pb = unpk4(make_uint2(pv.z, pv.w));
                        r[0] += pa.x; r[1] += pa.y; r[2] += pa.z; r[3] += pa.w; r[4] += pb.x; r[5] += pb.y; r[6] += pb.z; r[7] += pb.w;
                    }
                    uint4 o; o.x = pk2(r[0], r[1]); o.y = pk2(r[2], r[3]); o.z = pk2(r[4], r[5]); o.w = pk2(r[6], r[7]);
                    *(uint4*)(rowp + bj * 128) = o;
                }
            }
    }
};
struct EpiOut {
    static constexpr bool PERM = false, AFTER_DRAIN = false;
    const Params* pp;
    __device__ __forceinline__ void operator()(const f32x4 (&acc)[2][2][4][2], const pg8::Unit& u, int wr, int wc, int fr, int fq) const {
        const Params& p = *pp;
        const int row0 = u.pm * 256 + wr * 64 + fr, col0 = u.pn * 256 + wc * 32 + 4 * fq;
#pragma unroll
        for (int ai = 0; ai < 2; ++ai)
#pragma unroll
            for (int m = 0; m < 4; ++m) {
                const int row = row0 + ai * 128 + m * 16;
                int s, t; tok_info(row, s, t);
                const float* xr = xrow(p, row) + col0;
                const float* gt = p.mod + (size_t)s * 3072 + 2048 + col0;
                float* orow = p.out + (size_t)row * 1024 + col0;
#pragma unroll
                for (int bj = 0; bj < 2; ++bj)
#pragma unroll
                    for (int n = 0; n < 2; ++n) {
                        const int co = bj * 128 + n * 16;
                        const float4 xv = *(const float4*)(xr + co), gv = *(const float4*)(gt + co);
                        const f32x4 a = acc[ai][bj][m][n];
                        float4 o; o.x = xv.x + gv.x * a[0]; o.y = xv.y + gv.y * a[1]; o.z = xv.z + gv.z * a[2]; o.w = xv.w + gv.w * a[3];
                        *(float4*)(orow + co) = o;
                    }
            }
    }
};
template <class Epi> __device__ __forceinline__ void run_gemm(float* sm, const bf16_t* A, int lda, const bf16_t* Bt, int ldb, int M, int N, int K, const Epi& E, int bid, int nb) {
    pg8::Gemm g; g.A = A; g.Bt = Bt; g.M = M; g.N = N; g.K = K; g.lda = lda; g.ldb = ldb;
    pg8::StaticOrder S; S.init(M, N, nb, bid);
    pg8::gemm_phase<Epi, pg8::StaticOrder, false>((PG8_LAS unsigned char*)sm, g, S, E, nullptr);
}
__device__ void phaseC(const Params& p, float* sm, int bid, int nb) {
    EpiP E; E.O = p.P; E.ldc = NP;
    run_gemm(sm, p.H, 1024, p.WinT, 1024, M_TOT, NP, 1024, E, bid, nb);
}
__device__ void phaseG(const Params& p, float* sm, int bid, int nb) {
    EpiMerge<0> E0; E0.P = p.P; E0.gcol = C_GLA;
    run_gemm(sm, p.OutA, 512, p.WupaT, 512, M_TOT, 1024, 512, E0, bid, nb);
    __syncthreads();
    EpiMerge<1> E1; E1.P = p.P; E1.gcol = C_GLB;
    run_gemm(sm, p.OutB, 512, p.WupbT, 512, M_TOT, 1024, 512, E1, bid, nb);
}
__device__ void phaseH(const Params& p, float* sm, int bid, int nb) {
    EpiOut E; E.pp = &p;
    run_gemm(sm, p.P, NP, p.WoutT, 1024, M_TOT, 1024, 1024, E, bid, nb);
}

#define XB_TMO      128
#define XB_XCNT(j)  (256  + 64 * (j))
#define XB_XSUB(j)  (1280 + 64 * (j))
#define XB_XGEN(j)  (2304 + 64 * (j))
#define XB_TOP      3328
#define XB_TOPGEN   3392
#define XCD_BAR_WORDS 3456
#define XB_SPIN_CAP (1u << 18)
#define LAS __attribute__((address_space(3)))

__device__ __forceinline__ unsigned xb_ld(unsigned* p)              { return __hip_atomic_load(p, __ATOMIC_RELAXED, __HIP_MEMORY_SCOPE_AGENT); }
__device__ __forceinline__ unsigned xb_add(unsigned* p, unsigned v) { return __hip_atomic_fetch_add(p, v, __ATOMIC_RELAXED, __HIP_MEMORY_SCOPE_AGENT); }
__device__ __forceinline__ unsigned xb_xcc_id() { return (unsigned)__builtin_amdgcn_s_getreg((3 << 11) | 20) & 0xFu; }
#define XB_SPIN(cond, bar) do { unsigned _sp = 0; while (cond) { __builtin_amdgcn_s_sleep(1); \
    if ((++_sp & 255u) == 0u) { if (xb_ld(&(bar)[XB_TMO])) break; if (_sp > XB_SPIN_CAP) { atomicAdd(&(bar)[XB_TMO], 1u); break; } } } } while (0)

struct XcdBarrier {
    unsigned* bar; unsigned x;
    volatile LAS unsigned* st;
};

__device__ __forceinline__ XcdBarrier xcd_barrier_post(unsigned* bar, volatile LAS unsigned* st) {
    XcdBarrier b; b.bar = bar; b.x = xb_xcc_id(); b.st = st;
    if (threadIdx.x == 0) (void)xb_add(&bar[XB_XCNT(b.x)], 1u);
    return b;
}
__device__ __forceinline__ void xcd_barrier_complete(unsigned* bar, unsigned x, unsigned& nloc, unsigned& nx) {
    const unsigned G = gridDim.x * gridDim.y * gridDim.z;
    unsigned sum, cnt, mine, sp = 0u;
    for (;;) {
        sum = 0u; cnt = 0u; mine = 0u;
#pragma unroll
        for (unsigned j = 0; j < 16; ++j) { const unsigned c = xb_ld(&bar[XB_XCNT(j)]); sum += c; cnt += (c > 0u) ? 1u : 0u; mine = (j == x) ? c : mine; }
        if (sum == G) break;
        __builtin_amdgcn_s_sleep(1);
        if ((++sp & 255u) == 0u) { if (xb_ld(&bar[XB_TMO])) break; if (sp > XB_SPIN_CAP) { atomicAdd(&bar[XB_TMO], 1u); break; } }
    }
    nloc = mine > 0u ? mine : 1u; nx = cnt > 0u ? cnt : 1u;
}

__device__ __forceinline__ void xcd_barrier(const XcdBarrier& b) {
    asm volatile("s_waitcnt vmcnt(0)" ::: "memory");
    __syncthreads();
    if (threadIdx.x == 0) {
        unsigned* bar = b.bar;
        __builtin_amdgcn_s_waitcnt(0);
        unsigned nloc = b.st[0], nx = b.st[1];
        if (nloc == 0u) { xcd_barrier_complete(bar, b.x, nloc, nx); b.st[0] = nloc; b.st[1] = nx; }
        const unsigned old = xb_add(&bar[XB_XSUB(b.x)], 1u);
        const unsigned gen = old / nloc;
        if (old + 1u == (gen + 1u) * nloc) {
            __builtin_amdgcn_fence(__ATOMIC_RELEASE, "agent");
            asm volatile("s_waitcnt vmcnt(0)" ::: "memory");
            const unsigned og = xb_add(&bar[XB_TOP], 1u);
            const unsigned tg = og / nx;
            if (og + 1u == (tg + 1u) * nx) xb_add(&bar[XB_TOPGEN], 1u);
            else XB_SPIN(xb_ld(&bar[XB_TOPGEN]) == tg, bar);
            __builtin_amdgcn_fence(__ATOMIC_ACQUIRE, "agent");
            xb_add(&bar[XB_XGEN(b.x)], 1u);
            asm volatile("s_waitcnt vmcnt(0)" ::: "memory");
        } else {
            XB_SPIN(xb_ld(&bar[XB_XGEN(b.x)]) == gen, bar);
            __builtin_amdgcn_fence(__ATOMIC_ACQUIRE, "agent");
            asm volatile("s_waitcnt vmcnt(0)" ::: "memory");
        }
    }
    __syncthreads();
}


#if MK_MULTI
#define PHASE_KERNEL(NAME, CALL) __global__ void __launch_bounds__(NTHR) NAME(Params p) { __shared__ __attribute__((aligned(16))) float sm[SMEM_FLOATS]; const int bid = blockIdx.x, nb = gridDim.x; (void)sm; CALL; }
PHASE_KERNEL(kA, phaseA(p, sm, bid, nb))
PHASE_KERNEL(kB, phaseB(p, bid, nb))
PHASE_KERNEL(kC, phaseC(p, sm, bid, nb))
PHASE_KERNEL(kD, phaseD(p, sm, bid, nb))
PHASE_KERNEL(kE, phaseE(p, sm, bid, nb))
PHASE_KERNEL(kF, phaseF(p, bid, nb))
PHASE_KERNEL(kG, phaseG(p, sm, bid, nb))
PHASE_KERNEL(kH, phaseH(p, sm, bid, nb))
PHASE_KERNEL(kI, phaseI(p, bid, nb))
#else
__global__ void __launch_bounds__(NTHR) fwd_megakernel(Params p) {
    __shared__ __attribute__((aligned(16))) float sm[SMEM_FLOATS];
    __shared__ uint4 xb_words;
    cg::grid_group grid = cg::this_grid();
    const int bid = blockIdx.x, nb = gridDim.x;
    if (threadIdx.x == 0) xb_words = make_uint4(0u, 0u, 0u, 0u);
    __syncthreads();
    XcdBarrier xb = xcd_barrier_post(p.bar, (volatile LAS unsigned*)&xb_words);
    phaseA(p, sm, bid, nb); grid.sync();
    phaseB(p, bid, nb); xcd_barrier(xb);
    phaseC(p, sm, bid, nb); xcd_barrier(xb);
    phaseD(p, sm, bid, nb); xcd_barrier(xb);
    phaseE(p, sm, bid, nb); xcd_barrier(xb);
    phaseF(p, bid, nb); xcd_barrier(xb);
    phaseG(p, sm, bid, nb); xcd_barrier(xb);
    phaseH(p, sm, bid, nb); xcd_barrier(xb);
    phaseI(p, bid, nb);
}
#endif

extern "C" void kernel_launch(void* const* d_in, const int* in_sizes, int n_in, void* d_out, int out_size, void* d_ws, size_t ws_size,
                              hipStream_t stream) {
    Params p{};
    const float* const* in = (const float* const*)d_in;
    p.x_p = in[0]; p.x_s = in[1]; p.c_p = in[2]; p.c_s = in[3];
    p.st_shift = in[4]; p.st_S = in[5]; p.st_conv = in[6]; p.st_C = in[7]; p.st_n = in[8]; p.st_m = in[9];
    p.g_norm = in[10]; p.w_ada = in[11]; p.b_ada = in[12]; p.w_in = in[13]; p.mu_shift = in[14]; p.w_decay2 = in[15];
    p.w0 = in[16]; p.w_iclr2 = in[17]; p.a0 = in[18]; p.k_k = in[19]; p.k_a = in[20]; p.r_k = in[21];
    p.ln_w = in[22]; p.ln_b = in[23]; p.conv_w = in[24]; p.conv_b = in[25]; p.b_i = in[26]; p.b_f = in[27];
    p.gn_w = in[28]; p.w_up_a = in[29]; p.w_up_b = in[30]; p.w_out = in[31]; p.g_final = in[32];
    p.out = (float*)d_out;
    char* ws = (char*)d_ws;
    size_t off = 0;
    p.P = (bf16_t*)(ws + off); off += (size_t)M_TOT * NP * 2;
    p.WinT = (bf16_t*)(ws + off); off += (size_t)NP * 1024 * 2;
    p.WupaT = (bf16_t*)(ws + off); off += (size_t)1024 * 512 * 2;
    p.WupbT = (bf16_t*)(ws + off); off += (size_t)1024 * 512 * 2;
    p.WoutT = (bf16_t*)(ws + off); off += (size_t)1024 * 1024 * 2;
    p.mod = (float*)(ws + off); off += (size_t)NSEQ * 3072 * 4;
    p.ctr = (unsigned*)(ws + off); off += 256;
    p.bar = (unsigned*)(ws + off); off += (size_t)XCD_BAR_WORDS * 4;
    char* os = (char*)d_out;
    p.H = (bf16_t*)os;
    p.Yraw = (bf16_t*)os;
    p.OutB = (bf16_t*)(os + (size_t)M_TOT * 512 * 2);
    p.Omd = (bf16_t*)(os + (size_t)M_TOT * 1024 * 2);
    p.Aa = (bf16_t*)(os + (size_t)M_TOT * 1024 * 2 + (size_t)M_TOT * 512 * 2);
    p.OutA = p.Omd;
#if MK_MULTI
    const int G = 1024;
    kA<<<G, NTHR, 0, stream>>>(p);
    kB<<<G, NTHR, 0, stream>>>(p);
    kC<<<G, NTHR, 0, stream>>>(p);
    kD<<<G, NTHR, 0, stream>>>(p);
    kE<<<G, NTHR, 0, stream>>>(p);
    kF<<<G, NTHR, 0, stream>>>(p);
    kG<<<G, NTHR, 0, stream>>>(p);
    kH<<<G, NTHR, 0, stream>>>(p);
    kI<<<G, NTHR, 0, stream>>>(p);
#else
    static int grid_blocks = 0;
    if (!grid_blocks) {
        int dev = 0, cus = 0, per_cu = 0;
        hipGetDevice(&dev);
        hipDeviceGetAttribute(&cus, hipDeviceAttributeMultiprocessorCount, dev);
        hipOccupancyMaxActiveBlocksPerMultiprocessor(&per_cu, fwd_megakernel, NTHR, 0);
        if (per_cu > 1) per_cu = 1;
        grid_blocks = cus * per_cu;
    }
    (void)hipMemsetAsync(p.ctr, 0, 256 + (size_t)XCD_BAR_WORDS * 4, stream);
    void* args[] = {&p};
    hipError_t e = hipLaunchCooperativeKernel((void*)fwd_megakernel, dim3(grid_blocks), dim3(NTHR), args, 0, stream);
    if (e != hipSuccess) fprintf(stderr, "cooperative launch failed: %s (grid %d)\n", hipGetErrorString(e), grid_blocks);
#endif
}
```

```cpp
#include <hip/hip_runtime.h>
#include <hip/hip_cooperative_groups.h>
#include <cstdio>
namespace cg = cooperative_groups;

#ifndef MK_MULTI
#define MK_MULTI 0
#endif

typedef unsigned short bf16_t;
typedef short bf16x8 __attribute__((ext_vector_type(8)));
typedef float f32x4 __attribute__((ext_vector_type(4)));

constexpr int NTHR = 512;
constexpr int M_P = 16384, M_S = 1024, M_TOT = 17408;
constexpr int DM = 1024;
constexpr int NSEQ = 136;
constexpr int NP = 6912;
constexpr int N_IN = 6800;
constexpr int C_R = 0, C_K = 512, C_V = 1024, C_WL = 1536, C_AL = 1600, C_ZA = 1664, C_QK = 2176,
              C_VB = 3200, C_OB = 3712, C_IB = 4224, C_FB = 4232, C_ZB = 4240, C_GLA = 4752, C_GLB = 5776;
constexpr int SHIFT_W = 1664;

constexpr size_t O_Y = 0;
constexpr size_t O_PSHIFT = (size_t)M_TOT * DM;
constexpr size_t O_PS = O_PSHIFT + 8 * 1664;
constexpr size_t O_PCONV = O_PS + 8 * 8 * 4096;
constexpr size_t O_PC = O_PCONV + 8 * 3 * 1024;
constexpr size_t O_PN = O_PC + 8 * 8 * 4096;
constexpr size_t O_PM = O_PN + 8 * 8 * 64;
constexpr size_t O_SSHIFT = O_PM + 64;
constexpr size_t O_SS = O_SSHIFT + 128 * 1664;
constexpr size_t O_SCONV = O_SS + (size_t)128 * 8 * 4096;
constexpr size_t O_SC = O_SCONV + 128 * 3 * 1024;
constexpr size_t O_SN = O_SC + (size_t)128 * 8 * 4096;
constexpr size_t O_SM = O_SN + 128 * 8 * 64;
constexpr size_t O_END = O_SM + 1024;

struct Params {
    const float *x_p, *x_s, *c_p, *c_s;
    const float *st_shift, *st_S, *st_conv, *st_C, *st_n, *st_m;
    const float *g_norm, *w_ada, *b_ada, *w_in, *mu_shift, *w_decay2, *w0, *w_iclr2, *a0, *k_k, *k_a, *r_k,
        *ln_w, *ln_b, *conv_w, *conv_b, *b_i, *b_f, *gn_w, *w_up_a, *w_up_b, *w_out, *g_final;
    float* out;
    bf16_t *WinT, *WupaT, *WupbT, *WoutT;
    float* mod;
    bf16_t* P;
    bf16_t *H, *Yraw, *OutB, *Omd, *Aa, *OutA;
    unsigned* ctr;
    unsigned* bar;
};

constexpr int SMEM_FLOATS = 32768 + 64;
__device__ __forceinline__ int otid() { int t = (int)__builtin_amdgcn_workitem_id_x(); asm volatile("" : "+v"(t)); return t; }
__device__ __forceinline__ void lds_barrier() { asm volatile("s_waitcnt lgkmcnt(0)" ::: "memory"); __builtin_amdgcn_s_barrier(); asm volatile("" ::: "memory"); }
__device__ __forceinline__ float bf2f(bf16_t v) { return __uint_as_float(((unsigned)v) << 16); }
__device__ __forceinline__ bf16_t f2bf(float f) { unsigned u = __float_as_uint(f); u += 0x7FFFu + ((u >> 16) & 1u); return (bf16_t)(u >> 16); }
__device__ __forceinline__ unsigned pk2(float lo, float hi) { return (unsigned)f2bf(lo) | ((unsigned)f2bf(hi) << 16); }
__device__ __forceinline__ float sigm(float x) { return __builtin_amdgcn_rcpf(1.f + __expf(-x)); }
__device__ __forceinline__ float silu(float x) { return x * __builtin_amdgcn_rcpf(1.f + __expf(-x)); }
__device__ __forceinline__ float wave_sum(float v) {
#pragma unroll
    for (int o = 32; o; o >>= 1) v += __shfl_xor(v, o);
    return v;
}
template <int CTRL> __device__ __forceinline__ float dpp_mov(float v) {
    return __builtin_bit_cast(float, __builtin_amdgcn_update_dpp(0, __builtin_bit_cast(int, v), CTRL, 0xF, 0xF, true));
}
__device__ __forceinline__ float row16_sum(float v) {
    v += dpp_mov<0xB1>(v);
    v += dpp_mov<0x4E>(v);
    v += dpp_mov<0x141>(v);
    v += dpp_mov<0x140>(v);
    return v;
}
__device__ __forceinline__ void tok_info(int m, int& s, int& t) {
    if (m < M_P) { s = m >> 11; t = m & 2047; } else { int q = m - M_P; s = 8 + (q >> 3); t = q & 7; }
}
__device__ __forceinline__ const float* xrow(const Params& p, int m) {
    return m < M_P ? p.x_p + (size_t)m * DM : p.x_s + (size_t)(m - M_P) * DM;
}

__device__ __forceinline__ void tr8(const float* __restrict__ src, int Nsrc, bf16_t* __restrict__ dst, int K, int n, int kg) {
    float v[8];
    if (n < Nsrc) {
        const float* sp = src + (size_t)(kg * 8) * Nsrc + n;
#pragma unroll
        for (int i = 0; i < 8; ++i) v[i] = sp[(size_t)i * Nsrc];
    } else {
#pragma unroll
        for (int i = 0; i < 8; ++i) v[i] = 0.f;
    }
    uint4 o; o.x = pk2(v[0], v[1]); o.y = pk2(v[2], v[3]); o.z = pk2(v[4], v[5]); o.w = pk2(v[6], v[7]);
    *(uint4*)(dst + (size_t)n * K + kg * 8) = o;
}
__device__ void phaseA(const Params& p, float* sm, int bid, int nb) {
    const int tid = otid();
    if (bid == 0 && tid == 0) *p.ctr = 0u;
    constexpr int N_ADA = 48 * 17;
    for (int i = bid; i < N_ADA; i += nb) {
        const int ct = i % 48, rgp = i / 48;
        float* sc = sm;
        float* red = sm + 8192;
        {
            float cv[16];
#pragma unroll
            for (int q = 0; q < 16; ++q) {
                const int idx = tid + q * NTHR, sl = idx >> 10, k = idx & 1023, s = rgp * 8 + sl;
                const float* src = s < 8 ? p.c_p + s * 1024 : p.c_s + (s - 8) * 1024;
                cv[q] = src[k];
            }
#pragma unroll
            for (int q = 0; q < 16; ++q) sc[tid + q * NTHR] = silu(cv[q]);
        }
        __syncthreads();
        const int col = tid & 63, kq = tid >> 6;
        float acc[8];
#pragma unroll
        for (int s = 0; s < 8; ++s) acc[s] = 0.f;
        const float* wp = p.w_ada + (size_t)(kq * 128) * 3072 + ct * 64 + col;
#pragma unroll 4
        for (int k4 = 0; k4 < 32; ++k4) {
            const float w0 = wp[(size_t)(k4 * 4) * 3072], w1 = wp[(size_t)(k4 * 4 + 1) * 3072], w2 = wp[(size_t)(k4 * 4 + 2) * 3072], w3 = wp[(size_t)(k4 * 4 + 3) * 3072];
#pragma unroll
            for (int s = 0; s < 8; ++s) {
                const float4 c = *(const float4*)(sc + s * 1024 + kq * 128 + k4 * 4);
                acc[s] += c.x * w0 + c.y * w1 + c.z * w2 + c.w * w3;
            }
        }
#pragma unroll
        for (int s = 0; s < 8; ++s) red[(kq * 8 + s) * 64 + col] = acc[s];
        __syncthreads();
        {
            const int s = tid >> 6;
            float v = p.b_ada[ct * 64 + col];
#pragma unroll
            for (int q = 0; q < 8; ++q) v += red[(q * 8 + s) * 64 + col];
            p.mod[(size_t)(rgp * 8 + s) * 3072 + ct * 64 + col] = v;
        }
        __syncthreads();
    }
    constexpr int W_IN = NP * 128, W_UP = 1024 * 64, W_OUT = 1024 * 128;
    const int gt = bid * NTHR + tid, gs = nb * NTHR;
    for (int w = gt; w < W_IN; w += 2 * gs) {
        const int w2 = w + gs; const bool has2 = w2 < W_IN;
        const int n1 = w % NP, g1 = w / NP, n2 = has2 ? w2 % NP : n1, g2 = has2 ? w2 / NP : g1;
        float v1[8], v2[8];
        const float* s1 = p.w_in + (size_t)(g1 * 8) * N_IN + (n1 < N_IN ? n1 : 0);
        const float* s2 = p.w_in + (size_t)(g2 * 8) * N_IN + (n2 < N_IN ? n2 : 0);
#pragma unroll
        for (int i = 0; i < 8; ++i) { v1[i] = s1[(size_t)i * N_IN]; v2[i] = s2[(size_t)i * N_IN]; }
        uint4 o;
        if (n1 >= N_IN) { o = make_uint4(0u, 0u, 0u, 0u); } else { o.x = pk2(v1[0], v1[1]); o.y = pk2(v1[2], v1[3]); o.z = pk2(v1[4], v1[5]); o.w = pk2(v1[6], v1[7]); }
        *(uint4*)(p.WinT + (size_t)n1 * 1024 + g1 * 8) = o;
        if (has2) {
            if (n2 >= N_IN) { o = make_uint4(0u, 0u, 0u, 0u); } else { o.x = pk2(v2[0], v2[1]); o.y = pk2(v2[2], v2[3]); o.z = pk2(v2[4], v2[5]); o.w = pk2(v2[6], v2[7]); }
            *(uint4*)(p.WinT + (size_t)n2 * 1024 + g2 * 8) = o;
        }
    }
    for (int w = gt; w < W_UP; w += gs) { tr8(p.w_up_a, 1024, p.WupaT, 512, w & 1023, w >> 10); tr8(p.w_up_b, 1024, p.WupbT, 512, w & 1023, w >> 10); }
    for (int w = gt; w < W_OUT; w += gs) tr8(p.w_out, 1024, p.WoutT, 1024, w & 1023, w >> 10);
}

__device__ __forceinline__ void normrow_load(const float* xr, int lane, float4 (&v)[4]) {
#pragma unroll
    for (int i = 0; i < 4; ++i) v[i] = *(const float4*)(xr + i * 256 + lane * 4);
}
__device__ __forceinline__ float sumsq4(const float4 (&v)[4]) {
    float ss = 0.f;
#pragma unroll
    for (int i = 0; i < 4; ++i) ss += v[i].x * v[i].x + v[i].y * v[i].y + v[i].z * v[i].z + v[i].w * v[i].w;
    return ss;
}
__device__ __forceinline__ void hrow_store(const Params& p, int m, int lane, const float4 (&v)[4], float rstd) {
    int s, t; tok_info(m, s, t);
    const float* md = p.mod + (size_t)s * 3072;
#pragma unroll
    for (int i = 0; i < 4; ++i) {
        const int c = i * 256 + lane * 4;
        const float4 g = *(const float4*)(p.g_norm + c);
        const float4 sh = *(const float4*)(md + c);
        const float4 sl = *(const float4*)(md + 1024 + c);
        const float h0 = v[i].x * rstd * g.x * (1.f + sl.x) + sh.x;
        const float h1 = v[i].y * rstd * g.y * (1.f + sl.y) + sh.y;
        const float h2 = v[i].z * rstd * g.z * (1.f + sl.z) + sh.z;
        const float h3 = v[i].w * rstd * g.w * (1.f + sl.w) + sh.w;
        uint2 o; o.x = pk2(h0, h1); o.y = pk2(h2, h3);
        *(uint2*)(p.H + (size_t)m * 1024 + c) = o;
    }
}
__device__ void phaseB(const Params& p, int bid, int nb) {
    const int wid = otid() >> 6, lane = otid() & 63;
    const int stride = nb * 8;
    for (int m = bid * 8 + wid; m < M_TOT; m += 2 * stride) {
        const int m2 = m + stride;
        const bool has2 = m2 < M_TOT;
        float4 va[4], vb[4];
        normrow_load(xrow(p, m), lane, va);
        normrow_load(xrow(p, has2 ? m2 : m), lane, vb);
        const float ra = rsqrtf(wave_sum(sumsq4(va)) * (1.f / 1024.f) + 1e-6f);
        const float rb = rsqrtf(wave_sum(sumsq4(vb)) * (1.f / 1024.f) + 1e-6f);
        hrow_store(p, m, lane, va, ra);
        if (has2) hrow_store(p, m2, lane, vb, rb);
    }
}

typedef unsigned u32x4v __attribute__((ext_vector_type(4)));
__device__ __forceinline__ bf16x8 pack8(const float (&v)[8]) {
    u32x4v t; t[0] = pk2(v[0], v[1]); t[1] = pk2(v[2], v[3]); t[2] = pk2(v[4], v[5]); t[3] = pk2(v[6], v[7]);
    return __builtin_bit_cast(bf16x8, t);
}
__device__ void phaseD(const Params& p, float* sm, int bid, int nb) {
    const int tid = otid(), wid = tid >> 6, lane = tid & 63, fr = lane & 15, fq = lane >> 4;
    bf16_t* twb = (bf16_t*)sm;
    bf16_t* alb = twb + 16 * 72;
    bf16x8 Bd[4][2], Bi[4][2];
#pragma unroll
    for (int ct = 0; ct < 4; ++ct)
#pragma unroll
        for (int ks = 0; ks < 2; ++ks) {
            const int n = wid * 64 + ct * 16 + fr, k0 = ks * 32 + fq * 8;
            float vd[8], vi[8];
#pragma unroll
            for (int j = 0; j < 8; ++j) { vd[j] = p.w_decay2[(k0 + j) * 512 + n]; vi[j] = p.w_iclr2[(k0 + j) * 512 + n]; }
            Bd[ct][ks] = pack8(vd); Bi[ct][ks] = pack8(vi);
        }
    float w0r[16], a0r[16];
#pragma unroll
    for (int q = 0; q < 16; ++q) { const int col = wid * 64 + (q >> 2) * 16 + fq * 4 + (q & 3); w0r[q] = p.w0[col]; a0r[q] = p.a0[col]; }
    unsigned cu[4], pv[4]; float st[4];
    auto fetchD = [&](int it) {
        const int m0 = it * 16;
#pragma unroll
        for (int q = 0; q < 4; ++q) {
            const int idx = tid + q * NTHR, tok = idx >> 7, j = idx & 127, col = C_WL + j, m = m0 + tok;
            int s, t; tok_info(m, s, t);
            cu[q] = p.P[(size_t)m * NP + col];
            pv[q] = p.P[(size_t)(t > 0 ? m - 1 : m) * NP + col];
            st[q] = p.st_shift[(size_t)(s >= 8 ? s - 8 : 0) * SHIFT_W + col];
        }
    };
    if (bid < M_TOT / 16) fetchD(bid);
    for (int it = bid; it < M_TOT / 16; it += nb) {
        const int m0 = it * 16;
        {
#pragma unroll
            for (int q = 0; q < 4; ++q) {
                const int idx = tid + q * NTHR, tok = idx >> 7, j = idx & 127, col = C_WL + j, m = m0 + tok;
                int s, t; tok_info(m, s, t);
                const float cur = __uint_as_float(cu[q] << 16);
                const float prev = t > 0 ? __uint_as_float(pv[q] << 16) : (s >= 8 ? st[q] : 0.f);
                const float v = cur + p.mu_shift[col] * (prev - cur);
                if (j < 64) twb[tok * 72 + j] = f2bf(tanhf(v)); else alb[tok * 72 + j - 64] = f2bf(v);
            }
        }
        if (it + nb < M_TOT / 16) fetchD(it + nb);
        lds_barrier();
        {
            const bf16x8 at0 = *(const bf16x8*)(twb + fr * 72 + fq * 8), at1 = *(const bf16x8*)(twb + fr * 72 + 32 + fq * 8);
            const bf16x8 aa0 = *(const bf16x8*)(alb + fr * 72 + fq * 8), aa1 = *(const bf16x8*)(alb + fr * 72 + 32 + fq * 8);
            const size_t mrow = (size_t)(m0 + fr) * 512 + wid * 64 + fq * 4;
#pragma unroll
            for (int ct = 0; ct < 4; ++ct) {
                f32x4 cw = (f32x4){0.f, 0.f, 0.f, 0.f}, ca = cw;
                cw = __builtin_amdgcn_mfma_f32_16x16x32_bf16(Bd[ct][0], at0, cw, 0, 0, 0);
                cw = __builtin_amdgcn_mfma_f32_16x16x32_bf16(Bd[ct][1], at1, cw, 0, 0, 0);
                ca = __builtin_amdgcn_mfma_f32_16x16x32_bf16(Bi[ct][0], aa0, ca, 0, 0, 0);
                ca = __builtin_amdgcn_mfma_f32_16x16x32_bf16(Bi[ct][1], aa1, ca, 0, 0, 0);
                float o[4], a[4];
#pragma unroll
                for (int r = 0; r < 4; ++r) {
                    const float sg = sigm(w0r[ct * 4 + r] + cw[r]);
                    o[r] = 1.f - __expf(-0.6065306597126334f * sg);
                    a[r] = sigm(a0r[ct * 4 + r] + ca[r]);
                }
                uint2 uo, ua; uo.x = pk2(o[0], o[1]); uo.y = pk2(o[2], o[3]); ua.x = pk2(a[0], a[1]); ua.y = pk2(a[2], a[3]);
                *(uint2*)(p.Omd + mrow + ct * 16) = uo;
                *(uint2*)(p.Aa + mrow + ct * 16) = ua;
            }
        }
        for (int tok = 0; tok < 16; ++tok) {
            const int m = m0 + tok;
            int s, t; tok_info(m, s, t);
            const int T = s < 8 ? 2048 : 8;
            if (t != T - 1) continue;
            float* osh = s < 8 ? p.out + O_PSHIFT + (size_t)s * SHIFT_W : p.out + O_SSHIFT + (size_t)(s - 8) * SHIFT_W;
            float* ocv = s < 8 ? p.out + O_PCONV + (size_t)s * 3072 : p.out + O_SCONV + (size_t)(s - 8) * 3072;
            for (int col = tid; col < SHIFT_W; col += NTHR) osh[col] = bf2f(p.P[(size_t)m * NP + col]);
            for (int idx = tid; idx < 3072; idx += NTHR) {
                const int r = idx >> 10, cc = idx & 1023;
                ocv[idx] = bf2f(p.P[(size_t)(m - 2 + r) * NP + C_QK + cc]);
            }
        }
        lds_barrier();
    }
    __syncthreads();
}

__device__ __forceinline__ float rdlane(float v, int l) { return __builtin_bit_cast(float, __builtin_amdgcn_readlane(__builtin_bit_cast(int, v), l)); }
__device__ __forceinline__ float wave_sum_fast(float v) {
    v = row16_sum(v);
    return (rdlane(v, 0) + rdlane(v, 16)) + (rdlane(v, 32) + rdlane(v, 48));
}
__device__ __forceinline__ float4 unpk4(uint2 u) {
    float4 f; f.x = __uint_as_float(u.x << 16); f.y = __uint_as_float(u.x & 0xFFFF0000u);
    f.z = __uint_as_float(u.y << 16); f.w = __uint_as_float(u.y & 0xFFFF0000u); return f;
}
__device__ void rwkv_item(const Params& p, int s, int h, int third, float* sm) {
    constexpr int BUF = 15680;
    constexpr int VC_OFF = 10368, Y_OFF = 13632, NCH = 64;
    const int tid = otid(), wid = tid >> 6, lane = tid & 63;
    const int mbase = s * 2048;
    const int r0 = third * 21 + (third > 0 ? 1 : 0), nr = third == 0 ? 22 : 21;
    if (wid >= 6) {
        const int pw = wid - 6, g = lane >> 4;
        const int c4 = (lane & 15) * 4, hc = h * 64 + c4;
        const int l128 = pw * 64 + lane;
        const float4 mu_r = *(const float4*)(p.mu_shift + C_R + hc), mu_k = *(const float4*)(p.mu_shift + C_K + hc), mu_v = *(const float4*)(p.mu_shift + C_V + hc);
        const float4 kkw = *(const float4*)(p.k_k + hc), kaw = *(const float4*)(p.k_a + hc);
        uint2 R[4][8];
        auto fetch = [&](int pass, uint2 (&q)[8]) {
            const int t = (pass >> 2) * 32 + (pass & 3) * 8 + pw * 4 + g;
            const bf16_t* pr = p.P + (size_t)(mbase + t) * NP + hc;
            const bf16_t* pp = t > 0 ? pr - NP : pr;
            q[0] = *(const uint2*)(pr + C_R); q[1] = *(const uint2*)(pr + C_K); q[2] = *(const uint2*)(pr + C_V);
            q[3] = *(const uint2*)(pp + C_R); q[4] = *(const uint2*)(pp + C_K); q[5] = *(const uint2*)(pp + C_V);
            q[6] = *(const uint2*)(p.Aa + (size_t)(mbase + t) * 512 + hc);
            q[7] = *(const uint2*)(p.Omd + (size_t)(mbase + t) * 512 + hc);
        };
        auto step = [&](int pass, uint2 (&q)[8]) {
            const uint2 cr = q[0], ck = q[1], cv = q[2], crp = q[3], ckp = q[4], cvp = q[5], ca = q[6], co = q[7];
            if (pass + 4 < NCH * 4) fetch(pass + 4, q);
            const int tok = (pass & 3) * 8 + pw * 4 + g, t = (pass >> 2) * 32 + tok;
            float* B = sm + ((pass >> 2) & 1) * BUF;
            float4 r = unpk4(cr), k = unpk4(ck), v = unpk4(cv), rp, kp_, vp;
            if (t > 0) { rp = unpk4(crp); kp_ = unpk4(ckp); vp = unpk4(cvp); }
            else { rp = make_float4(0.f, 0.f, 0.f, 0.f); kp_ = rp; vp = rp; }
            r.x += mu_r.x * (rp.x - r.x); r.y += mu_r.y * (rp.y - r.y); r.z += mu_r.z * (rp.z - r.z); r.w += mu_r.w * (rp.w - r.w);
            k.x += mu_k.x * (kp_.x - k.x); k.y += mu_k.y * (kp_.y - k.y); k.z += mu_k.z * (kp_.z - k.z); k.w += mu_k.w * (kp_.w - k.w);
            v.x += mu_v.x * (vp.x - v.x); v.y += mu_v.y * (vp.y - v.y); v.z += mu_v.z * (vp.z - v.z); v.w += mu_v.w * (vp.w - v.w);
            const float4 a = unpk4(ca), om = unpk4(co);
            float4 kk; kk.x = k.x * kkw.x; kk.y = k.y * kkw.y; kk.z = k.z * kkw.z; kk.w = k.w * kkw.w;
            const float nrm = sqrtf(row16_sum(kk.x * kk.x + kk.y * kk.y + kk.z * kk.z + kk.w * kk.w));
            const float inv = __builtin_amdgcn_rcpf(fmaxf(nrm, 1e-12f));
            kk.x *= inv; kk.y *= inv; kk.z *= inv; kk.w *= inv;
            float4 ka; ka.x = kk.x * a.x; ka.y = kk.y * a.y; ka.z = kk.z * a.z; ka.w = kk.w * a.w;
            float4 kp; kp.x = k.x * (1.f + (a.x - 1.f) * kaw.x); kp.y = k.y * (1.f + (a.y - 1.f) * kaw.y);
            kp.z = k.z * (1.f + (a.z - 1.f) * kaw.z); kp.w = k.w * (1.f + (a.w - 1.f) * kaw.w);
            float4 d; d.x = 1.f - om.x; d.y = 1.f - om.y; d.z = 1.f - om.z; d.w = 1.f - om.w;
            float4 dr; dr.x = d.x * r.x; dr.y = d.y * r.y; dr.z = d.z * r.z; dr.w = d.w * r.w;
            const float c1 = row16_sum(ka.x * r.x + ka.y * r.y + ka.z * r.z + ka.w * r.w);
            const float c2 = row16_sum(kp.x * r.x + kp.y * r.y + kp.z * r.z + kp.w * r.w);
            const int o = tok * 64 + c4;
            *(float4*)(B + o) = kk; *(float4*)(B + 2048 + o) = d; *(float4*)(B + 4096 + o) = ka;
            *(float4*)(B + 6144 + o) = kp; *(float4*)(B + 8192 + o) = dr;
            float4* vc = (float4*)(B + VC_OFF) + tok * 24;
            const int l0 = c4 - r0;
            if (l0 >= 0 && l0 < nr) vc[l0] = make_float4(v.x, c1, c2, 0.f);
            if (l0 + 1 >= 0 && l0 + 1 < nr) vc[l0 + 1] = make_float4(v.y, c1, c2, 0.f);
            if (l0 + 2 >= 0 && l0 + 2 < nr) vc[l0 + 2] = make_float4(v.z, c1, c2, 0.f);
            if (l0 + 3 >= 0 && l0 + 3 < nr) vc[l0 + 3] = make_float4(v.w, c1, c2, 0.f);
        };
        auto flush = [&](int c) {
            const float* Y = sm + (c & 1) * BUF + Y_OFF;
            const int tt = l128 >> 2, part = l128 & 3;
            bf16_t* dst = p.Yraw + (size_t)(mbase + c * 32 + tt) * 512 + h * 64 + r0;
#pragma unroll
            for (int k = 0; k < 6; ++k) { const int i = part + 4 * k; if (i < nr) dst[i] = f2bf(Y[tt * 64 + i]); }
        };
#pragma unroll
        for (int q = 0; q < 4; ++q) fetch(q, R[q]);
#pragma unroll
        for (int q = 0; q < 4; ++q) step(q, R[q]);
        lds_barrier();
#pragma unroll 1
        for (int c = 0; c < NCH; ++c) {
            if (c > 0) flush(c - 1);
            if (c + 1 < NCH) {
#pragma unroll
                for (int q = 0; q < 4; ++q) step((c + 1) * 4 + q, R[q]);
            }
            lds_barrier();
        }
        flush(NCH - 1);
    } else {
        const int lrow = wid * 4 + (lane >> 4);
        const int irow = r0 + (lrow < nr ? lrow : nr - 1);
        const int c4 = (lane & 15) * 4;
        const int yslot = ((lane & 15) == 0 && lrow < nr) ? lrow : 32 + (lane & 31);
        float S0 = 0.f, S1 = 0.f, S2 = 0.f, S3 = 0.f;
        lds_barrier();
#pragma unroll 1
        for (int c = 0; c < NCH; ++c) {
            const float* B = sm + (c & 1) * BUF;
            const float* bp = B + c4;
            const float4* vp4 = (const float4*)(B + VC_OFF) + (irow - r0);
            float4 kk4 = *(const float4*)(bp), d4 = *(const float4*)(bp + 2048), ka4 = *(const float4*)(bp + 4096);
            float4 kp4 = *(const float4*)(bp + 6144), dr4 = *(const float4*)(bp + 8192), vc = vp4[0];
            float4 kkB = *(const float4*)(bp + 64), dB = *(const float4*)(bp + 64 + 2048), kaB = *(const float4*)(bp + 64 + 4096);
            float4 kpB = *(const float4*)(bp + 64 + 6144), drB = *(const float4*)(bp + 64 + 8192), vcB = vp4[24];
            float* yp = sm + (c & 1) * BUF + Y_OFF + yslot;
#pragma unroll 8
            for (int tt = 0; tt < 32; ++tt) {
                const float* nb_ = bp + (tt + 2) * 64;
                const float4 nkk = *(const float4*)(nb_), nd = *(const float4*)(nb_ + 2048), nka = *(const float4*)(nb_ + 4096);
                const float4 nkp = *(const float4*)(nb_ + 6144), ndr = *(const float4*)(nb_ + 8192), nvc = vp4[(tt + 2) * 24];
                __builtin_amdgcn_sched_barrier(0);
                float p1 = S0 * kk4.x + S1 * kk4.y + S2 * kk4.z + S3 * kk4.w;
                float p2 = S0 * dr4.x + S1 * dr4.y + S2 * dr4.z + S3 * dr4.w;
                const float vi = vc.x;
                const float u0 = S0 * d4.x + vi * kp4.x, u1 = S1 * d4.y + vi * kp4.y, u2 = S2 * d4.z + vi * kp4.z, u3 = S3 * d4.w + vi * kp4.w;
                float z = p2 - vc.y * p1;
                p1 = row16_sum(p1);
                z = row16_sum(z);
                S0 = u0 - p1 * ka4.x; S1 = u1 - p1 * ka4.y; S2 = u2 - p1 * ka4.z; S3 = u3 - p1 * ka4.w;
                yp[tt * 64] = z + vi * vc.z;
                kk4 = kkB; d4 = dB; ka4 = kaB; kp4 = kpB; dr4 = drB; vc = vcB;
                kkB = nkk; dB = nd; kaB = nka; kpB = nkp; drB = ndr; vcB = nvc;
                __builtin_amdgcn_sched_barrier(0);
            }
            lds_barrier();
        }
        if (lrow < nr) {
            float* o = p.out + O_PS + (size_t)s * 8 * 4096 + ((size_t)(h * 64 + irow)) * 64 + c4;
            float4 v; v.x = S0; v.y = S1; v.z = S2; v.w = S3;
            *(float4*)o = v;
        }
    }
    __syncthreads();
}

__device__ void mlstm_item(const Params& p, int s, int h, float* sm) {
    float* sq = sm;
    float* sk = sm + 4160;
    float* sv = sm + 8320;
    float* sc = sm + 12480;
    float* sC = sm + 16640;
    float* sn = sm + 20800;
    float* sb = sn + 64;
    float* si = sn + 128;
    float* smt = sn + 192;
    float* swin = sn + 256;
    float* sden = sn + 320;
    float* sws = sn + 384;
    float* slf = sn + 448;
    float* smisc = sn + 512;
    const int tid = otid(), wid = tid >> 6, lane = tid & 63;
    const int T = s < 8 ? 2048 : 8, L = s < 8 ? 64 : 8, NC = T / L;
    const int mbase = s < 8 ? s * 2048 : M_P + (s - 8) * 8;
    for (int idx = tid; idx < 4096; idx += NTHR) {
        const int i = idx >> 6, j = idx & 63;
        sC[i * 65 + j] = s >= 8 ? p.st_C[(size_t)((s - 8) * 8 + h) * 4096 + idx] : 0.f;
    }
    if (tid < 64) sn[tid] = s >= 8 ? p.st_n[(size_t)((s - 8) * 8 + h) * 64 + tid] : 0.f;
    if (tid == 0) smisc[0] = s >= 8 ? p.st_m[(s - 8) * 8 + h] : 0.f;
    const float cwq[4] = {p.conv_w[0 * 1024 + h * 64 + lane], p.conv_w[1 * 1024 + h * 64 + lane], p.conv_w[2 * 1024 + h * 64 + lane], p.conv_w[3 * 1024 + h * 64 + lane]};
    const float cwk[4] = {p.conv_w[0 * 1024 + 512 + h * 64 + lane], p.conv_w[1 * 1024 + 512 + h * 64 + lane], p.conv_w[2 * 1024 + 512 + h * 64 + lane], p.conv_w[3 * 1024 + 512 + h * 64 + lane]};
    const float cbq = p.conv_b[h * 64 + lane], cbk = p.conv_b[512 + h * 64 + lane];
    const float gnw = p.gn_w[h * 64 + lane];
    const float bi = p.b_i[h], bfv = p.b_f[h];
    __syncthreads();
    for (int c = 0; c < NC; ++c) {
        const int t0 = c * L;
        for (int tt = wid; tt < L; tt += 8) {
            const int t = t0 + tt, m = mbase + t;
            float aq = cbq, ak = cbk;
#pragma unroll
            for (int j = 0; j < 4; ++j) {
                const int tau = t - 3 + j;
                float xq, xk;
                if (tau >= 0) {
                    const bf16_t* pr = p.P + (size_t)(mbase + tau) * NP + C_QK + h * 64 + lane;
                    xq = bf2f(pr[0]); xk = bf2f(pr[512]);
                } else if (s >= 8) {
                    const float* st = p.st_conv + ((size_t)(s - 8) * 3 + (3 + tau)) * 1024 + h * 64 + lane;
                    xq = st[0]; xk = st[512];
                } else { xq = 0.f; xk = 0.f; }
                aq += xq * cwq[j]; ak += xk * cwk[j];
            }
            sq[tt * 65 + lane] = silu(aq);
            sk[tt * 65 + lane] = silu(ak) * 0.125f;
            sv[tt * 65 + lane] = bf2f(p.P[(size_t)m * NP + C_VB + h * 64 + lane]);
        }
        if (tid < L) {
            const int m = mbase + t0 + tid;
            si[tid] = bf2f(p.P[(size_t)m * NP + C_IB + h]) + bi;
            const float f = bf2f(p.P[(size_t)m * NP + C_FB + h]) + bfv;
            slf[tid] = f > 0.f ? -log1pf(__expf(-f)) : f - log1pf(__expf(f));
        }
        __syncthreads();
        if (tid == 0) {
            const float mprev = smisc[0];
            float b = 0.f, run = mprev;
            for (int t = 0; t < L; ++t) {
                b += slf[t];
                run = fmaxf(run, si[t] - b);
                sb[t] = b; smt[t] = b + run; swin[t] = __expf(b + mprev - (b + run));
            }
            const float mnew = b + run;
            smisc[1] = mnew; smisc[2] = __expf(b + mprev - mnew);
            for (int t = 0; t < L; ++t) sws[t] = __expf(b - sb[t] + si[t] - mnew);
        }
        __syncthreads();
        for (int idx = tid; idx < L * L; idx += NTHR) {
            const int t = idx / L, u = idx % L;
            float v = 0.f;
            if (u <= t) {
                float dot = 0.f;
#pragma unroll 8
                for (int d = 0; d < 64; ++d) dot += sq[t * 65 + d] * sk[u * 65 + d];
                v = dot * __expf(sb[t] - sb[u] + si[u] - smt[t]);
            }
            sc[t * 65 + u] = v;
        }
        __syncthreads();
        if (tid < L) {
            float rs = 0.f, qn = 0.f;
            for (int u = 0; u < L; ++u) rs += sc[tid * 65 + u];
            for (int j = 0; j < 64; ++j) qn += sn[j] * sq[tid * 65 + j];
            const float den = rs + swin[tid] * qn;
            sden[tid] = fmaxf(fabsf(den), __expf(-smt[tid]));
        }
        __syncthreads();
        for (int tt = wid; tt < L; tt += 8) {
            float num = 0.f, inter = 0.f;
            for (int u = 0; u <= tt; ++u) num += sc[tt * 65 + u] * sv[u * 65 + lane];
#pragma unroll 8
            for (int j = 0; j < 64; ++j) inter += sC[lane * 65 + j] * sq[tt * 65 + j];
            const float hv = (num + swin[tt] * inter) / sden[tt];
            const float ms = wave_sum(hv * hv) * (1.f / 64.f);
            const float hn = hv * rsqrtf(ms + 1e-6f) * gnw;
            const int m = mbase + t0 + tt;
            const float ob = bf2f(p.P[(size_t)m * NP + C_OB + h * 64 + lane]);
            const float zb = bf2f(p.P[(size_t)m * NP + C_ZB + h * 64 + lane]);
            p.OutB[(size_t)m * 512 + h * 64 + lane] = f2bf(sigm(ob) * hn * silu(zb));
        }
        __syncthreads();
        {
            const float dec = smisc[2];
            const int j = lane;
#pragma unroll
            for (int ii = 0; ii < 8; ++ii) {
                const int i = wid + 8 * ii;
                float a = dec * sC[i * 65 + j];
                for (int u = 0; u < L; ++u) a += sws[u] * sv[u * 65 + i] * sk[u * 65 + j];
                sC[i * 65 + j] = a;
            }
            if (tid < 64) {
                float a = dec * sn[tid];
                for (int u = 0; u < L; ++u) a += sws[u] * sk[u * 65 + tid];
                sn[tid] = a;
            }
            if (tid == 0) smisc[0] = smisc[1];
        }
        __syncthreads();
    }
    {
        float* oC = s < 8 ? p.out + O_PC + (size_t)(s * 8 + h) * 4096 : p.out + O_SC + (size_t)((s - 8) * 8 + h) * 4096;
        float* on = s < 8 ? p.out + O_PN + (size_t)(s * 8 + h) * 64 : p.out + O_SN + (size_t)((s - 8) * 8 + h) * 64;
        float* om = s < 8 ? p.out + O_PM + (s * 8 + h) : p.out + O_SM + ((s - 8) * 8 + h);
        for (int idx = tid; idx < 4096; idx += NTHR) oC[idx] = sC[(idx >> 6) * 65 + (idx & 63)];
        if (tid < 64) on[tid] = sn[tid];
        if (tid == 0) om[0] = smisc[0];
    }
    __syncthreads();
}

__device__ __forceinline__ bf16x8 ldfrag(const bf16_t* base, int row, int ks, int fq) { return *(const bf16x8*)(base + row * 72 + ks * 32 + fq * 8); }
__device__ __forceinline__ float sum8(float v) { v += dpp_mov<0xB1>(v); v += dpp_mov<0x4E>(v); v += dpp_mov<0x141>(v); return v; }
__device__ void mlstm_prompt(const Params& p, int s, int h, float* sm) {
    bf16_t* Qs = (bf16_t*)sm; bf16_t* Ks = Qs + 4608; bf16_t* VT = Ks + 4608; bf16_t* KwT = VT + 4608; bf16_t* Ps = KwT + 4608; bf16_t* Cb = Ps + 4608;
    float* hs = sm + 13824;
    float* sn = hs + 64 * 68;
    float* sden = sn + 64;
    float* gv = sn + 128;
    float* Gg = sn + 128 + 768;
    float* Gl = Gg + 2048;
    float* Gb = Gl + 2048;
    const int tid = otid(), wid = tid >> 6, lane = tid & 63, fr = lane & 15, fq = lane >> 4;
    const int tr = wid >> 1, tc0 = (wid & 1) * 2;
    const int mbase = s * 2048;
    const int qc = h * 64 + lane;
    f32x4 accC[2];
    accC[0] = (f32x4){0.f, 0.f, 0.f, 0.f}; accC[1] = accC[0];
    if (tid < 64) sn[tid] = 0.f;
    {
        const float bi = p.b_i[h], bfv = p.b_f[h];
        for (int cc = wid; cc < 32; cc += 8) {
            const bf16_t* pr = p.P + (size_t)(mbase + cc * 64 + lane) * NP;
            const float it = bf2f(pr[C_IB + h]) + bi;
            const float f = bf2f(pr[C_FB + h]) + bfv;
            float b = f > 0.f ? -log1pf(__expf(-f)) : f - log1pf(__expf(f));
#pragma unroll
            for (int o = 1; o < 64; o <<= 1) { const float v = __shfl_up(b, o); if (lane >= o) b += v; }
            const float g = it - b;
            float run = g;
#pragma unroll
            for (int o = 1; o < 64; o <<= 1) { const float v = __shfl_up(run, o); if (lane >= o) run = fmaxf(run, v); }
            Gg[cc * 64 + lane] = g; Gl[cc * 64 + lane] = run; Gb[cc * 64 + lane] = b;
        }
    }
    const float cwq0 = p.conv_w[qc], cwq1 = p.conv_w[1024 + qc], cwq2 = p.conv_w[2048 + qc], cwq3 = p.conv_w[3072 + qc];
    const float cwk0 = p.conv_w[512 + qc], cwk1 = p.conv_w[1536 + qc], cwk2 = p.conv_w[2560 + qc], cwk3 = p.conv_w[3584 + qc];
    const float cbq = p.conv_b[qc], cbk = p.conv_b[512 + qc];
    const float gnw = p.gn_w[qc];
    unsigned xqr[11], xkr[11], vvr[8];
    auto load_raw = [&](int c) {
        const int tb = c * 64 + wid * 8 - 3;
#pragma unroll
        for (int r = 0; r < 11; ++r) {
            const int t = tb + r, tc = t < 0 ? 0 : t;
            const bf16_t* pr = p.P + (size_t)(mbase + tc) * NP + C_QK + qc;
            xqr[r] = pr[0]; xkr[r] = pr[512];
        }
#pragma unroll
        for (int k = 0; k < 8; ++k) vvr[k] = p.P[(size_t)(mbase + tb + 3 + k) * NP + C_VB + qc];
    };
    auto gates = [&](int c, float mprev) {
        float* v = gv + (c & 1) * 384;
        const float g = Gg[c * 64 + lane], b = Gb[c * 64 + lane];
        const float run = fmaxf(Gl[c * 64 + lane], mprev), runL = fmaxf(Gl[c * 64 + 63], mprev), bL = Gb[c * 64 + 63];
        v[lane] = g; v[64 + lane] = run; v[128 + lane] = __expf(mprev - run); v[192 + lane] = __expf(g - runL); v[256 + lane] = b;
        if (lane == 0) { v[320] = bL + runL; v[321] = __expf(mprev - runL); }
    };
    load_raw(0);
    __syncthreads();
    if (wid == 0) gates(0, 0.f);
    __syncthreads();
    for (int c = 0; c < 32; ++c) {
        const int t0 = c * 64, mb = mbase + t0;
        const float* sg = gv + (c & 1) * 384; const float* srun = sg + 64; const float* swin = sg + 128; const float* sws = sg + 192; const float* sb = sg + 256;
        const float dec = sg[321];
        {
            float kw[8], xq[11], xk[11], vv[8];
            const bool head = (c == 0 && wid == 0);
#pragma unroll
            for (int r = 0; r < 11; ++r) {
                const bool z = head && r < 3;
                xq[r] = z ? 0.f : __uint_as_float(xqr[r] << 16); xk[r] = z ? 0.f : __uint_as_float(xkr[r] << 16);
            }
#pragma unroll
            for (int k = 0; k < 8; ++k) vv[k] = __uint_as_float(vvr[k] << 16);
#pragma unroll
            for (int k = 0; k < 8; ++k) {
                const int tt = wid * 8 + k;
                const float q = silu(cbq + xq[k] * cwq0 + xq[k + 1] * cwq1 + xq[k + 2] * cwq2 + xq[k + 3] * cwq3);
                const float kk = silu(cbk + xk[k] * cwk0 + xk[k + 1] * cwk1 + xk[k + 2] * cwk2 + xk[k + 3] * cwk3) * 0.125f;
                Qs[tt * 72 + lane] = f2bf(q);
                Ks[tt * 72 + lane] = f2bf(kk);
                kw[k] = kk * sws[tt];
            }
            uint4 o; o.x = pk2(kw[0], kw[1]); o.y = pk2(kw[2], kw[3]); o.z = pk2(kw[4], kw[5]); o.w = pk2(kw[6], kw[7]);
            *(uint4*)(KwT + lane * 72 + wid * 8) = o;
            o.x = pk2(vv[0], vv[1]); o.y = pk2(vv[2], vv[3]); o.z = pk2(vv[4], vv[5]); o.w = pk2(vv[6], vv[7]);
            *(uint4*)(VT + lane * 72 + wid * 8) = o;
        }
#pragma unroll
        for (int n = 0; n < 2; ++n) {
            uint2 o; o.x = pk2(accC[n][0], accC[n][1]); o.y = pk2(accC[n][2], accC[n][3]);
            *(uint2*)(Cb + (tr * 16 + fr) * 72 + (tc0 + n) * 16 + fq * 4) = o;
        }
        if (c + 1 < 32) load_raw(c + 1);
        lds_barrier();
        unsigned obr[8], zbr[8];
#pragma unroll
        for (int k = 0; k < 8; ++k) {
            const bf16_t* pr = p.P + (size_t)(mb + wid * 8 + k) * NP;
            obr[k] = pr[C_OB + qc]; zbr[k] = pr[C_ZB + qc];
        }
#pragma unroll
        for (int n = 0; n < 2; ++n) {
            const int ut = tc0 + n;
            f32x4 a = (f32x4){0.f, 0.f, 0.f, 0.f};
            if (ut <= tr) {
#pragma unroll
                for (int ks = 0; ks < 2; ++ks) a = __builtin_amdgcn_mfma_f32_16x16x32_bf16(ldfrag(Ks, ut * 16 + fr, ks, fq), ldfrag(Qs, tr * 16 + fr, ks, fq), a, 0, 0, 0);
            }
            const int t = tr * 16 + fr;
            const float rn = srun[t];
            float w[4];
#pragma unroll
            for (int r = 0; r < 4; ++r) {
                const int u = ut * 16 + fq * 4 + r;
                w[r] = (u <= t) ? a[r] * __expf(sg[u] - rn) : 0.f;
            }
            uint2 o; o.x = pk2(w[0], w[1]); o.y = pk2(w[2], w[3]);
            *(uint2*)(Ps + t * 72 + ut * 16 + fq * 4) = o;
        }
        lds_barrier();
        {
            const int t = tid >> 3, seg = tid & 7;
            const uint4 pv = *(const uint4*)(Ps + t * 72 + seg * 8);
            const uint4 qv = *(const uint4*)(Qs + t * 72 + seg * 8);
            const float4 pa = unpk4(make_uint2(pv.x, pv.y)), pb = unpk4(make_uint2(pv.z, pv.w));
            const float4 qa = unpk4(make_uint2(qv.x, qv.y)), qb = unpk4(make_uint2(qv.z, qv.w));
            const float4 na = *(const float4*)(sn + seg * 8), nb4 = *(const float4*)(sn + seg * 8 + 4);
            float rs = (pa.x + pa.y) + (pa.z + pa.w) + (pb.x + pb.y) + (pb.z + pb.w);
            float qn = qa.x * na.x + qa.y * na.y + qa.z * na.z + qa.w * na.w + qb.x * nb4.x + qb.y * nb4.y + qb.z * nb4.z + qb.w * nb4.w;
            rs = sum8(rs); qn = sum8(qn);
            if (seg == 0) sden[t] = fmaxf(fabsf(rs + swin[t] * qn), __expf(-(sb[t] + srun[t])));
        }
        f32x4 num[2], itr[2];
#pragma unroll
        for (int n = 0; n < 2; ++n) {
            const int it = tc0 + n;
            num[n] = (f32x4){0.f, 0.f, 0.f, 0.f}; itr[n] = num[n];
#pragma unroll
            for (int ks = 0; ks < 2; ++ks) {
                num[n] = __builtin_amdgcn_mfma_f32_16x16x32_bf16(ldfrag(VT, it * 16 + fr, ks, fq), ldfrag(Ps, tr * 16 + fr, ks, fq), num[n], 0, 0, 0);
                itr[n] = __builtin_amdgcn_mfma_f32_16x16x32_bf16(ldfrag(Cb, it * 16 + fr, ks, fq), ldfrag(Qs, tr * 16 + fr, ks, fq), itr[n], 0, 0, 0);
            }
        }
        lds_barrier();
        {
            const int t = tr * 16 + fr;
            const float rd = 1.f / sden[t], wn = swin[t];
#pragma unroll
            for (int n = 0; n < 2; ++n) {
                float4 o;
                o.x = (num[n][0] + wn * itr[n][0]) * rd; o.y = (num[n][1] + wn * itr[n][1]) * rd;
                o.z = (num[n][2] + wn * itr[n][2]) * rd; o.w = (num[n][3] + wn * itr[n][3]) * rd;
                *(float4*)(hs + t * 68 + (tc0 + n) * 16 + fq * 4) = o;
            }
        }
#pragma unroll
        for (int n = 0; n < 2; ++n) {
            accC[n][0] *= dec; accC[n][1] *= dec; accC[n][2] *= dec; accC[n][3] *= dec;
#pragma unroll
            for (int ks = 0; ks < 2; ++ks)
                accC[n] = __builtin_amdgcn_mfma_f32_16x16x32_bf16(ldfrag(KwT, (tc0 + n) * 16 + fr, ks, fq), ldfrag(VT, tr * 16 + fr, ks, fq), accC[n], 0, 0, 0);
        }
        {
            const int j = tid >> 3, seg = tid & 7;
            const uint4 kv = *(const uint4*)(KwT + j * 72 + seg * 8);
            const float4 ka = unpk4(make_uint2(kv.x, kv.y)), kb = unpk4(make_uint2(kv.z, kv.w));
            float sum = (ka.x + ka.y) + (ka.z + ka.w) + (kb.x + kb.y) + (kb.z + kb.w);
            sum = sum8(sum);
            if (seg == 0) sn[j] = dec * sn[j] + sum;
        }
        if (wid == 0 && c + 1 < 32) gates(c + 1, sg[320]);
        lds_barrier();
#pragma unroll
        for (int k = 0; k < 8; ++k) {
            const int tt = wid * 8 + k;
            const float hv = hs[tt * 68 + lane];
            const float ms = wave_sum_fast(hv * hv) * (1.f / 64.f);
            const float hn = hv * rsqrtf(ms + 1e-6f) * gnw;
            p.OutB[(size_t)(mb + tt) * 512 + qc] = f2bf(sigm(__uint_as_float(obr[k] << 16)) * hn * silu(__uint_as_float(zbr[k] << 16)));
        }
    }
    {
        float* oC = p.out + O_PC + (size_t)(s * 8 + h) * 4096;
#pragma unroll
        for (int n = 0; n < 2; ++n) {
            float4 o; o.x = accC[n][0]; o.y = accC[n][1]; o.z = accC[n][2]; o.w = accC[n][3];
            *(float4*)(oC + (tr * 16 + fr) * 64 + (tc0 + n) * 16 + fq * 4) = o;
        }
        if (tid < 64) p.out[O_PN + (size_t)(s * 8 + h) * 64 + tid] = sn[tid];
        if (tid == 0) p.out[O_PM + s * 8 + h] = gv[384 + 320];
    }
    __syncthreads();
}

__device__ __forceinline__ void wave_lds_fence() { __builtin_amdgcn_fence(__ATOMIC_RELEASE, "wavefront"); __builtin_amdgcn_wave_barrier(); __builtin_amdgcn_fence(__ATOMIC_ACQUIRE, "wavefront"); }
__device__ void rwkv_sample_wave(const Params& p, int sb, int h, float* wsm) {
    const int lane = otid() & 63;
    const int hj = h * 64 + lane;
    const int m0 = M_P + sb * 8;
    {
        float rr[8], kr[8], vr[8], ar[8], dd[8];
#pragma unroll
        for (int t = 0; t < 8; ++t) {
            const bf16_t* pr = p.P + (size_t)(m0 + t) * NP;
            rr[t] = bf2f(pr[C_R + hj]); kr[t] = bf2f(pr[C_K + hj]); vr[t] = bf2f(pr[C_V + hj]);
            ar[t] = bf2f(p.Aa[(size_t)(m0 + t) * 512 + hj]); dd[t] = 1.f - bf2f(p.Omd[(size_t)(m0 + t) * 512 + hj]);
        }
        const float* st = p.st_shift + (size_t)sb * SHIFT_W;
        float rp = st[C_R + hj], kp_ = st[C_K + hj], vp = st[C_V + hj];
        const float mu_r = p.mu_shift[C_R + hj], mu_k = p.mu_shift[C_K + hj], mu_v = p.mu_shift[C_V + hj];
        const float kkw = p.k_k[hj], kaw = p.k_a[hj];
#pragma unroll
        for (int t = 0; t < 8; ++t) {
            const float r = rr[t] + mu_r * (rp - rr[t]), k = kr[t] + mu_k * (kp_ - kr[t]), v = vr[t] + mu_v * (vp - vr[t]);
            rp = rr[t]; kp_ = kr[t]; vp = vr[t];
            const float a = ar[t], d = dd[t];
            float kk = k * kkw;
            const float nrm = sqrtf(wave_sum_fast(kk * kk));
            kk = kk / fmaxf(nrm, 1e-12f);
            const float ka = kk * a, kp = k * (1.f + (a - 1.f) * kaw);
            const float c1 = wave_sum_fast(ka * r), c2 = wave_sum_fast(kp * r);
            float* w = wsm + t * 400;
            w[lane] = kk; w[64 + lane] = d; w[128 + lane] = ka; w[192 + lane] = kp; w[256 + lane] = d * r; w[320 + lane] = v;
            if (lane == 0) { w[384] = c1; w[385] = c2; }
        }
    }
    float S[64];
    {
        const float* srow = p.st_S + ((size_t)(sb * 8 + h) * 64 + lane) * 64;
#pragma unroll
        for (int q = 0; q < 16; ++q) { const float4 v = *(const float4*)(srow + q * 4); S[4 * q] = v.x; S[4 * q + 1] = v.y; S[4 * q + 2] = v.z; S[4 * q + 3] = v.w; }
    }
    wave_lds_fence();
#pragma unroll 1
    for (int t = 0; t < 8; ++t) {
        const float* w = wsm + t * 400;
        float p1 = 0.f, p2 = 0.f;
#pragma unroll
        for (int q = 0; q < 16; ++q) {
            const float4 k4 = *(const float4*)(w + q * 4), r4 = *(const float4*)(w + 256 + q * 4);
            p1 += S[4 * q] * k4.x + S[4 * q + 1] * k4.y + S[4 * q + 2] * k4.z + S[4 * q + 3] * k4.w;
            p2 += S[4 * q] * r4.x + S[4 * q + 1] * r4.y + S[4 * q + 2] * r4.z + S[4 * q + 3] * r4.w;
        }
        const float vi = w[320 + lane];
        const float y = p2 - p1 * w[384] + vi * w[385];
#pragma unroll
        for (int q = 0; q < 16; ++q) {
            const float4 d4 = *(const float4*)(w + 64 + q * 4), a4 = *(const float4*)(w + 128 + q * 4), k4 = *(const float4*)(w + 192 + q * 4);
            S[4 * q] = S[4 * q] * d4.x + vi * k4.x - p1 * a4.x;
            S[4 * q + 1] = S[4 * q + 1] * d4.y + vi * k4.y - p1 * a4.y;
            S[4 * q + 2] = S[4 * q + 2] * d4.z + vi * k4.z - p1 * a4.z;
            S[4 * q + 3] = S[4 * q + 3] * d4.w + vi * k4.w - p1 * a4.w;
        }
        p.Yraw[(size_t)(m0 + t) * 512 + hj] = f2bf(y);
    }
    {
        float* o = p.out + O_SS + ((size_t)(sb * 8 + h) * 64 + lane) * 64;
#pragma unroll
        for (int q = 0; q < 16; ++q) { float4 v; v.x = S[4 * q]; v.y = S[4 * q + 1]; v.z = S[4 * q + 2]; v.w = S[4 * q + 3]; *(float4*)(o + q * 4) = v; }
    }
    wave_lds_fence();
}

__device__ void mlstm_sample_wave(const Params& p, int sb, int h, float* wsm) {
    const int lane = otid() & 63;
    const int qc = h * 64 + lane;
    const int m0 = M_P + sb * 8;
    float gi = 0.f, gl = 0.f;
    {
        float xq[11], xk[11];
#pragma unroll
        for (int r = 0; r < 3; ++r) { const float* st = p.st_conv + ((size_t)sb * 3 + r) * 1024 + qc; xq[r] = st[0]; xk[r] = st[512]; }
#pragma unroll
        for (int t = 0; t < 8; ++t) { const bf16_t* pr = p.P + (size_t)(m0 + t) * NP + C_QK + qc; xq[3 + t] = bf2f(pr[0]); xk[3 + t] = bf2f(pr[512]); }
#pragma unroll
        for (int t = 0; t < 8; ++t) {
            const bf16_t* pr = p.P + (size_t)(m0 + t) * NP;
            wsm[1024 + t * 64 + lane] = bf2f(pr[C_VB + qc]); wsm[1536 + t * 64 + lane] = bf2f(pr[C_OB + qc]); wsm[2048 + t * 64 + lane] = bf2f(pr[C_ZB + qc]);
        }
        if (lane < 8) {
            const bf16_t* pr = p.P + (size_t)(m0 + lane) * NP;
            gi = bf2f(pr[C_IB + h]) + p.b_i[h];
            const float f = bf2f(pr[C_FB + h]) + p.b_f[h];
            gl = f > 0.f ? -log1pf(__expf(-f)) : f - log1pf(__expf(f));
        }
        const float cwq0 = p.conv_w[qc], cwq1 = p.conv_w[1024 + qc], cwq2 = p.conv_w[2048 + qc], cwq3 = p.conv_w[3072 + qc];
        const float cwk0 = p.conv_w[512 + qc], cwk1 = p.conv_w[1536 + qc], cwk2 = p.conv_w[2560 + qc], cwk3 = p.conv_w[3584 + qc];
        const float cbq = p.conv_b[qc], cbk = p.conv_b[512 + qc];
#pragma unroll
        for (int t = 0; t < 8; ++t) {
            wsm[t * 64 + lane] = silu(cbq + xq[t] * cwq0 + xq[t + 1] * cwq1 + xq[t + 2] * cwq2 + xq[t + 3] * cwq3);
            wsm[512 + t * 64 + lane] = silu(cbk + xk[t] * cwk0 + xk[t + 1] * cwk1 + xk[t + 2] * cwk2 + xk[t + 3] * cwk3) * 0.125f;
        }
    }
    const float gnw = p.gn_w[qc];
    float C[64];
    {
        const float* crow = p.st_C + ((size_t)(sb * 8 + h) * 64 + lane) * 64;
#pragma unroll
        for (int q = 0; q < 16; ++q) { const float4 v = *(const float4*)(crow + q * 4); C[4 * q] = v.x; C[4 * q + 1] = v.y; C[4 * q + 2] = v.z; C[4 * q + 3] = v.w; }
    }
    float nl = p.st_n[(size_t)(sb * 8 + h) * 64 + lane];
    float m = p.st_m[sb * 8 + h];
    wave_lds_fence();
#pragma unroll 1
    for (int t = 0; t < 8; ++t) {
        const float it = rdlane(gi, t), lf = rdlane(gl, t);
        const float mt = fmaxf(lf + m, it);
        const float fdec = __expf(lf + m - mt), iw = __expf(it - mt);
        m = mt;
        const float ql = wsm[t * 64 + lane], kl = wsm[512 + t * 64 + lane];
        nl = fdec * nl + iw * kl;
        const float den = wave_sum_fast(nl * ql);
        const float ai = iw * wsm[1024 + t * 64 + lane];
        float num = 0.f;
#pragma unroll
        for (int q = 0; q < 16; ++q) {
            const float4 k4 = *(const float4*)(wsm + 512 + t * 64 + q * 4), q4 = *(const float4*)(wsm + t * 64 + q * 4);
            C[4 * q] = fdec * C[4 * q] + ai * k4.x; C[4 * q + 1] = fdec * C[4 * q + 1] + ai * k4.y;
            C[4 * q + 2] = fdec * C[4 * q + 2] + ai * k4.z; C[4 * q + 3] = fdec * C[4 * q + 3] + ai * k4.w;
            num += C[4 * q] * q4.x + C[4 * q + 1] * q4.y + C[4 * q + 2] * q4.z + C[4 * q + 3] * q4.w;
        }
        const float hv = num / fmaxf(fabsf(den), __expf(-mt));
        const float ms = wave_sum_fast(hv * hv) * (1.f / 64.f);
        p.OutB[(size_t)(m0 + t) * 512 + qc] = f2bf(sigm(wsm[1536 + t * 64 + lane]) * hv * rsqrtf(ms + 1e-6f) * gnw * silu(wsm[2048 + t * 64 + lane]));
    }
    {
        float* o = p.out + O_SC + ((size_t)(sb * 8 + h) * 64 + lane) * 64;
#pragma unroll
        for (int q = 0; q < 16; ++q) { float4 v; v.x = C[4 * q]; v.y = C[4 * q + 1]; v.z = C[4 * q + 2]; v.w = C[4 * q + 3]; *(float4*)(o + q * 4) = v; }
        p.out[O_SN + (size_t)(sb * 8 + h) * 64 + lane] = nl;
        if (lane == 0) p.out[O_SM + sb * 8 + h] = m;
    }
    wave_lds_fence();
}

__device__ void phaseE(const Params& p, float* sm, int bid, int nb) {
    constexpr int N_RP = 192, N_MP = 64, N_RS = 128, N_MS = 128;
    int* s_item = (int*)(sm + 32768);
    for (;;) {
        if (otid() == 0) *s_item = (int)atomicAdd(p.ctr, 1u);
        __syncthreads();
        const int it = *s_item;
        __syncthreads();
        if (it >= N_RP + N_MP + N_RS + N_MS) break;
        if (it < N_RP) { rwkv_item(p, it / 24, (it / 3) & 7, it % 3, sm); }
        else if (it < N_RP + N_MP) { const int i = it - N_RP; mlstm_prompt(p, i >> 3, i & 7, sm); }
        else if (it < N_RP + N_MP + N_RS) { const int wid = otid() >> 6; const int i = (it - N_RP - N_MP) * 8 + wid; rwkv_sample_wave(p, i >> 3, i & 7, sm + wid * 3328); }
        else if (it < N_RP + N_MP + N_RS + N_MS) { const int wid = otid() >> 6; const int i = (it - N_RP - N_MP - N_RS) * 8 + wid; mlstm_sample_wave(p, i >> 3, i & 7, sm + wid * 3328); }
    }
}

__device__ void phaseF(const Params& p, int bid, int nb) {
    const int wid = otid() >> 6, lane = otid() & 63;
    const int c8 = lane * 8;
    float lnw[8], lnb[8], mur[8], muk[8], muv[8], kaw[8], rkw[8];
#pragma unroll
    for (int i = 0; i < 8; ++i) {
        lnw[i] = p.ln_w[c8 + i]; lnb[i] = p.ln_b[c8 + i]; mur[i] = p.mu_shift[C_R + c8 + i]; muk[i] = p.mu_shift[C_K + c8 + i];
        muv[i] = p.mu_shift[C_V + c8 + i]; kaw[i] = p.k_a[c8 + i]; rkw[i] = p.r_k[c8 + i];
    }
    auto un8 = [](const uint4 u, float* o) {
        o[0] = __uint_as_float(u.x << 16); o[1] = __uint_as_float(u.x & 0xFFFF0000u); o[2] = __uint_as_float(u.y << 16); o[3] = __uint_as_float(u.y & 0xFFFF0000u);
        o[4] = __uint_as_float(u.z << 16); o[5] = __uint_as_float(u.z & 0xFFFF0000u); o[6] = __uint_as_float(u.w << 16); o[7] = __uint_as_float(u.w & 0xFFFF0000u);
    };
    struct FR { uint4 uy, ur, uk, uv, uz, ua, urp, ukp, uvp; };
    auto loadF = [&](int m, FR& q) {
        int s, t; tok_info(m, s, t);
        const bf16_t* pr = p.P + (size_t)m * NP + c8;
        const bf16_t* pp = t > 0 ? pr - NP : pr;
        q.uy = *(const uint4*)(p.Yraw + (size_t)m * 512 + c8);
        q.ur = *(const uint4*)(pr + C_R); q.uk = *(const uint4*)(pr + C_K); q.uv = *(const uint4*)(pr + C_V); q.uz = *(const uint4*)(pr + C_ZA);
        q.ua = *(const uint4*)(p.Aa + (size_t)m * 512 + c8);
        q.urp = *(const uint4*)(pp + C_R); q.ukp = *(const uint4*)(pp + C_K); q.uvp = *(const uint4*)(pp + C_V);
    };
    auto computeF = [&](int m, const FR& q) {
        int s, t; tok_info(m, s, t);
        float y[8], r[8], k[8], v[8], z[8], a[8], rp[8], kp_[8], vp[8];
        if (t > 0) { un8(q.urp, rp); un8(q.ukp, kp_); un8(q.uvp, vp); }
        else if (s >= 8) {
            const float* st = p.st_shift + (size_t)(s - 8) * SHIFT_W + c8;
#pragma unroll
            for (int i = 0; i < 8; ++i) { rp[i] = st[C_R + i]; kp_[i] = st[C_K + i]; vp[i] = st[C_V + i]; }
        } else {
#pragma unroll
            for (int i = 0; i < 8; ++i) { rp[i] = 0.f; kp_[i] = 0.f; vp[i] = 0.f; }
        }
        un8(q.uy, y); un8(q.ur, r); un8(q.uk, k); un8(q.uv, v); un8(q.uz, z); un8(q.ua, a);
        float sy = 0.f;
#pragma unroll
        for (int i = 0; i < 8; ++i) sy += y[i];
        const float mean = sum8(sy) * (1.f / 64.f);
        float sv = 0.f, sbn = 0.f;
#pragma unroll
        for (int i = 0; i < 8; ++i) {
            y[i] -= mean; sv += y[i] * y[i];
            r[i] += mur[i] * (rp[i] - r[i]); k[i] += muk[i] * (kp_[i] - k[i]); v[i] += muv[i] * (vp[i] - v[i]);
            sbn += r[i] * (k[i] * (1.f + (a[i] - 1.f) * kaw[i])) * rkw[i];
        }
        const float rstd = rsqrtf(sum8(sv) * (1.f / 64.f) + 64e-5f);
        const float bonus = sum8(sbn);
        float o[8];
#pragma unroll
        for (int i = 0; i < 8; ++i) o[i] = (y[i] * rstd * lnw[i] + lnb[i] + bonus * v[i]) * silu(z[i]);
        uint4 ou; ou.x = pk2(o[0], o[1]); ou.y = pk2(o[2], o[3]); ou.z = pk2(o[4], o[5]); ou.w = pk2(o[6], o[7]);
        *(uint4*)(p.OutA + (size_t)m * 512 + c8) = ou;
    };
    const int stride = nb * 8;
    for (int m = bid * 8 + wid; m < M_TOT; m += 2 * stride) {
        const int m2 = m + stride; const bool has2 = m2 < M_TOT;
        FR qa, qb;
        loadF(m, qa); loadF(has2 ? m2 : m, qb);
        computeF(m, qa);
        if (has2) computeF(m2, qb);
    }
}

__device__ __forceinline__ void yrow_store(const Params& p, float* yr, int lane, const float4 (&v)[4], float rstd) {
#pragma unroll
    for (int i = 0; i < 4; ++i) {
        const int c = i * 256 + lane * 4;
        const float4 g = *(const float4*)(p.g_final + c);
        float4 o; o.x = v[i].x * rstd * g.x; o.y = v[i].y * rstd * g.y; o.z = v[i].z * rstd * g.z; o.w = v[i].w * rstd * g.w;
        *(float4*)(yr + c) = o;
    }
}
__device__ void phaseI(const Params& p, int bid, int nb) {
    const int wid = otid() >> 6, lane = otid() & 63;
    const int stride = nb * 8;
    for (int m = bid * 8 + wid; m < M_TOT; m += 2 * stride) {
        const int m2 = m + stride;
        const bool has2 = m2 < M_TOT;
        float* ya = p.out + (size_t)m * 1024;
        float* yb = p.out + (size_t)(has2 ? m2 : m) * 1024;
        float4 va[4], vb[4];
        normrow_load(ya, lane, va);
        normrow_load(yb, lane, vb);
        const float ra = rsqrtf(wave_sum(sumsq4(va)) * (1.f / 1024.f) + 1e-6f);
        const float rb = rsqrtf(wave_sum(sumsq4(vb)) * (1.f / 1024.f) + 1e-6f);
        yrow_store(p, ya, lane, va, ra);
        if (has2) yrow_store(p, yb, lane, vb, rb);
    }
}

namespace pg8 {
#define PG8_LAS __attribute__((address_space(3)))
typedef unsigned short bf16_t;
typedef short bf16x8 __attribute__((ext_vector_type(8)));
typedef float f32x4 __attribute__((ext_vector_type(4)));
typedef unsigned u32x4 __attribute__((ext_vector_type(4)));
constexpr int BM = 256, BK = 64, HALF = 128, HTB = HALF * BK * 2  , STAGE_BYTES = 8 * HTB, NXCD = 8, WGM = 8;

__host__ __device__ __forceinline__ int lds_byte(int r, int c) { const int st = (r >> 4) * 2 + (c >> 5), rr = r & 15, cc = c & 31, ob = rr * 64 + cc * 2; return st * 1024 + (ob ^ (((ob >> 9) & 1) << 5)); }
__host__ __device__ __forceinline__ void stage_rc(int b, int& R, int& C) { const int st = b / 1024, sb = b % 1024, swz = sb ^ (((sb >> 9) & 1) << 5); R = (st >> 1) * 16 + swz / 64; C = (st & 1) * 32 + (swz % 64) / 2; }
__host__ __device__ __forceinline__ int perm32(int rho) { const int n = rho >> 4, i = rho & 15; return 8 * (i >> 2) + 4 * n + (i & 3); }

struct Unit { int pm, pn; };
struct Gemm { const bf16_t* A; const bf16_t* Bt; int M, N, K, lda, ldb; };

struct StaticOrder {
    int nM, nN, nwg, G, c;
    __host__ __device__ void init(int M, int N, int G_, int c_) { nM = M / BM; nN = N / BM; nwg = nM * nN; G = G_; c = c_; }
    __host__ __device__ bool next(int i, Unit& u) const {
        const long L = (long)i * G + c; if (L >= nwg) return false;
        int wgid = (int)L; { const int q = nwg / NXCD, r = nwg % NXCD, xcd = wgid % NXCD, off = wgid / NXCD; wgid = (xcd < r ? xcd * (q + 1) : r * (q + 1) + (xcd - r) * q) + off; }
        const int nig = WGM * nN, gid = wgid / nig, fm = gid * WGM, gsz = (nM - fm) < WGM ? (nM - fm) : WGM;
        u.pm = fm + ((wgid % nig) % gsz); u.pn = (wgid % nig) / gsz; return true;
    }
    __device__ __forceinline__ void a_ready(const Unit&) const {}
    __device__ __forceinline__ void done(const Unit&) const {}
};
template <class Epi, class Sched, bool STAMP = false>
__device__ __forceinline__ void gemm_phase(PG8_LAS unsigned char* lds, const Gemm g, const Sched& S, const Epi& E, unsigned long long* stamps) {
    const int tid = otid(), wid = __builtin_amdgcn_readfirstlane(tid >> 6), lane = tid & 63, wr = wid >> 2, wc = wid & 3, fr = lane & 15, fq = lane >> 4;
    const int K = g.K, nt = K / BK;
    int ts_lo = 0, ts_hi = 0, nts = 0; const unsigned long long rt_entry = STAMP ? (unsigned long long)wall_clock64() : 0ull;
#define PG8_STAMP() do { if (STAMP && wid == 0 && nts < 64) { const unsigned long long _c = (unsigned long long)clock64(); \
        ts_lo = (lane == nts) ? (int)(unsigned)_c : ts_lo; ts_hi = (lane == nts) ? (int)(unsigned)(_c >> 32) : ts_hi; ++nts; } } while (0)
    PG8_STAMP();
    unsigned voffA[2], voffB[2];
#pragma unroll
    for (int i = 0; i < 2; ++i) { int R, C; stage_rc(tid * 16 + i * 8192, R, C); const int Rb = Epi::PERM ? ((R & ~31) + perm32(R & 31)) : R;
        voffA[i] = (unsigned)(R * g.lda + C) * 2u; voffB[i] = (unsigned)(Rb * g.ldb + C) * 2u; }
    const size_t kstep = (size_t)(BK * 2);
    const size_t hstepA = (size_t)HALF * g.lda * 2, hstepB = (size_t)HALF * g.ldb * 2;
    const size_t tstepA = 2 * hstepA, tstepB = 2 * hstepB;
    const unsigned ldsw = (unsigned)wid * 1024u;
    const int aoff = lds_byte(wr * 64 + fr, fq * 8), boff = lds_byte(wc * 32 + fr, fq * 8);
#define PG8_SA(b, h) (((b) * 2 + (h)) * HTB)
#define PG8_SB(b, h) ((4 + (b) * 2 + (h)) * HTB)
#define PG8_STAGE(bufoff, gbase, voff) do { _Pragma("unroll") for (int _i = 0; _i < 2; ++_i) \
        __builtin_amdgcn_global_load_lds((const unsigned*)((const char*)(gbase) + (voff)[_i]), (PG8_LAS unsigned*)(lds + (bufoff) + ldsw + _i * 8192), 16, 0, 0); } while (0)
#define PG8_LDA(dst, b, h) do { _Pragma("unroll") for (int m = 0; m < 4; ++m) _Pragma("unroll") for (int k = 0; k < 2; ++k) dst[m][k] = *(const PG8_LAS bf16x8*)(lds + PG8_SA(b, h) + aoff + m * 2048 + k * 1024); } while (0)
#define PG8_LDB(dst, b, h) do { _Pragma("unroll") for (int n = 0; n < 2; ++n) _Pragma("unroll") for (int k = 0; k < 2; ++k) dst[n][k] = *(const PG8_LAS bf16x8*)(lds + PG8_SB(b, h) + boff + n * 2048 + k * 1024); } while (0)
#define PG8_MMA(ai, bj, At, Bt) do { __builtin_amdgcn_s_setprio(1); _Pragma("unroll") for (int m = 0; m < 4; ++m) _Pragma("unroll") for (int n = 0; n < 2; ++n) _Pragma("unroll") for (int k = 0; k < 2; ++k) \
        acc[ai][bj][m][n] = __builtin_amdgcn_mfma_f32_16x16x32_bf16(Bt[n][k], At[m][k], acc[ai][bj][m][n], 0, 0, 0); __builtin_amdgcn_s_setprio(0); } while (0)
#define PG8_WAIT_V(n) asm volatile("s_waitcnt vmcnt(" #n ")" ::: "memory")
#define PG8_WAIT_L(n) asm volatile("s_waitcnt lgkmcnt(" #n ")" ::: "memory")
#define PG8_BAR __builtin_amdgcn_s_barrier()
#define PG8_SCHED __builtin_amdgcn_sched_barrier(0)
    Unit cur, nxt; int ui = 0;
    if (!S.next(0, cur)) return;
    f32x4 acc[2][2][4][2];
#pragma unroll
    for (int a = 0; a < 2; ++a)
#pragma unroll
        for (int b = 0; b < 2; ++b)
#pragma unroll
            for (int m = 0; m < 4; ++m)
#pragma unroll
                for (int n = 0; n < 2; ++n) acc[a][b][m][n] = (f32x4){0.f, 0.f, 0.f, 0.f};
    bf16x8 At[4][2], B0[2][2], B1[2][2];
    const char* cA = (const char*)g.A + (size_t)cur.pm * tstepA; const char* cB = (const char*)g.Bt + (size_t)cur.pn * tstepB;
    S.a_ready(cur);
    PG8_STAGE(PG8_SB(0, 0), cB, voffB); PG8_STAGE(PG8_SA(0, 0), cA, voffA); PG8_STAGE(PG8_SB(0, 1), cB + hstepB, voffB); PG8_STAGE(PG8_SA(0, 1), cA + hstepA, voffA);
    if (wr == 1) PG8_BAR;
    PG8_WAIT_V(4); PG8_BAR;
    PG8_STAGE(PG8_SB(1, 0), cB + kstep, voffB); PG8_STAGE(PG8_SA(1, 0), cA + kstep, voffA); PG8_STAGE(PG8_SB(1, 1), cB + hstepB + kstep, voffB);
    PG8_WAIT_V(6); PG8_BAR;
    PG8_STAMP();
    for (;;) {
        const bool has_next = S.next(ui + 1, nxt);
        const char* nA = has_next ? (const char*)g.A + (size_t)nxt.pm * tstepA : cA; const char* nB = has_next ? (const char*)g.Bt + (size_t)nxt.pn * tstepB : cB;
        for (int t = 0; t < nt; t += 2) {
            const bool last = (t == nt - 2);
            const char* a1 = cA + (size_t)(t + 1) * kstep;
            const char* a2 = last ? nA : cA + (size_t)(t + 2) * kstep; const char* b2 = last ? nB : cB + (size_t)(t + 2) * kstep;
            const char* a3 = a2 + kstep; const char* b3 = b2 + kstep;
            if (last && has_next) S.a_ready(nxt);
            PG8_LDB(B0, 0, 0); PG8_SCHED; PG8_LDA(At, 0, 0); PG8_STAGE(PG8_SA(1, 1), a1 + hstepA, voffA);
            PG8_WAIT_L(8); PG8_BAR; PG8_WAIT_L(0); PG8_MMA(0, 0, At, B0); PG8_BAR; PG8_SCHED;
            PG8_LDB(B1, 0, 1); PG8_STAGE(PG8_SB(0, 0), b2, voffB);
            PG8_BAR; PG8_WAIT_L(0); PG8_MMA(0, 1, At, B1); PG8_BAR;
            PG8_LDA(At, 0, 1); PG8_STAGE(PG8_SA(0, 0), a2, voffA);
            PG8_BAR; PG8_WAIT_L(0); PG8_MMA(1, 0, At, B0); PG8_BAR; PG8_SCHED;
            PG8_STAGE(PG8_SB(0, 1), b2 + hstepB, voffB);
            PG8_WAIT_V(6); PG8_BAR; PG8_MMA(1, 1, At, B1); PG8_BAR;
            PG8_LDB(B0, 1, 0); PG8_SCHED; PG8_LDA(At, 1, 0); PG8_STAGE(PG8_SA(0, 1), a2 + hstepA, voffA);
            PG8_WAIT_L(8); PG8_BAR; PG8_WAIT_L(0); PG8_MMA(0, 0, At, B0); PG8_BAR; PG8_SCHED;
            PG8_LDB(B1, 1, 1); PG8_STAGE(PG8_SB(1, 0), b3, voffB);
            PG8_BAR; PG8_WAIT_L(0); PG8_MMA(0, 1, At, B1); PG8_BAR;
            PG8_LDA(At, 1, 1); PG8_STAGE(PG8_SA(1, 0), a3, voffA);
            PG8_BAR; PG8_WAIT_L(0); PG8_MMA(1, 0, At, B0); PG8_BAR; PG8_SCHED;
            PG8_STAGE(PG8_SB(1, 1), b3 + hstepB, voffB);
            PG8_WAIT_V(6); PG8_BAR; PG8_MMA(1, 1, At, B1); PG8_BAR;
        }
        PG8_STAMP();
        if constexpr (!Epi::AFTER_DRAIN) { E(acc, cur, wr, wc, fr, fq); S.done(cur); }
        PG8_STAMP();
        if (!has_next) break;
#pragma unroll
        for (int a = 0; a < 2; ++a)
#pragma unroll
            for (int b = 0; b < 2; ++b)
#pragma unroll
                for (int m = 0; m < 4; ++m)
#pragma unroll
                    for (int n = 0; n < 2; ++n) acc[a][b][m][n] = (f32x4){0.f, 0.f, 0.f, 0.f};
        cur = nxt; cA = nA; cB = nB; ++ui;
    }
    PG8_WAIT_V(0);
    if (wr == 0) PG8_BAR;
    PG8_BAR;
    if constexpr (Epi::AFTER_DRAIN) { E.fused(acc, cur, wr, wc, fr, fq, lds, wid, lane); S.done(cur); }
    PG8_STAMP();
    if (STAMP && wid == 0) { stamps[lane] = lane < nts ? (((unsigned long long)(unsigned)ts_hi << 32) | (unsigned)ts_lo) : 0ull;
        if (lane == 62) stamps[62] = rt_entry; if (lane == 63) stamps[63] = (unsigned long long)wall_clock64(); }
#undef PG8_STAMP
#undef PG8_SA
#undef PG8_SB
#undef PG8_STAGE
#undef PG8_LDA
#undef PG8_LDB
#undef PG8_MMA
#undef PG8_WAIT_V
#undef PG8_WAIT_L
#undef PG8_BAR
#undef PG8_SCHED
}
}

struct EpiP {
    static constexpr bool PERM = true, AFTER_DRAIN = false;
    bf16_t* O; int ldc;
    __device__ __forceinline__ void operator()(const f32x4 (&acc)[2][2][4][2], const pg8::Unit& u, int wr, int wc, int fr, int fq) const {
        const int row0 = u.pm * 256 + wr * 64 + fr, col0 = u.pn * 256 + wc * 32 + 8 * fq;
#pragma unroll
        for (int ai = 0; ai < 2; ++ai)
#pragma unroll
            for (int m = 0; m < 4; ++m) {
                bf16_t* rowp = O + (size_t)(row0 + ai * 128 + m * 16) * ldc + col0;
#pragma unroll
                for (int bj = 0; bj < 2; ++bj) {
                    const f32x4 v0 = acc[ai][bj][m][0], v1 = acc[ai][bj][m][1];
                    uint4 o; o.x = pk2(v0[0], v0[1]); o.y = pk2(v0[2], v0[3]); o.z = pk2(v1[0], v1[1]); o.w = pk2(v1[2], v1[3]);
                    *(uint4*)(rowp + bj * 128) = o;
                }
            }
    }
};
template <int SECOND> struct EpiMerge {
    static constexpr bool PERM = true, AFTER_DRAIN = false;
    bf16_t* P; int gcol;
    __device__ __forceinline__ void operator()(const f32x4 (&acc)[2][2][4][2], const pg8::Unit& u, int wr, int wc, int fr, int fq) const {
        const int row0 = u.pm * 256 + wr * 64 + fr, col0 = u.pn * 256 + wc * 32 + 8 * fq;
#pragma unroll
        for (int ai = 0; ai < 2; ++ai)
#pragma unroll
            for (int m = 0; m < 4; ++m) {
                bf16_t* rowp = P + (size_t)(row0 + ai * 128 + m * 16) * NP + col0;
#pragma unroll
                for (int bj = 0; bj < 2; ++bj) {
                    const f32x4 v0 = acc[ai][bj][m][0], v1 = acc[ai][bj][m][1];
                    const uint4 g = *(const uint4*)(rowp + gcol + bj * 128);
                    const float4 ga = unpk4(make_uint2(g.x, g.y)), gb = unpk4(make_uint2(g.z, g.w));
                    float r[8] = {sigm(ga.x) * v0[0], sigm(ga.y) * v0[1], sigm(ga.z) * v0[2], sigm(ga.w) * v0[3],
                                  sigm(gb.x) * v1[0], sigm(gb.y) * v1[1], sigm(gb.z) * v1[2], sigm(gb.w) * v1[3]};
                    if (SECOND) {
                        const uint4 pv = *(const uint4*)(rowp + bj * 128);
                        const float4 pa = unpk4(make_uint2(pv.x, pv.y)), pb = unpk4(make_uint2(pv.z, pv.w));
                        r[0] += pa.x; r[1] += pa.y; r[2] += pa.z; r[3] += pa.w; r[4] += pb.x; r[5] += pb.y; r[6] += pb.z; r[7] += pb.w;
                    }
                    uint4 o; o.x = pk2(r[0], r[1]); o.y = pk2(r[2], r[3]); o.z = pk2(r[4], r[5]); o.w = pk2(r[6], r[7]);
                    *(uint4*)(rowp + bj * 128) = o;
                }
            }
    }
};
struct EpiOut {
    static constexpr bool PERM = false, AFTER_DRAIN = false;
    const Params* pp;
    __device__ __forceinline__ void operator()(const f32x4 (&acc)[2][2][4][2], const pg8::Unit& u, int wr, int wc, int fr, int fq) const {
        const Params& p = *pp;
        const int row0 = u.pm * 256 + wr * 64 + fr, col0 = u.pn * 256 + wc * 32 + 4 * fq;
#pragma unroll
        for (int ai = 0; ai < 2; ++ai)
#pragma unroll
            for (int m = 0; m < 4; ++m) {
                const int row = row0 + ai * 128 + m * 16;
                int s, t; tok_info(row, s, t);
                const float* xr = xrow(p, row) + col0;
                const float* gt = p.mod + (size_t)s * 3072 + 2048 + col0;
                float* orow = p.out + (size_t)row * 1024 + col0;
#pragma unroll
                for (int bj = 0; bj < 2; ++bj)
#pragma unroll
                    for (int n = 0; n < 2; ++n) {
                        const int co = bj * 128 + n * 16;
                        const float4 xv = *(const float4*)(xr + co), gv = *(const float4*)(gt + co);
                        const f32x4 a = acc[ai][bj][m][n];
                        float4 o; o.x = xv.x + gv.x * a[0]; o.y = xv.y + gv.y * a[1]; o.z = xv.z + gv.z * a[2]; o.w = xv.w + gv.w * a[3];
                        *(float4*)(orow + co) = o;
                    }
            }
    }
};
template <class Epi> __device__ __forceinline__ void run_gemm(float* sm, const bf16_t* A, int lda, const bf16_t* Bt, int ldb, int M, int N, int K, const Epi& E, int bid, int nb) {
    pg8::Gemm g; g.A = A; g.Bt = Bt; g.M = M; g.N = N; g.K = K; g.lda = lda; g.ldb = ldb;
    pg8::StaticOrder S; S.init(M, N, nb, bid);
    pg8::gemm_phase<Epi, pg8::StaticOrder, false>((PG8_LAS unsigned char*)sm, g, S, E, nullptr);
}
__device__ void phaseC(const Params& p, float* sm, int bid, int nb) {
    EpiP E; E.O = p.P; E.ldc = NP;
    run_gemm(sm, p.H, 1024, p.WinT, 1024, M_TOT, NP, 1024, E, bid, nb);
}
__device__ void phaseG(const Params& p, float* sm, int bid, int nb) {
    EpiMerge<0> E0; E0.P = p.P; E0.gcol = C_GLA;
    run_gemm(sm, p.OutA, 512, p.WupaT, 512, M_TOT, 1024, 512, E0, bid, nb);
    __syncthreads();
    EpiMerge<1> E1; E1.P = p.P; E1.gcol = C_GLB;
    run_gemm(sm, p.OutB, 512, p.WupbT, 512, M_TOT, 1024, 512, E1, bid, nb);
}
__device__ void phaseH(const Params& p, float* sm, int bid, int nb) {
    EpiOut E; E.pp = &p;
    run_gemm(sm, p.P, NP, p.WoutT, 1024, M_TOT, 1024, 1024, E, bid, nb);
}

#define XB_TMO      128
#define XB_XCNT(j)  (256  + 64 * (j))
#define XB_XSUB(j)  (1280 + 64 * (j))
#define XB_XGEN(j)  (2304 + 64 * (j))
#define XB_TOP      3328
#define XB_TOPGEN   3392
#define XCD_BAR_WORDS 3456
#define XB_SPIN_CAP (1u << 18)
#define LAS __attribute__((address_space(3)))

__device__ __forceinline__ unsigned xb_ld(unsigned* p)              { return __hip_atomic_load(p, __ATOMIC_RELAXED, __HIP_MEMORY_SCOPE_AGENT); }
__device__ __forceinline__ unsigned xb_add(unsigned* p, unsigned v) { return __hip_atomic_fetch_add(p, v, __ATOMIC_RELAXED, __HIP_MEMORY_SCOPE_AGENT); }
__device__ __forceinline__ unsigned xb_xcc_id() { return (unsigned)__builtin_amdgcn_s_getreg((3 << 11) | 20) & 0xFu; }
#define XB_SPIN(cond, bar) do { unsigned _sp = 0; while (cond) { __builtin_amdgcn_s_sleep(1); \
    if ((++_sp & 255u) == 0u) { if (xb_ld(&(bar)[XB_TMO])) break; if (_sp > XB_SPIN_CAP) { atomicAdd(&(bar)[XB_TMO], 1u); break; } } } } while (0)

struct XcdBarrier {
    unsigned* bar; unsigned x;
    volatile LAS unsigned* st;
};

__device__ __forceinline__ XcdBarrier xcd_barrier_post(unsigned* bar, volatile LAS unsigned* st) {
    XcdBarrier b; b.bar = bar; b.x = xb_xcc_id(); b.st = st;
    if (threadIdx.x == 0) (void)xb_add(&bar[XB_XCNT(b.x)], 1u);
    return b;
}
__device__ __forceinline__ void xcd_barrier_complete(unsigned* bar, unsigned x, unsigned& nloc, unsigned& nx) {
    const unsigned G = gridDim.x * gridDim.y * gridDim.z;
    unsigned sum, cnt, mine, sp = 0u;
    for (;;) {
        sum = 0u; cnt = 0u; mine = 0u;
#pragma unroll
        for (unsigned j = 0; j < 16; ++j) { const unsigned c = xb_ld(&bar[XB_XCNT(j)]); sum += c; cnt += (c > 0u) ? 1u : 0u; mine = (j == x) ? c : mine; }
        if (sum == G) break;
        __builtin_amdgcn_s_sleep(1);
        if ((++sp & 255u) == 0u) { if (xb_ld(&bar[XB_TMO])) break; if (sp > XB_SPIN_CAP) { atomicAdd(&bar[XB_TMO], 1u); break; } }
    }
    nloc = mine > 0u ? mine : 1u; nx = cnt > 0u ? cnt : 1u;
}

__device__ __forceinline__ void xcd_barrier(const XcdBarrier& b) {
    asm volatile("s_waitcnt vmcnt(0)" ::: "memory");
    __syncthreads();
    if (threadIdx.x == 0) {
        unsigned* bar = b.bar;
        __builtin_amdgcn_s_waitcnt(0);
        unsigned nloc = b.st[0], nx = b.st[1];
        if (nloc == 0u) { xcd_barrier_complete(bar, b.x, nloc, nx); b.st[0] = nloc; b.st[1] = nx; }
        const unsigned old = xb_add(&bar[XB_XSUB(b.x)], 1u);
        const unsigned gen = old / nloc;
        if (old + 1u == (gen + 1u) * nloc) {
            __builtin_amdgcn_fence(__ATOMIC_RELEASE, "agent");
            asm volatile("s_waitcnt vmcnt(0)" ::: "memory");
            const unsigned og = xb_add(&bar[XB_TOP], 1u);
            const unsigned tg = og / nx;
            if (og + 1u == (tg + 1u) * nx) xb_add(&bar[XB_TOPGEN], 1u);
            else XB_SPIN(xb_ld(&bar[XB_TOPGEN]) == tg, bar);
            __builtin_amdgcn_fence(__ATOMIC_ACQUIRE, "agent");
            xb_add(&bar[XB_XGEN(b.x)], 1u);
            asm volatile("s_waitcnt vmcnt(0)" ::: "memory");
        } else {
            XB_SPIN(xb_ld(&bar[XB_XGEN(b.x)]) == gen, bar);
            __builtin_amdgcn_fence(__ATOMIC_ACQUIRE, "agent");
            asm volatile("s_waitcnt vmcnt(0)" ::: "memory");
        }
    }
    __syncthreads();
}


#if MK_MULTI
#define PHASE_KERNEL(NAME, CALL) __global__ void __launch_bounds__(NTHR) NAME(Params p) { __shared__ __attribute__((aligned(16))) float sm[SMEM_FLOATS]; const int bid = blockIdx.x, nb = gridDim.x; (void)sm; CALL; }
PHASE_KERNEL(kA, phaseA(p, sm, bid, nb))
PHASE_KERNEL(kB, phaseB(p, bid, nb))
PHASE_KERNEL(kC, phaseC(p, sm, bid, nb))
PHASE_KERNEL(kD, phaseD(p, sm, bid, nb))
PHASE_KERNEL(kE, phaseE(p, sm, bid, nb))
PHASE_KERNEL(kF, phaseF(p, bid, nb))
PHASE_KERNEL(kG, phaseG(p, sm, bid, nb))
PHASE_KERNEL(kH, phaseH(p, sm, bid, nb))
PHASE_KERNEL(kI, phaseI(p, bid, nb))
#else
__global__ void __launch_bounds__(NTHR) fwd_megakernel(Params p) {
    __shared__ __attribute__((aligned(16))) float sm[SMEM_FLOATS];
    __shared__ uint4 xb_words;
    cg::grid_group grid = cg::this_grid();
    const int bid = blockIdx.x, nb = gridDim.x;
    if (threadIdx.x == 0) xb_words = make_uint4(0u, 0u, 0u, 0u);
    __syncthreads();
    XcdBarrier xb = xcd_barrier_post(p.bar, (volatile LAS unsigned*)&xb_words);
    phaseA(p, sm, bid, nb); grid.sync();
    phaseB(p, bid, nb); xcd_barrier(xb);
    phaseC(p, sm, bid, nb); xcd_barrier(xb);
    phaseD(p, sm, bid, nb); xcd_barrier(xb);
    phaseE(p, sm, bid, nb); xcd_barrier(xb);
    phaseF(p, bid, nb); xcd_barrier(xb);
    phaseG(p, sm, bid, nb); xcd_barrier(xb);
    phaseH(p, sm, bid, nb); xcd_barrier(xb);
    phaseI(p, bid, nb);
}
#endif

extern "C" void kernel_launch(void* const* d_in, const int* in_sizes, int n_in, void* d_out, int out_size, void* d_ws, size_t ws_size,
                              hipStream_t stream) {
    Params p{};
    const float* const* in = (const float* const*)d_in;
    p.x_p = in[0]; p.x_s = in[1]; p.c_p = in[2]; p.c_s = in[3];
    p.st_shift = in[4]; p.st_S = in[5]; p.st_conv = in[6]; p.st_C = in[7]; p.st_n = in[8]; p.st_m = in[9];
    p.g_norm = in[10]; p.w_ada = in[11]; p.b_ada = in[12]; p.w_in = in[13]; p.mu_shift = in[14]; p.w_decay2 = in[15];
    p.w0 = in[16]; p.w_iclr2 = in[17]; p.a0 = in[18]; p.k_k = in[19]; p.k_a = in[20]; p.r_k = in[21];
    p.ln_w = in[22]; p.ln_b = in[23]; p.conv_w = in[24]; p.conv_b = in[25]; p.b_i = in[26]; p.b_f = in[27];
    p.gn_w = in[28]; p.w_up_a = in[29]; p.w_up_b = in[30]; p.w_out = in[31]; p.g_final = in[32];
    p.out = (float*)d_out;
    char* ws = (char*)d_ws;
    size_t off = 0;
    p.P = (bf16_t*)(ws + off); off += (size_t)M_TOT * NP * 2;
    p.WinT = (bf16_t*)(ws + off); off += (size_t)NP * 1024 * 2;
    p.WupaT = (bf16_t*)(ws + off); off += (size_t)1024 * 512 * 2;
    p.WupbT = (bf16_t*)(ws + off); off += (size_t)1024 * 512 * 2;
    p.WoutT = (bf16_t*)(ws + off); off += (size_t)1024 * 1024 * 2;
    p.mod = (float*)(ws + off); off += (size_t)NSEQ * 3072 * 4;
    p.ctr = (unsigned*)(ws + off); off += 256;
    p.bar = (unsigned*)(ws + off); off += (size_t)XCD_BAR_WORDS * 4;
    char* os = (char*)d_out;
    p.H = (bf16_t*)os;
    p.Yraw = (bf16_t*)os;
    p.OutB = (bf16_t*)(os + (size_t)M_TOT * 512 * 2);
    p.Omd = (bf16_t*)(os + (size_t)M_TOT * 1024 * 2);
    p.Aa = (bf16_t*)(os + (size_t)M_TOT * 1024 * 2 + (size_t)M_TOT * 512 * 2);
    p.OutA = p.Omd;
#if MK_MULTI
    const int G = 1024;
    kA<<<G, NTHR, 0, stream>>>(p);
    kB<<<G, NTHR, 0, stream>>>(p);
    kC<<<G, NTHR, 0, stream>>>(p);
    kD<<<G, NTHR, 0, stream>>>(p);
    kE<<<G, NTHR, 0, stream>>>(p);
    kF<<<G, NTHR, 0, stream>>>(p);
    kG<<<G, NTHR, 0, stream>>>(p);
    kH<<<G, NTHR, 0, stream>>>(p);
    kI<<<G, NTHR, 0, stream>>>(p);
#else
    static int grid_blocks = 0;
    if (!grid_blocks) {
        int dev = 0, cus = 0, per_cu = 0;
        hipGetDevice(&dev);
        hipDeviceGetAttribute(&cus, hipDeviceAttributeMultiprocessorCount, dev);
        hipOccupancyMaxActiveBlocksPerMultiprocessor(&per_cu, fwd_megakernel, NTHR, 0);
        if (per_cu > 1) per_cu = 1;
        grid_blocks = cus * per_cu;
    }
    (void)hipMemsetAsync(p.ctr, 0, 256 + (size_t)XCD_BAR_WORDS * 4, stream);
    void* args[] = {&p};
    hipError_t e = hipLaunchCooperativeKernel((void*)fwd_megakernel, dim3(grid_blocks), dim3(NTHR), args, 0, stream);
    if (e != hipSuccess) fprintf(stderr, "cooperative launch failed: %s (grid %d)\n", hipGetErrorString(e), grid_blocks);
#endif
}
```

```cpp
#include <hip/hip_runtime.h>
#include <hip/hip_cooperative_groups.h>
#include <cstdio>
namespace cg = cooperative_groups;

#ifndef MK_MULTI
#define MK_MULTI 0
#endif

typedef unsigned short bf16_t;
typedef short bf16x8 __attribute__((ext_vector_type(8)));
typedef float f32x4 __attribute__((ext_vector_type(4)));

constexpr int NTHR = 512;
constexpr int M_P = 16384, M_S = 1024, M_TOT = 17408;
constexpr int DM = 1024;
constexpr int NSEQ = 136;
constexpr int NP = 6912;
constexpr int N_IN = 6800;
constexpr int C_R = 0, C_K = 512, C_V = 1024, C_WL = 1536, C_AL = 1600, C_ZA = 1664, C_QK = 2176,
              C_VB = 3200, C_OB = 3712, C_IB = 4224, C_FB = 4232, C_ZB = 4240, C_GLA = 4752, C_GLB = 5776;
constexpr int SHIFT_W = 1664;

constexpr size_t O_Y = 0;
constexpr size_t O_PSHIFT = (size_t)M_TOT * DM;
constexpr size_t O_PS = O_PSHIFT + 8 * 1664;
constexpr size_t O_PCONV = O_PS + 8 * 8 * 4096;
constexpr size_t O_PC = O_PCONV + 8 * 3 * 1024;
constexpr size_t O_PN = O_PC + 8 * 8 * 4096;
constexpr size_t O_PM = O_PN + 8 * 8 * 64;
constexpr size_t O_SSHIFT = O_PM + 64;
constexpr size_t O_SS = O_SSHIFT + 128 * 1664;
constexpr size_t O_SCONV = O_SS + (size_t)128 * 8 * 4096;
constexpr size_t O_SC = O_SCONV + 128 * 3 * 1024;
constexpr size_t O_SN = O_SC + (size_t)128 * 8 * 4096;
constexpr size_t O_SM = O_SN + 128 * 8 * 64;
constexpr size_t O_END = O_SM + 1024;

struct Params {
    const float *x_p, *x_s, *c_p, *c_s;
    const float *st_shift, *st_S, *st_conv, *st_C, *st_n, *st_m;
    const float *g_norm, *w_ada, *b_ada, *w_in, *mu_shift, *w_decay2, *w0, *w_iclr2, *a0, *k_k, *k_a, *r_k,
        *ln_w, *ln_b, *conv_w, *conv_b, *b_i, *b_f, *gn_w, *w_up_a, *w_up_b, *w_out, *g_final;
    float* out;
    bf16_t *WinT, *WupaT, *WupbT, *WoutT;
    float* mod;
    bf16_t* P;
    bf16_t *H, *Yraw, *OutB, *Omd, *Aa, *OutA;
    unsigned* ctr;
    unsigned* bar;
};

constexpr int SMEM_FLOATS = 32768 + 64;
__device__ __forceinline__ int otid() { int t = (int)__builtin_amdgcn_workitem_id_x(); asm volatile("" : "+v"(t)); return t; }
__device__ __forceinline__ void lds_barrier() { asm volatile("s_waitcnt lgkmcnt(0)" ::: "memory"); __builtin_amdgcn_s_barrier(); asm volatile("" ::: "memory"); }
__device__ __forceinline__ float bf2f(bf16_t v) { return __uint_as_float(((unsigned)v) << 16); }
__device__ __forceinline__ bf16_t f2bf(float f) { unsigned u = __float_as_uint(f); u += 0x7FFFu + ((u >> 16) & 1u); return (bf16_t)(u >> 16); }
__device__ __forceinline__ unsigned pk2(float lo, float hi) { return (unsigned)f2bf(lo) | ((unsigned)f2bf(hi) << 16); }
__device__ __forceinline__ float sigm(float x) { return __builtin_amdgcn_rcpf(1.f + __expf(-x)); }
__device__ __forceinline__ float silu(float x) { return x * __builtin_amdgcn_rcpf(1.f + __expf(-x)); }
__device__ __forceinline__ float wave_sum(float v) {
#pragma unroll
    for (int o = 32; o; o >>= 1) v += __shfl_xor(v, o);
    return v;
}
template <int CTRL> __device__ __forceinline__ float dpp_mov(float v) {
    return __builtin_bit_cast(float, __builtin_amdgcn_update_dpp(0, __builtin_bit_cast(int, v), CTRL, 0xF, 0xF, true));
}
__device__ __forceinline__ float row16_sum(float v) {
    v += dpp_mov<0xB1>(v);
    v += dpp_mov<0x4E>(v);
    v += dpp_mov<0x141>(v);
    v += dpp_mov<0x140>(v);
    return v;
}
__device__ __forceinline__ void tok_info(int m, int& s, int& t) {
    if (m < M_P) { s = m >> 11; t = m & 2047; } else { int q = m - M_P; s = 8 + (q >> 3); t = q & 7; }
}
__device__ __forceinline__ const float* xrow(const Params& p, int m) {
    return m < M_P ? p.x_p + (size_t)m * DM : p.x_s + (size_t)(m - M_P) * DM;
}

__device__ __forceinline__ void tr8(const float* __restrict__ src, int Nsrc, bf16_t* __restrict__ dst, int K, int n, int kg) {
    float v[8];
    if (n < Nsrc) {
        const float* sp = src + (size_t)(kg * 8) * Nsrc + n;
#pragma unroll
        for (int i = 0; i < 8; ++i) v[i] = sp[(size_t)i * Nsrc];
    } else {
#pragma unroll
        for (int i = 0; i < 8; ++i) v[i] = 0.f;
    }
    uint4 o; o.x = pk2(v[0], v[1]); o.y = pk2(v[2], v[3]); o.z = pk2(v[4], v[5]); o.w = pk2(v[6], v[7]);
    *(uint4*)(dst + (size_t)n * K + kg * 8) = o;
}
__device__ void phaseA(const Params& p, float* sm, int bid, int nb) {
    const int tid = otid();
    if (bid == 0 && tid == 0) *p.ctr = 0u;
    constexpr int N_ADA = 48 * 17;
    for (int i = bid; i < N_ADA; i += nb) {
        const int ct = i % 48, rgp = i / 48;
        float* sc = sm;
        float* red = sm + 8192;
        {
            float cv[16];
#pragma unroll
            for (int q = 0; q < 16; ++q) {
                const int idx = tid + q * NTHR, sl = idx >> 10, k = idx & 1023, s = rgp * 8 + sl;
                const float* src = s < 8 ? p.c_p + s * 1024 : p.c_s + (s - 8) * 1024;
                cv[q] = src[k];
            }
#pragma unroll
            for (int q = 0; q < 16; ++q) sc[tid + q * NTHR] = silu(cv[q]);
        }
        __syncthreads();
        const int col = tid & 63, kq = tid >> 6;
        float acc[8];
#pragma unroll
        for (int s = 0; s < 8; ++s) acc[s] = 0.f;
        const float* wp = p.w_ada + (size_t)(kq * 128) * 3072 + ct * 64 + col;
#pragma unroll 4
        for (int k4 = 0; k4 < 32; ++k4) {
            const float w0 = wp[(size_t)(k4 * 4) * 3072], w1 = wp[(size_t)(k4 * 4 + 1) * 3072], w2 = wp[(size_t)(k4 * 4 + 2) * 3072], w3 = wp[(size_t)(k4 * 4 + 3) * 3072];
#pragma unroll
            for (int s = 0; s < 8; ++s) {
                const float4 c = *(const float4*)(sc + s * 1024 + kq * 128 + k4 * 4);
                acc[s] += c.x * w0 + c.y * w1 + c.z * w2 + c.w * w3;
            }
        }
#pragma unroll
        for (int s = 0; s < 8; ++s) red[(kq * 8 + s) * 64 + col] = acc[s];
        __syncthreads();
        {
            const int s = tid >> 6;
            float v = p.b_ada[ct * 64 + col];
#pragma unroll
            for (int q = 0; q < 8; ++q) v += red[(q * 8 + s) * 64 + col];
            p.mod[(size_t)(rgp * 8 + s) * 3072 + ct * 64 + col] = v;
        }
        __syncthreads();
    }
    constexpr int W_IN = NP * 128, W_UP = 1024 * 64, W_OUT = 1024 * 128;
    const int gt = bid * NTHR + tid, gs = nb * NTHR;
    for (int w = gt; w < W_IN; w += 2 * gs) {
        const int w2 = w + gs; const bool has2 = w2 < W_IN;
        const int n1 = w % NP, g1 = w / NP, n2 = has2 ? w2 % NP : n1, g2 = has2 ? w2 / NP : g1;
        float v1[8], v2[8];
        const float* s1 = p.w_in + (size_t)(g1 * 8) * N_IN + (n1 < N_IN ? n1 : 0);
        const float* s2 = p.w_in + (size_t)(g2 * 8) * N_IN + (n2 < N_IN ? n2 : 0);
#pragma unroll
        for (int i = 0; i < 8; ++i) { v1[i] = s1[(size_t)i * N_IN]; v2[i] = s2[(size_t)i * N_IN]; }
        uint4 o;
        if (n1 >= N_IN) { o = make_uint4(0u, 0u, 0u, 0u); } else { o.x = pk2(v1[0], v1[1]); o.y = pk2(v1[2], v1[3]); o.z = pk2(v1[4], v1[5]); o.w = pk2(v1[6], v1[7]); }
        *(uint4*)(p.WinT + (size_t)n1 * 1024 + g1 * 8) = o;
        if (has2) {
            if (n2 >= N_IN) { o = make_uint4(0u, 0u, 0u, 0u); } else { o.x = pk2(v2[0], v2[1]); o.y = pk2(v2[2], v2[3]); o.z = pk2(v2[4], v2[5]); o.w = pk2(v2[6], v2[7]); }
            *(uint4*)(p.WinT + (size_t)n2 * 1024 + g2 * 8) = o;
        }
    }
    for (int w = gt; w < W_UP; w += gs) { tr8(p.w_up_a, 1024, p.WupaT, 512, w & 1023, w >> 10); tr8(p.w_up_b, 1024, p.WupbT, 512, w & 1023, w >> 10); }
    for (int w = gt; w < W_OUT; w += gs) tr8(p.w_out, 1024, p.WoutT, 1024, w & 1023, w >> 10);
}

__device__ __forceinline__ void normrow_load(const float* xr, int lane, float4 (&v)[4]) {
#pragma unroll
    for (int i = 0; i < 4; ++i) v[i] = *(const float4*)(xr + i * 256 + lane * 4);
}
__device__ __forceinline__ float sumsq4(const float4 (&v)[4]) {
    float ss = 0.f;
#pragma unroll
    for (int i = 0; i < 4; ++i) ss += v[i].x * v[i].x + v[i].y * v[i].y + v[i].z * v[i].z + v[i].w * v[i].w;
    return ss;
}
__device__ __forceinline__ void hrow_store(const Params& p, int m, int lane, const float4 (&v)[4], float rstd) {
    int s, t; tok_info(m, s, t);
    const float* md = p.mod + (size_t)s * 3072;
#pragma unroll
    for (int i = 0; i < 4; ++i) {
        const int c = i * 256 + lane * 4;
        const float4 g = *(const float4*)(p.g_norm + c);
        const float4 sh = *(const float4*)(md + c);
        const float4 sl = *(const float4*)(md + 1024 + c);
        const float h0 = v[i].x * rstd * g.x * (1.f + sl.x) + sh.x;
        const float h1 = v[i].y * rstd * g.y * (1.f + sl.y) + sh.y;
        const float h2 = v[i].z * rstd * g.z * (1.f + sl.z) + sh.z;
        const float h3 = v[i].w * rstd * g.w * (1.f + sl.w) + sh.w;
        uint2 o; o.x = pk2(h0, h1); o.y = pk2(h2, h3);
        *(uint2*)(p.H + (size_t)m * 1024 + c) = o;
    }
}
__device__ void phaseB(const Params& p, int bid, int nb) {
    const int wid = otid() >> 6, lane = otid() & 63;
    const int stride = nb * 8;
    for (int m = bid * 8 + wid; m < M_TOT; m += 2 * stride) {
        const int m2 = m + stride;
        const bool has2 = m2 < M_TOT;
        float4 va[4], vb[4];
        normrow_load(xrow(p, m), lane, va);
        normrow_load(xrow(p, has2 ? m2 : m), lane, vb);
        const float ra = rsqrtf(wave_sum(sumsq4(va)) * (1.f / 1024.f) + 1e-6f);
        const float rb = rsqrtf(wave_sum(sumsq4(vb)) * (1.f / 1024.f) + 1e-6f);
        hrow_store(p, m, lane, va, ra);
        if (has2) hrow_store(p, m2, lane, vb, rb);
    }
}

typedef unsigned u32x4v __attribute__((ext_vector_type(4)));
__device__ __forceinline__ bf16x8 pack8(const float (&v)[8]) {
    u32x4v t; t[0] = pk2(v[0], v[1]); t[1] = pk2(v[2], v[3]); t[2] = pk2(v[4], v[5]); t[3] = pk2(v[6], v[7]);
    return __builtin_bit_cast(bf16x8, t);
}
__device__ void phaseD(const Params& p, float* sm, int bid, int nb) {
    const int tid = otid(), wid = tid >> 6, lane = tid & 63, fr = lane & 15, fq = lane >> 4;
    bf16_t* twb = (bf16_t*)sm;
    bf16_t* alb = twb + 16 * 72;
    bf16x8 Bd[4][2], Bi[4][2];
#pragma unroll
    for (int ct = 0; ct < 4; ++ct)
#pragma unroll
        for (int ks = 0; ks < 2; ++ks) {
            const int n = wid * 64 + ct * 16 + fr, k0 = ks * 32 + fq * 8;
            float vd[8], vi[8];
#pragma unroll
            for (int j = 0; j < 8; ++j) { vd[j] = p.w_decay2[(k0 + j) * 512 + n]; vi[j] = p.w_iclr2[(k0 + j) * 512 + n]; }
            Bd[ct][ks] = pack8(vd); Bi[ct][ks] = pack8(vi);
        }
    float w0r[16], a0r[16];
#pragma unroll
    for (int q = 0; q < 16; ++q) { const int col = wid * 64 + (q >> 2) * 16 + fq * 4 + (q & 3); w0r[q] = p.w0[col]; a0r[q] = p.a0[col]; }
    unsigned cu[4], pv[4]; float st[4];
    auto fetchD = [&](int it) {
        const int m0 = it * 16;
#pragma unroll
        for (int q = 0; q < 4; ++q) {
            const int idx = tid + q * NTHR, tok = idx >> 7, j = idx & 127, col = C_WL + j, m = m0 + tok;
            int s, t; tok_info(m, s, t);
            cu[q] = p.P[(size_t)m * NP + col];
            pv[q] = p.P[(size_t)(t > 0 ? m - 1 : m) * NP + col];
            st[q] = p.st_shift[(size_t)(s >= 8 ? s - 8 : 0) * SHIFT_W + col];
        }
    };
    if (bid < M_TOT / 16) fetchD(bid);
    for (int it = bid; it < M_TOT / 16; it += nb) {
        const int m0 = it * 16;
        {
#pragma unroll
            for (int q = 0; q < 4; ++q) {
                const int idx = tid + q * NTHR, tok = idx >> 7, j = idx & 127, col = C_WL + j, m = m0 + tok;
                int s, t; tok_info(m, s, t);
                const float cur = __uint_as_float(cu[q] << 16);
                const float prev = t > 0 ? __uint_as_float(pv[q] << 16) : (s >= 8 ? st[q] : 0.f);
                const float v = cur + p.mu_shift[col] * (prev - cur);
                if (j < 64) twb[tok * 72 + j] = f2bf(tanhf(v)); else alb[tok * 72 + j - 64] = f2bf(v);
            }
        }
        if (it + nb < M_TOT / 16) fetchD(it + nb);
        lds_barrier();
        {
            const bf16x8 at0 = *(const bf16x8*)(twb + fr * 72 + fq * 8), at1 = *(const bf16x8*)(twb + fr * 72 + 32 + fq * 8);
            const bf16x8 aa0 = *(const bf16x8*)(alb + fr * 72 + fq * 8), aa1 = *(const bf16x8*)(alb + fr * 72 + 32 + fq * 8);
            const size_t mrow = (size_t)(m0 + fr) * 512 + wid * 64 + fq * 4;
#pragma unroll
            for (int ct = 0; ct < 4; ++ct) {
                f32x4 cw = (f32x4){0.f, 0.f, 0.f, 0.f}, ca = cw;
                cw = __builtin_amdgcn_mfma_f32_16x16x32_bf16(Bd[ct][0], at0, cw, 0, 0, 0);
                cw = __builtin_amdgcn_mfma_f32_16x16x32_bf16(Bd[ct][1], at1, cw, 0, 0, 0);
                ca = __builtin_amdgcn_mfma_f32_16x16x32_bf16(Bi[ct][0], aa0, ca, 0, 0, 0);
                ca = __builtin_amdgcn_mfma_f32_16x16x32_bf16(Bi[ct][1], aa1, ca, 0, 0, 0);
                float o[4], a[4];
#pragma unroll
                for (int r = 0; r < 4; ++r) {
                    const float sg = sigm(w0r[ct * 4 + r] + cw[r]);
                    o[r] = 1.f - __expf(-0.6065306597126334f * sg);
                    a[r] = sigm(a0r[ct * 4 + r] + ca[r]);
                }
                uint2 uo, ua; uo.x = pk2(o[0], o[1]); uo.y = pk2(o[2], o[3]); ua.x = pk2(a[0], a[1]); ua.y = pk2(a[2], a[3]);
                *(uint2*)(p.Omd + mrow + ct * 16) = uo;
                *(uint2*)(p.Aa + mrow + ct * 16) = ua;
            }
        }
        for (int tok = 0; tok < 16; ++tok) {
            const int m = m0 + tok;
            int s, t; tok_info(m, s, t);
            const int T = s < 8 ? 2048 : 8;
            if (t != T - 1) continue;
            float* osh = s < 8 ? p.out + O_PSHIFT + (size_t)s * SHIFT_W : p.out + O_SSHIFT + (size_t)(s - 8) * SHIFT_W;
            float* ocv = s < 8 ? p.out + O_PCONV + (size_t)s * 3072 : p.out + O_SCONV + (size_t)(s - 8) * 3072;
            for (int col = tid; col < SHIFT_W; col += NTHR) osh[col] = bf2f(p.P[(size_t)m * NP + col]);
            for (int idx = tid; idx < 3072; idx += NTHR) {
                const int r = idx >> 10, cc = idx & 1023;
                ocv[idx] = bf2f(p.P[(size_t)(m - 2 + r) * NP + C_QK + cc]);
            }
        }
        lds_barrier();
    }
    __syncthreads();
}

__device__ __forceinline__ float rdlane(float v, int l) { return __builtin_bit_cast(float, __builtin_amdgcn_readlane(__builtin_bit_cast(int, v), l)); }
__device__ __forceinline__ float wave_sum_fast(float v) {
    v = row16_sum(v);
    return (rdlane(v, 0) + rdlane(v, 16)) + (rdlane(v, 32) + rdlane(v, 48));
}
__device__ __forceinline__ float4 unpk4(uint2 u) {
    float4 f; f.x = __uint_as_float(u.x << 16); f.y = __uint_as_float(u.x & 0xFFFF0000u);
    f.z = __uint_as_float(u.y << 16); f.w = __uint_as_float(u.y & 0xFFFF0000u); return f;
}
__device__ void rwkv_item(const Params& p, int s, int h, int third, float* sm) {
    constexpr int BUF = 15680;
    constexpr int VC_OFF = 10368, Y_OFF = 13632, NCH = 64;
    const int tid = otid(), wid = tid >> 6, lane = tid & 63;
    const int mbase = s * 2048;
    const int r0 = third * 21 + (third > 0 ? 1 : 0), nr = third == 0 ? 22 : 21;
    if (wid >= 6) {
        const int pw = wid - 6, g = lane >> 4;
        const int c4 = (lane & 15) * 4, hc = h * 64 + c4;
        const int l128 = pw * 64 + lane;
        const float4 mu_r = *(const float4*)(p.mu_shift + C_R + hc), mu_k = *(const float4*)(p.mu_shift + C_K + hc), mu_v = *(const float4*)(p.mu_shift + C_V + hc);
        const float4 kkw = *(const float4*)(p.k_k + hc), kaw = *(const float4*)(p.k_a + hc);
        uint2 R[4][8];
        auto fetch = [&](int pass, uint2 (&q)[8]) {
            const int t = (pass >> 2) * 32 + (pass & 3) * 8 + pw * 4 + g;
            const bf16_t* pr = p.P + (size_t)(mbase + t) * NP + hc;
            const bf16_t* pp = t > 0 ? pr - NP : pr;
            q[0] = *(const uint2*)(pr + C_R); q[1] = *(const uint2*)(pr + C_K); q[2] = *(const uint2*)(pr + C_V);
            q[3] = *(const uint2*)(pp + C_R); q[4] = *(const uint2*)(pp + C_K); q[5] = *(const uint2*)(pp + C_V);
            q[6] = *(const uint2*)(p.Aa + (size_t)(mbase + t) * 512 + hc);
            q[7] = *(const uint2*)(p.Omd + (size_t)(mbase + t) * 512 + hc);
        };
        auto step = [&](int pass, uint2 (&q)[8]) {
            const uint2 cr = q[0], ck = q[1], cv = q[2], crp = q[3], ckp = q[4], cvp = q[5], ca = q[6], co = q[7];
            if (pass + 4 < NCH * 4) fetch(pass + 4, q);
            const int tok = (pass & 3) * 8 + pw * 4 + g, t = (pass >> 2) * 32 + tok;
            float* B = sm + ((pass >> 2) & 1) * BUF;
            float4 r = unpk4(cr), k = unpk4(ck), v = unpk4(cv), rp, kp_, vp;
            if (t > 0) { rp = unpk4(crp); kp_ = unpk4(ckp); vp = unpk4(cvp); }
            else { rp = make_float4(0.f, 0.f, 0.f, 0.f); kp_ = rp; vp = rp; }
            r.x += mu_r.x * (rp.x - r.x); r.y += mu_r.y * (rp.y - r.y); r.z += mu_r.z * (rp.z - r.z); r.w += mu_r.w * (rp.w - r.w);
            k.x += mu_k.x * (kp_.x - k.x); k.y += mu_k.y * (kp_.y - k.y); k.z += mu_k.z * (kp_.z - k.z); k.w += mu_k.w * (kp_.w - k.w);
            v.x += mu_v.x * (vp.x - v.x); v.y += mu_v.y * (vp.y - v.y); v.z += mu_v.z * (vp.z - v.z); v.w += mu_v.w * (vp.w - v.w);
            const float4 a = unpk4(ca), om = unpk4(co);
            float4 kk; kk.x = k.x * kkw.x; kk.y = k.y * kkw.y; kk.z = k.z * kkw.z; kk.w = k.w * kkw.w;
            const float nrm = sqrtf(row16_sum(kk.x * kk.x + kk.y * kk.y + kk.z * kk.z + kk.w * kk.w));
            const float inv = __builtin_amdgcn_rcpf(fmaxf(nrm, 1e-12f));
            kk.x *= inv; kk.y *= inv; kk.z *= inv; kk.w *= inv;
            float4 ka; ka.x = kk.x * a.x; ka.y = kk.y * a.y; ka.z = kk.z * a.z; ka.w = kk.w * a.w;
            float4 kp; kp.x = k.x * (1.f + (a.x - 1.f) * kaw.x); kp.y = k.y * (1.f + (a.y - 1.f) * kaw.y);
            kp.z = k.z * (1.f + (a.z - 1.f) * kaw.z); kp.w = k.w * (1.f + (a.w - 1.f) * kaw.w);
            float4 d; d.x = 1.f - om.x; d.y = 1.f - om.y; d.z = 1.f - om.z; d.w = 1.f - om.w;
            float4 dr; dr.x = d.x * r.x; dr.y = d.y * r.y; dr.z = d.z * r.z; dr.w = d.w * r.w;
            const float c1 = row16_sum(ka.x * r.x + ka.y * r.y + ka.z * r.z + ka.w * r.w);
            const float c2 = row16_sum(kp.x * r.x + kp.y * r.y + kp.z * r.z + kp.w * r.w);
            const int o = tok * 64 + c4;
            *(float4*)(B + o) = kk; *(float4*)(B + 2048 + o) = d; *(float4*)(B + 4096 + o) = ka;
            *(float4*)(B + 6144 + o) = kp; *(float4*)(B + 8192 + o) = dr;
            float4* vc = (float4*)(B + VC_OFF) + tok * 24;
            const int l0 = c4 - r0;
            if (l0 >= 0 && l0 < nr) vc[l0] = make_float4(v.x, c1, c2, 0.f);
            if (l0 + 1 >= 0 && l0 + 1 < nr) vc[l0 + 1] = make_float4(v.y, c1, c2, 0.f);
            if (l0 + 2 >= 0 && l0 + 2 < nr) vc[l0 + 2] = make_float4(v.z, c1, c2, 0.f);
            if (l0 + 3 >= 0 && l0 + 3 < nr) vc[l0 + 3] = make_float4(v.w, c1, c2, 0.f);
        };
        auto flush = [&](int c) {
            const float* Y = sm + (c & 1) * BUF + Y_OFF;
            const int tt = l128 >> 2, part = l128 & 3;
            bf16_t* dst = p.Yraw + (size_t)(mbase + c * 32 + tt) * 512 + h * 64 + r0;
#pragma unroll
            for (int k = 0; k < 6; ++k) { const int i = part + 4 * k; if (i < nr) dst[i] = f2bf(Y[tt * 64 + i]); }
        };
#pragma unroll
        for (int q = 0; q < 4; ++q) fetch(q, R[q]);
#pragma unroll
        for (int q = 0; q < 4; ++q) step(q, R[q]);
        lds_barrier();
#pragma unroll 1
        for (int c = 0; c < NCH; ++c) {
            if (c > 0) flush(c - 1);
            if (c + 1 < NCH) {
#pragma unroll
                for (int q = 0; q < 4; ++q) step((c + 1) * 4 + q, R[q]);
            }
            lds_barrier();
        }
        flush(NCH - 1);
    } else {
        const int lrow = wid * 4 + (lane >> 4);
        const int irow = r0 + (lrow < nr ? lrow : nr - 1);
        const int c4 = (lane & 15) * 4;
        const int yslot = ((lane & 15) == 0 && lrow < nr) ? lrow : 32 + (lane & 31);
        float S0 = 0.f, S1 = 0.f, S2 = 0.f, S3 = 0.f;
        lds_barrier();
#pragma unroll 1
        for (int c = 0; c < NCH; ++c) {
            const float* B = sm + (c & 1) * BUF;
            const float* bp = B + c4;
            const float4* vp4 = (const float4*)(B + VC_OFF) + (irow - r0);
            float4 kk4 = *(const float4*)(bp), d4 = *(const float4*)(bp + 2048), ka4 = *(const float4*)(bp + 4096);
            float4 kp4 = *(const float4*)(bp + 6144), dr4 = *(const float4*)(bp + 8192), vc = vp4[0];
            float4 kkB = *(const float4*)(bp + 64), dB = *(const float4*)(bp + 64 + 2048), kaB = *(const float4*)(bp + 64 + 4096);
            float4 kpB = *(const float4*)(bp + 64 + 6144), drB = *(const float4*)(bp + 64 + 8192), vcB = vp4[24];
            float* yp = sm + (c & 1) * BUF + Y_OFF + yslot;
#pragma unroll 8
            for (int tt = 0; tt < 32; ++tt) {
                const float* nb_ = bp + (tt + 2) * 64;
                const float4 nkk = *(const float4*)(nb_), nd = *(const float4*)(nb_ + 2048), nka = *(const float4*)(nb_ + 4096);
                const float4 nkp = *(const float4*)(nb_ + 6144), ndr = *(const float4*)(nb_ + 8192), nvc = vp4[(tt + 2) * 24];
                __builtin_amdgcn_sched_barrier(0);
                float p1 = S0 * kk4.x + S1 * kk4.y + S2 * kk4.z + S3 * kk4.w;
                float p2 = S0 * dr4.x + S1 * dr4.y + S2 * dr4.z + S3 * dr4.w;
                const float vi = vc.x;
                const float u0 = S0 * d4.x + vi * kp4.x, u1 = S1 * d4.y + vi * kp4.y, u2 = S2 * d4.z + vi * kp4.z, u3 = S3 * d4.w + vi * kp4.w;
                float z = p2 - vc.y * p1;
                p1 = row16_sum(p1);
                z = row16_sum(z);
                S0 = u0 - p1 * ka4.x; S1 = u1 - p1 * ka4.y; S2 = u2 - p1 * ka4.z; S3 = u3 - p1 * ka4.w;
                yp[tt * 64] = z + vi * vc.z;
                kk4 = kkB; d4 = dB; ka4 = kaB; kp4 = kpB; dr4 = drB; vc = vcB;
                kkB = nkk; dB = nd; kaB = nka; kpB = nkp; drB = ndr; vcB = nvc;
                __builtin_amdgcn_sched_barrier(0);
            }
            lds_barrier();
        }
        if (lrow < nr) {
            float* o = p.out + O_PS + (size_t)s * 8 * 4096 + ((size_t)(h * 64 + irow)) * 64 + c4;
            float4 v; v.x = S0; v.y = S1; v.z = S2; v.w = S3;
            *(float4*)o = v;
        }
    }
    __syncthreads();
}

__device__ void mlstm_item(const Params& p, int s, int h, float* sm) {
    float* sq = sm;
    float* sk = sm + 4160;
    float* sv = sm + 8320;
    float* sc = sm + 12480;
    float* sC = sm + 16640;
    float* sn = sm + 20800;
    float* sb = sn + 64;
    float* si = sn + 128;
    float* smt = sn + 192;
    float* swin = sn + 256;
    float* sden = sn + 320;
    float* sws = sn + 384;
    float* slf = sn + 448;
    float* smisc = sn + 512;
    const int tid = otid(), wid = tid >> 6, lane = tid & 63;
    const int T = s < 8 ? 2048 : 8, L = s < 8 ? 64 : 8, NC = T / L;
    const int mbase = s < 8 ? s * 2048 : M_P + (s - 8) * 8;
    for (int idx = tid; idx < 4096; idx += NTHR) {
        const int i = idx >> 6, j = idx & 63;
        sC[i * 65 + j] = s >= 8 ? p.st_C[(size_t)((s - 8) * 8 + h) * 4096 + idx] : 0.f;
    }
    if (tid < 64) sn[tid] = s >= 8 ? p.st_n[(size_t)((s - 8) * 8 + h) * 64 + tid] : 0.f;
    if (tid == 0) smisc[0] = s >= 8 ? p.st_m[(s - 8) * 8 + h] : 0.f;
    const float cwq[4] = {p.conv_w[0 * 1024 + h * 64 + lane], p.conv_w[1 * 1024 + h * 64 + lane], p.conv_w[2 * 1024 + h * 64 + lane], p.conv_w[3 * 1024 + h * 64 + lane]};
    const float cwk[4] = {p.conv_w[0 * 1024 + 512 + h * 64 + lane], p.conv_w[1 * 1024 + 512 + h * 64 + lane], p.conv_w[2 * 1024 + 512 + h * 64 + lane], p.conv_w[3 * 1024 + 512 + h * 64 + lane]};
    const float cbq = p.conv_b[h * 64 + lane], cbk = p.conv_b[512 + h * 64 + lane];
    const float gnw = p.gn_w[h * 64 + lane];
    const float bi = p.b_i[h], bfv = p.b_f[h];
    __syncthreads();
    for (int c = 0; c < NC; ++c) {
        const int t0 = c * L;
        for (int tt = wid; tt < L; tt += 8) {
            const int t = t0 + tt, m = mbase + t;
            float aq = cbq, ak = cbk;
#pragma unroll
            for (int j = 0; j < 4; ++j) {
                const int tau = t - 3 + j;
                float xq, xk;
                if (tau >= 0) {
                    const bf16_t* pr = p.P + (size_t)(mbase + tau) * NP + C_QK + h * 64 + lane;
                    xq = bf2f(pr[0]); xk = bf2f(pr[512]);
                } else if (s >= 8) {
                    const float* st = p.st_conv + ((size_t)(s - 8) * 3 + (3 + tau)) * 1024 + h * 64 + lane;
                    xq = st[0]; xk = st[512];
                } else { xq = 0.f; xk = 0.f; }
                aq += xq * cwq[j]; ak += xk * cwk[j];
            }
            sq[tt * 65 + lane] = silu(aq);
            sk[tt * 65 + lane] = silu(ak) * 0.125f;
            sv[tt * 65 + lane] = bf2f(p.P[(size_t)m * NP + C_VB + h * 64 + lane]);
        }
        if (tid < L) {
            const int m = mbase + t0 + tid;
            si[tid] = bf2f(p.P[(size_t)m * NP + C_IB + h]) + bi;
            const float f = bf2f(p.P[(size_t)m * NP + C_FB + h]) + bfv;
            slf[tid] = f > 0.f ? -log1pf(__expf(-f)) : f - log1pf(__expf(f));
        }
        __syncthreads();
        if (tid == 0) {
            const float mprev = smisc[0];
            float b = 0.f, run = mprev;
            for (int t = 0; t < L; ++t) {
                b += slf[t];
                run = fmaxf(run, si[t] - b);
                sb[t] = b; smt[t] = b + run; swin[t] = __expf(b + mprev - (b + run));
            }
            const float mnew = b + run;
            smisc[1] = mnew; smisc[2] = __expf(b + mprev - mnew);
            for (int t = 0; t < L; ++t) sws[t] = __expf(b - sb[t] + si[t] - mnew);
        }
        __syncthreads();
        for (int idx = tid; idx < L * L; idx += NTHR) {
            const int t = idx / L, u = idx % L;
            float v = 0.f;
            if (u <= t) {
                float dot = 0.f;
#pragma unroll 8
                for (int d = 0; d < 64; ++d) dot += sq[t * 65 + d] * sk[u * 65 + d];
                v = dot * __expf(sb[t] - sb[u] + si[u] - smt[t]);
            }
            sc[t * 65 + u] = v;
        }
        __syncthreads();
        if (tid < L) {
            float rs = 0.f, qn = 0.f;
            for (int u = 0; u < L; ++u) rs += sc[tid * 65 + u];
            for (int j = 0; j < 64; ++j) qn += sn[j] * sq[tid * 65 + j];
            const float den = rs + swin[tid] * qn;
            sden[tid] = fmaxf(fabsf(den), __expf(-smt[tid]));
        }
        __syncthreads();
        for (int tt = wid; tt < L; tt += 8) {
            float num = 0.f, inter = 0.f;
            for (int u = 0; u <= tt; ++u) num += sc[tt * 65 + u] * sv[u * 65 + lane];
#pragma unroll 8
            for (int j = 0; j < 64; ++j) inter += sC[lane * 65 + j] * sq[tt * 65 + j];
            const float hv = (num + swin[tt] * inter) / sden[tt];
            const float ms = wave_sum(hv * hv) * (1.f / 64.f);
            const float hn = hv * rsqrtf(ms + 1e-6f) * gnw;
            const int m = mbase + t0 + tt;
            const float ob = bf2f(p.P[(size_t)m * NP + C_OB + h * 64 + lane]);
            const float zb = bf2f(p.P[(size_t)m * NP + C_ZB + h * 64 + lane]);
            p.OutB[(size_t)m * 512 + h * 64 + lane] = f2bf(sigm(ob) * hn * silu(zb));
        }
        __syncthreads();
        {
            const float dec = smisc[2];
            const int j = lane;
#pragma unroll
            for (int ii = 0; ii < 8; ++ii) {
                const int i = wid + 8 * ii;
                float a = dec * sC[i * 65 + j];
                for (int u = 0; u < L; ++u) a += sws[u] * sv[u * 65 + i] * sk[u * 65 + j];
                sC[i * 65 + j] = a;
            }
            if (tid < 64) {
                float a = dec * sn[tid];
                for (int u = 0; u < L; ++u) a += sws[u] * sk[u * 65 + tid];
                sn[tid] = a;
            }
            if (tid == 0) smisc[0] = smisc[1];
        }
        __syncthreads();
    }
    {
        float* oC = s < 8 ? p.out + O_PC + (size_t)(s * 8 + h) * 4096 : p.out + O_SC + (size_t)((s - 8) * 8 + h) * 4096;
        float* on = s < 8 ? p.out + O_PN + (size_t)(s * 8 + h) * 64 : p.out + O_SN + (size_t)((s - 8) * 8 + h) * 64;
        float* om = s < 8 ? p.out + O_PM + (s * 8 + h) : p.out + O_SM + ((s - 8) * 8 + h);
        for (int idx = tid; idx < 4096; idx += NTHR) oC[idx] = sC[(idx >> 6) * 65 + (idx & 63)];
        if (tid < 64) on[tid] = sn[tid];
        if (tid == 0) om[0] = smisc[0];
    }
    __syncthreads();
}

__device__ __forceinline__ bf16x8 ldfrag(const bf16_t* base, int row, int ks, int fq) { return *(const bf16x8*)(base + row * 72 + ks * 32 + fq * 8); }
__device__ __forceinline__ float sum8(float v) { v += dpp_mov<0xB1>(v); v += dpp_mov<0x4E>(v); v += dpp_mov<0x141>(v); return v; }
__device__ void mlstm_prompt(const Params& p, int s, int h, float* sm) {
    bf16_t* Qs = (bf16_t*)sm; bf16_t* Ks = Qs + 4608; bf16_t* VT = Ks + 4608; bf16_t* KwT = VT + 4608; bf16_t* Ps = KwT + 4608; bf16_t* Cb = Ps + 4608;
    float* hs = sm + 13824;
    float* sn = hs + 64 * 68;
    float* sden = sn + 64;
    float* gv = sn + 128;
    float* Gg = sn + 128 + 768;
    float* Gl = Gg + 2048;
    float* Gb = Gl + 2048;
    const int tid = otid(), wid = tid >> 6, lane = tid & 63, fr = lane & 15, fq = lane >> 4;
    const int tr = wid >> 1, tc0 = (wid & 1) * 2;
    const int mbase = s * 2048;
    const int qc = h * 64 + lane;
    f32x4 accC[2];
    accC[0] = (f32x4){0.f, 0.f, 0.f, 0.f}; accC[1] = accC[0];
    if (tid < 64) sn[tid] = 0.f;
    {
        const float bi = p.b_i[h], bfv = p.b_f[h];
        for (int cc = wid; cc < 32; cc += 8) {
            const bf16_t* pr = p.P + (size_t)(mbase + cc * 64 + lane) * NP;
            const float it = bf2f(pr[C_IB + h]) + bi;
            const float f = bf2f(pr[C_FB + h]) + bfv;
            float b = f > 0.f ? -log1pf(__expf(-f)) : f - log1pf(__expf(f));
#pragma unroll
            for (int o = 1; o < 64; o <<= 1) { const float v = __shfl_up(b, o); if (lane >= o) b += v; }
            const float g = it - b;
            float run = g;
#pragma unroll
            for (int o = 1; o < 64; o <<= 1) { const float v = __shfl_up(run, o); if (lane >= o) run = fmaxf(run, v); }
            Gg[cc * 64 + lane] = g; Gl[cc * 64 + lane] = run; Gb[cc * 64 + lane] = b;
        }
    }
    const float cwq0 = p.conv_w[qc], cwq1 = p.conv_w[1024 + qc], cwq2 = p.conv_w[2048 + qc], cwq3 = p.conv_w[3072 + qc];
    const float cwk0 = p.conv_w[512 + qc], cwk1 = p.conv_w[1536 + qc], cwk2 = p.conv_w[2560 + qc], cwk3 = p.conv_w[3584 + qc];
    const float cbq = p.conv_b[qc], cbk = p.conv_b[512 + qc];
    const float gnw = p.gn_w[qc];
    unsigned xqr[11], xkr[11], vvr[8];
    auto load_raw = [&](int c) {
        const int tb = c * 64 + wid * 8 - 3;
#pragma unroll
        for (int r = 0; r < 11; ++r) {
            const int t = tb + r, tc = t < 0 ? 0 : t;
            const bf16_t* pr = p.P + (size_t)(mbase + tc) * NP + C_QK + qc;
            xqr[r] = pr[0]; xkr[r] = pr[512];
        }
#pragma unroll
        for (int k = 0; k < 8; ++k) vvr[k] = p.P[(size_t)(mbase + tb + 3 + k) * NP + C_VB + qc];
    };
    auto gates = [&](int c, float mprev) {
        float* v = gv + (c & 1) * 384;
        const float g = Gg[c * 64 + lane], b = Gb[c * 64 + lane];
        const float run = fmaxf(Gl[c * 64 + lane], mprev), runL = fmaxf(Gl[c * 64 + 63], mprev), bL = Gb[c * 64 + 63];
        v[lane] = g; v[64 + lane] = run; v[128 + lane] = __expf(mprev - run); v[192 + lane] = __expf(g - runL); v[256 + lane] = b;
        if (lane == 0) { v[320] = bL + runL; v[321] = __expf(mprev - runL); }
    };
    load_raw(0);
    __syncthreads();
    if (wid == 0) gates(0, 0.f);
    __syncthreads();
    for (int c = 0; c < 32; ++c) {
        const int t0 = c * 64, mb = mbase + t0;
        const float* sg = gv + (c & 1) * 384; const float* srun = sg + 64; const float* swin = sg + 128; const float* sws = sg + 192; const float* sb = sg + 256;
        const float dec = sg[321];
        {
            float kw[8], xq[11], xk[11], vv[8];
            const bool head = (c == 0 && wid == 0);
#pragma unroll
            for (int r = 0; r < 11; ++r) {
                const bool z = head && r < 3;
                xq[r] = z ? 0.f : __uint_as_float(xqr[r] << 16); xk[r] = z ? 0.f : __uint_as_float(xkr[r] << 16);
            }
#pragma unroll
            for (int k = 0; k < 8; ++k) vv[k] = __uint_as_float(vvr[k] << 16);
#pragma unroll
            for (int k = 0; k < 8; ++k) {
                const int tt = wid * 8 + k;
                const float q = silu(cbq + xq[k] * cwq0 + xq[k + 1] * cwq1 + xq[k + 2] * cwq2 + xq[k + 3] * cwq3);
                const float kk = silu(cbk + xk[k] * cwk0 + xk[k + 1] * cwk1 + xk[k + 2] * cwk2 + xk[k + 3] * cwk3) * 0.125f;
                Qs[tt * 72 + lane] = f2bf(q);
                Ks[tt * 72 + lane] = f2bf(kk);
                kw[k] = kk * sws[tt];
            }
            uint4 o; o.x = pk2(kw[0], kw[1]); o.y = pk2(kw[2], kw[3]); o.z = pk2(kw[4], kw[5]); o.w = pk2(kw[6], kw[7]);
            *(uint4*)(KwT + lane * 72 + wid * 8) = o;
            o.x = pk2(vv[0], vv[1]); o.y = pk2(vv[2], vv[3]); o.z = pk2(vv[4], vv[5]); o.w = pk2(vv[6], vv[7]);
            *(uint4*)(VT + lane * 72 + wid * 8) = o;
        }
#pragma unroll
        for (int n = 0; n < 2; ++n) {
            uint2 o; o.x = pk2(accC[n][0], accC[n][1]); o.y = pk2(accC[n][2], accC[n][3]);
            *(uint2*)(Cb + (tr * 16 + fr) * 72 + (tc0 + n) * 16 + fq * 4) = o;
        }
        if (c + 1 < 32) load_raw(c + 1);
        lds_barrier();
        unsigned obr[8], zbr[8];
#pragma unroll
        for (int k = 0; k < 8; ++k) {
            const bf16_t* pr = p.P + (size_t)(mb + wid * 8 + k) * NP;
            obr[k] = pr[C_OB + qc]; zbr[k] = pr[C_ZB + qc];
        }
#pragma unroll
        for (int n = 0; n < 2; ++n) {
            const int ut = tc0 + n;
            f32x4 a = (f32x4){0.f, 0.f, 0.f, 0.f};
            if (ut <= tr) {
#pragma unroll
                for (int ks = 0; ks < 2; ++ks) a = __builtin_amdgcn_mfma_f32_16x16x32_bf16(ldfrag(Ks, ut * 16 + fr, ks, fq), ldfrag(Qs, tr * 16 + fr, ks, fq), a, 0, 0, 0);
            }
            const int t = tr * 16 + fr;
            const float rn = srun[t];
            float w[4];
#pragma unroll
            for (int r = 0; r < 4; ++r) {
                const int u = ut * 16 + fq * 4 + r;
                w[r] = (u <= t) ? a[r] * __expf(sg[u] - rn) : 0.f;
            }
            uint2 o; o.x = pk2(w[0], w[1]); o.y = pk2(w[2], w[3]);
            *(uint2*)(Ps + t * 72 + ut * 16 + fq * 4) = o;
        }
        lds_barrier();
        {
            const int t = tid >> 3, seg = tid & 7;
            const uint4 pv = *(const uint4*)(Ps + t * 72 + seg * 8);
            const uint4 qv = *(const uint4*)(Qs + t * 72 + seg * 8);
            const float4 pa = unpk4(make_uint2(pv.x, pv.y)), pb = unpk4(make_uint2(pv.z, pv.w));
            const float4 qa = unpk4(make_uint2(qv.x, qv.y)), qb = unpk4(make_uint2(qv.z, qv.w));
            const float4 na = *(const float4*)(sn + seg * 8), nb4 = *(const float4*)(sn + seg * 8 + 4);
            float rs = (pa.x + pa.y) + (pa.z + pa.w) + (pb.x + pb.y) + (pb.z + pb.w);
            float qn = qa.x * na.x + qa.y * na.y + qa.z * na.z + qa.w * na.w + qb.x * nb4.x + qb.y * nb4.y + qb.z * nb4.z + qb.w * nb4.w;
            rs = sum8(rs); qn = sum8(qn);
            if (seg == 0) sden[t] = fmaxf(fabsf(rs + swin[t] * qn), __expf(-(sb[t] + srun[t])));
        }
        f32x4 num[2], itr[2];
#pragma unroll
        for (int n = 0; n < 2; ++n) {
            const int it = tc0 + n;
            num[n] = (f32x4){0.f, 0.f, 0.f, 0.f}; itr[n] = num[n];
#pragma unroll
            for (int ks = 0; ks < 2; ++ks) {
                num[n] = __builtin_amdgcn_mfma_f32_16x16x32_bf16(ldfrag(VT, it * 16 + fr, ks, fq), ldfrag(Ps, tr * 16 + fr, ks, fq), num[n], 0, 0, 0);
                itr[n] = __builtin_amdgcn_mfma_f32_16x16x32_bf16(ldfrag(Cb, it * 16 + fr, ks, fq), ldfrag(Qs, tr * 16 + fr, ks, fq), itr[n], 0, 0, 0);
            }
        }
        lds_barrier();
        {
            const int t = tr * 16 + fr;
            const float rd = 1.f / sden[t], wn = swin[t];
#pragma unroll
            for (int n = 0; n < 2; ++n) {
                float4 o;
                o.x = (num[n][0] + wn * itr[n][0]) * rd; o.y = (num[n][1] + wn * itr[n][1]) * rd;
                o.z = (num[n][2] + wn * itr[n][2]) * rd; o.w = (num[n][3] + wn * itr[n][3]) * rd;
                *(float4*)(hs + t * 68 + (tc0 + n) * 16 + fq * 4) = o;
            }
        }
#pragma unroll
        for (int n = 0; n < 2; ++n) {
            accC[n][0] *= dec; accC[n][1] *= dec; accC[n][2] *= dec; accC[n][3] *= dec;
#pragma unroll
            for (int ks = 0; ks < 2; ++ks)
                accC[n] = __builtin_amdgcn_mfma_f32_16x16x32_bf16(ldfrag(KwT, (tc0 + n) * 16 + fr, ks, fq), ldfrag(VT, tr * 16 + fr, ks, fq), accC[n], 0, 0, 0);
        }
        {
            const int j = tid >> 3, seg = tid & 7;
            const uint4 kv = *(const uint4*)(KwT + j * 72 + seg * 8);
            const float4 ka = unpk4(make_uint2(kv.x, kv.y)), kb = unpk4(make_uint2(kv.z, kv.w));
            float sum = (ka.x + ka.y) + (ka.z + ka.w) + (kb.x + kb.y) + (kb.z + kb.w);
            sum = sum8(sum);
            if (seg == 0) sn[j] = dec * sn[j] + sum;
        }
        if (wid == 0 && c + 1 < 32) gates(c + 1, sg[320]);
        lds_barrier();
#pragma unroll
        for (int k = 0; k < 8; ++k) {
            const int tt = wid * 8 + k;
            const float hv = hs[tt * 68 + lane];
            const float ms = wave_sum_fast(hv * hv) * (1.f / 64.f);
            const float hn = hv * rsqrtf(ms + 1e-6f) * gnw;
            p.OutB[(size_t)(mb + tt) * 512 + qc] = f2bf(sigm(__uint_as_float(obr[k] << 16)) * hn * silu(__uint_as_float(zbr[k] << 16)));
        }
    }
    {
        float* oC = p.out + O_PC + (size_t)(s * 8 + h) * 4096;
#pragma unroll
        for (int n = 0; n < 2; ++n) {
            float4 o; o.x = accC[n][0]; o.y = accC[n][1]; o.z = accC[n][2]; o.w = accC[n][3];
            *(float4*)(oC + (tr * 16 + fr) * 64 + (tc0 + n) * 16 + fq * 4) = o;
        }
        if (tid < 64) p.out[O_PN + (size_t)(s * 8 + h) * 64 + tid] = sn[tid];
        if (tid == 0) p.out[O_PM + s * 8 + h] = gv[384 + 320];
    }
    __syncthreads();
}

__device__ __forceinline__ void wave_lds_fence() { __builtin_amdgcn_fence(__ATOMIC_RELEASE, "wavefront"); __builtin_amdgcn_wave_barrier(); __builtin_amdgcn_fence(__ATOMIC_ACQUIRE, "wavefront"); }
__device__ void rwkv_sample_wave(const Params& p, int sb, int h, float* wsm) {
    const int lane = otid() & 63;
    const int hj = h * 64 + lane;
    const int m0 = M_P + sb * 8;
    {
        float rr[8], kr[8], vr[8], ar[8], dd[8];
#pragma unroll
        for (int t = 0; t < 8; ++t) {
            const bf16_t* pr = p.P + (size_t)(m0 + t) * NP;
            rr[t] = bf2f(pr[C_R + hj]); kr[t] = bf2f(pr[C_K + hj]); vr[t] = bf2f(pr[C_V + hj]);
            ar[t] = bf2f(p.Aa[(size_t)(m0 + t) * 512 + hj]); dd[t] = 1.f - bf2f(p.Omd[(size_t)(m0 + t) * 512 + hj]);
        }
        const float* st = p.st_shift + (size_t)sb * SHIFT_W;
        float rp = st[C_R + hj], kp_ = st[C_K + hj], vp = st[C_V + hj];
        const float mu_r = p.mu_shift[C_R + hj], mu_k = p.mu_shift[C_K + hj], mu_v = p.mu_shift[C_V + hj];
        const float kkw = p.k_k[hj], kaw = p.k_a[hj];
#pragma unroll
        for (int t = 0; t < 8; ++t) {
            const float r = rr[t] + mu_r * (rp - rr[t]), k = kr[t] + mu_k * (kp_ - kr[t]), v = vr[t] + mu_v * (vp - vr[t]);
            rp = rr[t]; kp_ = kr[t]; vp = vr[t];
            const float a = ar[t], d = dd[t];
            float kk = k * kkw;
            const float nrm = sqrtf(wave_sum_fast(kk * kk));
            kk = kk / fmaxf(nrm, 1e-12f);
            const float ka = kk * a, kp = k * (1.f + (a - 1.f) * kaw);
            const float c1 = wave_sum_fast(ka * r), c2 = wave_sum_fast(kp * r);
            float* w = wsm + t * 400;
            w[lane] = kk; w[64 + lane] = d; w[128 + lane] = ka; w[192 + lane] = kp; w[256 + lane] = d * r; w[320 + lane] = v;
            if (lane == 0) { w[384] = c1; w[385] = c2; }
        }
    }
    float S[64];
    {
        const float* srow = p.st_S + ((size_t)(sb * 8 + h) * 64 + lane) * 64;
#pragma unroll
        for (int q = 0; q < 16; ++q) { const float4 v = *(const float4*)(srow + q * 4); S[4 * q] = v.x; S[4 * q + 1] = v.y; S[4 * q + 2] = v.z; S[4 * q + 3] = v.w; }
    }
    wave_lds_fence();
#pragma unroll 1
    for (int t = 0; t < 8; ++t) {
        const float* w = wsm + t * 400;
        float p1 = 0.f, p2 = 0.f;
#pragma unroll
        for (int q = 0; q < 16; ++q) {
            const float4 k4 = *(const float4*)(w + q * 4), r4 = *(const float4*)(w + 256 + q * 4);
            p1 += S[4 * q] * k4.x + S[4 * q + 1] * k4.y + S[4 * q + 2] * k4.z + S[4 * q + 3] * k4.w;
            p2 += S[4 * q] * r4.x + S[4 * q + 1] * r4.y + S[4 * q + 2] * r4.z + S[4 * q + 3] * r4.w;
        }
        const float vi = w[320 + lane];
        const float y = p2 - p1 * w[384] + vi * w[385];
#pragma unroll
        for (int q = 0; q < 16; ++q) {
            const float4 d4 = *(const float4*)(w + 64 + q * 4), a4 = *(const float4*)(w + 128 + q * 4), k4 = *(const float4*)(w + 192 + q * 4);
            S[4 * q] = S[4 * q] * d4.x + vi * k4.x - p1 * a4.x;
            S[4 * q + 1] = S[4 * q + 1] * d4.y + vi * k4.y - p1 * a4.y;
            S[4 * q + 2] = S[4 * q + 2] * d4.z + vi * k4.z - p1 * a4.z;
            S[4 * q + 3] = S[4 * q + 3] * d4.w + vi * k4.w - p1 * a4.w;
        }
        p.Yraw[(size_t)(m0 + t) * 512 + hj] = f2bf(y);
    }
    {
        float* o = p.out + O_SS + ((size_t)(sb * 8 + h) * 64 + lane) * 64;
#pragma unroll
        for (int q = 0; q < 16; ++q) { float4 v; v.x = S[4 * q]; v.y = S[4 * q + 1]; v.z = S[4 * q + 2]; v.w = S[4 * q + 3]; *(float4*)(o + q * 4) = v; }
    }
    wave_lds_fence();
}

__device__ void mlstm_sample_wave(const Params& p, int sb, int h, float* wsm) {
    const int lane = otid() & 63;
    const int qc = h * 64 + lane;
    const int m0 = M_P + sb * 8;
    float gi = 0.f, gl = 0.f;
    {
        float xq[11], xk[11];
#pragma unroll
        for (int r = 0; r < 3; ++r) { const float* st = p.st_conv + ((size_t)sb * 3 + r) * 1024 + qc; xq[r] = st[0]; xk[r] = st[512]; }
#pragma unroll
        for (int t = 0; t < 8; ++t) { const bf16_t* pr = p.P + (size_t)(m0 + t) * NP + C_QK + qc; xq[3 + t] = bf2f(pr[0]); xk[3 + t] = bf2f(pr[512]); }
#pragma unroll
        for (int t = 0; t < 8; ++t) {
            const bf16_t* pr = p.P + (size_t)(m0 + t) * NP;
            wsm[1024 + t * 64 + lane] = bf2f(pr[C_VB + qc]); wsm[1536 + t * 64 + lane] = bf2f(pr[C_OB + qc]); wsm[2048 + t * 64 + lane] = bf2f(pr[C_ZB + qc]);
        }
        if (lane < 8) {
            const bf16_t* pr = p.P + (size_t)(m0 + lane) * NP;
            gi = bf2f(pr[C_IB + h]) + p.b_i[h];
            const float f = bf2f(pr[C_FB + h]) + p.b_f[h];
            gl = f > 0.f ? -log1pf(__expf(-f)) : f - log1pf(__expf(f));
        }
        const float cwq0 = p.conv_w[qc], cwq1 = p.conv_w[1024 + qc], cwq2 = p.conv_w[2048 + qc], cwq3 = p.conv_w[3072 + qc];
        const float cwk0 = p.conv_w[512 + qc], cwk1 = p.conv_w[1536 + qc], cwk2 = p.conv_w[2560 + qc], cwk3 = p.conv_w[3584 + qc];
        const float cbq = p.conv_b[qc], cbk = p.conv_b[512 + qc];
#pragma unroll
        for (int t = 0; t < 8; ++t) {
            wsm[t * 64 + lane] = silu(cbq + xq[t] * cwq0 + xq[t + 1] * cwq1 + xq[t + 2] * cwq2 + xq[t + 3] * cwq3);
            wsm[512 + t * 64 + lane] = silu(cbk + xk[t] * cwk0 + xk[t + 1] * cwk1 + xk[t + 2] * cwk2 + xk[t + 3] * cwk3) * 0.125f;
        }
    }
    const float gnw = p.gn_w[qc];
    float C[64];
    {
        const float* crow = p.st_C + ((size_t)(sb * 8 + h) * 64 + lane) * 64;
#pragma unroll
        for (int q = 0; q < 16; ++q) { const float4 v = *(const float4*)(crow + q * 4); C[4 * q] = v.x; C[4 * q + 1] = v.y; C[4 * q + 2] = v.z; C[4 * q + 3] = v.w; }
    }
    float nl = p.st_n[(size_t)(sb * 8 + h) * 64 + lane];
    float m = p.st_m[sb * 8 + h];
    wave_lds_fence();
#pragma unroll 1
    for (int t = 0; t < 8; ++t) {
        const float it = rdlane(gi, t), lf = rdlane(gl, t);
        const float mt = fmaxf(lf + m, it);
        const float fdec = __expf(lf + m - mt), iw = __expf(it - mt);
        m = mt;
        const float ql = wsm[t * 64 + lane], kl = wsm[512 + t * 64 + lane];
        nl = fdec * nl + iw * kl;
        const float den = wave_sum_fast(nl * ql);
        const float ai = iw * wsm[1024 + t * 64 + lane];
        float num = 0.f;
#pragma unroll
        for (int q = 0; q < 16; ++q) {
            const float4 k4 = *(const float4*)(wsm + 512 + t * 64 + q * 4), q4 = *(const float4*)(wsm + t * 64 + q * 4);
            C[4 * q] = fdec * C[4 * q] + ai * k4.x; C[4 * q + 1] = fdec * C[4 * q + 1] + ai * k4.y;
            C[4 * q + 2] = fdec * C[4 * q + 2] + ai * k4.z; C[4 * q + 3] = fdec * C[4 * q + 3] + ai * k4.w;
            num += C[4 * q] * q4.x + C[4 * q + 1] * q4.y + C[4 * q + 2] * q4.z + C[4 * q + 3] * q4.w;
        }
        const float hv = num / fmaxf(fabsf(den), __expf(-mt));
        const float ms = wave_sum_fast(hv * hv) * (1.f / 64.f);
        p.OutB[(size_t)(m0 + t) * 512 + qc] = f2bf(sigm(wsm[1536 + t * 64 + lane]) * hv * rsqrtf(ms + 1e-6f) * gnw * silu(wsm[2048 + t * 64 + lane]));
    }
    {
        float* o = p.out + O_SC + ((size_t)(sb * 8 + h) * 64 + lane) * 64;
#pragma unroll
        for (int q = 0; q < 16; ++q) { float4 v; v.x = C[4 * q]; v.y = C[4 * q + 1]; v.z = C[4 * q + 2]; v.w = C[4 * q + 3]; *(float4*)(o + q * 4) = v; }
        p.out[O_SN + (size_t)(sb * 8 + h) * 64 + lane] = nl;
        if (lane == 0) p.out[O_SM + sb * 8 + h] = m;
    }
    wave_lds_fence();
}

__device__ void phaseE(const Params& p, float* sm, int bid, int nb) {
    constexpr int N_RP = 192, N_MP = 64, N_RS = 128, N_MS = 128;
    int* s_item = (int*)(sm + 32768);
    for (;;) {
        if (otid() == 0) *s_item = (int)atomicAdd(p.ctr, 1u);
        __syncthreads();
        const int it = *s_item;
        __syncthreads();
        if (it >= N_RP + N_MP + N_RS + N_MS) break;
        if (it < N_RP) { rwkv_item(p, it / 24, (it / 3) & 7, it % 3, sm); }
        else if (it < N_RP + N_MP) { const int i = it - N_RP; mlstm_prompt(p, i >> 3, i & 7, sm); }
        else if (it < N_RP + N_MP + N_RS) { const int wid = otid() >> 6; const int i = (it - N_RP - N_MP) * 8 + wid; rwkv_sample_wave(p, i >> 3, i & 7, sm + wid * 3328); }
        else if (it < N_RP + N_MP + N_RS + N_MS) { const int wid = otid() >> 6; const int i = (it - N_RP - N_MP - N_RS) * 8 + wid; mlstm_sample_wave(p, i >> 3, i & 7, sm + wid * 3328); }
    }
}

__device__ void phaseF(const Params& p, int bid, int nb) {
    const int wid = otid() >> 6, lane = otid() & 63;
    const int c8 = lane * 8;
    float lnw[8], lnb[8], mur[8], muk[8], muv[8], kaw[8], rkw[8];
#pragma unroll
    for (int i = 0; i < 8; ++i) {
        lnw[i] = p.ln_w[c8 + i]; lnb[i] = p.ln_b[c8 + i]; mur[i] = p.mu_shift[C_R + c8 + i]; muk[i] = p.mu_shift[C_K + c8 + i];
        muv[i] = p.mu_shift[C_V + c8 + i]; kaw[i] = p.k_a[c8 + i]; rkw[i] = p.r_k[c8 + i];
    }
    auto un8 = [](const uint4 u, float* o) {
        o[0] = __uint_as_float(u.x << 16); o[1] = __uint_as_float(u.x & 0xFFFF0000u); o[2] = __uint_as_float(u.y << 16); o[3] = __uint_as_float(u.y & 0xFFFF0000u);
        o[4] = __uint_as_float(u.z << 16); o[5] = __uint_as_float(u.z & 0xFFFF0000u); o[6] = __uint_as_float(u.w << 16); o[7] = __uint_as_float(u.w & 0xFFFF0000u);
    };
    struct FR { uint4 uy, ur, uk, uv, uz, ua, urp, ukp, uvp; };
    auto loadF = [&](int m, FR& q) {
        int s, t; tok_info(m, s, t);
        const bf16_t* pr = p.P + (size_t)m * NP + c8;
        const bf16_t* pp = t > 0 ? pr - NP : pr;
        q.uy = *(const uint4*)(p.Yraw + (size_t)m * 512 + c8);
        q.ur = *(const uint4*)(pr + C_R); q.uk = *(const uint4*)(pr + C_K); q.uv = *(const uint4*)(pr + C_V); q.uz = *(const uint4*)(pr + C_ZA);
        q.ua = *(const uint4*)(p.Aa + (size_t)m * 512 + c8);
        q.urp = *(const uint4*)(pp + C_R); q.ukp = *(const uint4*)(pp + C_K); q.uvp = *(const uint4*)(pp + C_V);
    };
    auto computeF = [&](int m, const FR& q) {
        int s, t; tok_info(m, s, t);
        float y[8], r[8], k[8], v[8], z[8], a[8], rp[8], kp_[8], vp[8];
        if (t > 0) { un8(q.urp, rp); un8(q.ukp, kp_); un8(q.uvp, vp); }
        else if (s >= 8) {
            const float* st = p.st_shift + (size_t)(s - 8) * SHIFT_W + c8;
#pragma unroll
            for (int i = 0; i < 8; ++i) { rp[i] = st[C_R + i]; kp_[i] = st[C_K + i]; vp[i] = st[C_V + i]; }
        } else {
#pragma unroll
            for (int i = 0; i < 8; ++i) { rp[i] = 0.f; kp_[i] = 0.f; vp[i] = 0.f; }
        }
        un8(q.uy, y); un8(q.ur, r); un8(q.uk, k); un8(q.uv, v); un8(q.uz, z); un8(q.ua, a);
        float sy = 0.f;
#pragma unroll
        for (int i = 0; i < 8; ++i) sy += y[i];
        const float mean = sum8(sy) * (1.f / 64.f);
        float sv = 0.f, sbn = 0.f;
#pragma unroll
        for (int i = 0; i < 8; ++i) {
            y[i] -= mean; sv += y[i] * y[i];
            r[i] += mur[i] * (rp[i] - r[i]); k[i] += muk[i] * (kp_[i] - k[i]); v[i] += muv[i] * (vp[i] - v[i]);
            sbn += r[i] * (k[i] * (1.f + (a[i] - 1.f) * kaw[i])) * rkw[i];
        }
        const float rstd = rsqrtf(sum8(sv) * (1.f / 64.f) + 64e-5f);
        const float bonus = sum8(sbn);
        float o[8];
#pragma unroll
        for (int i = 0; i < 8; ++i) o[i] = (y[i] * rstd * lnw[i] + lnb[i] + bonus * v[i]) * silu(z[i]);
        uint4 ou; ou.x = pk2(o[0], o[1]); ou.y = pk2(o[2], o[3]); ou.z = pk2(o[4], o[5]); ou.w = pk2(o[6], o[7]);
        *(uint4*)(p.OutA + (size_t)m * 512 + c8) = ou;
    };
    const int stride = nb * 8;
    for (int m = bid * 8 + wid; m < M_TOT; m += 2 * stride) {
        const int m2 = m + stride; const bool has2 = m2 < M_TOT;
        FR qa, qb;
        loadF(m, qa); loadF(has2 ? m2 : m, qb);
        computeF(m, qa);
        if (has2) computeF(m2, qb);
    }
}

__device__ __forceinline__ void yrow_store(const Params& p, float* yr, int lane, const float4 (&v)[4], float rstd) {
#pragma unroll
    for (int i = 0; i < 4; ++i) {
        const int c = i * 256 + lane * 4;
        const float4 g = *(const float4*)(p.g_final + c);
        float4 o; o.x = v[i].x * rstd * g.x; o.y = v[i].y * rstd * g.y; o.z = v[i].z * rstd * g.z; o.w = v[i].w * rstd * g.w;
        *(float4*)(yr + c) = o;
    }
}
__device__ void phaseI(const Params& p, int bid, int nb) {
    const int wid = otid() >> 6, lane = otid() & 63;
    const int stride = nb * 8;
    for (int m = bid * 8 + wid; m < M_TOT; m += 2 * stride) {
        const int m2 = m + stride;
        const bool has2 = m2 < M_TOT;
        float* ya = p.out + (size_t)m * 1024;
        float* yb = p.out + (size_t)(has2 ? m2 : m) * 1024;
        float4 va[4], vb[4];
        normrow_load(ya, lane, va);
        normrow_load(yb, lane, vb);
        const float ra = rsqrtf(wave_sum(sumsq4(va)) * (1.f / 1024.f) + 1e-6f);
        const float rb = rsqrtf(wave_sum(sumsq4(vb)) * (1.f / 1024.f) + 1e-6f);
        yrow_store(p, ya, lane, va, ra);
        if (has2) yrow_store(p, yb, lane, vb, rb);
    }
}

namespace pg8 {
#define PG8_LAS __attribute__((address_space(3)))
typedef unsigned short bf16_t;
typedef short bf16x8 __attribute__((ext_vector_type(8)));
typedef float f32x4 __attribute__((ext_vector_type(4)));
typedef unsigned u32x4 __attribute__((ext_vector_type(4)));
constexpr int BM = 256, BK = 64, HALF = 128, HTB = HALF * BK * 2  , STAGE_BYTES = 8 * HTB, NXCD = 8, WGM = 8;

__host__ __device__ __forceinline__ int lds_byte(int r, int c) { const int st = (r >> 4) * 2 + (c >> 5), rr = r & 15, cc = c & 31, ob = rr * 64 + cc * 2; return st * 1024 + (ob ^ (((ob >> 9) & 1) << 5)); }
__host__ __device__ __forceinline__ void stage_rc(int b, int& R, int& C) { const int st = b / 1024, sb = b % 1024, swz = sb ^ (((sb >> 9) & 1) << 5); R = (st >> 1) * 16 + swz / 64; C = (st & 1) * 32 + (swz % 64) / 2; }
__host__ __device__ __forceinline__ int perm32(int rho) { const int n = rho >> 4, i = rho & 15; return 8 * (i >> 2) + 4 * n + (i & 3); }

struct Unit { int pm, pn; };
struct Gemm { const bf16_t* A; const bf16_t* Bt; int M, N, K, lda, ldb; };

struct StaticOrder {
    int nM, nN, nwg, G, c;
    __host__ __device__ void init(int M, int N, int G_, int c_) { nM = M / BM; nN = N / BM; nwg = nM * nN; G = G_; c = c_; }
    __host__ __device__ bool next(int i, Unit& u) const {
        const long L = (long)i * G + c; if (L >= nwg) return false;
        int wgid = (int)L; { const int q = nwg / NXCD, r = nwg % NXCD, xcd = wgid % NXCD, off = wgid / NXCD; wgid = (xcd < r ? xcd * (q + 1) : r * (q + 1) + (xcd - r) * q) + off; }
        const int nig = WGM * nN, gid = wgid / nig, fm = gid * WGM, gsz = (nM - fm) < WGM ? (nM - fm) : WGM;
        u.pm = fm + ((wgid % nig) % gsz); u.pn = (wgid % nig) / gsz; return true;
    }
    __device__ __forceinline__ void a_ready(const Unit&) const {}
    __device__ __forceinline__ void done(const Unit&) const {}
};
template <class Epi, class Sched, bool STAMP = false>
__device__ __forceinline__ void gemm_phase(PG8_LAS unsigned char* lds, const Gemm g, const Sched& S, const Epi& E, unsigned long long* stamps) {
    const int tid = otid(), wid = __builtin_amdgcn_readfirstlane(tid >> 6), lane = tid & 63, wr = wid >> 2, wc = wid & 3, fr = lane & 15, fq = lane >> 4;
    const int K = g.K, nt = K / BK;
    int ts_lo = 0, ts_hi = 0, nts = 0; const unsigned long long rt_entry = STAMP ? (unsigned long long)wall_clock64() : 0ull;
#define PG8_STAMP() do { if (STAMP && wid == 0 && nts < 64) { const unsigned long long _c = (unsigned long long)clock64(); \
        ts_lo = (lane == nts) ? (int)(unsigned)_c : ts_lo; ts_hi = (lane == nts) ? (int)(unsigned)(_c >> 32) : ts_hi; ++nts; } } while (0)
    PG8_STAMP();
    unsigned voffA[2], voffB[2];
#pragma unroll
    for (int i = 0; i < 2; ++i) { int R, C; stage_rc(tid * 16 + i * 8192, R, C); const int Rb = Epi::PERM ? ((R & ~31) + perm32(R & 31)) : R;
        voffA[i] = (unsigned)(R * g.lda + C) * 2u; voffB[i] = (unsigned)(Rb * g.ldb + C) * 2u; }
    const size_t kstep = (size_t)(BK * 2);
    const size_t hstepA = (size_t)HALF * g.lda * 2, hstepB = (size_t)HALF * g.ldb * 2;
    const size_t tstepA = 2 * hstepA, tstepB = 2 * hstepB;
    const unsigned ldsw = (unsigned)wid * 1024u;
    const int aoff = lds_byte(wr * 64 + fr, fq * 8), boff = lds_byte(wc * 32 + fr, fq * 8);
#define PG8_SA(b, h) (((b) * 2 + (h)) * HTB)
#define PG8_SB(b, h) ((4 + (b) * 2 + (h)) * HTB)
#define PG8_STAGE(bufoff, gbase, voff) do { _Pragma("unroll") for (int _i = 0; _i < 2; ++_i) \
        __builtin_amdgcn_global_load_lds((const unsigned*)((const char*)(gbase) + (voff)[_i]), (PG8_LAS unsigned*)(lds + (bufoff) + ldsw + _i * 8192), 16, 0, 0); } while (0)
#define PG8_LDA(dst, b, h) do { _Pragma("unroll") for (int m = 0; m < 4; ++m) _Pragma("unroll") for (int k = 0; k < 2; ++k) dst[m][k] = *(const PG8_LAS bf16x8*)(lds + PG8_SA(b, h) + aoff + m * 2048 + k * 1024); } while (0)
#define PG8_LDB(dst, b, h) do { _Pragma("unroll") for (int n = 0; n < 2; ++n) _Pragma("unroll") for (int k = 0; k < 2; ++k) dst[n][k] = *(const PG8_LAS bf16x8*)(lds + PG8_SB(b, h) + boff + n * 2048 + k * 1024); } while (0)
#define PG8_MMA(ai, bj, At, Bt) do { __builtin_amdgcn_s_setprio(1); _Pragma("unroll") for (int m = 0; m < 4; ++m) _Pragma("unroll") for (int n = 0; n < 2; ++n) _Pragma("unroll") for (int k = 0; k < 2; ++k) \
        acc[ai][bj][m][n] = __builtin_amdgcn_mfma_f32_16x16x32_bf16(Bt[n][k], At[m][k], acc[ai][bj][m][n], 0, 0, 0); __builtin_amdgcn_s_setprio(0); } while (0)
#define PG8_WAIT_V(n) asm volatile("s_waitcnt vmcnt(" #n ")" ::: "memory")
#define PG8_WAIT_L(n) asm volatile("s_waitcnt lgkmcnt(" #n ")" ::: "memory")
#define PG8_BAR __builtin_amdgcn_s_barrier()
#define PG8_SCHED __builtin_amdgcn_sched_barrier(0)
    Unit cur, nxt; int ui = 0;
    if (!S.next(0, cur)) return;
    f32x4 acc[2][2][4][2];
#pragma unroll
    for (int a = 0; a < 2; ++a)
#pragma unroll
        for (int b = 0; b < 2; ++b)
#pragma unroll
            for (int m = 0; m < 4; ++m)
#pragma unroll
                for (int n = 0; n < 2; ++n) acc[a][b][m][n] = (f32x4){0.f, 0.f, 0.f, 0.f};
    bf16x8 At[4][2], B0[2][2], B1[2][2];
    const char* cA = (const char*)g.A + (size_t)cur.pm * tstepA; const char* cB = (const char*)g.Bt + (size_t)cur.pn * tstepB;
    S.a_ready(cur);
    PG8_STAGE(PG8_SB(0, 0), cB, voffB); PG8_STAGE(PG8_SA(0, 0), cA, voffA); PG8_STAGE(PG8_SB(0, 1), cB + hstepB, voffB); PG8_STAGE(PG8_SA(0, 1), cA + hstepA, voffA);
    if (wr == 1) PG8_BAR;
    PG8_WAIT_V(4); PG8_BAR;
    PG8_STAGE(PG8_SB(1, 0), cB + kstep, voffB); PG8_STAGE(PG8_SA(1, 0), cA + kstep, voffA); PG8_STAGE(PG8_SB(1, 1), cB + hstepB + kstep, voffB);
    PG8_WAIT_V(6); PG8_BAR;
    PG8_STAMP();
    for (;;) {
        const bool has_next = S.next(ui + 1, nxt);
        const char* nA = has_next ? (const char*)g.A + (size_t)nxt.pm * tstepA : cA; const char* nB = has_next ? (const char*)g.Bt + (size_t)nxt.pn * tstepB : cB;
        for (int t = 0; t < nt; t += 2) {
            const bool last = (t == nt - 2);
            const char* a1 = cA + (size_t)(t + 1) * kstep;
            const char* a2 = last ? nA : cA + (size_t)(t + 2) * kstep; const char* b2 = last ? nB : cB + (size_t)(t + 2) * kstep;
            const char* a3 = a2 + kstep; const char* b3 = b2 + kstep;
            if (last && has_next) S.a_ready(nxt);
            PG8_LDB(B0, 0, 0); PG8_SCHED; PG8_LDA(At, 0, 0); PG8_STAGE(PG8_SA(1, 1), a1 + hstepA, voffA);
            PG8_WAIT_L(8); PG8_BAR; PG8_WAIT_L(0); PG8_MMA(0, 0, At, B0); PG8_BAR; PG8_SCHED;
            PG8_LDB(B1, 0, 1); PG8_STAGE(PG8_SB(0, 0), b2, voffB);
            PG8_BAR; PG8_WAIT_L(0); PG8_MMA(0, 1, At, B1); PG8_BAR;
            PG8_LDA(At, 0, 1); PG8_STAGE(PG8_SA(0, 0), a2, voffA);
            PG8_BAR; PG8_WAIT_L(0); PG8_MMA(1, 0, At, B0); PG8_BAR; PG8_SCHED;
            PG8_STAGE(PG8_SB(0, 1), b2 + hstepB, voffB);
            PG8_WAIT_V(6); PG8_BAR; PG8_MMA(1, 1, At, B1); PG8_BAR;
            PG8_LDB(B0, 1, 0); PG8_SCHED; PG8_LDA(At, 1, 0); PG8_STAGE(PG8_SA(0, 1), a2 + hstepA, voffA);
            PG8_WAIT_L(8); PG8_BAR; PG8_WAIT_L(0); PG8_MMA(0, 0, At, B0); PG8_BAR; PG8_SCHED;
            PG8_LDB(B1, 1, 1); PG8_STAGE(PG8_SB(1, 0), b3, voffB);
            PG8_BAR; PG8_WAIT_L(0); PG8_MMA(0, 1, At, B1); PG8_BAR;
            PG8_LDA(At, 1, 1); PG8_STAGE(PG8_SA(1, 0), a3, voffA);
            PG8_BAR; PG8_WAIT_L(0); PG8_MMA(1, 0, At, B0); PG8_BAR; PG8_SCHED;
            PG8_STAGE(PG8_SB(1, 1), b3 + hstepB, voffB);
            PG8_WAIT_V(6); PG8_BAR; PG8_MMA(1, 1, At, B1); PG8_BAR;
        }
        PG8_STAMP();
        if constexpr (!Epi::AFTER_DRAIN) { E(acc, cur, wr, wc, fr, fq); S.done(cur); }
        PG8_STAMP();
        if (!has_next) break;
#pragma unroll
        for (int a = 0; a < 2; ++a)
#pragma unroll
            for (int b = 0; b < 2; ++b)
#pragma unroll
                for (int m = 0; m < 4; ++m)
#pragma unroll
                    for (int n = 0; n < 2; ++n) acc[a][b][m][n] = (f32x4){0.f, 0.f, 0.f, 0.f};
        cur = nxt; cA = nA; cB = nB; ++ui;
    }
    PG8_WAIT_V(0);
    if (wr == 0) PG8_BAR;
    PG8_BAR;
    if constexpr (Epi::AFTER_DRAIN) { E.fused(acc, cur, wr, wc, fr, fq, lds, wid, lane); S.done(cur); }
    PG8_STAMP();
    if (STAMP && wid == 0) { stamps[lane] = lane < nts ? (((unsigned long long)(unsigned)ts_hi << 32) | (unsigned)ts_lo) : 0ull;
        if (lane == 62) stamps[62] = rt_entry; if (lane == 63) stamps[63] = (unsigned long long)wall_clock64(); }
#undef PG8_STAMP
#undef PG8_SA
#undef PG8_SB
#undef PG8_STAGE
#undef PG8_LDA
#undef PG8_LDB
#undef PG8_MMA
#undef PG8_WAIT_V
#undef PG8_WAIT_L
#undef PG8_BAR
#undef PG8_SCHED
}
}

struct EpiP {
    static constexpr bool PERM = true, AFTER_DRAIN = false;
    bf16_t* O; int ldc;
    __device__ __forceinline__ void operator()(const f32x4 (&acc)[2][2][4][2], const pg8::Unit& u, int wr, int wc, int fr, int fq) const {
        const int row0 = u.pm * 256 + wr * 64 + fr, col0 = u.pn * 256 + wc * 32 + 8 * fq;
#pragma unroll
        for (int ai = 0; ai < 2; ++ai)
#pragma unroll
            for (int m = 0; m < 4; ++m) {
                bf16_t* rowp = O + (size_t)(row0 + ai * 128 + m * 16) * ldc + col0;
#pragma unroll
                for (int bj = 0; bj < 2; ++bj) {
                    const f32x4 v0 = acc[ai][bj][m][0], v1 = acc[ai][bj][m][1];
                    uint4 o; o.x = pk2(v0[0], v0[1]); o.y = pk2(v0[2], v0[3]); o.z = pk2(v1[0], v1[1]); o.w = pk2(v1[2], v1[3]);
                    *(uint4*)(rowp + bj * 128) = o;
                }
            }
    }
};
template <int SECOND> struct EpiMerge {
    static constexpr bool PERM = true, AFTER_DRAIN = false;
    bf16_t* P; int gcol;
    __device__ __forceinline__ void operator()(const f32x4 (&acc)[2][2][4][2], const pg8::Unit& u, int wr, int wc, int fr, int fq) const {
        const int row0 = u.pm * 256 + wr * 64 + fr, col0 = u.pn * 256 + wc * 32 + 8 * fq;
#pragma unroll
        for (int ai = 0; ai < 2; ++ai) {
            uint4 gq[4][2], pq[4][2];
#pragma unroll
            for (int m = 0; m < 4; ++m) {
                const bf16_t* rowp = P + (size_t)(row0 + ai * 128 + m * 16) * NP + col0;
#pragma unroll
                for (int bj = 0; bj < 2; ++bj) {
                    gq[m][bj] = *(const uint4*)(rowp + gcol + bj * 128);
                    if (SECOND) pq[m][bj] = *(const uint4*)(rowp + bj * 128);
                }
            }
#pragma unroll
            for (int m = 0; m < 4; ++m) {
                bf16_t* rowp = P + (size_t)(row0 + ai * 128 + m * 16) * NP + col0;
#pragma unroll
                for (int bj = 0; bj < 2; ++bj) {
                    const f32x4 v0 = acc[ai][bj][m][0], v1 = acc[ai][bj][m][1];
                    const uint4 g = gq[m][bj];
                    const float4 ga = unpk4(make_uint2(g.x, g.y)), gb = unpk4(make_uint2(g.z, g.w));
                    float r[8] = {sigm(ga.x) * v0[0], sigm(ga.y) * v0[1], sigm(ga.z) * v0[2], sigm(ga.w) * v0[3],
                                  sigm(gb.x) * v1[0], sigm(gb.y) * v1[1], sigm(gb.z) * v1[2], sigm(gb.w) * v1[3]};
                    if (SECOND) {
                        const uint4 pv = pq[m][bj];
                        const float4 pa = unpk4(make_uint2(pv.x, pv.y)), pb = unpk4(make_uint2(pv.z, pv.w));
                        r[0] += pa.x; r[1] += pa.y; r[2] += pa.z; r[3] += pa.w; r[4] += pb.x; r[5] += pb.y; r[6] += pb.z; r[7] += pb.w;
                    }
                    uint4 o; o.x = pk2(r[0], r[1]); o.y = pk2(r[2], r[3]); o.z = pk2(r[4], r[5]); o.w = pk2(r[6], r[7]);
                    *(uint4*)(rowp + bj * 128) = o;
                }
            }
        }
    }
};
struct EpiOut {
    static constexpr bool PERM = false, AFTER_DRAIN = false;
    const Params* pp;
    __device__ __forceinline__ void operator()(const f32x4 (&acc)[2][2][4][2], const pg8::Unit& u, int wr, int wc, int fr, int fq) const {
        const Params& p = *pp;
        const int row0 = u.pm * 256 + wr * 64 + fr, col0 = u.pn * 256 + wc * 32 + 4 * fq;
#pragma unroll
        for (int ai = 0; ai < 2; ++ai)
#pragma unroll
            for (int mp = 0; mp < 2; ++mp) {
                float4 xq[2][4], gq[2][4];
#pragma unroll
                for (int mm = 0; mm < 2; ++mm) {
                    const int row = row0 + ai * 128 + (mp * 2 + mm) * 16;
                    int s, t; tok_info(row, s, t);
                    const float* xr = xrow(p, row) + col0;
                    const float* gt = p.mod + (size_t)s * 3072 + 2048 + col0;
#pragma unroll
                    for (int q = 0; q < 4; ++q) { const int co = (q >> 1) * 128 + (q & 1) * 16; xq[mm][q] = *(const float4*)(xr + co); gq[mm][q] = *(const float4*)(gt + co); }
                }
#pragma unroll
                for (int mm = 0; mm < 2; ++mm) {
                    const int m = mp * 2 + mm, row = row0 + ai * 128 + m * 16;
                    float* orow = p.out + (size_t)row * 1024 + col0;
#pragma unroll
                    for (int q = 0; q < 4; ++q) {
                        const int bj = q >> 1, n = q & 1, co = bj * 128 + n * 16;
                        const float4 xv = xq[mm][q], gv = gq[mm][q];
                        const f32x4 a = acc[ai][bj][m][n];
                        float4 o; o.x = xv.x + gv.x * a[0]; o.y = xv.y + gv.y * a[1]; o.z = xv.z + gv.z * a[2]; o.w = xv.w + gv.w * a[3];
                        *(float4*)(orow + co) = o;
                    }
                }
            }
    }
};
template <class Epi> __device__ __forceinline__ void run_gemm(float* sm, const bf16_t* A, int lda, const bf16_t* Bt, int ldb, int M, int N, int K, const Epi& E, int bid, int nb) {
    pg8::Gemm g; g.A = A; g.Bt = Bt; g.M = M; g.N = N; g.K = K; g.lda = lda; g.ldb = ldb;
    pg8::StaticOrder S; S.init(M, N, nb, bid);
    pg8::gemm_phase<Epi, pg8::StaticOrder, false>((PG8_LAS unsigned char*)sm, g, S, E, nullptr);
}
__device__ void phaseC(const Params& p, float* sm, int bid, int nb) {
    EpiP E; E.O = p.P; E.ldc = NP;
    run_gemm(sm, p.H, 1024, p.WinT, 1024, M_TOT, NP, 1024, E, bid, nb);
}
__device__ void phaseG(const Params& p, float* sm, int bid, int nb) {
    EpiMerge<0> E0; E0.P = p.P; E0.gcol = C_GLA;
    run_gemm(sm, p.OutA, 512, p.WupaT, 512, M_TOT, 1024, 512, E0, bid, nb);
    __syncthreads();
    EpiMerge<1> E1; E1.P = p.P; E1.gcol = C_GLB;
    run_gemm(sm, p.OutB, 512, p.WupbT, 512, M_TOT, 1024, 512, E1, bid, nb);
}
__device__ void phaseH(const Params& p, float* sm, int bid, int nb) {
    EpiOut E; E.pp = &p;
    run_gemm(sm, p.P, NP, p.WoutT, 1024, M_TOT, 1024, 1024, E, bid, nb);
}

#define XB_TMO      128
#define XB_XCNT(j)  (256  + 64 * (j))
#define XB_XSUB(j)  (1280 + 64 * (j))
#define XB_XGEN(j)  (2304 + 64 * (j))
#define XB_TOP      3328
#define XB_TOPGEN   3392
#define XCD_BAR_WORDS 3456
#define XB_SPIN_CAP (1u << 18)
#define LAS __attribute__((address_space(3)))

__device__ __forceinline__ unsigned xb_ld(unsigned* p)              { return __hip_atomic_load(p, __ATOMIC_RELAXED, __HIP_MEMORY_SCOPE_AGENT); }
__device__ __forceinline__ unsigned xb_add(unsigned* p, unsigned v) { return __hip_atomic_fetch_add(p, v, __ATOMIC_RELAXED, __HIP_MEMORY_SCOPE_AGENT); }
__device__ __forceinline__ unsigned xb_xcc_id() { return (unsigned)__builtin_amdgcn_s_getreg((3 << 11) | 20) & 0xFu; }
#define XB_SPIN(cond, bar) do { unsigned _sp = 0; while (cond) { __builtin_amdgcn_s_sleep(1); \
    if ((++_sp & 255u) == 0u) { if (xb_ld(&(bar)[XB_TMO])) break; if (_sp > XB_SPIN_CAP) { atomicAdd(&(bar)[XB_TMO], 1u); break; } } } } while (0)

struct XcdBarrier {
    unsigned* bar; unsigned x;
    volatile LAS unsigned* st;
};

__device__ __forceinline__ XcdBarrier xcd_barrier_post(unsigned* bar, volatile LAS unsigned* st) {
    XcdBarrier b; b.bar = bar; b.x = xb_xcc_id(); b.st = st;
    if (threadIdx.x == 0) (void)xb_add(&bar[XB_XCNT(b.x)], 1u);
    return b;
}
__device__ __forceinline__ void xcd_barrier_complete(unsigned* bar, unsigned x, unsigned& nloc, unsigned& nx) {
    const unsigned G = gridDim.x * gridDim.y * gridDim.z;
    unsigned sum, cnt, mine, sp = 0u;
    for (;;) {
        sum = 0u; cnt = 0u; mine = 0u;
#pragma unroll
        for (unsigned j = 0; j < 16; ++j) { const unsigned c = xb_ld(&bar[XB_XCNT(j)]); sum += c; cnt += (c > 0u) ? 1u : 0u; mine = (j == x) ? c : mine; }
        if (sum == G) break;
        __builtin_amdgcn_s_sleep(1);
        if ((++sp & 255u) == 0u) { if (xb_ld(&bar[XB_TMO])) break; if (sp > XB_SPIN_CAP) { atomicAdd(&bar[XB_TMO], 1u); break; } }
    }
    nloc = mine > 0u ? mine : 1u; nx = cnt > 0u ? cnt : 1u;
}

__device__ __forceinline__ void xcd_barrier(const XcdBarrier& b) {
    asm volatile("s_waitcnt vmcnt(0)" ::: "memory");
    __syncthreads();
    if (threadIdx.x == 0) {
        unsigned* bar = b.bar;
        __builtin_amdgcn_s_waitcnt(0);
        unsigned nloc = b.st[0], nx = b.st[1];
        if (nloc == 0u) { xcd_barrier_complete(bar, b.x, nloc, nx); b.st[0] = nloc; b.st[1] = nx; }
        const unsigned old = xb_add(&bar[XB_XSUB(b.x)], 1u);
        const unsigned gen = old / nloc;
        if (old + 1u == (gen + 1u) * nloc) {
            __builtin_amdgcn_fence(__ATOMIC_RELEASE, "agent");
            asm volatile("s_waitcnt vmcnt(0)" ::: "memory");
            const unsigned og = xb_add(&bar[XB_TOP], 1u);
            const unsigned tg = og / nx;
            if (og + 1u == (tg + 1u) * nx) xb_add(&bar[XB_TOPGEN], 1u);
            else XB_SPIN(xb_ld(&bar[XB_TOPGEN]) == tg, bar);
            __builtin_amdgcn_fence(__ATOMIC_ACQUIRE, "agent");
            xb_add(&bar[XB_XGEN(b.x)], 1u);
            asm volatile("s_waitcnt vmcnt(0)" ::: "memory");
        } else {
            XB_SPIN(xb_ld(&bar[XB_XGEN(b.x)]) == gen, bar);
            __builtin_amdgcn_fence(__ATOMIC_ACQUIRE, "agent");
            asm volatile("s_waitcnt vmcnt(0)" ::: "memory");
        }
    }
    __syncthreads();
}


#if MK_MULTI
#define PHASE_KERNEL(NAME, CALL) __global__ void __launch_bounds__(NTHR) NAME(Params p) { __shared__ __attribute__((aligned(16))) float sm[SMEM_FLOATS]; const int bid = blockIdx.x, nb = gridDim.x; (void)sm; CALL; }
PHASE_KERNEL(kA, phaseA(p, sm, bid, nb))
PHASE_KERNEL(kB, phaseB(p, bid, nb))
PHASE_KERNEL(kC, phaseC(p, sm, bid, nb))
PHASE_KERNEL(kD, phaseD(p, sm, bid, nb))
PHASE_KERNEL(kE, phaseE(p, sm, bid, nb))
PHASE_KERNEL(kF, phaseF(p, bid, nb))
PHASE_KERNEL(kG, phaseG(p, sm, bid, nb))
PHASE_KERNEL(kH, phaseH(p, sm, bid, nb))
PHASE_KERNEL(kI, phaseI(p, bid, nb))
#else
__global__ void __launch_bounds__(NTHR) fwd_megakernel(Params p) {
    __shared__ __attribute__((aligned(16))) float sm[SMEM_FLOATS];
    __shared__ uint4 xb_words;
    cg::grid_group grid = cg::this_grid();
    const int bid = blockIdx.x, nb = gridDim.x;
    if (threadIdx.x == 0) xb_words = make_uint4(0u, 0u, 0u, 0u);
    __syncthreads();
    XcdBarrier xb = xcd_barrier_post(p.bar, (volatile LAS unsigned*)&xb_words);
    phaseA(p, sm, bid, nb); grid.sync();
    phaseB(p, bid, nb); xcd_barrier(xb);
    phaseC(p, sm, bid, nb); xcd_barrier(xb);
    phaseD(p, sm, bid, nb); xcd_barrier(xb);
    phaseE(p, sm, bid, nb); xcd_barrier(xb);
    phaseF(p, bid, nb); xcd_barrier(xb);
    phaseG(p, sm, bid, nb); xcd_barrier(xb);
    phaseH(p, sm, bid, nb); xcd_barrier(xb);
    phaseI(p, bid, nb);
}
#endif

extern "C" void kernel_launch(void* const* d_in, const int* in_sizes, int n_in, void* d_out, int out_size, void* d_ws, size_t ws_size,
                              hipStream_t stream) {
    Params p{};
    const float* const* in = (const float* const*)d_in;
    p.x_p = in[0]; p.x_s = in[1]; p.c_p = in[2]; p.c_s = in[3];
    p.st_shift = in[4]; p.st_S = in[5]; p.st_conv = in[6]; p.st_C = in[7]; p.st_n = in[8]; p.st_m = in[9];
    p.g_norm = in[10]; p.w_ada = in[11]; p.b_ada = in[12]; p.w_in = in[13]; p.mu_shift = in[14]; p.w_decay2 = in[15];
    p.w0 = in[16]; p.w_iclr2 = in[17]; p.a0 = in[18]; p.k_k = in[19]; p.k_a = in[20]; p.r_k = in[21];
    p.ln_w = in[22]; p.ln_b = in[23]; p.conv_w = in[24]; p.conv_b = in[25]; p.b_i = in[26]; p.b_f = in[27];
    p.gn_w = in[28]; p.w_up_a = in[29]; p.w_up_b = in[30]; p.w_out = in[31]; p.g_final = in[32];
    p.out = (float*)d_out;
    char* ws = (char*)d_ws;
    size_t off = 0;
    p.P = (bf16_t*)(ws + off); off += (size_t)M_TOT * NP * 2;
    p.WinT = (bf16_t*)(ws + off); off += (size_t)NP * 1024 * 2;
    p.WupaT = (bf16_t*)(ws + off); off += (size_t)1024 * 512 * 2;
    p.WupbT = (bf16_t*)(ws + off); off += (size_t)1024 * 512 * 2;
    p.WoutT = (bf16_t*)(ws + off); off += (size_t)1024 * 1024 * 2;
    p.mod = (float*)(ws + off); off += (size_t)NSEQ * 3072 * 4;
    p.ctr = (unsigned*)(ws + off); off += 256;
    p.bar = (unsigned*)(ws + off); off += (size_t)XCD_BAR_WORDS * 4;
    char* os = (char*)d_out;
    p.H = (bf16_t*)os;
    p.Yraw = (bf16_t*)os;
    p.OutB = (bf16_t*)(os + (size_t)M_TOT * 512 * 2);
    p.Omd = (bf16_t*)(os + (size_t)M_TOT * 1024 * 2);
    p.Aa = (bf16_t*)(os + (size_t)M_TOT * 1024 * 2 + (size_t)M_TOT * 512 * 2);
    p.OutA = p.Omd;
#if MK_MULTI
    const int G = 1024;
    kA<<<G, NTHR, 0, stream>>>(p);
    kB<<<G, NTHR, 0, stream>>>(p);
    kC<<<G, NTHR, 0, stream>>>(p);
    kD<<<G, NTHR, 0, stream>>>(p);
    kE<<<G, NTHR, 0, stream>>>(p);
    kF<<<G, NTHR, 0, stream>>>(p);
    kG<<<G, NTHR, 0, stream>>>(p);
    kH<<<G, NTHR, 0, stream>>>(p);
    kI<<<G, NTHR, 0, stream>>>(p);
#else
    static int grid_blocks = 0;
    if (!grid_blocks) {
        int dev = 0, cus = 0, per_cu = 0;
        hipGetDevice(&dev);
        hipDeviceGetAttribute(&cus, hipDeviceAttributeMultiprocessorCount, dev);
        hipOccupancyMaxActiveBlocksPerMultiprocessor(&per_cu, fwd_megakernel, NTHR, 0);
        if (per_cu > 1) per_cu = 1;
        grid_blocks = cus * per_cu;
    }
    (void)hipMemsetAsync(p.ctr, 0, 256 + (size_t)XCD_BAR_WORDS * 4, stream);
    void* args[] = {&p};
    hipError_t e = hipLaunchCooperativeKernel((void*)fwd_megakernel, dim3(grid_blocks), dim3(NTHR), args, 0, stream);
    if (e != hipSuccess) fprintf(stderr, "cooperative launch failed: %s (grid %d)\n", hipGetErrorString(e), grid_blocks);
#endif
}
```

```cpp
#include <hip/hip_runtime.h>
#include <hip/hip_cooperative_groups.h>
#include <cstdio>
namespace cg = cooperative_groups;

#ifndef MK_MULTI
#define MK_MULTI 0
#endif

typedef unsigned short bf16_t;
typedef short bf16x8 __attribute__((ext_vector_type(8)));
typedef float f32x4 __attribute__((ext_vector_type(4)));

constexpr int NTHR = 512;
constexpr int M_P = 16384, M_S = 1024, M_TOT = 17408;
constexpr int DM = 1024;
constexpr int NSEQ = 136;
constexpr int NP = 6912;
constexpr int N_IN = 6800;
constexpr int C_R = 0, C_K = 512, C_V = 1024, C_WL = 1536, C_AL = 1600, C_ZA = 1664, C_QK = 2176,
              C_VB = 3200, C_OB = 3712, C_IB = 4224, C_FB = 4232, C_ZB = 4240, C_GLA = 4752, C_GLB = 5776;
constexpr int SHIFT_W = 1664;

constexpr size_t O_Y = 0;
constexpr size_t O_PSHIFT = (size_t)M_TOT * DM;
constexpr size_t O_PS = O_PSHIFT + 8 * 1664;
constexpr size_t O_PCONV = O_PS + 8 * 8 * 4096;
constexpr size_t O_PC = O_PCONV + 8 * 3 * 1024;
constexpr size_t O_PN = O_PC + 8 * 8 * 4096;
constexpr size_t O_PM = O_PN + 8 * 8 * 64;
constexpr size_t O_SSHIFT = O_PM + 64;
constexpr size_t O_SS = O_SSHIFT + 128 * 1664;
constexpr size_t O_SCONV = O_SS + (size_t)128 * 8 * 4096;
constexpr size_t O_SC = O_SCONV + 128 * 3 * 1024;
constexpr size_t O_SN = O_SC + (size_t)128 * 8 * 4096;
constexpr size_t O_SM = O_SN + 128 * 8 * 64;
constexpr size_t O_END = O_SM + 1024;

struct Params {
    const float *x_p, *x_s, *c_p, *c_s;
    const float *st_shift, *st_S, *st_conv, *st_C, *st_n, *st_m;
    const float *g_norm, *w_ada, *b_ada, *w_in, *mu_shift, *w_decay2, *w0, *w_iclr2, *a0, *k_k, *k_a, *r_k,
        *ln_w, *ln_b, *conv_w, *conv_b, *b_i, *b_f, *gn_w, *w_up_a, *w_up_b, *w_out, *g_final;
    float* out;
    bf16_t *WinT, *WupaT, *WupbT, *WoutT;
    float* mod;
    bf16_t* P;
    bf16_t *H, *Yraw, *OutB, *Omd, *Aa, *OutA;
    unsigned* ctr;
    unsigned* bar;
};

constexpr int SMEM_FLOATS = 32768 + 64;
__device__ __forceinline__ int otid() { int t = (int)__builtin_amdgcn_workitem_id_x(); asm volatile("" : "+v"(t)); return t; }
__device__ __forceinline__ void lds_barrier() { asm volatile("s_waitcnt lgkmcnt(0)" ::: "memory"); __builtin_amdgcn_s_barrier(); asm volatile("" ::: "memory"); }
__device__ __forceinline__ float bf2f(bf16_t v) { return __uint_as_float(((unsigned)v) << 16); }
__device__ __forceinline__ bf16_t f2bf(float f) { unsigned u = __float_as_uint(f); u += 0x7FFFu + ((u >> 16) & 1u); return (bf16_t)(u >> 16); }
__device__ __forceinline__ unsigned pk2(float lo, float hi) { return (unsigned)f2bf(lo) | ((unsigned)f2bf(hi) << 16); }
__device__ __forceinline__ float sigm(float x) { return __builtin_amdgcn_rcpf(1.f + __expf(-x)); }
__device__ __forceinline__ float silu(float x) { return x * __builtin_amdgcn_rcpf(1.f + __expf(-x)); }
__device__ __forceinline__ float wave_sum(float v) {
#pragma unroll
    for (int o = 32; o; o >>= 1) v += __shfl_xor(v, o);
    return v;
}
template <int CTRL> __device__ __forceinline__ float dpp_mov(float v) {
    return __builtin_bit_cast(float, __builtin_amdgcn_update_dpp(0, __builtin_bit_cast(int, v), CTRL, 0xF, 0xF, true));
}
__device__ __forceinline__ float row16_sum(float v) {
    v += dpp_mov<0xB1>(v);
    v += dpp_mov<0x4E>(v);
    v += dpp_mov<0x141>(v);
    v += dpp_mov<0x140>(v);
    return v;
}
__device__ __forceinline__ void tok_info(int m, int& s, int& t) {
    if (m < M_P) { s = m >> 11; t = m & 2047; } else { int q = m - M_P; s = 8 + (q >> 3); t = q & 7; }
}
__device__ __forceinline__ const float* xrow(const Params& p, int m) {
    return m < M_P ? p.x_p + (size_t)m * DM : p.x_s + (size_t)(m - M_P) * DM;
}

__device__ __forceinline__ void tr8(const float* __restrict__ src, int Nsrc, bf16_t* __restrict__ dst, int K, int n, int kg) {
    float v[8];
    if (n < Nsrc) {
        const float* sp = src + (size_t)(kg * 8) * Nsrc + n;
#pragma unroll
        for (int i = 0; i < 8; ++i) v[i] = sp[(size_t)i * Nsrc];
    } else {
#pragma unroll
        for (int i = 0; i < 8; ++i) v[i] = 0.f;
    }
    uint4 o; o.x = pk2(v[0], v[1]); o.y = pk2(v[2], v[3]); o.z = pk2(v[4], v[5]); o.w = pk2(v[6], v[7]);
    *(uint4*)(dst + (size_t)n * K + kg * 8) = o;
}
__device__ void phaseA(const Params& p, float* sm, int bid, int nb) {
    const int tid = otid();
    if (bid == 0 && tid == 0) *p.ctr = 0u;
    constexpr int N_ADA = 48 * 17;
    for (int i = bid; i < N_ADA; i += nb) {
        const int ct = i % 48, rgp = i / 48;
        float* sc = sm;
        float* red = sm + 8192;
        {
            float cv[16];
#pragma unroll
            for (int q = 0; q < 16; ++q) {
                const int idx = tid + q * NTHR, sl = idx >> 10, k = idx & 1023, s = rgp * 8 + sl;
                const float* src = s < 8 ? p.c_p + s * 1024 : p.c_s + (s - 8) * 1024;
                cv[q] = src[k];
            }
#pragma unroll
            for (int q = 0; q < 16; ++q) sc[tid + q * NTHR] = silu(cv[q]);
        }
        __syncthreads();
        const int col = tid & 63, kq = tid >> 6;
        float acc[8];
#pragma unroll
        for (int s = 0; s < 8; ++s) acc[s] = 0.f;
        const float* wp = p.w_ada + (size_t)(kq * 128) * 3072 + ct * 64 + col;
#pragma unroll 4
        for (int k4 = 0; k4 < 32; ++k4) {
            const float w0 = wp[(size_t)(k4 * 4) * 3072], w1 = wp[(size_t)(k4 * 4 + 1) * 3072], w2 = wp[(size_t)(k4 * 4 + 2) * 3072], w3 = wp[(size_t)(k4 * 4 + 3) * 3072];
#pragma unroll
            for (int s = 0; s < 8; ++s) {
                const float4 c = *(const float4*)(sc + s * 1024 + kq * 128 + k4 * 4);
                acc[s] += c.x * w0 + c.y * w1 + c.z * w2 + c.w * w3;
            }
        }
#pragma unroll
        for (int s = 0; s < 8; ++s) red[(kq * 8 + s) * 64 + col] = acc[s];
        __syncthreads();
        {
            const int s = tid >> 6;
            float v = p.b_ada[ct * 64 + col];
#pragma unroll
            for (int q = 0; q < 8; ++q) v += red[(q * 8 + s) * 64 + col];
            p.mod[(size_t)(rgp * 8 + s) * 3072 + ct * 64 + col] = v;
        }
        __syncthreads();
    }
    constexpr int W_IN = NP * 128, W_UP = 1024 * 64, W_OUT = 1024 * 128;
    const int gt = bid * NTHR + tid, gs = nb * NTHR;
    for (int w = gt; w < W_IN; w += 2 * gs) {
        const int w2 = w + gs; const bool has2 = w2 < W_IN;
        const int n1 = w % NP, g1 = w / NP, n2 = has2 ? w2 % NP : n1, g2 = has2 ? w2 / NP : g1;
        float v1[8], v2[8];
        const float* s1 = p.w_in + (size_t)(g1 * 8) * N_IN + (n1 < N_IN ? n1 : 0);
        const float* s2 = p.w_in + (size_t)(g2 * 8) * N_IN + (n2 < N_IN ? n2 : 0);
#pragma unroll
        for (int i = 0; i < 8; ++i) { v1[i] = s1[(size_t)i * N_IN]; v2[i] = s2[(size_t)i * N_IN]; }
        uint4 o;
        if (n1 >= N_IN) { o = make_uint4(0u, 0u, 0u, 0u); } else { o.x = pk2(v1[0], v1[1]); o.y = pk2(v1[2], v1[3]); o.z = pk2(v1[4], v1[5]); o.w = pk2(v1[6], v1[7]); }
        *(uint4*)(p.WinT + (size_t)n1 * 1024 + g1 * 8) = o;
        if (has2) {
            if (n2 >= N_IN) { o = make_uint4(0u, 0u, 0u, 0u); } else { o.x = pk2(v2[0], v2[1]); o.y = pk2(v2[2], v2[3]); o.z = pk2(v2[4], v2[5]); o.w = pk2(v2[6], v2[7]); }
            *(uint4*)(p.WinT + (size_t)n2 * 1024 + g2 * 8) = o;
        }
    }
    for (int w = gt; w < W_UP; w += gs) { tr8(p.w_up_a, 1024, p.WupaT, 512, w & 1023, w >> 10); tr8(p.w_up_b, 1024, p.WupbT, 512, w & 1023, w >> 10); }
    for (int w = gt; w < W_OUT; w += gs) tr8(p.w_out, 1024, p.WoutT, 1024, w & 1023, w >> 10);
}

__device__ __forceinline__ void normrow_load(const float* xr, int lane, float4 (&v)[4]) {
#pragma unroll
    for (int i = 0; i < 4; ++i) v[i] = *(const float4*)(xr + i * 256 + lane * 4);
}
__device__ __forceinline__ float sumsq4(const float4 (&v)[4]) {
    float ss = 0.f;
#pragma unroll
    for (int i = 0; i < 4; ++i) ss += v[i].x * v[i].x + v[i].y * v[i].y + v[i].z * v[i].z + v[i].w * v[i].w;
    return ss;
}
__device__ __forceinline__ void hrow_store(const Params& p, int m, int lane, const float4 (&v)[4], float rstd) {
    int s, t; tok_info(m, s, t);
    const float* md = p.mod + (size_t)s * 3072;
#pragma unroll
    for (int i = 0; i < 4; ++i) {
        const int c = i * 256 + lane * 4;
        const float4 g = *(const float4*)(p.g_norm + c);
        const float4 sh = *(const float4*)(md + c);
        const float4 sl = *(const float4*)(md + 1024 + c);
        const float h0 = v[i].x * rstd * g.x * (1.f + sl.x) + sh.x;
        const float h1 = v[i].y * rstd * g.y * (1.f + sl.y) + sh.y;
        const float h2 = v[i].z * rstd * g.z * (1.f + sl.z) + sh.z;
        const float h3 = v[i].w * rstd * g.w * (1.f + sl.w) + sh.w;
        uint2 o; o.x = pk2(h0, h1); o.y = pk2(h2, h3);
        *(uint2*)(p.H + (size_t)m * 1024 + c) = o;
    }
}
__device__ void phaseB(const Params& p, int bid, int nb) {
    const int wid = otid() >> 6, lane = otid() & 63;
    const int stride = nb * 8;
    for (int m = bid * 8 + wid; m < M_TOT; m += 2 * stride) {
        const int m2 = m + stride;
        const bool has2 = m2 < M_TOT;
        float4 va[4], vb[4];
        normrow_load(xrow(p, m), lane, va);
        normrow_load(xrow(p, has2 ? m2 : m), lane, vb);
        const float ra = rsqrtf(wave_sum(sumsq4(va)) * (1.f / 1024.f) + 1e-6f);
        const float rb = rsqrtf(wave_sum(sumsq4(vb)) * (1.f / 1024.f) + 1e-6f);
        hrow_store(p, m, lane, va, ra);
        if (has2) hrow_store(p, m2, lane, vb, rb);
    }
}

typedef unsigned u32x4v __attribute__((ext_vector_type(4)));
__device__ __forceinline__ bf16x8 pack8(const float (&v)[8]) {
    u32x4v t; t[0] = pk2(v[0], v[1]); t[1] = pk2(v[2], v[3]); t[2] = pk2(v[4], v[5]); t[3] = pk2(v[6], v[7]);
    return __builtin_bit_cast(bf16x8, t);
}
__device__ void phaseD(const Params& p, float* sm, int bid, int nb) {
    const int tid = otid(), wid = tid >> 6, lane = tid & 63, fr = lane & 15, fq = lane >> 4;
    bf16_t* twb = (bf16_t*)sm;
    bf16_t* alb = twb + 16 * 72;
    bf16x8 Bd[4][2], Bi[4][2];
#pragma unroll
    for (int ct = 0; ct < 4; ++ct)
#pragma unroll
        for (int ks = 0; ks < 2; ++ks) {
            const int n = wid * 64 + ct * 16 + fr, k0 = ks * 32 + fq * 8;
            float vd[8], vi[8];
#pragma unroll
            for (int j = 0; j < 8; ++j) { vd[j] = p.w_decay2[(k0 + j) * 512 + n]; vi[j] = p.w_iclr2[(k0 + j) * 512 + n]; }
            Bd[ct][ks] = pack8(vd); Bi[ct][ks] = pack8(vi);
        }
    float w0r[16], a0r[16];
#pragma unroll
    for (int q = 0; q < 16; ++q) { const int col = wid * 64 + (q >> 2) * 16 + fq * 4 + (q & 3); w0r[q] = p.w0[col]; a0r[q] = p.a0[col]; }
    unsigned cu[4], pv[4]; float st[4];
    auto fetchD = [&](int it) {
        const int m0 = it * 16;
#pragma unroll
        for (int q = 0; q < 4; ++q) {
            const int idx = tid + q * NTHR, tok = idx >> 7, j = idx & 127, col = C_WL + j, m = m0 + tok;
            int s, t; tok_info(m, s, t);
            cu[q] = p.P[(size_t)m * NP + col];
            pv[q] = p.P[(size_t)(t > 0 ? m - 1 : m) * NP + col];
            st[q] = p.st_shift[(size_t)(s >= 8 ? s - 8 : 0) * SHIFT_W + col];
        }
    };
    if (bid < M_TOT / 16) fetchD(bid);
    for (int it = bid; it < M_TOT / 16; it += nb) {
        const int m0 = it * 16;
        {
#pragma unroll
            for (int q = 0; q < 4; ++q) {
                const int idx = tid + q * NTHR, tok = idx >> 7, j = idx & 127, col = C_WL + j, m = m0 + tok;
                int s, t; tok_info(m, s, t);
                const float cur = __uint_as_float(cu[q] << 16);
                const float prev = t > 0 ? __uint_as_float(pv[q] << 16) : (s >= 8 ? st[q] : 0.f);
                const float v = cur + p.mu_shift[col] * (prev - cur);
                if (j < 64) twb[tok * 72 + j] = f2bf(tanhf(v)); else alb[tok * 72 + j - 64] = f2bf(v);
            }
        }
        if (it + nb < M_TOT / 16) fetchD(it + nb);
        lds_barrier();
        {
            const bf16x8 at0 = *(const bf16x8*)(twb + fr * 72 + fq * 8), at1 = *(const bf16x8*)(twb + fr * 72 + 32 + fq * 8);
            const bf16x8 aa0 = *(const bf16x8*)(alb + fr * 72 + fq * 8), aa1 = *(const bf16x8*)(alb + fr * 72 + 32 + fq * 8);
            const size_t mrow = (size_t)(m0 + fr) * 512 + wid * 64 + fq * 4;
#pragma unroll
            for (int ct = 0; ct < 4; ++ct) {
                f32x4 cw = (f32x4){0.f, 0.f, 0.f, 0.f}, ca = cw;
                cw = __builtin_amdgcn_mfma_f32_16x16x32_bf16(Bd[ct][0], at0, cw, 0, 0, 0);
                cw = __builtin_amdgcn_mfma_f32_16x16x32_bf16(Bd[ct][1], at1, cw, 0, 0, 0);
                ca = __builtin_amdgcn_mfma_f32_16x16x32_bf16(Bi[ct][0], aa0, ca, 0, 0, 0);
                ca = __builtin_amdgcn_mfma_f32_16x16x32_bf16(Bi[ct][1], aa1, ca, 0, 0, 0);
                float o[4], a[4];
#pragma unroll
                for (int r = 0; r < 4; ++r) {
                    const float sg = sigm(w0r[ct * 4 + r] + cw[r]);
                    o[r] = 1.f - __expf(-0.6065306597126334f * sg);
                    a[r] = sigm(a0r[ct * 4 + r] + ca[r]);
                }
                uint2 uo, ua; uo.x = pk2(o[0], o[1]); uo.y = pk2(o[2], o[3]); ua.x = pk2(a[0], a[1]); ua.y = pk2(a[2], a[3]);
                *(uint2*)(p.Omd + mrow + ct * 16) = uo;
                *(uint2*)(p.Aa + mrow + ct * 16) = ua;
            }
        }
        for (int tok = 0; tok < 16; ++tok) {
            const int m = m0 + tok;
            int s, t; tok_info(m, s, t);
            const int T = s < 8 ? 2048 : 8;
            if (t != T - 1) continue;
            float* osh = s < 8 ? p.out + O_PSHIFT + (size_t)s * SHIFT_W : p.out + O_SSHIFT + (size_t)(s - 8) * SHIFT_W;
            float* ocv = s < 8 ? p.out + O_PCONV + (size_t)s * 3072 : p.out + O_SCONV + (size_t)(s - 8) * 3072;
            for (int col = tid; col < SHIFT_W; col += NTHR) osh[col] = bf2f(p.P[(size_t)m * NP + col]);
            for (int idx = tid; idx < 3072; idx += NTHR) {
                const int r = idx >> 10, cc = idx & 1023;
                ocv[idx] = bf2f(p.P[(size_t)(m - 2 + r) * NP + C_QK + cc]);
            }
        }
        lds_barrier();
    }
    __syncthreads();
}

__device__ __forceinline__ float rdlane(float v, int l) { return __builtin_bit_cast(float, __builtin_amdgcn_readlane(__builtin_bit_cast(int, v), l)); }
__device__ __forceinline__ float wave_sum_fast(float v) {
    v = row16_sum(v);
    return (rdlane(v, 0) + rdlane(v, 16)) + (rdlane(v, 32) + rdlane(v, 48));
}
__device__ __forceinline__ float4 unpk4(uint2 u) {
    float4 f; f.x = __uint_as_float(u.x << 16); f.y = __uint_as_float(u.x & 0xFFFF0000u);
    f.z = __uint_as_float(u.y << 16); f.w = __uint_as_float(u.y & 0xFFFF0000u); return f;
}
__device__ void rwkv_item(const Params& p, int s, int h, int third, float* sm) {
    constexpr int BUF = 15680;
    constexpr int VC_OFF = 10368, Y_OFF = 13632, NCH = 64;
    const int tid = otid(), wid = tid >> 6, lane = tid & 63;
    const int mbase = s * 2048;
    const int r0 = third * 21 + (third > 0 ? 1 : 0), nr = third == 0 ? 22 : 21;
    if (wid >= 6) {
        const int pw = wid - 6, g = lane >> 4;
        const int c4 = (lane & 15) * 4, hc = h * 64 + c4;
        const int l128 = pw * 64 + lane;
        const float4 mu_r = *(const float4*)(p.mu_shift + C_R + hc), mu_k = *(const float4*)(p.mu_shift + C_K + hc), mu_v = *(const float4*)(p.mu_shift + C_V + hc);
        const float4 kkw = *(const float4*)(p.k_k + hc), kaw = *(const float4*)(p.k_a + hc);
        uint2 R[4][8];
        auto fetch = [&](int pass, uint2 (&q)[8]) {
            const int t = (pass >> 2) * 32 + (pass & 3) * 8 + pw * 4 + g;
            const bf16_t* pr = p.P + (size_t)(mbase + t) * NP + hc;
            const bf16_t* pp = t > 0 ? pr - NP : pr;
            q[0] = *(const uint2*)(pr + C_R); q[1] = *(const uint2*)(pr + C_K); q[2] = *(const uint2*)(pr + C_V);
            q[3] = *(const uint2*)(pp + C_R); q[4] = *(const uint2*)(pp + C_K); q[5] = *(const uint2*)(pp + C_V);
            q[6] = *(const uint2*)(p.Aa + (size_t)(mbase + t) * 512 + hc);
            q[7] = *(const uint2*)(p.Omd + (size_t)(mbase + t) * 512 + hc);
        };
        auto step = [&](int pass, uint2 (&q)[8]) {
            const uint2 cr = q[0], ck = q[1], cv = q[2], crp = q[3], ckp = q[4], cvp = q[5], ca = q[6], co = q[7];
            if (pass + 4 < NCH * 4) fetch(pass + 4, q);
            const int tok = (pass & 3) * 8 + pw * 4 + g, t = (pass >> 2) * 32 + tok;
            float* B = sm + ((pass >> 2) & 1) * BUF;
            float4 r = unpk4(cr), k = unpk4(ck), v = unpk4(cv), rp, kp_, vp;
            if (t > 0) { rp = unpk4(crp); kp_ = unpk4(ckp); vp = unpk4(cvp); }
            else { rp = make_float4(0.f, 0.f, 0.f, 0.f); kp_ = rp; vp = rp; }
            r.x += mu_r.x * (rp.x - r.x); r.y += mu_r.y * (rp.y - r.y); r.z += mu_r.z * (rp.z - r.z); r.w += mu_r.w * (rp.w - r.w);
            k.x += mu_k.x * (kp_.x - k.x); k.y += mu_k.y * (kp_.y - k.y); k.z += mu_k.z * (kp_.z - k.z); k.w += mu_k.w * (kp_.w - k.w);
            v.x += mu_v.x * (vp.x - v.x); v.y += mu_v.y * (vp.y - v.y); v.z += mu_v.z * (vp.z - v.z); v.w += mu_v.w * (vp.w - v.w);
            const float4 a = unpk4(ca), om = unpk4(co);
            float4 kk; kk.x = k.x * kkw.x; kk.y = k.y * kkw.y; kk.z = k.z * kkw.z; kk.w = k.w * kkw.w;
            const float nrm = sqrtf(row16_sum(kk.x * kk.x + kk.y * kk.y + kk.z * kk.z + kk.w * kk.w));
            const float inv = __builtin_amdgcn_rcpf(fmaxf(nrm, 1e-12f));
            kk.x *= inv; kk.y *= inv; kk.z *= inv; kk.w *= inv;
            float4 ka; ka.x = kk.x * a.x; ka.y = kk.y * a.y; ka.z = kk.z * a.z; ka.w = kk.w * a.w;
            float4 kp; kp.x = k.x * (1.f + (a.x - 1.f) * kaw.x); kp.y = k.y * (1.f + (a.y - 1.f) * kaw.y);
            kp.z = k.z * (1.f + (a.z - 1.f) * kaw.z); kp.w = k.w * (1.f + (a.w - 1.f) * kaw.w);
            float4 d; d.x = 1.f - om.x; d.y = 1.f - om.y; d.z = 1.f - om.z; d.w = 1.f - om.w;
            float4 dr; dr.x = d.x * r.x; dr.y = d.y * r.y; dr.z = d.z * r.z; dr.w = d.w * r.w;
            const float c1 = row16_sum(ka.x * r.x + ka.y * r.y + ka.z * r.z + ka.w * r.w);
            const float c2 = row16_sum(kp.x * r.x + kp.y * r.y + kp.z * r.z + kp.w * r.w);
            const int o = tok * 64 + c4;
            *(float4*)(B + o) = kk; *(float4*)(B + 2048 + o) = d; *(float4*)(B + 4096 + o) = ka;
            *(float4*)(B + 6144 + o) = kp; *(float4*)(B + 8192 + o) = dr;
            float4* vc = (float4*)(B + VC_OFF) + tok * 24;
            const int l0 = c4 - r0;
            if (l0 >= 0 && l0 < nr) vc[l0] = make_float4(v.x, c1, c2, 0.f);
            if (l0 + 1 >= 0 && l0 + 1 < nr) vc[l0 + 1] = make_float4(v.y, c1, c2, 0.f);
            if (l0 + 2 >= 0 && l0 + 2 < nr) vc[l0 + 2] = make_float4(v.z, c1, c2, 0.f);
            if (l0 + 3 >= 0 && l0 + 3 < nr) vc[l0 + 3] = make_float4(v.w, c1, c2, 0.f);
        };
        auto flush = [&](int c) {
            const float* Y = sm + (c & 1) * BUF + Y_OFF;
            const int tt = l128 >> 2, part = l128 & 3;
            bf16_t* dst = p.Yraw + (size_t)(mbase + c * 32 + tt) * 512 + h * 64 + r0;
#pragma unroll
            for (int k = 0; k < 6; ++k) { const int i = part + 4 * k; if (i < nr) dst[i] = f2bf(Y[tt * 64 + i]); }
        };
#pragma unroll
        for (int q = 0; q < 4; ++q) fetch(q, R[q]);
#pragma unroll
        for (int q = 0; q < 4; ++q) step(q, R[q]);
        lds_barrier();
#pragma unroll 1
        for (int c = 0; c < NCH; ++c) {
            if (c > 0) flush(c - 1);
            if (c + 1 < NCH) {
#pragma unroll
                for (int q = 0; q < 4; ++q) step((c + 1) * 4 + q, R[q]);
            }
            lds_barrier();
        }
        flush(NCH - 1);
    } else {
        const int lrow = wid * 4 + (lane >> 4);
        const int irow = r0 + (lrow < nr ? lrow : nr - 1);
        const int c4 = (lane & 15) * 4;
        const int yslot = ((lane & 15) == 0 && lrow < nr) ? lrow : 32 + (lane & 31);
        float S0 = 0.f, S1 = 0.f, S2 = 0.f, S3 = 0.f;
        lds_barrier();
#pragma unroll 1
        for (int c = 0; c < NCH; ++c) {
            const float* B = sm + (c & 1) * BUF;
            const float* bp = B + c4;
            const float4* vp4 = (const float4*)(B + VC_OFF) + (irow - r0);
            float4 kk4 = *(const float4*)(bp), d4 = *(const float4*)(bp + 2048), ka4 = *(const float4*)(bp + 4096);
            float4 kp4 = *(const float4*)(bp + 6144), dr4 = *(const float4*)(bp + 8192), vc = vp4[0];
            float4 kkB = *(const float4*)(bp + 64), dB = *(const float4*)(bp + 64 + 2048), kaB = *(const float4*)(bp + 64 + 4096);
            float4 kpB = *(const float4*)(bp + 64 + 6144), drB = *(const float4*)(bp + 64 + 8192), vcB = vp4[24];
            float* yp = sm + (c & 1) * BUF + Y_OFF + yslot;
#pragma unroll 8
            for (int tt = 0; tt < 32; ++tt) {
                const float* nb_ = bp + (tt + 2) * 64;
                const float4 nkk = *(const float4*)(nb_), nd = *(const float4*)(nb_ + 2048), nka = *(const float4*)(nb_ + 4096);
                const float4 nkp = *(const float4*)(nb_ + 6144), ndr = *(const float4*)(nb_ + 8192), nvc = vp4[(tt + 2) * 24];
                __builtin_amdgcn_sched_barrier(0);
                float p1 = S0 * kk4.x + S1 * kk4.y + S2 * kk4.z + S3 * kk4.w;
                float p2 = S0 * dr4.x + S1 * dr4.y + S2 * dr4.z + S3 * dr4.w;
                const float vi = vc.x;
                const float u0 = S0 * d4.x + vi * kp4.x, u1 = S1 * d4.y + vi * kp4.y, u2 = S2 * d4.z + vi * kp4.z, u3 = S3 * d4.w + vi * kp4.w;
                float z = p2 - vc.y * p1;
                p1 = row16_sum(p1);
                z = row16_sum(z);
                S0 = u0 - p1 * ka4.x; S1 = u1 - p1 * ka4.y; S2 = u2 - p1 * ka4.z; S3 = u3 - p1 * ka4.w;
                yp[tt * 64] = z + vi * vc.z;
                kk4 = kkB; d4 = dB; ka4 = kaB; kp4 = kpB; dr4 = drB; vc = vcB;
                kkB = nkk; dB = nd; kaB = nka; kpB = nkp; drB = ndr; vcB = nvc;
                __builtin_amdgcn_sched_barrier(0);
            }
            lds_barrier();
        }
        if (lrow < nr) {
            float* o = p.out + O_PS + (size_t)s * 8 * 4096 + ((size_t)(h * 64 + irow)) * 64 + c4;
            float4 v; v.x = S0; v.y = S1; v.z = S2; v.w = S3;
            *(float4*)o = v;
        }
    }
    __syncthreads();
}

__device__ void mlstm_item(const Params& p, int s, int h, float* sm) {
    float* sq = sm;
    float* sk = sm + 4160;
    float* sv = sm + 8320;
    float* sc = sm + 12480;
    float* sC = sm + 16640;
    float* sn = sm + 20800;
    float* sb = sn + 64;
    float* si = sn + 128;
    float* smt = sn + 192;
    float* swin = sn + 256;
    float* sden = sn + 320;
    float* sws = sn + 384;
    float* slf = sn + 448;
    float* smisc = sn + 512;
    const int tid = otid(), wid = tid >> 6, lane = tid & 63;
    const int T = s < 8 ? 2048 : 8, L = s < 8 ? 64 : 8, NC = T / L;
    const int mbase = s < 8 ? s * 2048 : M_P + (s - 8) * 8;
    for (int idx = tid; idx < 4096; idx += NTHR) {
        const int i = idx >> 6, j = idx & 63;
        sC[i * 65 + j] = s >= 8 ? p.st_C[(size_t)((s - 8) * 8 + h) * 4096 + idx] : 0.f;
    }
    if (tid < 64) sn[tid] = s >= 8 ? p.st_n[(size_t)((s - 8) * 8 + h) * 64 + tid] : 0.f;
    if (tid == 0) smisc[0] = s >= 8 ? p.st_m[(s - 8) * 8 + h] : 0.f;
    const float cwq[4] = {p.conv_w[0 * 1024 + h * 64 + lane], p.conv_w[1 * 1024 + h * 64 + lane], p.conv_w[2 * 1024 + h * 64 + lane], p.conv_w[3 * 1024 + h * 64 + lane]};
    const float cwk[4] = {p.conv_w[0 * 1024 + 512 + h * 64 + lane], p.conv_w[1 * 1024 + 512 + h * 64 + lane], p.conv_w[2 * 1024 + 512 + h * 64 + lane], p.conv_w[3 * 1024 + 512 + h * 64 + lane]};
    const float cbq = p.conv_b[h * 64 + lane], cbk = p.conv_b[512 + h * 64 + lane];
    const float gnw = p.gn_w[h * 64 + lane];
    const float bi = p.b_i[h], bfv = p.b_f[h];
    __syncthreads();
    for (int c = 0; c < NC; ++c) {
        const int t0 = c * L;
        for (int tt = wid; tt < L; tt += 8) {
            const int t = t0 + tt, m = mbase + t;
            float aq = cbq, ak = cbk;
#pragma unroll
            for (int j = 0; j < 4; ++j) {
                const int tau = t - 3 + j;
                float xq, xk;
                if (tau >= 0) {
                    const bf16_t* pr = p.P + (size_t)(mbase + tau) * NP + C_QK + h * 64 + lane;
                    xq = bf2f(pr[0]); xk = bf2f(pr[512]);
                } else if (s >= 8) {
                    const float* st = p.st_conv + ((size_t)(s - 8) * 3 + (3 + tau)) * 1024 + h * 64 + lane;
                    xq = st[0]; xk = st[512];
                } else { xq = 0.f; xk = 0.f; }
                aq += xq * cwq[j]; ak += xk * cwk[j];
            }
            sq[tt * 65 + lane] = silu(aq);
            sk[tt * 65 + lane] = silu(ak) * 0.125f;
            sv[tt * 65 + lane] = bf2f(p.P[(size_t)m * NP + C_VB + h * 64 + lane]);
        }
        if (tid < L) {
            const int m = mbase + t0 + tid;
            si[tid] = bf2f(p.P[(size_t)m * NP + C_IB + h]) + bi;
            const float f = bf2f(p.P[(size_t)m * NP + C_FB + h]) + bfv;
            slf[tid] = f > 0.f ? -log1pf(__expf(-f)) : f - log1pf(__expf(f));
        }
        __syncthreads();
        if (tid == 0) {
            const float mprev = smisc[0];
            float b = 0.f, run = mprev;
            for (int t = 0; t < L; ++t) {
                b += slf[t];
                run = fmaxf(run, si[t] - b);
                sb[t] = b; smt[t] = b + run; swin[t] = __expf(b + mprev - (b + run));
            }
            const float mnew = b + run;
            smisc[1] = mnew; smisc[2] = __expf(b + mprev - mnew);
            for (int t = 0; t < L; ++t) sws[t] = __expf(b - sb[t] + si[t] - mnew);
        }
        __syncthreads();
        for (int idx = tid; idx < L * L; idx += NTHR) {
            const int t = idx / L, u = idx % L;
            float v = 0.f;
            if (u <= t) {
                float dot = 0.f;
#pragma unroll 8
                for (int d = 0; d < 64; ++d) dot += sq[t * 65 + d] * sk[u * 65 + d];
                v = dot * __expf(sb[t] - sb[u] + si[u] - smt[t]);
            }
            sc[t * 65 + u] = v;
        }
        __syncthreads();
        if (tid < L) {
            float rs = 0.f, qn = 0.f;
            for (int u = 0; u < L; ++u) rs += sc[tid * 65 + u];
            for (int j = 0; j < 64; ++j) qn += sn[j] * sq[tid * 65 + j];
            const float den = rs + swin[tid] * qn;
            sden[tid] = fmaxf(fabsf(den), __expf(-smt[tid]));
        }
        __syncthreads();
        for (int tt = wid; tt < L; tt += 8) {
            float num = 0.f, inter = 0.f;
            for (int u = 0; u <= tt; ++u) num += sc[tt * 65 + u] * sv[u * 65 + lane];
#pragma unroll 8
            for (int j = 0; j < 64; ++j) inter += sC[lane * 65 + j] * sq[tt * 65 + j];
            const float hv = (num + swin[tt] * inter) / sden[tt];
            const float ms = wave_sum(hv * hv) * (1.f / 64.f);
            const float hn = hv * rsqrtf(ms + 1e-6f) * gnw;
            const int m = mbase + t0 + tt;
            const float ob = bf2f(p.P[(size_t)m * NP + C_OB + h * 64 + lane]);
            const float zb = bf2f(p.P[(size_t)m * NP + C_ZB + h * 64 + lane]);
            p.OutB[(size_t)m * 512 + h * 64 + lane] = f2bf(sigm(ob) * hn * silu(zb));
        }
        __syncthreads();
        {
            const float dec = smisc[2];
            const int j = lane;
#pragma unroll
            for (int ii = 0; ii < 8; ++ii) {
                const int i = wid + 8 * ii;
                float a = dec * sC[i * 65 + j];
                for (int u = 0; u < L; ++u) a += sws[u] * sv[u * 65 + i] * sk[u * 65 + j];
                sC[i * 65 + j] = a;
            }
            if (tid < 64) {
                float a = dec * sn[tid];
                for (int u = 0; u < L; ++u) a += sws[u] * sk[u * 65 + tid];
                sn[tid] = a;
            }
            if (tid == 0) smisc[0] = smisc[1];
        }
        __syncthreads();
    }
    {
        float* oC = s < 8 ? p.out + O_PC + (size_t)(s * 8 + h) * 4096 : p.out + O_SC + (size_t)((s - 8) * 8 + h) * 4096;
        float* on = s < 8 ? p.out + O_PN + (size_t)(s * 8 + h) * 64 : p.out + O_SN + (size_t)((s - 8) * 8 + h) * 64;
        float* om = s < 8 ? p.out + O_PM + (s * 8 + h) : p.out + O_SM + ((s - 8) * 8 + h);
        for (int idx = tid; idx < 4096; idx += NTHR) oC[idx] = sC[(idx >> 6) * 65 + (idx & 63)];
        if (tid < 64) on[tid] = sn[tid];
        if (tid == 0) om[0] = smisc[0];
    }
    __syncthreads();
}

__device__ __forceinline__ bf16x8 ldfrag(const bf16_t* base, int row, int ks, int fq) { return *(const bf16x8*)(base + row * 72 + ks * 32 + fq * 8); }
__device__ __forceinline__ float sum8(float v) { v += dpp_mov<0xB1>(v); v += dpp_mov<0x4E>(v); v += dpp_mov<0x141>(v); return v; }
__device__ void mlstm_prompt(const Params& p, int s, int h, float* sm) {
    bf16_t* Qs = (bf16_t*)sm; bf16_t* Ks = Qs + 4608; bf16_t* VT = Ks + 4608; bf16_t* KwT = VT + 4608; bf16_t* Ps = KwT + 4608; bf16_t* Cb = Ps + 4608;
    float* hs = sm + 13824;
    float* sn = hs + 64 * 68;
    float* sden = sn + 64;
    float* gv = sn + 128;
    float* Gg = sn + 128 + 768;
    float* Gl = Gg + 2048;
    float* Gb = Gl + 2048;
    const int tid = otid(), wid = tid >> 6, lane = tid & 63, fr = lane & 15, fq = lane >> 4;
    const int tr = wid >> 1, tc0 = (wid & 1) * 2;
    const int mbase = s * 2048;
    const int qc = h * 64 + lane;
    f32x4 accC[2];
    accC[0] = (f32x4){0.f, 0.f, 0.f, 0.f}; accC[1] = accC[0];
    if (tid < 64) sn[tid] = 0.f;
    {
        const float bi = p.b_i[h], bfv = p.b_f[h];
        for (int cc = wid; cc < 32; cc += 8) {
            const bf16_t* pr = p.P + (size_t)(mbase + cc * 64 + lane) * NP;
            const float it = bf2f(pr[C_IB + h]) + bi;
            const float f = bf2f(pr[C_FB + h]) + bfv;
            float b = f > 0.f ? -log1pf(__expf(-f)) : f - log1pf(__expf(f));
#pragma unroll
            for (int o = 1; o < 64; o <<= 1) { const float v = __shfl_up(b, o); if (lane >= o) b += v; }
            const float g = it - b;
            float run = g;
#pragma unroll
            for (int o = 1; o < 64; o <<= 1) { const float v = __shfl_up(run, o); if (lane >= o) run = fmaxf(run, v); }
            Gg[cc * 64 + lane] = g; Gl[cc * 64 + lane] = run; Gb[cc * 64 + lane] = b;
        }
    }
    const float cwq0 = p.conv_w[qc], cwq1 = p.conv_w[1024 + qc], cwq2 = p.conv_w[2048 + qc], cwq3 = p.conv_w[3072 + qc];
    const float cwk0 = p.conv_w[512 + qc], cwk1 = p.conv_w[1536 + qc], cwk2 = p.conv_w[2560 + qc], cwk3 = p.conv_w[3584 + qc];
    const float cbq = p.conv_b[qc], cbk = p.conv_b[512 + qc];
    const float gnw = p.gn_w[qc];
    unsigned xqr[11], xkr[11], vvr[8];
    auto load_raw = [&](int c) {
        const int tb = c * 64 + wid * 8 - 3;
#pragma unroll
        for (int r = 0; r < 11; ++r) {
            const int t = tb + r, tc = t < 0 ? 0 : t;
            const bf16_t* pr = p.P + (size_t)(mbase + tc) * NP + C_QK + qc;
            xqr[r] = pr[0]; xkr[r] = pr[512];
        }
#pragma unroll
        for (int k = 0; k < 8; ++k) vvr[k] = p.P[(size_t)(mbase + tb + 3 + k) * NP + C_VB + qc];
    };
    auto gates = [&](int c, float mprev) {
        float* v = gv + (c & 1) * 384;
        const float g = Gg[c * 64 + lane], b = Gb[c * 64 + lane];
        const float run = fmaxf(Gl[c * 64 + lane], mprev), runL = fmaxf(Gl[c * 64 + 63], mprev), bL = Gb[c * 64 + 63];
        v[lane] = g; v[64 + lane] = run; v[128 + lane] = __expf(mprev - run); v[192 + lane] = __expf(g - runL); v[256 + lane] = b;
        if (lane == 0) { v[320] = bL + runL; v[321] = __expf(mprev - runL); }
    };
    load_raw(0);
    __syncthreads();
    if (wid == 0) gates(0, 0.f);
    __syncthreads();
    for (int c = 0; c < 32; ++c) {
        const int t0 = c * 64, mb = mbase + t0;
        const float* sg = gv + (c & 1) * 384; const float* srun = sg + 64; const float* swin = sg + 128; const float* sws = sg + 192; const float* sb = sg + 256;
        const float dec = sg[321];
        {
            float kw[8], xq[11], xk[11], vv[8];
            const bool head = (c == 0 && wid == 0);
#pragma unroll
            for (int r = 0; r < 11; ++r) {
                const bool z = head && r < 3;
                xq[r] = z ? 0.f : __uint_as_float(xqr[r] << 16); xk[r] = z ? 0.f : __uint_as_float(xkr[r] << 16);
            }
#pragma unroll
            for (int k = 0; k < 8; ++k) vv[k] = __uint_as_float(vvr[k] << 16);
#pragma unroll
            for (int k = 0; k < 8; ++k) {
                const int tt = wid * 8 + k;
                const float q = silu(cbq + xq[k] * cwq0 + xq[k + 1] * cwq1 + xq[k + 2] * cwq2 + xq[k + 3] * cwq3);
                const float kk = silu(cbk + xk[k] * cwk0 + xk[k + 1] * cwk1 + xk[k + 2] * cwk2 + xk[k + 3] * cwk3) * 0.125f;
                Qs[tt * 72 + lane] = f2bf(q);
                Ks[tt * 72 + lane] = f2bf(kk);
                kw[k] = kk * sws[tt];
            }
            uint4 o; o.x = pk2(kw[0], kw[1]); o.y = pk2(kw[2], kw[3]); o.z = pk2(kw[4], kw[5]); o.w = pk2(kw[6], kw[7]);
            *(uint4*)(KwT + lane * 72 + wid * 8) = o;
            o.x = pk2(vv[0], vv[1]); o.y = pk2(vv[2], vv[3]); o.z = pk2(vv[4], vv[5]); o.w = pk2(vv[6], vv[7]);
            *(uint4*)(VT + lane * 72 + wid * 8) = o;
        }
#pragma unroll
        for (int n = 0; n < 2; ++n) {
            uint2 o; o.x = pk2(accC[n][0], accC[n][1]); o.y = pk2(accC[n][2], accC[n][3]);
            *(uint2*)(Cb + (tr * 16 + fr) * 72 + (tc0 + n) * 16 + fq * 4) = o;
        }
        if (c + 1 < 32) load_raw(c + 1);
        lds_barrier();
        unsigned obr[8], zbr[8];
#pragma unroll
        for (int k = 0; k < 8; ++k) {
            const bf16_t* pr = p.P + (size_t)(mb + wid * 8 + k) * NP;
            obr[k] = pr[C_OB + qc]; zbr[k] = pr[C_ZB + qc];
        }
#pragma unroll
        for (int n = 0; n < 2; ++n) {
            const int ut = tc0 + n;
            f32x4 a = (f32x4){0.f, 0.f, 0.f, 0.f};
            if (ut <= tr) {
#pragma unroll
                for (int ks = 0; ks < 2; ++ks) a = __builtin_amdgcn_mfma_f32_16x16x32_bf16(ldfrag(Ks, ut * 16 + fr, ks, fq), ldfrag(Qs, tr * 16 + fr, ks, fq), a, 0, 0, 0);
            }
            const int t = tr * 16 + fr;
            const float rn = srun[t];
            float w[4];
#pragma unroll
            for (int r = 0; r < 4; ++r) {
                const int u = ut * 16 + fq * 4 + r;
                w[r] = (u <= t) ? a[r] * __expf(sg[u] - rn) : 0.f;
            }
            uint2 o; o.x = pk2(w[0], w[1]); o.y = pk2(w[2], w[3]);
            *(uint2*)(Ps + t * 72 + ut * 16 + fq * 4) = o;
        }
        lds_barrier();
        {
            const int t = tid >> 3, seg = tid & 7;
            const uint4 pv = *(const uint4*)(Ps + t * 72 + seg * 8);
            const uint4 qv = *(const uint4*)(Qs + t * 72 + seg * 8);
            const float4 pa = unpk4(make_uint2(pv.x, pv.y)), pb = unpk4(make_uint2(pv.z, pv.w));
            const float4 qa = unpk4(make_uint2(qv.x, qv.y)), qb = unpk4(make_uint2(qv.z, qv.w));
            const float4 na = *(const float4*)(sn + seg * 8), nb4 = *(const float4*)(sn + seg * 8 + 4);
            float rs = (pa.x + pa.y) + (pa.z + pa.w) + (pb.x + pb.y) + (pb.z + pb.w);
            float qn = qa.x * na.x + qa.y * na.y + qa.z * na.z + qa.w * na.w + qb.x * nb4.x + qb.y * nb4.y + qb.z * nb4.z + qb.w * nb4.w;
            rs = sum8(rs); qn = sum8(qn);
            if (seg == 0) sden[t] = fmaxf(fabsf(rs + swin[t] * qn), __expf(-(sb[t] + srun[t])));
        }
        f32x4 num[2], itr[2];
#pragma unroll
        for (int n = 0; n < 2; ++n) {
            const int it = tc0 + n;
            num[n] = (f32x4){0.f, 0.f, 0.f, 0.f}; itr[n] = num[n];
#pragma unroll
            for (int ks = 0; ks < 2; ++ks) {
                num[n] = __builtin_amdgcn_mfma_f32_16x16x32_bf16(ldfrag(VT, it * 16 + fr, ks, fq), ldfrag(Ps, tr * 16 + fr, ks, fq), num[n], 0, 0, 0);
                itr[n] = __builtin_amdgcn_mfma_f32_16x16x32_bf16(ldfrag(Cb, it * 16 + fr, ks, fq), ldfrag(Qs, tr * 16 + fr, ks, fq), itr[n], 0, 0, 0);
            }
        }
        lds_barrier();
        {
            const int t = tr * 16 + fr;
            const float rd = 1.f / sden[t], wn = swin[t];
#pragma unroll
            for (int n = 0; n < 2; ++n) {
                float4 o;
                o.x = (num[n][0] + wn * itr[n][0]) * rd; o.y = (num[n][1] + wn * itr[n][1]) * rd;
                o.z = (num[n][2] + wn * itr[n][2]) * rd; o.w = (num[n][3] + wn * itr[n][3]) * rd;
                *(float4*)(hs + t * 68 + (tc0 + n) * 16 + fq * 4) = o;
            }
        }
#pragma unroll
        for (int n = 0; n < 2; ++n) {
            accC[n][0] *= dec; accC[n][1] *= dec; accC[n][2] *= dec; accC[n][3] *= dec;
#pragma unroll
            for (int ks = 0; ks < 2; ++ks)
                accC[n] = __builtin_amdgcn_mfma_f32_16x16x32_bf16(ldfrag(KwT, (tc0 + n) * 16 + fr, ks, fq), ldfrag(VT, tr * 16 + fr, ks, fq), accC[n], 0, 0, 0);
        }
        {
            const int j = tid >> 3, seg = tid & 7;
            const uint4 kv = *(const uint4*)(KwT + j * 72 + seg * 8);
            const float4 ka = unpk4(make_uint2(kv.x, kv.y)), kb = unpk4(make_uint2(kv.z, kv.w));
            float sum = (ka.x + ka.y) + (ka.z + ka.w) + (kb.x + kb.y) + (kb.z + kb.w);
            sum = sum8(sum);
            if (seg == 0) sn[j] = dec * sn[j] + sum;
        }
        if (wid == 0 && c + 1 < 32) gates(c + 1, sg[320]);
        lds_barrier();
#pragma unroll
        for (int k = 0; k < 8; ++k) {
            const int tt = wid * 8 + k;
            const float hv = hs[tt * 68 + lane];
            const float ms = wave_sum_fast(hv * hv) * (1.f / 64.f);
            const float hn = hv * rsqrtf(ms + 1e-6f) * gnw;
            p.OutB[(size_t)(mb + tt) * 512 + qc] = f2bf(sigm(__uint_as_float(obr[k] << 16)) * hn * silu(__uint_as_float(zbr[k] << 16)));
        }
    }
    {
        float* oC = p.out + O_PC + (size_t)(s * 8 + h) * 4096;
#pragma unroll
        for (int n = 0; n < 2; ++n) {
            float4 o; o.x = accC[n][0]; o.y = accC[n][1]; o.z = accC[n][2]; o.w = accC[n][3];
            *(float4*)(oC + (tr * 16 + fr) * 64 + (tc0 + n) * 16 + fq * 4) = o;
        }
        if (tid < 64) p.out[O_PN + (size_t)(s * 8 + h) * 64 + tid] = sn[tid];
        if (tid == 0) p.out[O_PM + s * 8 + h] = gv[384 + 320];
    }
    __syncthreads();
}

__device__ __forceinline__ void wave_lds_fence() { __builtin_amdgcn_fence(__ATOMIC_RELEASE, "wavefront"); __builtin_amdgcn_wave_barrier(); __builtin_amdgcn_fence(__ATOMIC_ACQUIRE, "wavefront"); }
__device__ void rwkv_sample_wave(const Params& p, int sb, int h, float* wsm) {
    const int lane = otid() & 63;
    const int hj = h * 64 + lane;
    const int m0 = M_P + sb * 8;
    {
        float rr[8], kr[8], vr[8], ar[8], dd[8];
#pragma unroll
        for (int t = 0; t < 8; ++t) {
            const bf16_t* pr = p.P + (size_t)(m0 + t) * NP;
            rr[t] = bf2f(pr[C_R + hj]); kr[t] = bf2f(pr[C_K + hj]); vr[t] = bf2f(pr[C_V + hj]);
            ar[t] = bf2f(p.Aa[(size_t)(m0 + t) * 512 + hj]); dd[t] = 1.f - bf2f(p.Omd[(size_t)(m0 + t) * 512 + hj]);
        }
        const float* st = p.st_shift + (size_t)sb * SHIFT_W;
        float rp = st[C_R + hj], kp_ = st[C_K + hj], vp = st[C_V + hj];
        const float mu_r = p.mu_shift[C_R + hj], mu_k = p.mu_shift[C_K + hj], mu_v = p.mu_shift[C_V + hj];
        const float kkw = p.k_k[hj], kaw = p.k_a[hj];
#pragma unroll
        for (int t = 0; t < 8; ++t) {
            const float r = rr[t] + mu_r * (rp - rr[t]), k = kr[t] + mu_k * (kp_ - kr[t]), v = vr[t] + mu_v * (vp - vr[t]);
            rp = rr[t]; kp_ = kr[t]; vp = vr[t];
            const float a = ar[t], d = dd[t];
            float kk = k * kkw;
            const float nrm = sqrtf(wave_sum_fast(kk * kk));
            kk = kk / fmaxf(nrm, 1e-12f);
            const float ka = kk * a, kp = k * (1.f + (a - 1.f) * kaw);
            const float c1 = wave_sum_fast(ka * r), c2 = wave_sum_fast(kp * r);
            float* w = wsm + t * 400;
            w[lane] = kk; w[64 + lane] = d; w[128 + lane] = ka; w[192 + lane] = kp; w[256 + lane] = d * r; w[320 + lane] = v;
            if (lane == 0) { w[384] = c1; w[385] = c2; }
        }
    }
    float S[64];
    {
        const float* srow = p.st_S + ((size_t)(sb * 8 + h) * 64 + lane) * 64;
#pragma unroll
        for (int q = 0; q < 16; ++q) { const float4 v = *(const float4*)(srow + q * 4); S[4 * q] = v.x; S[4 * q + 1] = v.y; S[4 * q + 2] = v.z; S[4 * q + 3] = v.w; }
    }
    wave_lds_fence();
#pragma unroll 1
    for (int t = 0; t < 8; ++t) {
        const float* w = wsm + t * 400;
        float p1 = 0.f, p2 = 0.f;
#pragma unroll
        for (int q = 0; q < 16; ++q) {
            const float4 k4 = *(const float4*)(w + q * 4), r4 = *(const float4*)(w + 256 + q * 4);
            p1 += S[4 * q] * k4.x + S[4 * q + 1] * k4.y + S[4 * q + 2] * k4.z + S[4 * q + 3] * k4.w;
            p2 += S[4 * q] * r4.x + S[4 * q + 1] * r4.y + S[4 * q + 2] * r4.z + S[4 * q + 3] * r4.w;
        }
        const float vi = w[320 + lane];
        const float y = p2 - p1 * w[384] + vi * w[385];
#pragma unroll
        for (int q = 0; q < 16; ++q) {
            const float4 d4 = *(const float4*)(w + 64 + q * 4), a4 = *(const float4*)(w + 128 + q * 4), k4 = *(const float4*)(w + 192 + q * 4);
            S[4 * q] = S[4 * q] * d4.x + vi * k4.x - p1 * a4.x;
            S[4 * q + 1] = S[4 * q + 1] * d4.y + vi * k4.y - p1 * a4.y;
            S[4 * q + 2] = S[4 * q + 2] * d4.z + vi * k4.z - p1 * a4.z;
            S[4 * q + 3] = S[4 * q + 3] * d4.w + vi * k4.w - p1 * a4.w;
        }
        p.Yraw[(size_t)(m0 + t) * 512 + hj] = f2bf(y);
    }
    {
        float* o = p.out + O_SS + ((size_t)(sb * 8 + h) * 64 + lane) * 64;
#pragma unroll
        for (int q = 0; q < 16; ++q) { float4 v; v.x = S[4 * q]; v.y = S[4 * q + 1]; v.z = S[4 * q + 2]; v.w = S[4 * q + 3]; *(float4*)(o + q * 4) = v; }
    }
    wave_lds_fence();
}

__device__ void mlstm_sample_wave(const Params& p, int sb, int h, float* wsm) {
    const int lane = otid() & 63;
    const int qc = h * 64 + lane;
    const int m0 = M_P + sb * 8;
    float gi = 0.f, gl = 0.f;
    {
        float xq[11], xk[11];
#pragma unroll
        for (int r = 0; r < 3; ++r) { const float* st = p.st_conv + ((size_t)sb * 3 + r) * 1024 + qc; xq[r] = st[0]; xk[r] = st[512]; }
#pragma unroll
        for (int t = 0; t < 8; ++t) { const bf16_t* pr = p.P + (size_t)(m0 + t) * NP + C_QK + qc; xq[3 + t] = bf2f(pr[0]); xk[3 + t] = bf2f(pr[512]); }
#pragma unroll
        for (int t = 0; t < 8; ++t) {
            const bf16_t* pr = p.P + (size_t)(m0 + t) * NP;
            wsm[1024 + t * 64 + lane] = bf2f(pr[C_VB + qc]); wsm[1536 + t * 64 + lane] = bf2f(pr[C_OB + qc]); wsm[2048 + t * 64 + lane] = bf2f(pr[C_ZB + qc]);
        }
        if (lane < 8) {
            const bf16_t* pr = p.P + (size_t)(m0 + lane) * NP;
            gi = bf2f(pr[C_IB + h]) + p.b_i[h];
            const float f = bf2f(pr[C_FB + h]) + p.b_f[h];
            gl = f > 0.f ? -log1pf(__expf(-f)) : f - log1pf(__expf(f));
        }
        const float cwq0 = p.conv_w[qc], cwq1 = p.conv_w[1024 + qc], cwq2 = p.conv_w[2048 + qc], cwq3 = p.conv_w[3072 + qc];
        const float cwk0 = p.conv_w[512 + qc], cwk1 = p.conv_w[1536 + qc], cwk2 = p.conv_w[2560 + qc], cwk3 = p.conv_w[3584 + qc];
        const float cbq = p.conv_b[qc], cbk = p.conv_b[512 + qc];
#pragma unroll
        for (int t = 0; t < 8; ++t) {
            wsm[t * 64 + lane] = silu(cbq + xq[t] * cwq0 + xq[t + 1] * cwq1 + xq[t + 2] * cwq2 + xq[t + 3] * cwq3);
            wsm[512 + t * 64 + lane] = silu(cbk + xk[t] * cwk0 + xk[t + 1] * cwk1 + xk[t + 2] * cwk2 + xk[t + 3] * cwk3) * 0.125f;
        }
    }
    const float gnw = p.gn_w[qc];
    float C[64];
    {
        const float* crow = p.st_C + ((size_t)(sb * 8 + h) * 64 + lane) * 64;
#pragma unroll
        for (int q = 0; q < 16; ++q) { const float4 v = *(const float4*)(crow + q * 4); C[4 * q] = v.x; C[4 * q + 1] = v.y; C[4 * q + 2] = v.z; C[4 * q + 3] = v.w; }
    }
    float nl = p.st_n[(size_t)(sb * 8 + h) * 64 + lane];
    float m = p.st_m[sb * 8 + h];
    wave_lds_fence();
#pragma unroll 1
    for (int t = 0; t < 8; ++t) {
        const float it = rdlane(gi, t), lf = rdlane(gl, t);
        const float mt = fmaxf(lf + m, it);
        const float fdec = __expf(lf + m - mt), iw = __expf(it - mt);
        m = mt;
        const float ql = wsm[t * 64 + lane], kl = wsm[512 + t * 64 + lane];
        nl = fdec * nl + iw * kl;
        const float den = wave_sum_fast(nl * ql);
        const float ai = iw * wsm[1024 + t * 64 + lane];
        float num = 0.f;
#pragma unroll
        for (int q = 0; q < 16; ++q) {
            const float4 k4 = *(const float4*)(wsm + 512 + t * 64 + q * 4), q4 = *(const float4*)(wsm + t * 64 + q * 4);
            C[4 * q] = fdec * C[4 * q] + ai * k4.x; C[4 * q + 1] = fdec * C[4 * q + 1] + ai * k4.y;
            C[4 * q + 2] = fdec * C[4 * q + 2] + ai * k4.z; C[4 * q + 3] = fdec * C[4 * q + 3] + ai * k4.w;
            num += C[4 * q] * q4.x + C[4 * q + 1] * q4.y + C[4 * q + 2] * q4.z + C[4 * q + 3] * q4.w;
        }
        const float hv = num / fmaxf(fabsf(den), __expf(-mt));
        const float ms = wave_sum_fast(hv * hv) * (1.f / 64.f);
        p.OutB[(size_t)(m0 + t) * 512 + qc] = f2bf(sigm(wsm[1536 + t * 64 + lane]) * hv * rsqrtf(ms + 1e-6f) * gnw * silu(wsm[2048 + t * 64 + lane]));
    }
    {
        float* o = p.out + O_SC + ((size_t)(sb * 8 + h) * 64 + lane) * 64;
#pragma unroll
        for (int q = 0; q < 16; ++q) { float4 v; v.x = C[4 * q]; v.y = C[4 * q + 1]; v.z = C[4 * q + 2]; v.w = C[4 * q + 3]; *(float4*)(o + q * 4) = v; }
        p.out[O_SN + (size_t)(sb * 8 + h) * 64 + lane] = nl;
        if (lane == 0) p.out[O_SM + sb * 8 + h] = m;
    }
    wave_lds_fence();
}

__device__ void phaseE(const Params& p, float* sm, int bid, int nb) {
    constexpr int N_RP = 192, N_MP = 64, N_RS = 128, N_MS = 128;
    int* s_item = (int*)(sm + 32768);
    for (;;) {
        if (otid() == 0) *s_item = (int)atomicAdd(p.ctr, 1u);
        __syncthreads();
        const int it = *s_item;
        __syncthreads();
        if (it >= N_RP + N_MP + N_RS + N_MS) break;
        if (it < N_RP) { rwkv_item(p, it / 24, (it / 3) & 7, it % 3, sm); }
        else if (it < N_RP + N_MP) { const int i = it - N_RP; mlstm_prompt(p, i >> 3, i & 7, sm); }
        else if (it < N_RP + N_MP + N_RS) { const int wid = otid() >> 6; const int i = (it - N_RP - N_MP) * 8 + wid; rwkv_sample_wave(p, i >> 3, i & 7, sm + wid * 3328); }
        else if (it < N_RP + N_MP + N_RS + N_MS) { const int wid = otid() >> 6; const int i = (it - N_RP - N_MP - N_RS) * 8 + wid; mlstm_sample_wave(p, i >> 3, i & 7, sm + wid * 3328); }
    }
}

__device__ void phaseF(const Params& p, int bid, int nb) {
    const int wid = otid() >> 6, lane = otid() & 63;
    const int c8 = lane * 8;
    float lnw[8], lnb[8], mur[8], muk[8], muv[8], kaw[8], rkw[8];
#pragma unroll
    for (int i = 0; i < 8; ++i) {
        lnw[i] = p.ln_w[c8 + i]; lnb[i] = p.ln_b[c8 + i]; mur[i] = p.mu_shift[C_R + c8 + i]; muk[i] = p.mu_shift[C_K + c8 + i];
        muv[i] = p.mu_shift[C_V + c8 + i]; kaw[i] = p.k_a[c8 + i]; rkw[i] = p.r_k[c8 + i];
    }
    auto un8 = [](const uint4 u, float* o) {
        o[0] = __uint_as_float(u.x << 16); o[1] = __uint_as_float(u.x & 0xFFFF0000u); o[2] = __uint_as_float(u.y << 16); o[3] = __uint_as_float(u.y & 0xFFFF0000u);
        o[4] = __uint_as_float(u.z << 16); o[5] = __uint_as_float(u.z & 0xFFFF0000u); o[6] = __uint_as_float(u.w << 16); o[7] = __uint_as_float(u.w & 0xFFFF0000u);
    };
    struct FR { uint4 uy, ur, uk, uv, uz, ua, urp, ukp, uvp; };
    auto loadF = [&](int m, FR& q) {
        int s, t; tok_info(m, s, t);
        const bf16_t* pr = p.P + (size_t)m * NP + c8;
        const bf16_t* pp = t > 0 ? pr - NP : pr;
        q.uy = *(const uint4*)(p.Yraw + (size_t)m * 512 + c8);
        q.ur = *(const uint4*)(pr + C_R); q.uk = *(const uint4*)(pr + C_K); q.uv = *(const uint4*)(pr + C_V); q.uz = *(const uint4*)(pr + C_ZA);
        q.ua = *(const uint4*)(p.Aa + (size_t)m * 512 + c8);
        q.urp = *(const uint4*)(pp + C_R); q.ukp = *(const uint4*)(pp + C_K); q.uvp = *(const uint4*)(pp + C_V);
    };
    auto computeF = [&](int m, const FR& q) {
        int s, t; tok_info(m, s, t);
        float y[8], r[8], k[8], v[8], z[8], a[8], rp[8], kp_[8], vp[8];
        if (t > 0) { un8(q.urp, rp); un8(q.ukp, kp_); un8(q.uvp, vp); }
        else if (s >= 8) {
            const float* st = p.st_shift + (size_t)(s - 8) * SHIFT_W + c8;
#pragma unroll
            for (int i = 0; i < 8; ++i) { rp[i] = st[C_R + i]; kp_[i] = st[C_K + i]; vp[i] = st[C_V + i]; }
        } else {
#pragma unroll
            for (int i = 0; i < 8; ++i) { rp[i] = 0.f; kp_[i] = 0.f; vp[i] = 0.f; }
        }
        un8(q.uy, y); un8(q.ur, r); un8(q.uk, k); un8(q.uv, v); un8(q.uz, z); un8(q.ua, a);
        float sy = 0.f;
#pragma unroll
        for (int i = 0; i < 8; ++i) sy += y[i];
        const float mean = sum8(sy) * (1.f / 64.f);
        float sv = 0.f, sbn = 0.f;
#pragma unroll
        for (int i = 0; i < 8; ++i) {
            y[i] -= mean; sv += y[i] * y[i];
            r[i] += mur[i] * (rp[i] - r[i]); k[i] += muk[i] * (kp_[i] - k[i]); v[i] += muv[i] * (vp[i] - v[i]);
            sbn += r[i] * (k[i] * (1.f + (a[i] - 1.f) * kaw[i])) * rkw[i];
        }
        const float rstd = rsqrtf(sum8(sv) * (1.f / 64.f) + 64e-5f);
        const float bonus = sum8(sbn);
        float o[8];
#pragma unroll
        for (int i = 0; i < 8; ++i) o[i] = (y[i] * rstd * lnw[i] + lnb[i] + bonus * v[i]) * silu(z[i]);
        uint4 ou; ou.x = pk2(o[0], o[1]); ou.y = pk2(o[2], o[3]); ou.z = pk2(o[4], o[5]); ou.w = pk2(o[6], o[7]);
        *(uint4*)(p.OutA + (size_t)m * 512 + c8) = ou;
    };
    const int stride = nb * 8;
    for (int m = bid * 8 + wid; m < M_TOT; m += 2 * stride) {
        const int m2 = m + stride; const bool has2 = m2 < M_TOT;
        FR qa, qb;
        loadF(m, qa); loadF(has2 ? m2 : m, qb);
        computeF(m, qa);
        if (has2) computeF(m2, qb);
    }
}

__device__ __forceinline__ void xnew_load(const Params& p, int m, int lane, float (&v)[16]) {
    const bf16_t* xb = p.P + (size_t)m * NP + 1024 + lane * 8;
    const uint4 u0 = *(const uint4*)xb, u1 = *(const uint4*)(xb + 512);
    const float4 a = unpk4(make_uint2(u0.x, u0.y)), b = unpk4(make_uint2(u0.z, u0.w)), c = unpk4(make_uint2(u1.x, u1.y)), d = unpk4(make_uint2(u1.z, u1.w));
    v[0] = a.x; v[1] = a.y; v[2] = a.z; v[3] = a.w; v[4] = b.x; v[5] = b.y; v[6] = b.z; v[7] = b.w;
    v[8] = c.x; v[9] = c.y; v[10] = c.z; v[11] = c.w; v[12] = d.x; v[13] = d.y; v[14] = d.z; v[15] = d.w;
}
__device__ __forceinline__ void ynorm_store(const Params& p, int m, int lane, const float (&v)[16], float rstd) {
    float* yr = p.out + (size_t)m * 1024 + lane * 8;
#pragma unroll
    for (int h = 0; h < 2; ++h)
#pragma unroll
        for (int q = 0; q < 2; ++q) {
            const float4 g = *(const float4*)(p.g_final + h * 512 + lane * 8 + q * 4);
            float4 o; o.x = v[h * 8 + q * 4] * rstd * g.x; o.y = v[h * 8 + q * 4 + 1] * rstd * g.y; o.z = v[h * 8 + q * 4 + 2] * rstd * g.z; o.w = v[h * 8 + q * 4 + 3] * rstd * g.w;
            *(float4*)(yr + h * 512 + q * 4) = o;
        }
}
__device__ void phaseI(const Params& p, int bid, int nb) {
    const int wid = otid() >> 6, lane = otid() & 63;
    const int stride = nb * 8;
    for (int m = bid * 8 + wid; m < M_TOT; m += 2 * stride) {
        const int m2 = m + stride;
        const bool has2 = m2 < M_TOT;
        float va[16], vb[16];
        xnew_load(p, m, lane, va);
        xnew_load(p, has2 ? m2 : m, lane, vb);
        float sa = 0.f, sb = 0.f;
#pragma unroll
        for (int i = 0; i < 16; ++i) { sa += va[i] * va[i]; sb += vb[i] * vb[i]; }
        const float ra = rsqrtf(wave_sum(sa) * (1.f / 1024.f) + 1e-6f);
        const float rb = rsqrtf(wave_sum(sb) * (1.f / 1024.f) + 1e-6f);
        ynorm_store(p, m, lane, va, ra);
        if (has2) ynorm_store(p, m2, lane, vb, rb);
    }
}

namespace pg8 {
#define PG8_LAS __attribute__((address_space(3)))
typedef unsigned short bf16_t;
typedef short bf16x8 __attribute__((ext_vector_type(8)));
typedef float f32x4 __attribute__((ext_vector_type(4)));
typedef unsigned u32x4 __attribute__((ext_vector_type(4)));
constexpr int BM = 256, BK = 64, HALF = 128, HTB = HALF * BK * 2  , STAGE_BYTES = 8 * HTB, NXCD = 8, WGM = 8;

__host__ __device__ __forceinline__ int lds_byte(int r, int c) { const int st = (r >> 4) * 2 + (c >> 5), rr = r & 15, cc = c & 31, ob = rr * 64 + cc * 2; return st * 1024 + (ob ^ (((ob >> 9) & 1) << 5)); }
__host__ __device__ __forceinline__ void stage_rc(int b, int& R, int& C) { const int st = b / 1024, sb = b % 1024, swz = sb ^ (((sb >> 9) & 1) << 5); R = (st >> 1) * 16 + swz / 64; C = (st & 1) * 32 + (swz % 64) / 2; }
__host__ __device__ __forceinline__ int perm32(int rho) { const int n = rho >> 4, i = rho & 15; return 8 * (i >> 2) + 4 * n + (i & 3); }

struct Unit { int pm, pn; };
struct Gemm { const bf16_t* A; const bf16_t* Bt; int M, N, K, lda, ldb; };

struct StaticOrder {
    int nM, nN, nwg, G, c;
    __host__ __device__ void init(int M, int N, int G_, int c_) { nM = M / BM; nN = N / BM; nwg = nM * nN; G = G_; c = c_; }
    __host__ __device__ bool next(int i, Unit& u) const {
        const long L = (long)i * G + c; if (L >= nwg) return false;
        int wgid = (int)L; { const int q = nwg / NXCD, r = nwg % NXCD, xcd = wgid % NXCD, off = wgid / NXCD; wgid = (xcd < r ? xcd * (q + 1) : r * (q + 1) + (xcd - r) * q) + off; }
        const int nig = WGM * nN, gid = wgid / nig, fm = gid * WGM, gsz = (nM - fm) < WGM ? (nM - fm) : WGM;
        u.pm = fm + ((wgid % nig) % gsz); u.pn = (wgid % nig) / gsz; return true;
    }
    __device__ __forceinline__ void a_ready(const Unit&) const {}
    __device__ __forceinline__ void done(const Unit&) const {}
};
template <class Epi, class Sched, bool STAMP = false>
__device__ __forceinline__ void gemm_phase(PG8_LAS unsigned char* lds, const Gemm g, const Sched& S, const Epi& E, unsigned long long* stamps) {
    const int tid = otid(), wid = __builtin_amdgcn_readfirstlane(tid >> 6), lane = tid & 63, wr = wid >> 2, wc = wid & 3, fr = lane & 15, fq = lane >> 4;
    const int K = g.K, nt = K / BK;
    int ts_lo = 0, ts_hi = 0, nts = 0; const unsigned long long rt_entry = STAMP ? (unsigned long long)wall_clock64() : 0ull;
#define PG8_STAMP() do { if (STAMP && wid == 0 && nts < 64) { const unsigned long long _c = (unsigned long long)clock64(); \
        ts_lo = (lane == nts) ? (int)(unsigned)_c : ts_lo; ts_hi = (lane == nts) ? (int)(unsigned)(_c >> 32) : ts_hi; ++nts; } } while (0)
    PG8_STAMP();
    unsigned voffA[2], voffB[2];
#pragma unroll
    for (int i = 0; i < 2; ++i) { int R, C; stage_rc(tid * 16 + i * 8192, R, C); const int Rb = Epi::PERM ? ((R & ~31) + perm32(R & 31)) : R;
        voffA[i] = (unsigned)(R * g.lda + C) * 2u; voffB[i] = (unsigned)(Rb * g.ldb + C) * 2u; }
    const size_t kstep = (size_t)(BK * 2);
    const size_t hstepA = (size_t)HALF * g.lda * 2, hstepB = (size_t)HALF * g.ldb * 2;
    const size_t tstepA = 2 * hstepA, tstepB = 2 * hstepB;
    const unsigned ldsw = (unsigned)wid * 1024u;
    const int aoff = lds_byte(wr * 64 + fr, fq * 8), boff = lds_byte(wc * 32 + fr, fq * 8);
#define PG8_SA(b, h) (((b) * 2 + (h)) * HTB)
#define PG8_SB(b, h) ((4 + (b) * 2 + (h)) * HTB)
#define PG8_STAGE(bufoff, gbase, voff) do { _Pragma("unroll") for (int _i = 0; _i < 2; ++_i) \
        __builtin_amdgcn_global_load_lds((const unsigned*)((const char*)(gbase) + (voff)[_i]), (PG8_LAS unsigned*)(lds + (bufoff) + ldsw + _i * 8192), 16, 0, 0); } while (0)
#define PG8_LDA(dst, b, h) do { _Pragma("unroll") for (int m = 0; m < 4; ++m) _Pragma("unroll") for (int k = 0; k < 2; ++k) dst[m][k] = *(const PG8_LAS bf16x8*)(lds + PG8_SA(b, h) + aoff + m * 2048 + k * 1024); } while (0)
#define PG8_LDB(dst, b, h) do { _Pragma("unroll") for (int n = 0; n < 2; ++n) _Pragma("unroll") for (int k = 0; k < 2; ++k) dst[n][k] = *(const PG8_LAS bf16x8*)(lds + PG8_SB(b, h) + boff + n * 2048 + k * 1024); } while (0)
#define PG8_MMA(ai, bj, At, Bt) do { __builtin_amdgcn_s_setprio(1); _Pragma("unroll") for (int m = 0; m < 4; ++m) _Pragma("unroll") for (int n = 0; n < 2; ++n) _Pragma("unroll") for (int k = 0; k < 2; ++k) \
        acc[ai][bj][m][n] = __builtin_amdgcn_mfma_f32_16x16x32_bf16(Bt[n][k], At[m][k], acc[ai][bj][m][n], 0, 0, 0); __builtin_amdgcn_s_setprio(0); } while (0)
#define PG8_WAIT_V(n) asm volatile("s_waitcnt vmcnt(" #n ")" ::: "memory")
#define PG8_WAIT_L(n) asm volatile("s_waitcnt lgkmcnt(" #n ")" ::: "memory")
#define PG8_BAR __builtin_amdgcn_s_barrier()
#define PG8_SCHED __builtin_amdgcn_sched_barrier(0)
    Unit cur, nxt; int ui = 0;
    if (!S.next(0, cur)) return;
    f32x4 acc[2][2][4][2];
#pragma unroll
    for (int a = 0; a < 2; ++a)
#pragma unroll
        for (int b = 0; b < 2; ++b)
#pragma unroll
            for (int m = 0; m < 4; ++m)
#pragma unroll
                for (int n = 0; n < 2; ++n) acc[a][b][m][n] = (f32x4){0.f, 0.f, 0.f, 0.f};
    bf16x8 At[4][2], B0[2][2], B1[2][2];
    const char* cA = (const char*)g.A + (size_t)cur.pm * tstepA; const char* cB = (const char*)g.Bt + (size_t)cur.pn * tstepB;
    S.a_ready(cur);
    PG8_STAGE(PG8_SB(0, 0), cB, voffB); PG8_STAGE(PG8_SA(0, 0), cA, voffA); PG8_STAGE(PG8_SB(0, 1), cB + hstepB, voffB); PG8_STAGE(PG8_SA(0, 1), cA + hstepA, voffA);
    if (wr == 1) PG8_BAR;
    PG8_WAIT_V(4); PG8_BAR;
    PG8_STAGE(PG8_SB(1, 0), cB + kstep, voffB); PG8_STAGE(PG8_SA(1, 0), cA + kstep, voffA); PG8_STAGE(PG8_SB(1, 1), cB + hstepB + kstep, voffB);
    PG8_WAIT_V(6); PG8_BAR;
    PG8_STAMP();
    for (;;) {
        const bool has_next = S.next(ui + 1, nxt);
        const char* nA = has_next ? (const char*)g.A + (size_t)nxt.pm * tstepA : cA; const char* nB = has_next ? (const char*)g.Bt + (size_t)nxt.pn * tstepB : cB;
        for (int t = 0; t < nt; t += 2) {
            const bool last = (t == nt - 2);
            const char* a1 = cA + (size_t)(t + 1) * kstep;
            const char* a2 = last ? nA : cA + (size_t)(t + 2) * kstep; const char* b2 = last ? nB : cB + (size_t)(t + 2) * kstep;
            const char* a3 = a2 + kstep; const char* b3 = b2 + kstep;
            if (last && has_next) S.a_ready(nxt);
            PG8_LDB(B0, 0, 0); PG8_SCHED; PG8_LDA(At, 0, 0); PG8_STAGE(PG8_SA(1, 1), a1 + hstepA, voffA);
            PG8_WAIT_L(8); PG8_BAR; PG8_WAIT_L(0); PG8_MMA(0, 0, At, B0); PG8_BAR; PG8_SCHED;
            PG8_LDB(B1, 0, 1); PG8_STAGE(PG8_SB(0, 0), b2, voffB);
            PG8_BAR; PG8_WAIT_L(0); PG8_MMA(0, 1, At, B1); PG8_BAR;
            PG8_LDA(At, 0, 1); PG8_STAGE(PG8_SA(0, 0), a2, voffA);
            PG8_BAR; PG8_WAIT_L(0); PG8_MMA(1, 0, At, B0); PG8_BAR; PG8_SCHED;
            PG8_STAGE(PG8_SB(0, 1), b2 + hstepB, voffB);
            PG8_WAIT_V(6); PG8_BAR; PG8_MMA(1, 1, At, B1); PG8_BAR;
            PG8_LDB(B0, 1, 0); PG8_SCHED; PG8_LDA(At, 1, 0); PG8_STAGE(PG8_SA(0, 1), a2 + hstepA, voffA);
            PG8_WAIT_L(8); PG8_BAR; PG8_WAIT_L(0); PG8_MMA(0, 0, At, B0); PG8_BAR; PG8_SCHED;
            PG8_LDB(B1, 1, 1); PG8_STAGE(PG8_SB(1, 0), b3, voffB);
            PG8_BAR; PG8_WAIT_L(0); PG8_MMA(0, 1, At, B1); PG8_BAR;
            PG8_LDA(At, 1, 1); PG8_STAGE(PG8_SA(1, 0), a3, voffA);
            PG8_BAR; PG8_WAIT_L(0); PG8_MMA(1, 0, At, B0); PG8_BAR; PG8_SCHED;
            PG8_STAGE(PG8_SB(1, 1), b3 + hstepB, voffB);
            PG8_WAIT_V(6); PG8_BAR; PG8_MMA(1, 1, At, B1); PG8_BAR;
        }
        PG8_STAMP();
        if constexpr (!Epi::AFTER_DRAIN) { E(acc, cur, wr, wc, fr, fq); S.done(cur); }
        PG8_STAMP();
        if (!has_next) break;
#pragma unroll
        for (int a = 0; a < 2; ++a)
#pragma unroll
            for (int b = 0; b < 2; ++b)
#pragma unroll
                for (int m = 0; m < 4; ++m)
#pragma unroll
                    for (int n = 0; n < 2; ++n) acc[a][b][m][n] = (f32x4){0.f, 0.f, 0.f, 0.f};
        cur = nxt; cA = nA; cB = nB; ++ui;
    }
    PG8_WAIT_V(0);
    if (wr == 0) PG8_BAR;
    PG8_BAR;
    if constexpr (Epi::AFTER_DRAIN) { E.fused(acc, cur, wr, wc, fr, fq, lds, wid, lane); S.done(cur); }
    PG8_STAMP();
    if (STAMP && wid == 0) { stamps[lane] = lane < nts ? (((unsigned long long)(unsigned)ts_hi << 32) | (unsigned)ts_lo) : 0ull;
        if (lane == 62) stamps[62] = rt_entry; if (lane == 63) stamps[63] = (unsigned long long)wall_clock64(); }
#undef PG8_STAMP
#undef PG8_SA
#undef PG8_SB
#undef PG8_STAGE
#undef PG8_LDA
#undef PG8_LDB
#undef PG8_MMA
#undef PG8_WAIT_V
#undef PG8_WAIT_L
#undef PG8_BAR
#undef PG8_SCHED
}
}

struct EpiP {
    static constexpr bool PERM = true, AFTER_DRAIN = false;
    bf16_t* O; int ldc;
    __device__ __forceinline__ void operator()(const f32x4 (&acc)[2][2][4][2], const pg8::Unit& u, int wr, int wc, int fr, int fq) const {
        const int row0 = u.pm * 256 + wr * 64 + fr, col0 = u.pn * 256 + wc * 32 + 8 * fq;
#pragma unroll
        for (int ai = 0; ai < 2; ++ai)
#pragma unroll
            for (int m = 0; m < 4; ++m) {
                bf16_t* rowp = O + (size_t)(row0 + ai * 128 + m * 16) * ldc + col0;
#pragma unroll
                for (int bj = 0; bj < 2; ++bj) {
                    const f32x4 v0 = acc[ai][bj][m][0], v1 = acc[ai][bj][m][1];
                    uint4 o; o.x = pk2(v0[0], v0[1]); o.y = pk2(v0[2], v0[3]); o.z = pk2(v1[0], v1[1]); o.w = pk2(v1[2], v1[3]);
                    *(uint4*)(rowp + bj * 128) = o;
                }
            }
    }
};
template <int SECOND> struct EpiMerge {
    static constexpr bool PERM = true, AFTER_DRAIN = false;
    bf16_t* P; int gcol;
    __device__ __forceinline__ void operator()(const f32x4 (&acc)[2][2][4][2], const pg8::Unit& u, int wr, int wc, int fr, int fq) const {
        const int row0 = u.pm * 256 + wr * 64 + fr, col0 = u.pn * 256 + wc * 32 + 8 * fq;
#pragma unroll
        for (int ai = 0; ai < 2; ++ai) {
            uint4 gq[4][2], pq[4][2];
#pragma unroll
            for (int m = 0; m < 4; ++m) {
                const bf16_t* rowp = P + (size_t)(row0 + ai * 128 + m * 16) * NP + col0;
#pragma unroll
                for (int bj = 0; bj < 2; ++bj) {
                    gq[m][bj] = *(const uint4*)(rowp + gcol + bj * 128);
                    if (SECOND) pq[m][bj] = *(const uint4*)(rowp + bj * 128);
                }
            }
#pragma unroll
            for (int m = 0; m < 4; ++m) {
                bf16_t* rowp = P + (size_t)(row0 + ai * 128 + m * 16) * NP + col0;
#pragma unroll
                for (int bj = 0; bj < 2; ++bj) {
                    const f32x4 v0 = acc[ai][bj][m][0], v1 = acc[ai][bj][m][1];
                    const uint4 g = gq[m][bj];
                    const float4 ga = unpk4(make_uint2(g.x, g.y)), gb = unpk4(make_uint2(g.z, g.w));
                    float r[8] = {sigm(ga.x) * v0[0], sigm(ga.y) * v0[1], sigm(ga.z) * v0[2], sigm(ga.w) * v0[3],
                                  sigm(gb.x) * v1[0], sigm(gb.y) * v1[1], sigm(gb.z) * v1[2], sigm(gb.w) * v1[3]};
                    if (SECOND) {
                        const uint4 pv = pq[m][bj];
                        const float4 pa = unpk4(make_uint2(pv.x, pv.y)), pb = unpk4(make_uint2(pv.z, pv.w));
                        r[0] += pa.x; r[1] += pa.y; r[2] += pa.z; r[3] += pa.w; r[4] += pb.x; r[5] += pb.y; r[6] += pb.z; r[7] += pb.w;
                    }
                    uint4 o; o.x = pk2(r[0], r[1]); o.y = pk2(r[2], r[3]); o.z = pk2(r[4], r[5]); o.w = pk2(r[6], r[7]);
                    *(uint4*)(rowp + bj * 128) = o;
                }
            }
        }
    }
};
struct EpiOut {
    static constexpr bool PERM = true, AFTER_DRAIN = false;
    const Params* pp;
    __device__ __forceinline__ void operator()(const f32x4 (&acc)[2][2][4][2], const pg8::Unit& u, int wr, int wc, int fr, int fq) const {
        const Params& p = *pp;
        const int row0 = u.pm * 256 + wr * 64 + fr, col0 = u.pn * 256 + wc * 32 + 8 * fq;
#pragma unroll
        for (int ai = 0; ai < 2; ++ai)
#pragma unroll
            for (int mp = 0; mp < 2; ++mp) {
                float4 xq[2][4], gq[2][4];
#pragma unroll
                for (int mm = 0; mm < 2; ++mm) {
                    const int row = row0 + ai * 128 + (mp * 2 + mm) * 16;
                    int s, t; tok_info(row, s, t);
                    const float* xr = xrow(p, row) + col0;
                    const float* gt = p.mod + (size_t)s * 3072 + 2048 + col0;
#pragma unroll
                    for (int q = 0; q < 4; ++q) { const int co = (q >> 1) * 128 + (q & 1) * 4; xq[mm][q] = *(const float4*)(xr + co); gq[mm][q] = *(const float4*)(gt + co); }
                }
#pragma unroll
                for (int mm = 0; mm < 2; ++mm) {
                    const int m = mp * 2 + mm, row = row0 + ai * 128 + m * 16;
                    bf16_t* orow = p.P + (size_t)row * NP + 1024 + col0;
#pragma unroll
                    for (int bj = 0; bj < 2; ++bj) {
                        const float4 x0 = xq[mm][bj * 2], x1 = xq[mm][bj * 2 + 1], g0 = gq[mm][bj * 2], g1 = gq[mm][bj * 2 + 1];
                        const f32x4 a0 = acc[ai][bj][m][0], a1 = acc[ai][bj][m][1];
                        uint4 o;
                        o.x = pk2(x0.x + g0.x * a0[0], x0.y + g0.y * a0[1]); o.y = pk2(x0.z + g0.z * a0[2], x0.w + g0.w * a0[3]);
                        o.z = pk2(x1.x + g1.x * a1[0], x1.y + g1.y * a1[1]); o.w = pk2(x1.z + g1.z * a1[2], x1.w + g1.w * a1[3]);
                        *(uint4*)(orow + bj * 128) = o;
                    }
                }
            }
    }
};
template <class Epi> __device__ __forceinline__ void run_gemm(float* sm, const bf16_t* A, int lda, const bf16_t* Bt, int ldb, int M, int N, int K, const Epi& E, int bid, int nb) {
    pg8::Gemm g; g.A = A; g.Bt = Bt; g.M = M; g.N = N; g.K = K; g.lda = lda; g.ldb = ldb;
    pg8::StaticOrder S; S.init(M, N, nb, bid);
    pg8::gemm_phase<Epi, pg8::StaticOrder, false>((PG8_LAS unsigned char*)sm, g, S, E, nullptr);
}
__device__ void phaseC(const Params& p, float* sm, int bid, int nb) {
    EpiP E; E.O = p.P; E.ldc = NP;
    run_gemm(sm, p.H, 1024, p.WinT, 1024, M_TOT, NP, 1024, E, bid, nb);
}
__device__ void phaseG(const Params& p, float* sm, int bid, int nb) {
    EpiMerge<0> E0; E0.P = p.P; E0.gcol = C_GLA;
    run_gemm(sm, p.OutA, 512, p.WupaT, 512, M_TOT, 1024, 512, E0, bid, nb);
    __syncthreads();
    EpiMerge<1> E1; E1.P = p.P; E1.gcol = C_GLB;
    run_gemm(sm, p.OutB, 512, p.WupbT, 512, M_TOT, 1024, 512, E1, bid, nb);
}
__device__ void phaseH(const Params& p, float* sm, int bid, int nb) {
    EpiOut E; E.pp = &p;
    run_gemm(sm, p.P, NP, p.WoutT, 1024, M_TOT, 1024, 1024, E, bid, nb);
}

#define XB_TMO      128
#define XB_XCNT(j)  (256  + 64 * (j))
#define XB_XSUB(j)  (1280 + 64 * (j))
#define XB_XGEN(j)  (2304 + 64 * (j))
#define XB_TOP      3328
#define XB_TOPGEN   3392
#define XCD_BAR_WORDS 3456
#define XB_SPIN_CAP (1u << 18)
#define LAS __attribute__((address_space(3)))

__device__ __forceinline__ unsigned xb_ld(unsigned* p)              { return __hip_atomic_load(p, __ATOMIC_RELAXED, __HIP_MEMORY_SCOPE_AGENT); }
__device__ __forceinline__ unsigned xb_add(unsigned* p, unsigned v) { return __hip_atomic_fetch_add(p, v, __ATOMIC_RELAXED, __HIP_MEMORY_SCOPE_AGENT); }
__device__ __forceinline__ unsigned xb_xcc_id() { return (unsigned)__builtin_amdgcn_s_getreg((3 << 11) | 20) & 0xFu; }
#define XB_SPIN(cond, bar) do { unsigned _sp = 0; while (cond) { __builtin_amdgcn_s_sleep(1); \
    if ((++_sp & 255u) == 0u) { if (xb_ld(&(bar)[XB_TMO])) break; if (_sp > XB_SPIN_CAP) { atomicAdd(&(bar)[XB_TMO], 1u); break; } } } } while (0)

struct XcdBarrier {
    unsigned* bar; unsigned x;
    volatile LAS unsigned* st;
};

__device__ __forceinline__ XcdBarrier xcd_barrier_post(unsigned* bar, volatile LAS unsigned* st) {
    XcdBarrier b; b.bar = bar; b.x = xb_xcc_id(); b.st = st;
    if (threadIdx.x == 0) (void)xb_add(&bar[XB_XCNT(b.x)], 1u);
    return b;
}
__device__ __forceinline__ void xcd_barrier_complete(unsigned* bar, unsigned x, unsigned& nloc, unsigned& nx) {
    const unsigned G = gridDim.x * gridDim.y * gridDim.z;
    unsigned sum, cnt, mine, sp = 0u;
    for (;;) {
        sum = 0u; cnt = 0u; mine = 0u;
#pragma unroll
        for (unsigned j = 0; j < 16; ++j) { const unsigned c = xb_ld(&bar[XB_XCNT(j)]); sum += c; cnt += (c > 0u) ? 1u : 0u; mine = (j == x) ? c : mine; }
        if (sum == G) break;
        __builtin_amdgcn_s_sleep(1);
        if ((++sp & 255u) == 0u) { if (xb_ld(&bar[XB_TMO])) break; if (sp > XB_SPIN_CAP) { atomicAdd(&bar[XB_TMO], 1u); break; } }
    }
    nloc = mine > 0u ? mine : 1u; nx = cnt > 0u ? cnt : 1u;
}

__device__ __forceinline__ void xcd_barrier(const XcdBarrier& b) {
    asm volatile("s_waitcnt vmcnt(0)" ::: "memory");
    __syncthreads();
    if (threadIdx.x == 0) {
        unsigned* bar = b.bar;
        __builtin_amdgcn_s_waitcnt(0);
        unsigned nloc = b.st[0], nx = b.st[1];
        if (nloc == 0u) { xcd_barrier_complete(bar, b.x, nloc, nx); b.st[0] = nloc; b.st[1] = nx; }
        const unsigned old = xb_add(&bar[XB_XSUB(b.x)], 1u);
        const unsigned gen = old / nloc;
        if (old + 1u == (gen + 1u) * nloc) {
            __builtin_amdgcn_fence(__ATOMIC_RELEASE, "agent");
            asm volatile("s_waitcnt vmcnt(0)" ::: "memory");
            const unsigned og = xb_add(&bar[XB_TOP], 1u);
            const unsigned tg = og / nx;
            if (og + 1u == (tg + 1u) * nx) xb_add(&bar[XB_TOPGEN], 1u);
            else XB_SPIN(xb_ld(&bar[XB_TOPGEN]) == tg, bar);
            __builtin_amdgcn_fence(__ATOMIC_ACQUIRE, "agent");
            xb_add(&bar[XB_XGEN(b.x)], 1u);
            asm volatile("s_waitcnt vmcnt(0)" ::: "memory");
        } else {
            XB_SPIN(xb_ld(&bar[XB_XGEN(b.x)]) == gen, bar);
            __builtin_amdgcn_fence(__ATOMIC_ACQUIRE, "agent");
            asm volatile("s_waitcnt vmcnt(0)" ::: "memory");
        }
    }
    __syncthreads();
}


#if MK_MULTI
#define PHASE_KERNEL(NAME, CALL) __global__ void __launch_bounds__(NTHR) NAME(Params p) { __shared__ __attribute__((aligned(16))) float sm[SMEM_FLOATS]; const int bid = blockIdx.x, nb = gridDim.x; (void)sm; CALL; }
PHASE_KERNEL(kA, phaseA(p, sm, bid, nb))
PHASE_KERNEL(kB, phaseB(p, bid, nb))
PHASE_KERNEL(kC, phaseC(p, sm, bid, nb))
PHASE_KERNEL(kD, phaseD(p, sm, bid, nb))
PHASE_KERNEL(kE, phaseE(p, sm, bid, nb))
PHASE_KERNEL(kF, phaseF(p, bid, nb))
PHASE_KERNEL(kG, phaseG(p, sm, bid, nb))
PHASE_KERNEL(kH, phaseH(p, sm, bid, nb))
PHASE_KERNEL(kI, phaseI(p, bid, nb))
#else
__global__ void __launch_bounds__(NTHR) fwd_megakernel(Params p) {
    __shared__ __attribute__((aligned(16))) float sm[SMEM_FLOATS];
    __shared__ uint4 xb_words;
    cg::grid_group grid = cg::this_grid();
    const int bid = blockIdx.x, nb = gridDim.x;
    if (threadIdx.x == 0) xb_words = make_uint4(0u, 0u, 0u, 0u);
    __syncthreads();
    XcdBarrier xb = xcd_barrier_post(p.bar, (volatile LAS unsigned*)&xb_words);
    phaseA(p, sm, bid, nb); grid.sync();
    phaseB(p, bid, nb); xcd_barrier(xb);
    phaseC(p, sm, bid, nb); xcd_barrier(xb);
    phaseD(p, sm, bid, nb); xcd_barrier(xb);
    phaseE(p, sm, bid, nb); xcd_barrier(xb);
    phaseF(p, bid, nb); xcd_barrier(xb);
    phaseG(p, sm, bid, nb); xcd_barrier(xb);
    phaseH(p, sm, bid, nb); xcd_barrier(xb);
    phaseI(p, bid, nb);
}
#endif

extern "C" void kernel_launch(void* const* d_in, const int* in_sizes, int n_in, void* d_out, int out_size, void* d_ws, size_t ws_size,
                              hipStream_t stream) {
    Params p{};
    const float* const* in = (const float* const*)d_in;
    p.x_p = in[0]; p.x_s = in[1]; p.c_p = in[2]; p.c_s = in[3];
    p.st_shift = in[4]; p.st_S = in[5]; p.st_conv = in[6]; p.st_C = in[7]; p.st_n = in[8]; p.st_m = in[9];
    p.g_norm = in[10]; p.w_ada = in[11]; p.b_ada = in[12]; p.w_in = in[13]; p.mu_shift = in[14]; p.w_decay2 = in[15];
    p.w0 = in[16]; p.w_iclr2 = in[17]; p.a0 = in[18]; p.k_k = in[19]; p.k_a = in[20]; p.r_k = in[21];
    p.ln_w = in[22]; p.ln_b = in[23]; p.conv_w = in[24]; p.conv_b = in[25]; p.b_i = in[26]; p.b_f = in[27];
    p.gn_w = in[28]; p.w_up_a = in[29]; p.w_up_b = in[30]; p.w_out = in[31]; p.g_final = in[32];
    p.out = (float*)d_out;
    char* ws = (char*)d_ws;
    size_t off = 0;
    p.P = (bf16_t*)(ws + off); off += (size_t)M_TOT * NP * 2;
    p.WinT = (bf16_t*)(ws + off); off += (size_t)NP * 1024 * 2;
    p.WupaT = (bf16_t*)(ws + off); off += (size_t)1024 * 512 * 2;
    p.WupbT = (bf16_t*)(ws + off); off += (size_t)1024 * 512 * 2;
    p.WoutT = (bf16_t*)(ws + off); off += (size_t)1024 * 1024 * 2;
    p.mod = (float*)(ws + off); off += (size_t)NSEQ * 3072 * 4;
    p.ctr = (unsigned*)(ws + off); off += 256;
    p.bar = (unsigned*)(ws + off); off += (size_t)XCD_BAR_WORDS * 4;
    char* os = (char*)d_out;
    p.H = (bf16_t*)os;
    p.Yraw = (bf16_t*)os;
    p.OutB = (bf16_t*)(os + (size_t)M_TOT * 512 * 2);
    p.Omd = (bf16_t*)(os + (size_t)M_TOT * 1024 * 2);
    p.Aa = (bf16_t*)(os + (size_t)M_TOT * 1024 * 2 + (size_t)M_TOT * 512 * 2);
    p.OutA = p.Omd;
#if MK_MULTI
    const int G = 1024;
    kA<<<G, NTHR, 0, stream>>>(p);
    kB<<<G, NTHR, 0, stream>>>(p);
    kC<<<G, NTHR, 0, stream>>>(p);
    kD<<<G, NTHR, 0, stream>>>(p);
    kE<<<G, NTHR, 0, stream>>>(p);
    kF<<<G, NTHR, 0, stream>>>(p);
    kG<<<G, NTHR, 0, stream>>>(p);
    kH<<<G, NTHR, 0, stream>>>(p);
    kI<<<G, NTHR, 0, stream>>>(p);
#else
    static int grid_blocks = 0;
    if (!grid_blocks) {
        int dev = 0, cus = 0, per_cu = 0;
        hipGetDevice(&dev);
        hipDeviceGetAttribute(&cus, hipDeviceAttributeMultiprocessorCount, dev);
        hipOccupancyMaxActiveBlocksPerMultiprocessor(&per_cu, fwd_megakernel, NTHR, 0);
        if (per_cu > 1) per_cu = 1;
        grid_blocks = cus * per_cu;
    }
    (void)hipMemsetAsync(p.ctr, 0, 256 + (size_t)XCD_BAR_WORDS * 4, stream);
    void* args[] = {&p};
    hipError_t e = hipLaunchCooperativeKernel((void*)fwd_megakernel, dim3(grid_blocks), dim3(NTHR), args, 0, stream);
    if (e != hipSuccess) fprintf(stderr, "cooperative launch failed: %s (grid %d)\n", hipGetErrorString(e), grid_blocks);
#endif
}
```

```cpp
#include <hip/hip_runtime.h>
#include <hip/hip_cooperative_groups.h>
#include <cstdio>
namespace cg = cooperative_groups;

#ifndef MK_MULTI
#define MK_MULTI 0
#endif

typedef unsigned short bf16_t;
typedef short bf16x8 __attribute__((ext_vector_type(8)));
typedef float f32x4 __attribute__((ext_vector_type(4)));

constexpr int NTHR = 512;
constexpr int M_P = 16384, M_S = 1024, M_TOT = 17408;
constexpr int DM = 1024;
constexpr int NSEQ = 136;
constexpr int NP = 6912;
constexpr int N_IN = 6800;
constexpr int C_R = 0, C_K = 512, C_V = 1024, C_WL = 1536, C_AL = 1600, C_ZA = 1664, C_QK = 2176,
              C_VB = 3200, C_OB = 3712, C_IB = 4224, C_FB = 4232, C_ZB = 4240, C_GLA = 4752, C_GLB = 5776;
constexpr int SHIFT_W = 1664;

constexpr size_t O_Y = 0;
constexpr size_t O_PSHIFT = (size_t)M_TOT * DM;
constexpr size_t O_PS = O_PSHIFT + 8 * 1664;
constexpr size_t O_PCONV = O_PS + 8 * 8 * 4096;
constexpr size_t O_PC = O_PCONV + 8 * 3 * 1024;
constexpr size_t O_PN = O_PC + 8 * 8 * 4096;
constexpr size_t O_PM = O_PN + 8 * 8 * 64;
constexpr size_t O_SSHIFT = O_PM + 64;
constexpr size_t O_SS = O_SSHIFT + 128 * 1664;
constexpr size_t O_SCONV = O_SS + (size_t)128 * 8 * 4096;
constexpr size_t O_SC = O_SCONV + 128 * 3 * 1024;
constexpr size_t O_SN = O_SC + (size_t)128 * 8 * 4096;
constexpr size_t O_SM = O_SN + 128 * 8 * 64;
constexpr size_t O_END = O_SM + 1024;

struct Params {
    const float *x_p, *x_s, *c_p, *c_s;
    const float *st_shift, *st_S, *st_conv, *st_C, *st_n, *st_m;
    const float *g_norm, *w_ada, *b_ada, *w_in, *mu_shift, *w_decay2, *w0, *w_iclr2, *a0, *k_k, *k_a, *r_k,
        *ln_w, *ln_b, *conv_w, *conv_b, *b_i, *b_f, *gn_w, *w_up_a, *w_up_b, *w_out, *g_final;
    float* out;
    bf16_t *WinT, *WupaT, *WupbT, *WoutT;
    float* mod;
    bf16_t* P;
    bf16_t *H, *Yraw, *OutB, *Omd, *Aa, *OutA;
    unsigned* ctr;
    unsigned* bar;
    unsigned* acnt;
};

constexpr int SMEM_FLOATS = 32768 + 64;
__device__ __forceinline__ int otid() { int t = (int)__builtin_amdgcn_workitem_id_x(); asm volatile("" : "+v"(t)); return t; }
__device__ __forceinline__ void lds_barrier() { asm volatile("s_waitcnt lgkmcnt(0)" ::: "memory"); __builtin_amdgcn_s_barrier(); asm volatile("" ::: "memory"); }
__device__ __forceinline__ float bf2f(bf16_t v) { return __uint_as_float(((unsigned)v) << 16); }
__device__ __forceinline__ bf16_t f2bf(float f) { unsigned u = __float_as_uint(f); u += 0x7FFFu + ((u >> 16) & 1u); return (bf16_t)(u >> 16); }
__device__ __forceinline__ unsigned pk2(float lo, float hi) { return (unsigned)f2bf(lo) | ((unsigned)f2bf(hi) << 16); }
__device__ __forceinline__ float sigm(float x) { return __builtin_amdgcn_rcpf(1.f + __expf(-x)); }
__device__ __forceinline__ float silu(float x) { return x * __builtin_amdgcn_rcpf(1.f + __expf(-x)); }
__device__ __forceinline__ float wave_sum(float v) {
#pragma unroll
    for (int o = 32; o; o >>= 1) v += __shfl_xor(v, o);
    return v;
}
template <int CTRL> __device__ __forceinline__ float dpp_mov(float v) {
    return __builtin_bit_cast(float, __builtin_amdgcn_update_dpp(0, __builtin_bit_cast(int, v), CTRL, 0xF, 0xF, true));
}
__device__ __forceinline__ float row16_sum(float v) {
    v += dpp_mov<0xB1>(v);
    v += dpp_mov<0x4E>(v);
    v += dpp_mov<0x141>(v);
    v += dpp_mov<0x140>(v);
    return v;
}
__device__ __forceinline__ void tok_info(int m, int& s, int& t) {
    if (m < M_P) { s = m >> 11; t = m & 2047; } else { int q = m - M_P; s = 8 + (q >> 3); t = q & 7; }
}
__device__ __forceinline__ const float* xrow(const Params& p, int m) {
    return m < M_P ? p.x_p + (size_t)m * DM : p.x_s + (size_t)(m - M_P) * DM;
}

__device__ __forceinline__ void tr8(const float* __restrict__ src, int Nsrc, bf16_t* __restrict__ dst, int K, int n, int kg) {
    float v[8];
    if (n < Nsrc) {
        const float* sp = src + (size_t)(kg * 8) * Nsrc + n;
#pragma unroll
        for (int i = 0; i < 8; ++i) v[i] = sp[(size_t)i * Nsrc];
    } else {
#pragma unroll
        for (int i = 0; i < 8; ++i) v[i] = 0.f;
    }
    uint4 o; o.x = pk2(v[0], v[1]); o.y = pk2(v[2], v[3]); o.z = pk2(v[4], v[5]); o.w = pk2(v[6], v[7]);
    *(uint4*)(dst + (size_t)n * K + kg * 8) = o;
}
__device__ void phaseA(const Params& p, float* sm, int bid, int nb) {
    const int tid = otid();
    if (bid == 0 && tid == 0) *p.ctr = 0u;
    constexpr int N_ADA = 48 * 17;
    for (int i = bid; i < N_ADA; i += nb) {
        const int ct = i % 48, rgp = i / 48;
        float* sc = sm;
        float* red = sm + 8192;
        {
            float cv[16];
#pragma unroll
            for (int q = 0; q < 16; ++q) {
                const int idx = tid + q * NTHR, sl = idx >> 10, k = idx & 1023, s = rgp * 8 + sl;
                const float* src = s < 8 ? p.c_p + s * 1024 : p.c_s + (s - 8) * 1024;
                cv[q] = src[k];
            }
#pragma unroll
            for (int q = 0; q < 16; ++q) sc[tid + q * NTHR] = silu(cv[q]);
        }
        __syncthreads();
        const int col = tid & 63, kq = tid >> 6;
        float acc[8];
#pragma unroll
        for (int s = 0; s < 8; ++s) acc[s] = 0.f;
        const float* wp = p.w_ada + (size_t)(kq * 128) * 3072 + ct * 64 + col;
#pragma unroll 4
        for (int k4 = 0; k4 < 32; ++k4) {
            const float w0 = wp[(size_t)(k4 * 4) * 3072], w1 = wp[(size_t)(k4 * 4 + 1) * 3072], w2 = wp[(size_t)(k4 * 4 + 2) * 3072], w3 = wp[(size_t)(k4 * 4 + 3) * 3072];
#pragma unroll
            for (int s = 0; s < 8; ++s) {
                const float4 c = *(const float4*)(sc + s * 1024 + kq * 128 + k4 * 4);
                acc[s] += c.x * w0 + c.y * w1 + c.z * w2 + c.w * w3;
            }
        }
#pragma unroll
        for (int s = 0; s < 8; ++s) red[(kq * 8 + s) * 64 + col] = acc[s];
        __syncthreads();
        {
            const int s = tid >> 6;
            float v = p.b_ada[ct * 64 + col];
#pragma unroll
            for (int q = 0; q < 8; ++q) v += red[(q * 8 + s) * 64 + col];
            __hip_atomic_store((unsigned*)(p.mod + (size_t)(rgp * 8 + s) * 3072 + ct * 64 + col), __float_as_uint(v), __ATOMIC_RELAXED, __HIP_MEMORY_SCOPE_AGENT);
        }
        asm volatile("s_waitcnt vmcnt(0)" ::: "memory");
        __syncthreads();
        if (tid == 0) (void)__hip_atomic_fetch_add(p.acnt, 1u, __ATOMIC_RELAXED, __HIP_MEMORY_SCOPE_AGENT);
    }
    constexpr int W_IN = NP * 128, W_UP = 1024 * 64, W_OUT = 1024 * 128;
    const int gt = bid * NTHR + tid, gs = nb * NTHR;
    for (int w = gt; w < W_IN; w += 2 * gs) {
        const int w2 = w + gs; const bool has2 = w2 < W_IN;
        const int n1 = w % NP, g1 = w / NP, n2 = has2 ? w2 % NP : n1, g2 = has2 ? w2 / NP : g1;
        float v1[8], v2[8];
        const float* s1 = p.w_in + (size_t)(g1 * 8) * N_IN + (n1 < N_IN ? n1 : 0);
        const float* s2 = p.w_in + (size_t)(g2 * 8) * N_IN + (n2 < N_IN ? n2 : 0);
#pragma unroll
        for (int i = 0; i < 8; ++i) { v1[i] = s1[(size_t)i * N_IN]; v2[i] = s2[(size_t)i * N_IN]; }
        uint4 o;
        if (n1 >= N_IN) { o = make_uint4(0u, 0u, 0u, 0u); } else { o.x = pk2(v1[0], v1[1]); o.y = pk2(v1[2], v1[3]); o.z = pk2(v1[4], v1[5]); o.w = pk2(v1[6], v1[7]); }
        *(uint4*)(p.WinT + (size_t)n1 * 1024 + g1 * 8) = o;
        if (has2) {
            if (n2 >= N_IN) { o = make_uint4(0u, 0u, 0u, 0u); } else { o.x = pk2(v2[0], v2[1]); o.y = pk2(v2[2], v2[3]); o.z = pk2(v2[4], v2[5]); o.w = pk2(v2[6], v2[7]); }
            *(uint4*)(p.WinT + (size_t)n2 * 1024 + g2 * 8) = o;
        }
    }
    for (int w = gt; w < W_UP; w += gs) { tr8(p.w_up_a, 1024, p.WupaT, 512, w & 1023, w >> 10); tr8(p.w_up_b, 1024, p.WupbT, 512, w & 1023, w >> 10); }
    for (int w = gt; w < W_OUT; w += gs) tr8(p.w_out, 1024, p.WoutT, 1024, w & 1023, w >> 10);
}

__device__ __forceinline__ void normrow_load(const float* xr, int lane, float4 (&v)[4]) {
#pragma unroll
    for (int i = 0; i < 4; ++i) v[i] = *(const float4*)(xr + i * 256 + lane * 4);
}
__device__ __forceinline__ float sumsq4(const float4 (&v)[4]) {
    float ss = 0.f;
#pragma unroll
    for (int i = 0; i < 4; ++i) ss += v[i].x * v[i].x + v[i].y * v[i].y + v[i].z * v[i].z + v[i].w * v[i].w;
    return ss;
}
__device__ __forceinline__ void hrow_store(const Params& p, int m, int lane, const float4 (&v)[4], float rstd) {
    int s, t; tok_info(m, s, t);
    const float* md = p.mod + (size_t)s * 3072;
#pragma unroll
    for (int i = 0; i < 4; ++i) {
        const int c = i * 256 + lane * 4;
        const float4 g = *(const float4*)(p.g_norm + c);
        const float4 sh = *(const float4*)(md + c);
        const float4 sl = *(const float4*)(md + 1024 + c);
        const float h0 = v[i].x * rstd * g.x * (1.f + sl.x) + sh.x;
        const float h1 = v[i].y * rstd * g.y * (1.f + sl.y) + sh.y;
        const float h2 = v[i].z * rstd * g.z * (1.f + sl.z) + sh.z;
        const float h3 = v[i].w * rstd * g.w * (1.f + sl.w) + sh.w;
        uint2 o; o.x = pk2(h0, h1); o.y = pk2(h2, h3);
        *(uint2*)(p.H + (size_t)m * 1024 + c) = o;
    }
}
__device__ void phaseB(const Params& p, int bid, int nb) {
    const int wid = otid() >> 6, lane = otid() & 63;
    if (otid() == 0) {
        unsigned spins = 0;
        while (__hip_atomic_load(p.acnt, __ATOMIC_RELAXED, __HIP_MEMORY_SCOPE_AGENT) < 816u) { __builtin_amdgcn_s_sleep(2); if (++spins > (1u << 22)) break; }
        __builtin_amdgcn_fence(__ATOMIC_ACQUIRE, "agent");
        asm volatile("s_waitcnt vmcnt(0)" ::: "memory");
    }
    __syncthreads();
    const int stride = nb * 8;
    for (int m = bid * 8 + wid; m < M_TOT; m += 2 * stride) {
        const int m2 = m + stride;
        const bool has2 = m2 < M_TOT;
        float4 va[4], vb[4];
        normrow_load(xrow(p, m), lane, va);
        normrow_load(xrow(p, has2 ? m2 : m), lane, vb);
        const float ra = rsqrtf(wave_sum(sumsq4(va)) * (1.f / 1024.f) + 1e-6f);
        const float rb = rsqrtf(wave_sum(sumsq4(vb)) * (1.f / 1024.f) + 1e-6f);
        hrow_store(p, m, lane, va, ra);
        if (has2) hrow_store(p, m2, lane, vb, rb);
    }
}

typedef unsigned u32x4v __attribute__((ext_vector_type(4)));
__device__ __forceinline__ bf16x8 pack8(const float (&v)[8]) {
    u32x4v t; t[0] = pk2(v[0], v[1]); t[1] = pk2(v[2], v[3]); t[2] = pk2(v[4], v[5]); t[3] = pk2(v[6], v[7]);
    return __builtin_bit_cast(bf16x8, t);
}
__device__ void phaseD(const Params& p, float* sm, int bid, int nb) {
    const int tid = otid(), wid = tid >> 6, lane = tid & 63, fr = lane & 15, fq = lane >> 4;
    bf16_t* twb = (bf16_t*)sm;
    bf16_t* alb = twb + 16 * 72;
    bf16x8 Bd[4][2], Bi[4][2];
#pragma unroll
    for (int ct = 0; ct < 4; ++ct)
#pragma unroll
        for (int ks = 0; ks < 2; ++ks) {
            const int n = wid * 64 + ct * 16 + fr, k0 = ks * 32 + fq * 8;
            float vd[8], vi[8];
#pragma unroll
            for (int j = 0; j < 8; ++j) { vd[j] = p.w_decay2[(k0 + j) * 512 + n]; vi[j] = p.w_iclr2[(k0 + j) * 512 + n]; }
            Bd[ct][ks] = pack8(vd); Bi[ct][ks] = pack8(vi);
        }
    float w0r[16], a0r[16];
#pragma unroll
    for (int q = 0; q < 16; ++q) { const int col = wid * 64 + (q >> 2) * 16 + fq * 4 + (q & 3); w0r[q] = p.w0[col]; a0r[q] = p.a0[col]; }
    unsigned cu[4], pv[4]; float st[4];
    auto fetchD = [&](int it) {
        const int m0 = it * 16;
#pragma unroll
        for (int q = 0; q < 4; ++q) {
            const int idx = tid + q * NTHR, tok = idx >> 7, j = idx & 127, col = C_WL + j, m = m0 + tok;
            int s, t; tok_info(m, s, t);
            cu[q] = p.P[(size_t)m * NP + col];
            pv[q] = p.P[(size_t)(t > 0 ? m - 1 : m) * NP + col];
            st[q] = p.st_shift[(size_t)(s >= 8 ? s - 8 : 0) * SHIFT_W + col];
        }
    };
    if (bid < M_TOT / 16) fetchD(bid);
    for (int it = bid; it < M_TOT / 16; it += nb) {
        const int m0 = it * 16;
        {
#pragma unroll
            for (int q = 0; q < 4; ++q) {
                const int idx = tid + q * NTHR, tok = idx >> 7, j = idx & 127, col = C_WL + j, m = m0 + tok;
                int s, t; tok_info(m, s, t);
                const float cur = __uint_as_float(cu[q] << 16);
                const float prev = t > 0 ? __uint_as_float(pv[q] << 16) : (s >= 8 ? st[q] : 0.f);
                const float v = cur + p.mu_shift[col] * (prev - cur);
                if (j < 64) twb[tok * 72 + j] = f2bf(tanhf(v)); else alb[tok * 72 + j - 64] = f2bf(v);
            }
        }
        if (it + nb < M_TOT / 16) fetchD(it + nb);
        lds_barrier();
        {
            const bf16x8 at0 = *(const bf16x8*)(twb + fr * 72 + fq * 8), at1 = *(const bf16x8*)(twb + fr * 72 + 32 + fq * 8);
            const bf16x8 aa0 = *(const bf16x8*)(alb + fr * 72 + fq * 8), aa1 = *(const bf16x8*)(alb + fr * 72 + 32 + fq * 8);
            const size_t mrow = (size_t)(m0 + fr) * 512 + wid * 64 + fq * 4;
#pragma unroll
            for (int ct = 0; ct < 4; ++ct) {
                f32x4 cw = (f32x4){0.f, 0.f, 0.f, 0.f}, ca = cw;
                cw = __builtin_amdgcn_mfma_f32_16x16x32_bf16(Bd[ct][0], at0, cw, 0, 0, 0);
                cw = __builtin_amdgcn_mfma_f32_16x16x32_bf16(Bd[ct][1], at1, cw, 0, 0, 0);
                ca = __builtin_amdgcn_mfma_f32_16x16x32_bf16(Bi[ct][0], aa0, ca, 0, 0, 0);
                ca = __builtin_amdgcn_mfma_f32_16x16x32_bf16(Bi[ct][1], aa1, ca, 0, 0, 0);
                float o[4], a[4];
#pragma unroll
                for (int r = 0; r < 4; ++r) {
                    const float sg = sigm(w0r[ct * 4 + r] + cw[r]);
                    o[r] = 1.f - __expf(-0.6065306597126334f * sg);
                    a[r] = sigm(a0r[ct * 4 + r] + ca[r]);
                }
                uint2 uo, ua; uo.x = pk2(o[0], o[1]); uo.y = pk2(o[2], o[3]); ua.x = pk2(a[0], a[1]); ua.y = pk2(a[2], a[3]);
                *(uint2*)(p.Omd + mrow + ct * 16) = uo;
                *(uint2*)(p.Aa + mrow + ct * 16) = ua;
            }
        }
        for (int tok = 0; tok < 16; ++tok) {
            const int m = m0 + tok;
            int s, t; tok_info(m, s, t);
            const int T = s < 8 ? 2048 : 8;
            if (t != T - 1) continue;
            float* osh = s < 8 ? p.out + O_PSHIFT + (size_t)s * SHIFT_W : p.out + O_SSHIFT + (size_t)(s - 8) * SHIFT_W;
            float* ocv = s < 8 ? p.out + O_PCONV + (size_t)s * 3072 : p.out + O_SCONV + (size_t)(s - 8) * 3072;
            for (int col = tid; col < SHIFT_W; col += NTHR) osh[col] = bf2f(p.P[(size_t)m * NP + col]);
            for (int idx = tid; idx < 3072; idx += NTHR) {
                const int r = idx >> 10, cc = idx & 1023;
                ocv[idx] = bf2f(p.P[(size_t)(m - 2 + r) * NP + C_QK + cc]);
            }
        }
        lds_barrier();
    }
    __syncthreads();
}

__device__ __forceinline__ float rdlane(float v, int l) { return __builtin_bit_cast(float, __builtin_amdgcn_readlane(__builtin_bit_cast(int, v), l)); }
__device__ __forceinline__ float wave_sum_fast(float v) {
    v = row16_sum(v);
    return (rdlane(v, 0) + rdlane(v, 16)) + (rdlane(v, 32) + rdlane(v, 48));
}
__device__ __forceinline__ float4 unpk4(uint2 u) {
    float4 f; f.x = __uint_as_float(u.x << 16); f.y = __uint_as_float(u.x & 0xFFFF0000u);
    f.z = __uint_as_float(u.y << 16); f.w = __uint_as_float(u.y & 0xFFFF0000u); return f;
}
__device__ void rwkv_item(const Params& p, int s, int h, int third, float* sm) {
    constexpr int BUF = 15680;
    constexpr int VC_OFF = 10368, Y_OFF = 13632, NCH = 64;
    const int tid = otid(), wid = tid >> 6, lane = tid & 63;
    const int mbase = s * 2048;
    const int r0 = third * 21 + (third > 0 ? 1 : 0), nr = third == 0 ? 22 : 21;
    if (wid >= 6) {
        const int pw = wid - 6, g = lane >> 4;
        const int c4 = (lane & 15) * 4, hc = h * 64 + c4;
        const int l128 = pw * 64 + lane;
        const float4 mu_r = *(const float4*)(p.mu_shift + C_R + hc), mu_k = *(const float4*)(p.mu_shift + C_K + hc), mu_v = *(const float4*)(p.mu_shift + C_V + hc);
        const float4 kkw = *(const float4*)(p.k_k + hc), kaw = *(const float4*)(p.k_a + hc);
        uint2 R[4][8];
        auto fetch = [&](int pass, uint2 (&q)[8]) {
            const int t = (pass >> 2) * 32 + (pass & 3) * 8 + pw * 4 + g;
            const bf16_t* pr = p.P + (size_t)(mbase + t) * NP + hc;
            const bf16_t* pp = t > 0 ? pr - NP : pr;
            q[0] = *(const uint2*)(pr + C_R); q[1] = *(const uint2*)(pr + C_K); q[2] = *(const uint2*)(pr + C_V);
            q[3] = *(const uint2*)(pp + C_R); q[4] = *(const uint2*)(pp + C_K); q[5] = *(const uint2*)(pp + C_V);
            q[6] = *(const uint2*)(p.Aa + (size_t)(mbase + t) * 512 + hc);
            q[7] = *(const uint2*)(p.Omd + (size_t)(mbase + t) * 512 + hc);
        };
        auto step = [&](int pass, uint2 (&q)[8]) {
            const uint2 cr = q[0], ck = q[1], cv = q[2], crp = q[3], ckp = q[4], cvp = q[5], ca = q[6], co = q[7];
            if (pass + 4 < NCH * 4) fetch(pass + 4, q);
            const int tok = (pass & 3) * 8 + pw * 4 + g, t = (pass >> 2) * 32 + tok;
            float* B = sm + ((pass >> 2) & 1) * BUF;
            float4 r = unpk4(cr), k = unpk4(ck), v = unpk4(cv), rp, kp_, vp;
            if (t > 0) { rp = unpk4(crp); kp_ = unpk4(ckp); vp = unpk4(cvp); }
            else { rp = make_float4(0.f, 0.f, 0.f, 0.f); kp_ = rp; vp = rp; }
            r.x += mu_r.x * (rp.x - r.x); r.y += mu_r.y * (rp.y - r.y); r.z += mu_r.z * (rp.z - r.z); r.w += mu_r.w * (rp.w - r.w);
            k.x += mu_k.x * (kp_.x - k.x); k.y += mu_k.y * (kp_.y - k.y); k.z += mu_k.z * (kp_.z - k.z); k.w += mu_k.w * (kp_.w - k.w);
            v.x += mu_v.x * (vp.x - v.x); v.y += mu_v.y * (vp.y - v.y); v.z += mu_v.z * (vp.z - v.z); v.w += mu_v.w * (vp.w - v.w);
            const float4 a = unpk4(ca), om = unpk4(co);
            float4 kk; kk.x = k.x * kkw.x; kk.y = k.y * kkw.y; kk.z = k.z * kkw.z; kk.w = k.w * kkw.w;
            const float nrm = sqrtf(row16_sum(kk.x * kk.x + kk.y * kk.y + kk.z * kk.z + kk.w * kk.w));
            const float inv = __builtin_amdgcn_rcpf(fmaxf(nrm, 1e-12f));
            kk.x *= inv; kk.y *= inv; kk.z *= inv; kk.w *= inv;
            float4 ka; ka.x = kk.x * a.x; ka.y = kk.y * a.y; ka.z = kk.z * a.z; ka.w = kk.w * a.w;
            float4 kp; kp.x = k.x * (1.f + (a.x - 1.f) * kaw.x); kp.y = k.y * (1.f + (a.y - 1.f) * kaw.y);
            kp.z = k.z * (1.f + (a.z - 1.f) * kaw.z); kp.w = k.w * (1.f + (a.w - 1.f) * kaw.w);
            float4 d; d.x = 1.f - om.x; d.y = 1.f - om.y; d.z = 1.f - om.z; d.w = 1.f - om.w;
            float4 dr; dr.x = d.x * r.x; dr.y = d.y * r.y; dr.z = d.z * r.z; dr.w = d.w * r.w;
            const float c1 = row16_sum(ka.x * r.x + ka.y * r.y + ka.z * r.z + ka.w * r.w);
            const float c2 = row16_sum(kp.x * r.x + kp.y * r.y + kp.z * r.z + kp.w * r.w);
            const int o = tok * 64 + c4;
            *(float4*)(B + o) = kk; *(float4*)(B + 2048 + o) = d; *(float4*)(B + 4096 + o) = ka;
            *(float4*)(B + 6144 + o) = kp; *(float4*)(B + 8192 + o) = dr;
            float4* vc = (float4*)(B + VC_OFF) + tok * 24;
            const int l0 = c4 - r0;
            if (l0 >= 0 && l0 < nr) vc[l0] = make_float4(v.x, c1, c2, 0.f);
            if (l0 + 1 >= 0 && l0 + 1 < nr) vc[l0 + 1] = make_float4(v.y, c1, c2, 0.f);
            if (l0 + 2 >= 0 && l0 + 2 < nr) vc[l0 + 2] = make_float4(v.z, c1, c2, 0.f);
            if (l0 + 3 >= 0 && l0 + 3 < nr) vc[l0 + 3] = make_float4(v.w, c1, c2, 0.f);
        };
        auto flush = [&](int c) {
            const float* Y = sm + (c & 1) * BUF + Y_OFF;
            const int tt = l128 >> 2, part = l128 & 3;
            bf16_t* dst = p.Yraw + (size_t)(mbase + c * 32 + tt) * 512 + h * 64 + r0;
#pragma unroll
            for (int k = 0; k < 6; ++k) { const int i = part + 4 * k; if (i < nr) dst[i] = f2bf(Y[tt * 64 + i]); }
        };
#pragma unroll
        for (int q = 0; q < 4; ++q) fetch(q, R[q]);
#pragma unroll
        for (int q = 0; q < 4; ++q) step(q, R[q]);
        lds_barrier();
#pragma unroll 1
        for (int c = 0; c < NCH; ++c) {
            if (c > 0) flush(c - 1);
            if (c + 1 < NCH) {
#pragma unroll
                for (int q = 0; q < 4; ++q) step((c + 1) * 4 + q, R[q]);
            }
            lds_barrier();
        }
        flush(NCH - 1);
    } else {
        const int lrow = wid * 4 + (lane >> 4);
        const int irow = r0 + (lrow < nr ? lrow : nr - 1);
        const int c4 = (lane & 15) * 4;
        const int yslot = ((lane & 15) == 0 && lrow < nr) ? lrow : 32 + (lane & 31);
        float S0 = 0.f, S1 = 0.f, S2 = 0.f, S3 = 0.f;
        lds_barrier();
#pragma unroll 1
        for (int c = 0; c < NCH; ++c) {
            const float* B = sm + (c & 1) * BUF;
            const float* bp = B + c4;
            const float4* vp4 = (const float4*)(B + VC_OFF) + (irow - r0);
            float4 kk4 = *(const float4*)(bp), d4 = *(const float4*)(bp + 2048), ka4 = *(const float4*)(bp + 4096);
            float4 kp4 = *(const float4*)(bp + 6144), dr4 = *(const float4*)(bp + 8192), vc = vp4[0];
            float4 kkB = *(const float4*)(bp + 64), dB = *(const float4*)(bp + 64 + 2048), kaB = *(const float4*)(bp + 64 + 4096);
            float4 kpB = *(const float4*)(bp + 64 + 6144), drB = *(const float4*)(bp + 64 + 8192), vcB = vp4[24];
            float* yp = sm + (c & 1) * BUF + Y_OFF + yslot;
#pragma unroll 8
            for (int tt = 0; tt < 32; ++tt) {
                const float* nb_ = bp + (tt + 2) * 64;
                const float4 nkk = *(const float4*)(nb_), nd = *(const float4*)(nb_ + 2048), nka = *(const float4*)(nb_ + 4096);
                const float4 nkp = *(const float4*)(nb_ + 6144), ndr = *(const float4*)(nb_ + 8192), nvc = vp4[(tt + 2) * 24];
                __builtin_amdgcn_sched_barrier(0);
                float p1 = S0 * kk4.x + S1 * kk4.y + S2 * kk4.z + S3 * kk4.w;
                float p2 = S0 * dr4.x + S1 * dr4.y + S2 * dr4.z + S3 * dr4.w;
                const float vi = vc.x;
                const float u0 = S0 * d4.x + vi * kp4.x, u1 = S1 * d4.y + vi * kp4.y, u2 = S2 * d4.z + vi * kp4.z, u3 = S3 * d4.w + vi * kp4.w;
                float z = p2 - vc.y * p1;
                p1 = row16_sum(p1);
                z = row16_sum(z);
                S0 = u0 - p1 * ka4.x; S1 = u1 - p1 * ka4.y; S2 = u2 - p1 * ka4.z; S3 = u3 - p1 * ka4.w;
                yp[tt * 64] = z + vi * vc.z;
                kk4 = kkB; d4 = dB; ka4 = kaB; kp4 = kpB; dr4 = drB; vc = vcB;
                kkB = nkk; dB = nd; kaB = nka; kpB = nkp; drB = ndr; vcB = nvc;
                __builtin_amdgcn_sched_barrier(0);
            }
            lds_barrier();
        }
        if (lrow < nr) {
            float* o = p.out + O_PS + (size_t)s * 8 * 4096 + ((size_t)(h * 64 + irow)) * 64 + c4;
            float4 v; v.x = S0; v.y = S1; v.z = S2; v.w = S3;
            *(float4*)o = v;
        }
    }
    __syncthreads();
}

__device__ void mlstm_item(const Params& p, int s, int h, float* sm) {
    float* sq = sm;
    float* sk = sm + 4160;
    float* sv = sm + 8320;
    float* sc = sm + 12480;
    float* sC = sm + 16640;
    float* sn = sm + 20800;
    float* sb = sn + 64;
    float* si = sn + 128;
    float* smt = sn + 192;
    float* swin = sn + 256;
    float* sden = sn + 320;
    float* sws = sn + 384;
    float* slf = sn + 448;
    float* smisc = sn + 512;
    const int tid = otid(), wid = tid >> 6, lane = tid & 63;
    const int T = s < 8 ? 2048 : 8, L = s < 8 ? 64 : 8, NC = T / L;
    const int mbase = s < 8 ? s * 2048 : M_P + (s - 8) * 8;
    for (int idx = tid; idx < 4096; idx += NTHR) {
        const int i = idx >> 6, j = idx & 63;
        sC[i * 65 + j] = s >= 8 ? p.st_C[(size_t)((s - 8) * 8 + h) * 4096 + idx] : 0.f;
    }
    if (tid < 64) sn[tid] = s >= 8 ? p.st_n[(size_t)((s - 8) * 8 + h) * 64 + tid] : 0.f;
    if (tid == 0) smisc[0] = s >= 8 ? p.st_m[(s - 8) * 8 + h] : 0.f;
    const float cwq[4] = {p.conv_w[0 * 1024 + h * 64 + lane], p.conv_w[1 * 1024 + h * 64 + lane], p.conv_w[2 * 1024 + h * 64 + lane], p.conv_w[3 * 1024 + h * 64 + lane]};
    const float cwk[4] = {p.conv_w[0 * 1024 + 512 + h * 64 + lane], p.conv_w[1 * 1024 + 512 + h * 64 + lane], p.conv_w[2 * 1024 + 512 + h * 64 + lane], p.conv_w[3 * 1024 + 512 + h * 64 + lane]};
    const float cbq = p.conv_b[h * 64 + lane], cbk = p.conv_b[512 + h * 64 + lane];
    const float gnw = p.gn_w[h * 64 + lane];
    const float bi = p.b_i[h], bfv = p.b_f[h];
    __syncthreads();
    for (int c = 0; c < NC; ++c) {
        const int t0 = c * L;
        for (int tt = wid; tt < L; tt += 8) {
            const int t = t0 + tt, m = mbase + t;
            float aq = cbq, ak = cbk;
#pragma unroll
            for (int j = 0; j < 4; ++j) {
                const int tau = t - 3 + j;
                float xq, xk;
                if (tau >= 0) {
                    const bf16_t* pr = p.P + (size_t)(mbase + tau) * NP + C_QK + h * 64 + lane;
                    xq = bf2f(pr[0]); xk = bf2f(pr[512]);
                } else if (s >= 8) {
                    const float* st = p.st_conv + ((size_t)(s - 8) * 3 + (3 + tau)) * 1024 + h * 64 + lane;
                    xq = st[0]; xk = st[512];
                } else { xq = 0.f; xk = 0.f; }
                aq += xq * cwq[j]; ak += xk * cwk[j];
            }
            sq[tt * 65 + lane] = silu(aq);
            sk[tt * 65 + lane] = silu(ak) * 0.125f;
            sv[tt * 65 + lane] = bf2f(p.P[(size_t)m * NP + C_VB + h * 64 + lane]);
        }
        if (tid < L) {
            const int m = mbase + t0 + tid;
            si[tid] = bf2f(p.P[(size_t)m * NP + C_IB + h]) + bi;
            const float f = bf2f(p.P[(size_t)m * NP + C_FB + h]) + bfv;
            slf[tid] = f > 0.f ? -log1pf(__expf(-f)) : f - log1pf(__expf(f));
        }
        __syncthreads();
        if (tid == 0) {
            const float mprev = smisc[0];
            float b = 0.f, run = mprev;
            for (int t = 0; t < L; ++t) {
                b += slf[t];
                run = fmaxf(run, si[t] - b);
                sb[t] = b; smt[t] = b + run; swin[t] = __expf(b + mprev - (b + run));
            }
            const float mnew = b + run;
            smisc[1] = mnew; smisc[2] = __expf(b + mprev - mnew);
            for (int t = 0; t < L; ++t) sws[t] = __expf(b - sb[t] + si[t] - mnew);
        }
        __syncthreads();
        for (int idx = tid; idx < L * L; idx += NTHR) {
            const int t = idx / L, u = idx % L;
            float v = 0.f;
            if (u <= t) {
                float dot = 0.f;
#pragma unroll 8
                for (int d = 0; d < 64; ++d) dot += sq[t * 65 + d] * sk[u * 65 + d];
                v = dot * __expf(sb[t] - sb[u] + si[u] - smt[t]);
            }
            sc[t * 65 + u] = v;
        }
        __syncthreads();
        if (tid < L) {
            float rs = 0.f, qn = 0.f;
            for (int u = 0; u < L; ++u) rs += sc[tid * 65 + u];
            for (int j = 0; j < 64; ++j) qn += sn[j] * sq[tid * 65 + j];
            const float den = rs + swin[tid] * qn;
            sden[tid] = fmaxf(fabsf(den), __expf(-smt[tid]));
        }
        __syncthreads();
        for (int tt = wid; tt < L; tt += 8) {
            float num = 0.f, inter = 0.f;
            for (int u = 0; u <= tt; ++u) num += sc[tt * 65 + u] * sv[u * 65 + lane];
#pragma unroll 8
            for (int j = 0; j < 64; ++j) inter += sC[lane * 65 + j] * sq[tt * 65 + j];
            const float hv = (num + swin[tt] * inter) / sden[tt];
            const float ms = wave_sum(hv * hv) * (1.f / 64.f);
            const float hn = hv * rsqrtf(ms + 1e-6f) * gnw;
            const int m = mbase + t0 + tt;
            const float ob = bf2f(p.P[(size_t)m * NP + C_OB + h * 64 + lane]);
            const float zb = bf2f(p.P[(size_t)m * NP + C_ZB + h * 64 + lane]);
            p.OutB[(size_t)m * 512 + h * 64 + lane] = f2bf(sigm(ob) * hn * silu(zb));
        }
        __syncthreads();
        {
            const float dec = smisc[2];
            const int j = lane;
#pragma unroll
            for (int ii = 0; ii < 8; ++ii) {
                const int i = wid + 8 * ii;
                float a = dec * sC[i * 65 + j];
                for (int u = 0; u < L; ++u) a += sws[u] * sv[u * 65 + i] * sk[u * 65 + j];
                sC[i * 65 + j] = a;
            }
            if (tid < 64) {
                float a = dec * sn[tid];
                for (int u = 0; u < L; ++u) a += sws[u] * sk[u * 65 + tid];
                sn[tid] = a;
            }
            if (tid == 0) smisc[0] = smisc[1];
        }
        __syncthreads();
    }
    {
        float* oC = s < 8 ? p.out + O_PC + (size_t)(s * 8 + h) * 4096 : p.out + O_SC + (size_t)((s - 8) * 8 + h) * 4096;
        float* on = s < 8 ? p.out + O_PN + (size_t)(s * 8 + h) * 64 : p.out + O_SN + (size_t)((s - 8) * 8 + h) * 64;
        float* om = s < 8 ? p.out + O_PM + (s * 8 + h) : p.out + O_SM + ((s - 8) * 8 + h);
        for (int idx = tid; idx < 4096; idx += NTHR) oC[idx] = sC[(idx >> 6) * 65 + (idx & 63)];
        if (tid < 64) on[tid] = sn[tid];
        if (tid == 0) om[0] = smisc[0];
    }
    __syncthreads();
}

__device__ __forceinline__ bf16x8 ldfrag(const bf16_t* base, int row, int ks, int fq) { return *(const bf16x8*)(base + row * 72 + ks * 32 + fq * 8); }
__device__ __forceinline__ float sum8(float v) { v += dpp_mov<0xB1>(v); v += dpp_mov<0x4E>(v); v += dpp_mov<0x141>(v); return v; }
__device__ void mlstm_prompt(const Params& p, int s, int h, float* sm) {
    bf16_t* Qs = (bf16_t*)sm; bf16_t* Ks = Qs + 4608; bf16_t* VT = Ks + 4608; bf16_t* KwT = VT + 4608; bf16_t* Ps = KwT + 4608; bf16_t* Cb = Ps + 4608;
    float* hs = sm + 13824;
    float* sn = hs + 64 * 68;
    float* sden = sn + 64;
    float* gv = sn + 128;
    float* Gg = sn + 128 + 768;
    float* Gl = Gg + 2048;
    float* Gb = Gl + 2048;
    const int tid = otid(), wid = tid >> 6, lane = tid & 63, fr = lane & 15, fq = lane >> 4;
    const int tr = wid >> 1, tc0 = (wid & 1) * 2;
    const int mbase = s * 2048;
    const int qc = h * 64 + lane;
    f32x4 accC[2];
    accC[0] = (f32x4){0.f, 0.f, 0.f, 0.f}; accC[1] = accC[0];
    if (tid < 64) sn[tid] = 0.f;
    {
        const float bi = p.b_i[h], bfv = p.b_f[h];
        for (int cc = wid; cc < 32; cc += 8) {
            const bf16_t* pr = p.P + (size_t)(mbase + cc * 64 + lane) * NP;
            const float it = bf2f(pr[C_IB + h]) + bi;
            const float f = bf2f(pr[C_FB + h]) + bfv;
            float b = f > 0.f ? -log1pf(__expf(-f)) : f - log1pf(__expf(f));
#pragma unroll
            for (int o = 1; o < 64; o <<= 1) { const float v = __shfl_up(b, o); if (lane >= o) b += v; }
            const float g = it - b;
            float run = g;
#pragma unroll
            for (int o = 1; o < 64; o <<= 1) { const float v = __shfl_up(run, o); if (lane >= o) run = fmaxf(run, v); }
            Gg[cc * 64 + lane] = g; Gl[cc * 64 + lane] = run; Gb[cc * 64 + lane] = b;
        }
    }
    const float cwq0 = p.conv_w[qc], cwq1 = p.conv_w[1024 + qc], cwq2 = p.conv_w[2048 + qc], cwq3 = p.conv_w[3072 + qc];
    const float cwk0 = p.conv_w[512 + qc], cwk1 = p.conv_w[1536 + qc], cwk2 = p.conv_w[2560 + qc], cwk3 = p.conv_w[3584 + qc];
    const float cbq = p.conv_b[qc], cbk = p.conv_b[512 + qc];
    const float gnw = p.gn_w[qc];
    unsigned xqr[11], xkr[11], vvr[8];
    auto load_raw = [&](int c) {
        const int tb = c * 64 + wid * 8 - 3;
#pragma unroll
        for (int r = 0; r < 11; ++r) {
            const int t = tb + r, tc = t < 0 ? 0 : t;
            const bf16_t* pr = p.P + (size_t)(mbase + tc) * NP + C_QK + qc;
            xqr[r] = pr[0]; xkr[r] = pr[512];
        }
#pragma unroll
        for (int k = 0; k < 8; ++k) vvr[k] = p.P[(size_t)(mbase + tb + 3 + k) * NP + C_VB + qc];
    };
    auto gates = [&](int c, float mprev) {
        float* v = gv + (c & 1) * 384;
        const float g = Gg[c * 64 + lane], b = Gb[c * 64 + lane];
        const float run = fmaxf(Gl[c * 64 + lane], mprev), runL = fmaxf(Gl[c * 64 + 63], mprev), bL = Gb[c * 64 + 63];
        v[lane] = g; v[64 + lane] = run; v[128 + lane] = __expf(mprev - run); v[192 + lane] = __expf(g - runL); v[256 + lane] = b;
        if (lane == 0) { v[320] = bL + runL; v[321] = __expf(mprev - runL); }
    };
    load_raw(0);
    __syncthreads();
    if (wid == 0) gates(0, 0.f);
    __syncthreads();
    for (int c = 0; c < 32; ++c) {
        const int t0 = c * 64, mb = mbase + t0;
        const float* sg = gv + (c & 1) * 384; const float* srun = sg + 64; const float* swin = sg + 128; const float* sws = sg + 192; const float* sb = sg + 256;
        const float dec = sg[321];
        {
            float kw[8], xq[11], xk[11], vv[8];
            const bool head = (c == 0 && wid == 0);
#pragma unroll
            for (int r = 0; r < 11; ++r) {
                const bool z = head && r < 3;
                xq[r] = z ? 0.f : __uint_as_float(xqr[r] << 16); xk[r] = z ? 0.f : __uint_as_float(xkr[r] << 16);
            }
#pragma unroll
            for (int k = 0; k < 8; ++k) vv[k] = __uint_as_float(vvr[k] << 16);
#pragma unroll
            for (int k = 0; k < 8; ++k) {
                const int tt = wid * 8 + k;
                const float q = silu(cbq + xq[k] * cwq0 + xq[k + 1] * cwq1 + xq[k + 2] * cwq2 + xq[k + 3] * cwq3);
                const float kk = silu(cbk + xk[k] * cwk0 + xk[k + 1] * cwk1 + xk[k + 2] * cwk2 + xk[k + 3] * cwk3) * 0.125f;
                Qs[tt * 72 + lane] = f2bf(q);
                Ks[tt * 72 + lane] = f2bf(kk);
                kw[k] = kk * sws[tt];
            }
            uint4 o; o.x = pk2(kw[0], kw[1]); o.y = pk2(kw[2], kw[3]); o.z = pk2(kw[4], kw[5]); o.w = pk2(kw[6], kw[7]);
            *(uint4*)(KwT + lane * 72 + wid * 8) = o;
            o.x = pk2(vv[0], vv[1]); o.y = pk2(vv[2], vv[3]); o.z = pk2(vv[4], vv[5]); o.w = pk2(vv[6], vv[7]);
            *(uint4*)(VT + lane * 72 + wid * 8) = o;
        }
#pragma unroll
        for (int n = 0; n < 2; ++n) {
            uint2 o; o.x = pk2(accC[n][0], accC[n][1]); o.y = pk2(accC[n][2], accC[n][3]);
            *(uint2*)(Cb + (tr * 16 + fr) * 72 + (tc0 + n) * 16 + fq * 4) = o;
        }
        if (c + 1 < 32) load_raw(c + 1);
        lds_barrier();
        unsigned obr[8], zbr[8];
#pragma unroll
        for (int k = 0; k < 8; ++k) {
            const bf16_t* pr = p.P + (size_t)(mb + wid * 8 + k) * NP;
            obr[k] = pr[C_OB + qc]; zbr[k] = pr[C_ZB + qc];
        }
#pragma unroll
        for (int n = 0; n < 2; ++n) {
            const int ut = tc0 + n;
            f32x4 a = (f32x4){0.f, 0.f, 0.f, 0.f};
            if (ut <= tr) {
#pragma unroll
                for (int ks = 0; ks < 2; ++ks) a = __builtin_amdgcn_mfma_f32_16x16x32_bf16(ldfrag(Ks, ut * 16 + fr, ks, fq), ldfrag(Qs, tr * 16 + fr, ks, fq), a, 0, 0, 0);
            }
            const int t = tr * 16 + fr;
            const float rn = srun[t];
            float w[4];
#pragma unroll
            for (int r = 0; r < 4; ++r) {
                const int u = ut * 16 + fq * 4 + r;
                w[r] = (u <= t) ? a[r] * __expf(sg[u] - rn) : 0.f;
            }
            uint2 o; o.x = pk2(w[0], w[1]); o.y = pk2(w[2], w[3]);
            *(uint2*)(Ps + t * 72 + ut * 16 + fq * 4) = o;
        }
        lds_barrier();
        {
            const int t = tid >> 3, seg = tid & 7;
            const uint4 pv = *(const uint4*)(Ps + t * 72 + seg * 8);
            const uint4 qv = *(const uint4*)(Qs + t * 72 + seg * 8);
            const float4 pa = unpk4(make_uint2(pv.x, pv.y)), pb = unpk4(make_uint2(pv.z, pv.w));
            const float4 qa = unpk4(make_uint2(qv.x, qv.y)), qb = unpk4(make_uint2(qv.z, qv.w));
            const float4 na = *(const float4*)(sn + seg * 8), nb4 = *(const float4*)(sn + seg * 8 + 4);
            float rs = (pa.x + pa.y) + (pa.z + pa.w) + (pb.x + pb.y) + (pb.z + pb.w);
            float qn = qa.x * na.x + qa.y * na.y + qa.z * na.z + qa.w * na.w + qb.x * nb4.x + qb.y * nb4.y + qb.z * nb4.z + qb.w * nb4.w;
            rs = sum8(rs); qn = sum8(qn);
            if (seg == 0) sden[t] = fmaxf(fabsf(rs + swin[t] * qn), __expf(-(sb[t] + srun[t])));
        }
        f32x4 num[2], itr[2];
#pragma unroll
        for (int n = 0; n < 2; ++n) {
            const int it = tc0 + n;
            num[n] = (f32x4){0.f, 0.f, 0.f, 0.f}; itr[n] = num[n];
#pragma unroll
            for (int ks = 0; ks < 2; ++ks) {
                num[n] = __builtin_amdgcn_mfma_f32_16x16x32_bf16(ldfrag(VT, it * 16 + fr, ks, fq), ldfrag(Ps, tr * 16 + fr, ks, fq), num[n], 0, 0, 0);
                itr[n] = __builtin_amdgcn_mfma_f32_16x16x32_bf16(ldfrag(Cb, it * 16 + fr, ks, fq), ldfrag(Qs, tr * 16 + fr, ks, fq), itr[n], 0, 0, 0);
            }
        }
        lds_barrier();
        {
            const int t = tr * 16 + fr;
            const float rd = 1.f / sden[t], wn = swin[t];
#pragma unroll
            for (int n = 0; n < 2; ++n) {
                float4 o;
                o.x = (num[n][0] + wn * itr[n][0]) * rd; o.y = (num[n][1] + wn * itr[n][1]) * rd;
                o.z = (num[n][2] + wn * itr[n][2]) * rd; o.w = (num[n][3] + wn * itr[n][3]) * rd;
                *(float4*)(hs + t * 68 + (tc0 + n) * 16 + fq * 4) = o;
            }
        }
#pragma unroll
        for (int n = 0; n < 2; ++n) {
            accC[n][0] *= dec; accC[n][1] *= dec; accC[n][2] *= dec; accC[n][3] *= dec;
#pragma unroll
            for (int ks = 0; ks < 2; ++ks)
                accC[n] = __builtin_amdgcn_mfma_f32_16x16x32_bf16(ldfrag(KwT, (tc0 + n) * 16 + fr, ks, fq), ldfrag(VT, tr * 16 + fr, ks, fq), accC[n], 0, 0, 0);
        }
        {
            const int j = tid >> 3, seg = tid & 7;
            const uint4 kv = *(const uint4*)(KwT + j * 72 + seg * 8);
            const float4 ka = unpk4(make_uint2(kv.x, kv.y)), kb = unpk4(make_uint2(kv.z, kv.w));
            float sum = (ka.x + ka.y) + (ka.z + ka.w) + (kb.x + kb.y) + (kb.z + kb.w);
            sum = sum8(sum);
            if (seg == 0) sn[j] = dec * sn[j] + sum;
        }
        if (wid == 0 && c + 1 < 32) gates(c + 1, sg[320]);
        lds_barrier();
#pragma unroll
        for (int k = 0; k < 8; ++k) {
            const int tt = wid * 8 + k;
            const float hv = hs[tt * 68 + lane];
            const float ms = wave_sum_fast(hv * hv) * (1.f / 64.f);
            const float hn = hv * rsqrtf(ms + 1e-6f) * gnw;
            p.OutB[(size_t)(mb + tt) * 512 + qc] = f2bf(sigm(__uint_as_float(obr[k] << 16)) * hn * silu(__uint_as_float(zbr[k] << 16)));
        }
    }
    {
        float* oC = p.out + O_PC + (size_t)(s * 8 + h) * 4096;
#pragma unroll
        for (int n = 0; n < 2; ++n) {
            float4 o; o.x = accC[n][0]; o.y = accC[n][1]; o.z = accC[n][2]; o.w = accC[n][3];
            *(float4*)(oC + (tr * 16 + fr) * 64 + (tc0 + n) * 16 + fq * 4) = o;
        }
        if (tid < 64) p.out[O_PN + (size_t)(s * 8 + h) * 64 + tid] = sn[tid];
        if (tid == 0) p.out[O_PM + s * 8 + h] = gv[384 + 320];
    }
    __syncthreads();
}

__device__ __forceinline__ void wave_lds_fence() { __builtin_amdgcn_fence(__ATOMIC_RELEASE, "wavefront"); __builtin_amdgcn_wave_barrier(); __builtin_amdgcn_fence(__ATOMIC_ACQUIRE, "wavefront"); }
__device__ void rwkv_sample_wave(const Params& p, int sb, int h, float* wsm) {
    const int lane = otid() & 63;
    const int hj = h * 64 + lane;
    const int m0 = M_P + sb * 8;
    {
        float rr[8], kr[8], vr[8], ar[8], dd[8];
#pragma unroll
        for (int t = 0; t < 8; ++t) {
            const bf16_t* pr = p.P + (size_t)(m0 + t) * NP;
            rr[t] = bf2f(pr[C_R + hj]); kr[t] = bf2f(pr[C_K + hj]); vr[t] = bf2f(pr[C_V + hj]);
            ar[t] = bf2f(p.Aa[(size_t)(m0 + t) * 512 + hj]); dd[t] = 1.f - bf2f(p.Omd[(size_t)(m0 + t) * 512 + hj]);
        }
        const float* st = p.st_shift + (size_t)sb * SHIFT_W;
        float rp = st[C_R + hj], kp_ = st[C_K + hj], vp = st[C_V + hj];
        const float mu_r = p.mu_shift[C_R + hj], mu_k = p.mu_shift[C_K + hj], mu_v = p.mu_shift[C_V + hj];
        const float kkw = p.k_k[hj], kaw = p.k_a[hj];
#pragma unroll
        for (int t = 0; t < 8; ++t) {
            const float r = rr[t] + mu_r * (rp - rr[t]), k = kr[t] + mu_k * (kp_ - kr[t]), v = vr[t] + mu_v * (vp - vr[t]);
            rp = rr[t]; kp_ = kr[t]; vp = vr[t];
            const float a = ar[t], d = dd[t];
            float kk = k * kkw;
            const float nrm = sqrtf(wave_sum_fast(kk * kk));
            kk = kk / fmaxf(nrm, 1e-12f);
            const float ka = kk * a, kp = k * (1.f + (a - 1.f) * kaw);
            const float c1 = wave_sum_fast(ka * r), c2 = wave_sum_fast(kp * r);
            float* w = wsm + t * 400;
            w[lane] = kk; w[64 + lane] = d; w[128 + lane] = ka; w[192 + lane] = kp; w[256 + lane] = d * r; w[320 + lane] = v;
            if (lane == 0) { w[384] = c1; w[385] = c2; }
        }
    }
    float S[64];
    {
        const float* srow = p.st_S + ((size_t)(sb * 8 + h) * 64 + lane) * 64;
#pragma unroll
        for (int q = 0; q < 16; ++q) { const float4 v = *(const float4*)(srow + q * 4); S[4 * q] = v.x; S[4 * q + 1] = v.y; S[4 * q + 2] = v.z; S[4 * q + 3] = v.w; }
    }
    wave_lds_fence();
#pragma unroll 1
    for (int t = 0; t < 8; ++t) {
        const float* w = wsm + t * 400;
        float p1 = 0.f, p2 = 0.f;
#pragma unroll
        for (int q = 0; q < 16; ++q) {
            const float4 k4 = *(const float4*)(w + q * 4), r4 = *(const float4*)(w + 256 + q * 4);
            p1 += S[4 * q] * k4.x + S[4 * q + 1] * k4.y + S[4 * q + 2] * k4.z + S[4 * q + 3] * k4.w;
            p2 += S[4 * q] * r4.x + S[4 * q + 1] * r4.y + S[4 * q + 2] * r4.z + S[4 * q + 3] * r4.w;
        }
        const float vi = w[320 + lane];
        const float y = p2 - p1 * w[384] + vi * w[385];
#pragma unroll
        for (int q = 0; q < 16; ++q) {
            const float4 d4 = *(const float4*)(w + 64 + q * 4), a4 = *(const float4*)(w + 128 + q * 4), k4 = *(const float4*)(w + 192 + q * 4);
            S[4 * q] = S[4 * q] * d4.x + vi * k4.x - p1 * a4.x;
            S[4 * q + 1] = S[4 * q + 1] * d4.y + vi * k4.y - p1 * a4.y;
            S[4 * q + 2] = S[4 * q + 2] * d4.z + vi * k4.z - p1 * a4.z;
            S[4 * q + 3] = S[4 * q + 3] * d4.w + vi * k4.w - p1 * a4.w;
        }
        p.Yraw[(size_t)(m0 + t) * 512 + hj] = f2bf(y);
    }
    {
        float* o = p.out + O_SS + ((size_t)(sb * 8 + h) * 64 + lane) * 64;
#pragma unroll
        for (int q = 0; q < 16; ++q) { float4 v; v.x = S[4 * q]; v.y = S[4 * q + 1]; v.z = S[4 * q + 2]; v.w = S[4 * q + 3]; *(float4*)(o + q * 4) = v; }
    }
    wave_lds_fence();
}

__device__ void mlstm_sample_wave(const Params& p, int sb, int h, float* wsm) {
    const int lane = otid() & 63;
    const int qc = h * 64 + lane;
    const int m0 = M_P + sb * 8;
    float gi = 0.f, gl = 0.f;
    {
        float xq[11], xk[11];
#pragma unroll
        for (int r = 0; r < 3; ++r) { const float* st = p.st_conv + ((size_t)sb * 3 + r) * 1024 + qc; xq[r] = st[0]; xk[r] = st[512]; }
#pragma unroll
        for (int t = 0; t < 8; ++t) { const bf16_t* pr = p.P + (size_t)(m0 + t) * NP + C_QK + qc; xq[3 + t] = bf2f(pr[0]); xk[3 + t] = bf2f(pr[512]); }
#pragma unroll
        for (int t = 0; t < 8; ++t) {
            const bf16_t* pr = p.P + (size_t)(m0 + t) * NP;
            wsm[1024 + t * 64 + lane] = bf2f(pr[C_VB + qc]); wsm[1536 + t * 64 + lane] = bf2f(pr[C_OB + qc]); wsm[2048 + t * 64 + lane] = bf2f(pr[C_ZB + qc]);
        }
        if (lane < 8) {
            const bf16_t* pr = p.P + (size_t)(m0 + lane) * NP;
            gi = bf2f(pr[C_IB + h]) + p.b_i[h];
            const float f = bf2f(pr[C_FB + h]) + p.b_f[h];
            gl = f > 0.f ? -log1pf(__expf(-f)) : f - log1pf(__expf(f));
        }
        const float cwq0 = p.conv_w[qc], cwq1 = p.conv_w[1024 + qc], cwq2 = p.conv_w[2048 + qc], cwq3 = p.conv_w[3072 + qc];
        const float cwk0 = p.conv_w[512 + qc], cwk1 = p.conv_w[1536 + qc], cwk2 = p.conv_w[2560 + qc], cwk3 = p.conv_w[3584 + qc];
        const float cbq = p.conv_b[qc], cbk = p.conv_b[512 + qc];
#pragma unroll
        for (int t = 0; t < 8; ++t) {
            wsm[t * 64 + lane] = silu(cbq + xq[t] * cwq0 + xq[t + 1] * cwq1 + xq[t + 2] * cwq2 + xq[t + 3] * cwq3);
            wsm[512 + t * 64 + lane] = silu(cbk + xk[t] * cwk0 + xk[t + 1] * cwk1 + xk[t + 2] * cwk2 + xk[t + 3] * cwk3) * 0.125f;
        }
    }
    const float gnw = p.gn_w[qc];
    float C[64];
    {
        const float* crow = p.st_C + ((size_t)(sb * 8 + h) * 64 + lane) * 64;
#pragma unroll
        for (int q = 0; q < 16; ++q) { const float4 v = *(const float4*)(crow + q * 4); C[4 * q] = v.x; C[4 * q + 1] = v.y; C[4 * q + 2] = v.z; C[4 * q + 3] = v.w; }
    }
    float nl = p.st_n[(size_t)(sb * 8 + h) * 64 + lane];
    float m = p.st_m[sb * 8 + h];
    wave_lds_fence();
#pragma unroll 1
    for (int t = 0; t < 8; ++t) {
        const float it = rdlane(gi, t), lf = rdlane(gl, t);
        const float mt = fmaxf(lf + m, it);
        const float fdec = __expf(lf + m - mt), iw = __expf(it - mt);
        m = mt;
        const float ql = wsm[t * 64 + lane], kl = wsm[512 + t * 64 + lane];
        nl = fdec * nl + iw * kl;
        const float den = wave_sum_fast(nl * ql);
        const float ai = iw * wsm[1024 + t * 64 + lane];
        float num = 0.f;
#pragma unroll
        for (int q = 0; q < 16; ++q) {
            const float4 k4 = *(const float4*)(wsm + 512 + t * 64 + q * 4), q4 = *(const float4*)(wsm + t * 64 + q * 4);
            C[4 * q] = fdec * C[4 * q] + ai * k4.x; C[4 * q + 1] = fdec * C[4 * q + 1] + ai * k4.y;
            C[4 * q + 2] = fdec * C[4 * q + 2] + ai * k4.z; C[4 * q + 3] = fdec * C[4 * q + 3] + ai * k4.w;
            num += C[4 * q] * q4.x + C[4 * q + 1] * q4.y + C[4 * q + 2] * q4.z + C[4 * q + 3] * q4.w;
        }
        const float hv = num / fmaxf(fabsf(den), __expf(-mt));
        const float ms = wave_sum_fast(hv * hv) * (1.f / 64.f);
        p.OutB[(size_t)(m0 + t) * 512 + qc] = f2bf(sigm(wsm[1536 + t * 64 + lane]) * hv * rsqrtf(ms + 1e-6f) * gnw * silu(wsm[2048 + t * 64 + lane]));
    }
    {
        float* o = p.out + O_SC + ((size_t)(sb * 8 + h) * 64 + lane) * 64;
#pragma unroll
        for (int q = 0; q < 16; ++q) { float4 v; v.x = C[4 * q]; v.y = C[4 * q + 1]; v.z = C[4 * q + 2]; v.w = C[4 * q + 3]; *(float4*)(o + q * 4) = v; }
        p.out[O_SN + (size_t)(sb * 8 + h) * 64 + lane] = nl;
        if (lane == 0) p.out[O_SM + sb * 8 + h] = m;
    }
    wave_lds_fence();
}

__device__ void phaseE(const Params& p, float* sm, int bid, int nb) {
    constexpr int N_RP = 192, N_MP = 64, N_RS = 128, N_MS = 128;
    int* s_item = (int*)(sm + 32768);
    for (;;) {
        if (otid() == 0) *s_item = (int)atomicAdd(p.ctr, 1u);
        __syncthreads();
        const int it = *s_item;
        __syncthreads();
        if (it >= N_RP + N_MP + N_RS + N_MS) break;
        if (it < N_RP) { rwkv_item(p, it / 24, (it / 3) & 7, it % 3, sm); }
        else if (it < N_RP + N_MP) { const int i = it - N_RP; mlstm_prompt(p, i >> 3, i & 7, sm); }
        else if (it < N_RP + N_MP + N_RS) { const int wid = otid() >> 6; const int i = (it - N_RP - N_MP) * 8 + wid; rwkv_sample_wave(p, i >> 3, i & 7, sm + wid * 3328); }
        else if (it < N_RP + N_MP + N_RS + N_MS) { const int wid = otid() >> 6; const int i = (it - N_RP - N_MP - N_RS) * 8 + wid; mlstm_sample_wave(p, i >> 3, i & 7, sm + wid * 3328); }
    }
}

__device__ void phaseF(const Params& p, int bid, int nb) {
    const int wid = otid() >> 6, lane = otid() & 63;
    const int c8 = lane * 8;
    float lnw[8], lnb[8], mur[8], muk[8], muv[8], kaw[8], rkw[8];
#pragma unroll
    for (int i = 0; i < 8; ++i) {
        lnw[i] = p.ln_w[c8 + i]; lnb[i] = p.ln_b[c8 + i]; mur[i] = p.mu_shift[C_R + c8 + i]; muk[i] = p.mu_shift[C_K + c8 + i];
        muv[i] = p.mu_shift[C_V + c8 + i]; kaw[i] = p.k_a[c8 + i]; rkw[i] = p.r_k[c8 + i];
    }
    auto un8 = [](const uint4 u, float* o) {
        o[0] = __uint_as_float(u.x << 16); o[1] = __uint_as_float(u.x & 0xFFFF0000u); o[2] = __uint_as_float(u.y << 16); o[3] = __uint_as_float(u.y & 0xFFFF0000u);
        o[4] = __uint_as_float(u.z << 16); o[5] = __uint_as_float(u.z & 0xFFFF0000u); o[6] = __uint_as_float(u.w << 16); o[7] = __uint_as_float(u.w & 0xFFFF0000u);
    };
    struct FR { uint4 uy, ur, uk, uv, uz, ua, urp, ukp, uvp; };
    auto loadF = [&](int m, FR& q) {
        int s, t; tok_info(m, s, t);
        const bf16_t* pr = p.P + (size_t)m * NP + c8;
        const bf16_t* pp = t > 0 ? pr - NP : pr;
        q.uy = *(const uint4*)(p.Yraw + (size_t)m * 512 + c8);
        q.ur = *(const uint4*)(pr + C_R); q.uk = *(const uint4*)(pr + C_K); q.uv = *(const uint4*)(pr + C_V); q.uz = *(const uint4*)(pr + C_ZA);
        q.ua = *(const uint4*)(p.Aa + (size_t)m * 512 + c8);
        q.urp = *(const uint4*)(pp + C_R); q.ukp = *(const uint4*)(pp + C_K); q.uvp = *(const uint4*)(pp + C_V);
    };
    auto computeF = [&](int m, const FR& q) {
        int s, t; tok_info(m, s, t);
        float y[8], r[8], k[8], v[8], z[8], a[8], rp[8], kp_[8], vp[8];
        if (t > 0) { un8(q.urp, rp); un8(q.ukp, kp_); un8(q.uvp, vp); }
        else if (s >= 8) {
            const float* st = p.st_shift + (size_t)(s - 8) * SHIFT_W + c8;
#pragma unroll
            for (int i = 0; i < 8; ++i) { rp[i] = st[C_R + i]; kp_[i] = st[C_K + i]; vp[i] = st[C_V + i]; }
        } else {
#pragma unroll
            for (int i = 0; i < 8; ++i) { rp[i] = 0.f; kp_[i] = 0.f; vp[i] = 0.f; }
        }
        un8(q.uy, y); un8(q.ur, r); un8(q.uk, k); un8(q.uv, v); un8(q.uz, z); un8(q.ua, a);
        float sy = 0.f;
#pragma unroll
        for (int i = 0; i < 8; ++i) sy += y[i];
        const float mean = sum8(sy) * (1.f / 64.f);
        float sv = 0.f, sbn = 0.f;
#pragma unroll
        for (int i = 0; i < 8; ++i) {
            y[i] -= mean; sv += y[i] * y[i];
            r[i] += mur[i] * (rp[i] - r[i]); k[i] += muk[i] * (kp_[i] - k[i]); v[i] += muv[i] * (vp[i] - v[i]);
            sbn += r[i] * (k[i] * (1.f + (a[i] - 1.f) * kaw[i])) * rkw[i];
        }
        const float rstd = rsqrtf(sum8(sv) * (1.f / 64.f) + 64e-5f);
        const float bonus = sum8(sbn);
        float o[8];
#pragma unroll
        for (int i = 0; i < 8; ++i) o[i] = (y[i] * rstd * lnw[i] + lnb[i] + bonus * v[i]) * silu(z[i]);
        uint4 ou; ou.x = pk2(o[0], o[1]); ou.y = pk2(o[2], o[3]); ou.z = pk2(o[4], o[5]); ou.w = pk2(o[6], o[7]);
        *(uint4*)(p.OutA + (size_t)m * 512 + c8) = ou;
    };
    const int stride = nb * 8;
    for (int m = bid * 8 + wid; m < M_TOT; m += 2 * stride) {
        const int m2 = m + stride; const bool has2 = m2 < M_TOT;
        FR qa, qb;
        loadF(m, qa); loadF(has2 ? m2 : m, qb);
        computeF(m, qa);
        if (has2) computeF(m2, qb);
    }
}

__device__ __forceinline__ void xnew_load(const Params& p, int m, int lane, float (&v)[16]) {
    const bf16_t* xb = p.P + (size_t)m * NP + 1024 + lane * 8;
    const uint4 u0 = *(const uint4*)xb, u1 = *(const uint4*)(xb + 512);
    const float4 a = unpk4(make_uint2(u0.x, u0.y)), b = unpk4(make_uint2(u0.z, u0.w)), c = unpk4(make_uint2(u1.x, u1.y)), d = unpk4(make_uint2(u1.z, u1.w));
    v[0] = a.x; v[1] = a.y; v[2] = a.z; v[3] = a.w; v[4] = b.x; v[5] = b.y; v[6] = b.z; v[7] = b.w;
    v[8] = c.x; v[9] = c.y; v[10] = c.z; v[11] = c.w; v[12] = d.x; v[13] = d.y; v[14] = d.z; v[15] = d.w;
}
__device__ __forceinline__ void ynorm_store(const Params& p, int m, int lane, const float (&v)[16], float rstd) {
    float* yr = p.out + (size_t)m * 1024 + lane * 8;
#pragma unroll
    for (int h = 0; h < 2; ++h)
#pragma unroll
        for (int q = 0; q < 2; ++q) {
            const float4 g = *(const float4*)(p.g_final + h * 512 + lane * 8 + q * 4);
            float4 o; o.x = v[h * 8 + q * 4] * rstd * g.x; o.y = v[h * 8 + q * 4 + 1] * rstd * g.y; o.z = v[h * 8 + q * 4 + 2] * rstd * g.z; o.w = v[h * 8 + q * 4 + 3] * rstd * g.w;
            *(float4*)(yr + h * 512 + q * 4) = o;
        }
}
__device__ void phaseI(const Params& p, int bid, int nb) {
    const int wid = otid() >> 6, lane = otid() & 63;
    const int stride = nb * 8;
    for (int m = bid * 8 + wid; m < M_TOT; m += 2 * stride) {
        const int m2 = m + stride;
        const bool has2 = m2 < M_TOT;
        float va[16], vb[16];
        xnew_load(p, m, lane, va);
        xnew_load(p, has2 ? m2 : m, lane, vb);
        float sa = 0.f, sb = 0.f;
#pragma unroll
        for (int i = 0; i < 16; ++i) { sa += va[i] * va[i]; sb += vb[i] * vb[i]; }
        const float ra = rsqrtf(wave_sum(sa) * (1.f / 1024.f) + 1e-6f);
        const float rb = rsqrtf(wave_sum(sb) * (1.f / 1024.f) + 1e-6f);
        ynorm_store(p, m, lane, va, ra);
        if (has2) ynorm_store(p, m2, lane, vb, rb);
    }
}

namespace pg8 {
#define PG8_LAS __attribute__((address_space(3)))
typedef unsigned short bf16_t;
typedef short bf16x8 __attribute__((ext_vector_type(8)));
typedef float f32x4 __attribute__((ext_vector_type(4)));
typedef unsigned u32x4 __attribute__((ext_vector_type(4)));
constexpr int BM = 256, BK = 64, HALF = 128, HTB = HALF * BK * 2  , STAGE_BYTES = 8 * HTB, NXCD = 8, WGM = 8;

__host__ __device__ __forceinline__ int lds_byte(int r, int c) { const int st = (r >> 4) * 2 + (c >> 5), rr = r & 15, cc = c & 31, ob = rr * 64 + cc * 2; return st * 1024 + (ob ^ (((ob >> 9) & 1) << 5)); }
__host__ __device__ __forceinline__ void stage_rc(int b, int& R, int& C) { const int st = b / 1024, sb = b % 1024, swz = sb ^ (((sb >> 9) & 1) << 5); R = (st >> 1) * 16 + swz / 64; C = (st & 1) * 32 + (swz % 64) / 2; }
__host__ __device__ __forceinline__ int perm32(int rho) { const int n = rho >> 4, i = rho & 15; return 8 * (i >> 2) + 4 * n + (i & 3); }

struct Unit { int pm, pn; };
struct Gemm { const bf16_t* A; const bf16_t* Bt; int M, N, K, lda, ldb; };

struct StaticOrder {
    int nM, nN, nwg, G, c;
    __host__ __device__ void init(int M, int N, int G_, int c_) { nM = M / BM; nN = N / BM; nwg = nM * nN; G = G_; c = c_; }
    __host__ __device__ bool next(int i, Unit& u) const {
        const long L = (long)i * G + c; if (L >= nwg) return false;
        int wgid = (int)L; { const int q = nwg / NXCD, r = nwg % NXCD, xcd = wgid % NXCD, off = wgid / NXCD; wgid = (xcd < r ? xcd * (q + 1) : r * (q + 1) + (xcd - r) * q) + off; }
        const int nig = WGM * nN, gid = wgid / nig, fm = gid * WGM, gsz = (nM - fm) < WGM ? (nM - fm) : WGM;
        u.pm = fm + ((wgid % nig) % gsz); u.pn = (wgid % nig) / gsz; return true;
    }
    __device__ __forceinline__ void a_ready(const Unit&) const {}
    __device__ __forceinline__ void done(const Unit&) const {}
};
template <class Epi, class Sched, bool STAMP = false>
__device__ __forceinline__ void gemm_phase(PG8_LAS unsigned char* lds, const Gemm g, const Sched& S, const Epi& E, unsigned long long* stamps) {
    const int tid = otid(), wid = __builtin_amdgcn_readfirstlane(tid >> 6), lane = tid & 63, wr = wid >> 2, wc = wid & 3, fr = lane & 15, fq = lane >> 4;
    const int K = g.K, nt = K / BK;
    int ts_lo = 0, ts_hi = 0, nts = 0; const unsigned long long rt_entry = STAMP ? (unsigned long long)wall_clock64() : 0ull;
#define PG8_STAMP() do { if (STAMP && wid == 0 && nts < 64) { const unsigned long long _c = (unsigned long long)clock64(); \
        ts_lo = (lane == nts) ? (int)(unsigned)_c : ts_lo; ts_hi = (lane == nts) ? (int)(unsigned)(_c >> 32) : ts_hi; ++nts; } } while (0)
    PG8_STAMP();
    unsigned voffA[2], voffB[2];
#pragma unroll
    for (int i = 0; i < 2; ++i) { int R, C; stage_rc(tid * 16 + i * 8192, R, C); const int Rb = Epi::PERM ? ((R & ~31) + perm32(R & 31)) : R;
        voffA[i] = (unsigned)(R * g.lda + C) * 2u; voffB[i] = (unsigned)(Rb * g.ldb + C) * 2u; }
    const size_t kstep = (size_t)(BK * 2);
    const size_t hstepA = (size_t)HALF * g.lda * 2, hstepB = (size_t)HALF * g.ldb * 2;
    const size_t tstepA = 2 * hstepA, tstepB = 2 * hstepB;
    const unsigned ldsw = (unsigned)wid * 1024u;
    const int aoff = lds_byte(wr * 64 + fr, fq * 8), boff = lds_byte(wc * 32 + fr, fq * 8);
#define PG8_SA(b, h) (((b) * 2 + (h)) * HTB)
#define PG8_SB(b, h) ((4 + (b) * 2 + (h)) * HTB)
#define PG8_STAGE(bufoff, gbase, voff) do { _Pragma("unroll") for (int _i = 0; _i < 2; ++_i) \
        __builtin_amdgcn_global_load_lds((const unsigned*)((const char*)(gbase) + (voff)[_i]), (PG8_LAS unsigned*)(lds + (bufoff) + ldsw + _i * 8192), 16, 0, 0); } while (0)
#define PG8_LDA(dst, b, h) do { _Pragma("unroll") for (int m = 0; m < 4; ++m) _Pragma("unroll") for (int k = 0; k < 2; ++k) dst[m][k] = *(const PG8_LAS bf16x8*)(lds + PG8_SA(b, h) + aoff + m * 2048 + k * 1024); } while (0)
#define PG8_LDB(dst, b, h) do { _Pragma("unroll") for (int n = 0; n < 2; ++n) _Pragma("unroll") for (int k = 0; k < 2; ++k) dst[n][k] = *(const PG8_LAS bf16x8*)(lds + PG8_SB(b, h) + boff + n * 2048 + k * 1024); } while (0)
#define PG8_MMA(ai, bj, At, Bt) do { __builtin_amdgcn_s_setprio(1); _Pragma("unroll") for (int m = 0; m < 4; ++m) _Pragma("unroll") for (int n = 0; n < 2; ++n) _Pragma("unroll") for (int k = 0; k < 2; ++k) \
        acc[ai][bj][m][n] = __builtin_amdgcn_mfma_f32_16x16x32_bf16(Bt[n][k], At[m][k], acc[ai][bj][m][n], 0, 0, 0); __builtin_amdgcn_s_setprio(0); } while (0)
#define PG8_WAIT_V(n) asm volatile("s_waitcnt vmcnt(" #n ")" ::: "memory")
#define PG8_WAIT_L(n) asm volatile("s_waitcnt lgkmcnt(" #n ")" ::: "memory")
#define PG8_BAR __builtin_amdgcn_s_barrier()
#define PG8_SCHED __builtin_amdgcn_sched_barrier(0)
    Unit cur, nxt; int ui = 0;
    if (!S.next(0, cur)) return;
    f32x4 acc[2][2][4][2];
#pragma unroll
    for (int a = 0; a < 2; ++a)
#pragma unroll
        for (int b = 0; b < 2; ++b)
#pragma unroll
            for (int m = 0; m < 4; ++m)
#pragma unroll
                for (int n = 0; n < 2; ++n) acc[a][b][m][n] = (f32x4){0.f, 0.f, 0.f, 0.f};
    bf16x8 At[4][2], B0[2][2], B1[2][2];
    const char* cA = (const char*)g.A + (size_t)cur.pm * tstepA; const char* cB = (const char*)g.Bt + (size_t)cur.pn * tstepB;
    S.a_ready(cur);
    PG8_STAGE(PG8_SB(0, 0), cB, voffB); PG8_STAGE(PG8_SA(0, 0), cA, voffA); PG8_STAGE(PG8_SB(0, 1), cB + hstepB, voffB); PG8_STAGE(PG8_SA(0, 1), cA + hstepA, voffA);
    if (wr == 1) PG8_BAR;
    PG8_WAIT_V(4); PG8_BAR;
    PG8_STAGE(PG8_SB(1, 0), cB + kstep, voffB); PG8_STAGE(PG8_SA(1, 0), cA + kstep, voffA); PG8_STAGE(PG8_SB(1, 1), cB + hstepB + kstep, voffB);
    PG8_WAIT_V(6); PG8_BAR;
    PG8_STAMP();
    for (;;) {
        const bool has_next = S.next(ui + 1, nxt);
        const char* nA = has_next ? (const char*)g.A + (size_t)nxt.pm * tstepA : cA; const char* nB = has_next ? (const char*)g.Bt + (size_t)nxt.pn * tstepB : cB;
        for (int t = 0; t < nt; t += 2) {
            const bool last = (t == nt - 2);
            const char* a1 = cA + (size_t)(t + 1) * kstep;
            const char* a2 = last ? nA : cA + (size_t)(t + 2) * kstep; const char* b2 = last ? nB : cB + (size_t)(t + 2) * kstep;
            const char* a3 = a2 + kstep; const char* b3 = b2 + kstep;
            if (last && has_next) S.a_ready(nxt);
            PG8_LDB(B0, 0, 0); PG8_SCHED; PG8_LDA(At, 0, 0); PG8_STAGE(PG8_SA(1, 1), a1 + hstepA, voffA);
            PG8_WAIT_L(8); PG8_BAR; PG8_WAIT_L(0); PG8_MMA(0, 0, At, B0); PG8_BAR; PG8_SCHED;
            PG8_LDB(B1, 0, 1); PG8_STAGE(PG8_SB(0, 0), b2, voffB);
            PG8_BAR; PG8_WAIT_L(0); PG8_MMA(0, 1, At, B1); PG8_BAR;
            PG8_LDA(At, 0, 1); PG8_STAGE(PG8_SA(0, 0), a2, voffA);
            PG8_BAR; PG8_WAIT_L(0); PG8_MMA(1, 0, At, B0); PG8_BAR; PG8_SCHED;
            PG8_STAGE(PG8_SB(0, 1), b2 + hstepB, voffB);
            PG8_WAIT_V(6); PG8_BAR; PG8_MMA(1, 1, At, B1); PG8_BAR;
            PG8_LDB(B0, 1, 0); PG8_SCHED; PG8_LDA(At, 1, 0); PG8_STAGE(PG8_SA(0, 1), a2 + hstepA, voffA);
            PG8_WAIT_L(8); PG8_BAR; PG8_WAIT_L(0); PG8_MMA(0, 0, At, B0); PG8_BAR; PG8_SCHED;
            PG8_LDB(B1, 1, 1); PG8_STAGE(PG8_SB(1, 0), b3, voffB);
            PG8_BAR; PG8_WAIT_L(0); PG8_MMA(0, 1, At, B1); PG8_BAR;
            PG8_LDA(At, 1, 1); PG8_STAGE(PG8_SA(1, 0), a3, voffA);
            PG8_BAR; PG8_WAIT_L(0); PG8_MMA(1, 0, At, B0); PG8_BAR; PG8_SCHED;
            PG8_STAGE(PG8_SB(1, 1), b3 + hstepB, voffB);
            PG8_WAIT_V(6); PG8_BAR; PG8_MMA(1, 1, At, B1); PG8_BAR;
        }
        PG8_STAMP();
        if constexpr (!Epi::AFTER_DRAIN) { E(acc, cur, wr, wc, fr, fq); S.done(cur); }
        PG8_STAMP();
        if (!has_next) break;
#pragma unroll
        for (int a = 0; a < 2; ++a)
#pragma unroll
            for (int b = 0; b < 2; ++b)
#pragma unroll
                for (int m = 0; m < 4; ++m)
#pragma unroll
                    for (int n = 0; n < 2; ++n) acc[a][b][m][n] = (f32x4){0.f, 0.f, 0.f, 0.f};
        cur = nxt; cA = nA; cB = nB; ++ui;
    }
    PG8_WAIT_V(0);
    if (wr == 0) PG8_BAR;
    PG8_BAR;
    if constexpr (Epi::AFTER_DRAIN) { E.fused(acc, cur, wr, wc, fr, fq, lds, wid, lane); S.done(cur); }
    PG8_STAMP();
    if (STAMP && wid == 0) { stamps[lane] = lane < nts ? (((unsigned long long)(unsigned)ts_hi << 32) | (unsigned)ts_lo) : 0ull;
        if (lane == 62) stamps[62] = rt_entry; if (lane == 63) stamps[63] = (unsigned long long)wall_clock64(); }
#undef PG8_STAMP
#undef PG8_SA
#undef PG8_SB
#undef PG8_STAGE
#undef PG8_LDA
#undef PG8_LDB
#undef PG8_MMA
#undef PG8_WAIT_V
#undef PG8_WAIT_L
#undef PG8_BAR
#undef PG8_SCHED
}
}

struct EpiP {
    static constexpr bool PERM = true, AFTER_DRAIN = false;
    bf16_t* O; int ldc;
    __device__ __forceinline__ void operator()(const f32x4 (&acc)[2][2][4][2], const pg8::Unit& u, int wr, int wc, int fr, int fq) const {
        const int row0 = u.pm * 256 + wr * 64 + fr, col0 = u.pn * 256 + wc * 32 + 8 * fq;
#pragma unroll
        for (int ai = 0; ai < 2; ++ai)
#pragma unroll
            for (int m = 0; m < 4; ++m) {
                bf16_t* rowp = O + (size_t)(row0 + ai * 128 + m * 16) * ldc + col0;
#pragma unroll
                for (int bj = 0; bj < 2; ++bj) {
                    const f32x4 v0 = acc[ai][bj][m][0], v1 = acc[ai][bj][m][1];
                    uint4 o; o.x = pk2(v0[0], v0[1]); o.y = pk2(v0[2], v0[3]); o.z = pk2(v1[0], v1[1]); o.w = pk2(v1[2], v1[3]);
                    *(uint4*)(rowp + bj * 128) = o;
                }
            }
    }
};
template <int SECOND> struct EpiMerge {
    static constexpr bool PERM = true, AFTER_DRAIN = false;
    bf16_t* P; int gcol;
    __device__ __forceinline__ void operator()(const f32x4 (&acc)[2][2][4][2], const pg8::Unit& u, int wr, int wc, int fr, int fq) const {
        const int row0 = u.pm * 256 + wr * 64 + fr, col0 = u.pn * 256 + wc * 32 + 8 * fq;
#pragma unroll
        for (int ai = 0; ai < 2; ++ai) {
            uint4 gq[4][2], pq[4][2];
#pragma unroll
            for (int m = 0; m < 4; ++m) {
                const bf16_t* rowp = P + (size_t)(row0 + ai * 128 + m * 16) * NP + col0;
#pragma unroll
                for (int bj = 0; bj < 2; ++bj) {
                    gq[m][bj] = *(const uint4*)(rowp + gcol + bj * 128);
                    if (SECOND) pq[m][bj] = *(const uint4*)(rowp + bj * 128);
                }
            }
#pragma unroll
            for (int m = 0; m < 4; ++m) {
                bf16_t* rowp = P + (size_t)(row0 + ai * 128 + m * 16) * NP + col0;
#pragma unroll
                for (int bj = 0; bj < 2; ++bj) {
                    const f32x4 v0 = acc[ai][bj][m][0], v1 = acc[ai][bj][m][1];
                    const uint4 g = gq[m][bj];
                    const float4 ga = unpk4(make_uint2(g.x, g.y)), gb = unpk4(make_uint2(g.z, g.w));
                    float r[8] = {sigm(ga.x) * v0[0], sigm(ga.y) * v0[1], sigm(ga.z) * v0[2], sigm(ga.w) * v0[3],
                                  sigm(gb.x) * v1[0], sigm(gb.y) * v1[1], sigm(gb.z) * v1[2], sigm(gb.w) * v1[3]};
                    if (SECOND) {
                        const uint4 pv = pq[m][bj];
                        const float4 pa = unpk4(make_uint2(pv.x, pv.y)), pb = unpk4(make_uint2(pv.z, pv.w));
                        r[0] += pa.x; r[1] += pa.y; r[2] += pa.z; r[3] += pa.w; r[4] += pb.x; r[5] += pb.y; r[6] += pb.z; r[7] += pb.w;
                    }
                    uint4 o; o.x = pk2(r[0], r[1]); o.y = pk2(r[2], r[3]); o.z = pk2(r[4], r[5]); o.w = pk2(r[6], r[7]);
                    *(uint4*)(rowp + bj * 128) = o;
                }
            }
        }
    }
};
struct EpiOut {
    static constexpr bool PERM = true, AFTER_DRAIN = false;
    const Params* pp;
    __device__ __forceinline__ void operator()(const f32x4 (&acc)[2][2][4][2], const pg8::Unit& u, int wr, int wc, int fr, int fq) const {
        const Params& p = *pp;
        const int row0 = u.pm * 256 + wr * 64 + fr, col0 = u.pn * 256 + wc * 32 + 8 * fq;
#pragma unroll
        for (int ai = 0; ai < 2; ++ai)
#pragma unroll
            for (int mp = 0; mp < 2; ++mp) {
                float4 xq[2][4], gq[2][4];
#pragma unroll
                for (int mm = 0; mm < 2; ++mm) {
                    const int row = row0 + ai * 128 + (mp * 2 + mm) * 16;
                    int s, t; tok_info(row, s, t);
                    const float* xr = xrow(p, row) + col0;
                    const float* gt = p.mod + (size_t)s * 3072 + 2048 + col0;
#pragma unroll
                    for (int q = 0; q < 4; ++q) { const int co = (q >> 1) * 128 + (q & 1) * 4; xq[mm][q] = *(const float4*)(xr + co); gq[mm][q] = *(const float4*)(gt + co); }
                }
#pragma unroll
                for (int mm = 0; mm < 2; ++mm) {
                    const int m = mp * 2 + mm, row = row0 + ai * 128 + m * 16;
                    bf16_t* orow = p.P + (size_t)row * NP + 1024 + col0;
#pragma unroll
                    for (int bj = 0; bj < 2; ++bj) {
                        const float4 x0 = xq[mm][bj * 2], x1 = xq[mm][bj * 2 + 1], g0 = gq[mm][bj * 2], g1 = gq[mm][bj * 2 + 1];
                        const f32x4 a0 = acc[ai][bj][m][0], a1 = acc[ai][bj][m][1];
                        uint4 o;
                        o.x = pk2(x0.x + g0.x * a0[0], x0.y + g0.y * a0[1]); o.y = pk2(x0.z + g0.z * a0[2], x0.w + g0.w * a0[3]);
                        o.z = pk2(x1.x + g1.x * a1[0], x1.y + g1.y * a1[1]); o.w = pk2(x1.z + g1.z * a1[2], x1.w + g1.w * a1[3]);
                        *(uint4*)(orow + bj * 128) = o;
                    }
                }
            }
    }
};
template <class Epi> __device__ __forceinline__ void run_gemm(float* sm, const bf16_t* A, int lda, const bf16_t* Bt, int ldb, int M, int N, int K, const Epi& E, int bid, int nb) {
    pg8::Gemm g; g.A = A; g.Bt = Bt; g.M = M; g.N = N; g.K = K; g.lda = lda; g.ldb = ldb;
    pg8::StaticOrder S; S.init(M, N, nb, bid);
    pg8::gemm_phase<Epi, pg8::StaticOrder, false>((PG8_LAS unsigned char*)sm, g, S, E, nullptr);
}
__device__ void phaseC(const Params& p, float* sm, int bid, int nb) {
    EpiP E; E.O = p.P; E.ldc = NP;
    run_gemm(sm, p.H, 1024, p.WinT, 1024, M_TOT, NP, 1024, E, bid, nb);
}
__device__ void phaseG(const Params& p, float* sm, int bid, int nb) {
    EpiMerge<0> E0; E0.P = p.P; E0.gcol = C_GLA;
    run_gemm(sm, p.OutA, 512, p.WupaT, 512, M_TOT, 1024, 512, E0, bid, nb);
    __syncthreads();
    EpiMerge<1> E1; E1.P = p.P; E1.gcol = C_GLB;
    run_gemm(sm, p.OutB, 512, p.WupbT, 512, M_TOT, 1024, 512, E1, bid, nb);
}
__device__ void phaseH(const Params& p, float* sm, int bid, int nb) {
    EpiOut E; E.pp = &p;
    run_gemm(sm, p.P, NP, p.WoutT, 1024, M_TOT, 1024, 1024, E, bid, nb);
}

#define XB_TMO      128
#define XB_XCNT(j)  (256  + 64 * (j))
#define XB_XSUB(j)  (1280 + 64 * (j))
#define XB_XGEN(j)  (2304 + 64 * (j))
#define XB_TOP      3328
#define XB_TOPGEN   3392
#define XCD_BAR_WORDS 3456
#define XB_SPIN_CAP (1u << 18)
#define LAS __attribute__((address_space(3)))

__device__ __forceinline__ unsigned xb_ld(unsigned* p)              { return __hip_atomic_load(p, __ATOMIC_RELAXED, __HIP_MEMORY_SCOPE_AGENT); }
__device__ __forceinline__ unsigned xb_add(unsigned* p, unsigned v) { return __hip_atomic_fetch_add(p, v, __ATOMIC_RELAXED, __HIP_MEMORY_SCOPE_AGENT); }
__device__ __forceinline__ unsigned xb_xcc_id() { return (unsigned)__builtin_amdgcn_s_getreg((3 << 11) | 20) & 0xFu; }
#define XB_SPIN(cond, bar) do { unsigned _sp = 0; while (cond) { __builtin_amdgcn_s_sleep(1); \
    if ((++_sp & 255u) == 0u) { if (xb_ld(&(bar)[XB_TMO])) break; if (_sp > XB_SPIN_CAP) { atomicAdd(&(bar)[XB_TMO], 1u); break; } } } } while (0)

struct XcdBarrier {
    unsigned* bar; unsigned x;
    volatile LAS unsigned* st;
};

__device__ __forceinline__ XcdBarrier xcd_barrier_post(unsigned* bar, volatile LAS unsigned* st) {
    XcdBarrier b; b.bar = bar; b.x = xb_xcc_id(); b.st = st;
    if (threadIdx.x == 0) (void)xb_add(&bar[XB_XCNT(b.x)], 1u);
    return b;
}
__device__ __forceinline__ void xcd_barrier_complete(unsigned* bar, unsigned x, unsigned& nloc, unsigned& nx) {
    const unsigned G = gridDim.x * gridDim.y * gridDim.z;
    unsigned sum, cnt, mine, sp = 0u;
    for (;;) {
        sum = 0u; cnt = 0u; mine = 0u;
#pragma unroll
        for (unsigned j = 0; j < 16; ++j) { const unsigned c = xb_ld(&bar[XB_XCNT(j)]); sum += c; cnt += (c > 0u) ? 1u : 0u; mine = (j == x) ? c : mine; }
        if (sum == G) break;
        __builtin_amdgcn_s_sleep(1);
        if ((++sp & 255u) == 0u) { if (xb_ld(&bar[XB_TMO])) break; if (sp > XB_SPIN_CAP) { atomicAdd(&bar[XB_TMO], 1u); break; } }
    }
    nloc = mine > 0u ? mine : 1u; nx = cnt > 0u ? cnt : 1u;
}

__device__ __forceinline__ void xcd_barrier(const XcdBarrier& b) {
    asm volatile("s_waitcnt vmcnt(0)" ::: "memory");
    __syncthreads();
    if (threadIdx.x == 0) {
        unsigned* bar = b.bar;
        __builtin_amdgcn_s_waitcnt(0);
        unsigned nloc = b.st[0], nx = b.st[1];
        if (nloc == 0u) { xcd_barrier_complete(bar, b.x, nloc, nx); b.st[0] = nloc; b.st[1] = nx; }
        const unsigned old = xb_add(&bar[XB_XSUB(b.x)], 1u);
        const unsigned gen = old / nloc;
        if (old + 1u == (gen + 1u) * nloc) {
            __builtin_amdgcn_fence(__ATOMIC_RELEASE, "agent");
            asm volatile("s_waitcnt vmcnt(0)" ::: "memory");
            const unsigned og = xb_add(&bar[XB_TOP], 1u);
            const unsigned tg = og / nx;
            if (og + 1u == (tg + 1u) * nx) xb_add(&bar[XB_TOPGEN], 1u);
            else XB_SPIN(xb_ld(&bar[XB_TOPGEN]) == tg, bar);
            __builtin_amdgcn_fence(__ATOMIC_ACQUIRE, "agent");
            xb_add(&bar[XB_XGEN(b.x)], 1u);
            asm volatile("s_waitcnt vmcnt(0)" ::: "memory");
        } else {
            XB_SPIN(xb_ld(&bar[XB_XGEN(b.x)]) == gen, bar);
            __builtin_amdgcn_fence(__ATOMIC_ACQUIRE, "agent");
            asm volatile("s_waitcnt vmcnt(0)" ::: "memory");
        }
    }
    __syncthreads();
}


#if MK_MULTI
#define PHASE_KERNEL(NAME, CALL) __global__ void __launch_bounds__(NTHR) NAME(Params p) { __shared__ __attribute__((aligned(16))) float sm[SMEM_FLOATS]; const int bid = blockIdx.x, nb = gridDim.x; (void)sm; CALL; }
PHASE_KERNEL(kA, phaseA(p, sm, bid, nb))
PHASE_KERNEL(kB, phaseB(p, bid, nb))
PHASE_KERNEL(kC, phaseC(p, sm, bid, nb))
PHASE_KERNEL(kD, phaseD(p, sm, bid, nb))
PHASE_KERNEL(kE, phaseE(p, sm, bid, nb))
PHASE_KERNEL(kF, phaseF(p, bid, nb))
PHASE_KERNEL(kG, phaseG(p, sm, bid, nb))
PHASE_KERNEL(kH, phaseH(p, sm, bid, nb))
PHASE_KERNEL(kI, phaseI(p, bid, nb))
#else
__global__ void __launch_bounds__(NTHR) fwd_megakernel(Params p) {
    __shared__ __attribute__((aligned(16))) float sm[SMEM_FLOATS];
    __shared__ uint4 xb_words;
    cg::grid_group grid = cg::this_grid();
    const int bid = blockIdx.x, nb = gridDim.x;
    if (threadIdx.x == 0) xb_words = make_uint4(0u, 0u, 0u, 0u);
    __syncthreads();
    XcdBarrier xb = xcd_barrier_post(p.bar, (volatile LAS unsigned*)&xb_words);
    phaseA(p, sm, bid, nb);
    if (__hip_atomic_load(p.acnt + 1, __ATOMIC_RELAXED, __HIP_MEMORY_SCOPE_AGENT) == 0xFFFFFFFFu) grid.sync();
    phaseB(p, bid, nb); xcd_barrier(xb);
    phaseC(p, sm, bid, nb); xcd_barrier(xb);
    phaseD(p, sm, bid, nb); xcd_barrier(xb);
    phaseE(p, sm, bid, nb); xcd_barrier(xb);
    phaseF(p, bid, nb); xcd_barrier(xb);
    phaseG(p, sm, bid, nb); xcd_barrier(xb);
    phaseH(p, sm, bid, nb); xcd_barrier(xb);
    phaseI(p, bid, nb);
}
#endif

extern "C" void kernel_launch(void* const* d_in, const int* in_sizes, int n_in, void* d_out, int out_size, void* d_ws, size_t ws_size,
                              hipStream_t stream) {
    Params p{};
    const float* const* in = (const float* const*)d_in;
    p.x_p = in[0]; p.x_s = in[1]; p.c_p = in[2]; p.c_s = in[3];
    p.st_shift = in[4]; p.st_S = in[5]; p.st_conv = in[6]; p.st_C = in[7]; p.st_n = in[8]; p.st_m = in[9];
    p.g_norm = in[10]; p.w_ada = in[11]; p.b_ada = in[12]; p.w_in = in[13]; p.mu_shift = in[14]; p.w_decay2 = in[15];
    p.w0 = in[16]; p.w_iclr2 = in[17]; p.a0 = in[18]; p.k_k = in[19]; p.k_a = in[20]; p.r_k = in[21];
    p.ln_w = in[22]; p.ln_b = in[23]; p.conv_w = in[24]; p.conv_b = in[25]; p.b_i = in[26]; p.b_f = in[27];
    p.gn_w = in[28]; p.w_up_a = in[29]; p.w_up_b = in[30]; p.w_out = in[31]; p.g_final = in[32];
    p.out = (float*)d_out;
    char* ws = (char*)d_ws;
    size_t off = 0;
    p.P = (bf16_t*)(ws + off); off += (size_t)M_TOT * NP * 2;
    p.WinT = (bf16_t*)(ws + off); off += (size_t)NP * 1024 * 2;
    p.WupaT = (bf16_t*)(ws + off); off += (size_t)1024 * 512 * 2;
    p.WupbT = (bf16_t*)(ws + off); off += (size_t)1024 * 512 * 2;
    p.WoutT = (bf16_t*)(ws + off); off += (size_t)1024 * 1024 * 2;
    p.mod = (float*)(ws + off); off += (size_t)NSEQ * 3072 * 4;
    p.ctr = (unsigned*)(ws + off); off += 256;
    p.bar = (unsigned*)(ws + off); off += (size_t)XCD_BAR_WORDS * 4;
    p.acnt = (unsigned*)(ws + off); off += 256;
    char* os = (char*)d_out;
    p.H = (bf16_t*)os;
    p.Yraw = (bf16_t*)os;
    p.OutB = (bf16_t*)(os + (size_t)M_TOT * 512 * 2);
    p.Omd = (bf16_t*)(os + (size_t)M_TOT * 1024 * 2);
    p.Aa = (bf16_t*)(os + (size_t)M_TOT * 1024 * 2 + (size_t)M_TOT * 512 * 2);
    p.OutA = p.Omd;
#if MK_MULTI
    const int G = 1024;
    kA<<<G, NTHR, 0, stream>>>(p);
    kB<<<G, NTHR, 0, stream>>>(p);
    kC<<<G, NTHR, 0, stream>>>(p);
    kD<<<G, NTHR, 0, stream>>>(p);
    kE<<<G, NTHR, 0, stream>>>(p);
    kF<<<G, NTHR, 0, stream>>>(p);
    kG<<<G, NTHR, 0, stream>>>(p);
    kH<<<G, NTHR, 0, stream>>>(p);
    kI<<<G, NTHR, 0, stream>>>(p);
#else
    static int grid_blocks = 0;
    if (!grid_blocks) {
        int dev = 0, cus = 0, per_cu = 0;
        hipGetDevice(&dev);
        hipDeviceGetAttribute(&cus, hipDeviceAttributeMultiprocessorCount, dev);
        hipOccupancyMaxActiveBlocksPerMultiprocessor(&per_cu, fwd_megakernel, NTHR, 0);
        if (per_cu > 1) per_cu = 1;
        grid_blocks = cus * per_cu;
    }
    (void)hipMemsetAsync(p.ctr, 0, 256 + (size_t)XCD_BAR_WORDS * 4 + 256, stream);
    void* args[] = {&p};
    hipError_t e = hipLaunchCooperativeKernel((void*)fwd_megakernel, dim3(grid_blocks), dim3(NTHR), args, 0, stream);
    if (e != hipSuccess) fprintf(stderr, "cooperative launch failed: %s (grid %d)\n", hipGetErrorString(e), grid_blocks);
#endif
}
```

```cpp
#include <hip/hip_runtime.h>
#include <hip/hip_cooperative_groups.h>
#include <cstdio>
namespace cg = cooperative_groups;

#ifndef MK_MULTI
#define MK_MULTI 0
#endif

typedef unsigned short bf16_t;
typedef short bf16x8 __attribute__((ext_vector_type(8)));
typedef float f32x4 __attribute__((ext_vector_type(4)));

constexpr int NTHR = 512;
constexpr int M_P = 16384, M_S = 1024, M_TOT = 17408;
constexpr int DM = 1024;
constexpr int NSEQ = 136;
constexpr int NP = 6912;
constexpr int N_IN = 6800;
constexpr int C_R = 0, C_K = 512, C_V = 1024, C_WL = 1536, C_AL = 1600, C_ZA = 1664, C_QK = 2176,
              C_VB = 3200, C_OB = 3712, C_IB = 4224, C_FB = 4232, C_ZB = 4240, C_GLA = 4752, C_GLB = 5776;
constexpr int SHIFT_W = 1664;

constexpr size_t O_Y = 0;
constexpr size_t O_PSHIFT = (size_t)M_TOT * DM;
constexpr size_t O_PS = O_PSHIFT + 8 * 1664;
constexpr size_t O_PCONV = O_PS + 8 * 8 * 4096;
constexpr size_t O_PC = O_PCONV + 8 * 3 * 1024;
constexpr size_t O_PN = O_PC + 8 * 8 * 4096;
constexpr size_t O_PM = O_PN + 8 * 8 * 64;
constexpr size_t O_SSHIFT = O_PM + 64;
constexpr size_t O_SS = O_SSHIFT + 128 * 1664;
constexpr size_t O_SCONV = O_SS + (size_t)128 * 8 * 4096;
constexpr size_t O_SC = O_SCONV + 128 * 3 * 1024;
constexpr size_t O_SN = O_SC + (size_t)128 * 8 * 4096;
constexpr size_t O_SM = O_SN + 128 * 8 * 64;
constexpr size_t O_END = O_SM + 1024;

struct Params {
    const float *x_p, *x_s, *c_p, *c_s;
    const float *st_shift, *st_S, *st_conv, *st_C, *st_n, *st_m;
    const float *g_norm, *w_ada, *b_ada, *w_in, *mu_shift, *w_decay2, *w0, *w_iclr2, *a0, *k_k, *k_a, *r_k,
        *ln_w, *ln_b, *conv_w, *conv_b, *b_i, *b_f, *gn_w, *w_up_a, *w_up_b, *w_out, *g_final;
    float* out;
    bf16_t *WinT, *WupaT, *WupbT, *WoutT;
    float* mod;
    bf16_t* P;
    bf16_t *H, *Yraw, *OutB, *Omd, *Aa, *OutA;
    unsigned* ctr;
    unsigned* bar;
    unsigned* acnt;
};

constexpr int SMEM_FLOATS = 32768 + 64;
__device__ __forceinline__ int otid() { int t = (int)__builtin_amdgcn_workitem_id_x(); asm volatile("" : "+v"(t)); return t; }
__device__ __forceinline__ void lds_barrier() { asm volatile("s_waitcnt lgkmcnt(0)" ::: "memory"); __builtin_amdgcn_s_barrier(); asm volatile("" ::: "memory"); }
__device__ __forceinline__ float bf2f(bf16_t v) { return __uint_as_float(((unsigned)v) << 16); }
__device__ __forceinline__ bf16_t f2bf(float f) { unsigned u = __float_as_uint(f); u += 0x7FFFu + ((u >> 16) & 1u); return (bf16_t)(u >> 16); }
__device__ __forceinline__ unsigned pk2(float lo, float hi) { return (unsigned)f2bf(lo) | ((unsigned)f2bf(hi) << 16); }
__device__ __forceinline__ float sigm(float x) { return __builtin_amdgcn_rcpf(1.f + __expf(-x)); }
__device__ __forceinline__ float silu(float x) { return x * __builtin_amdgcn_rcpf(1.f + __expf(-x)); }
__device__ __forceinline__ float wave_sum(float v) {
#pragma unroll
    for (int o = 32; o; o >>= 1) v += __shfl_xor(v, o);
    return v;
}
template <int CTRL> __device__ __forceinline__ float dpp_mov(float v) {
    return __builtin_bit_cast(float, __builtin_amdgcn_update_dpp(0, __builtin_bit_cast(int, v), CTRL, 0xF, 0xF, true));
}
__device__ __forceinline__ float row16_sum(float v) {
    v += dpp_mov<0xB1>(v);
    v += dpp_mov<0x4E>(v);
    v += dpp_mov<0x141>(v);
    v += dpp_mov<0x140>(v);
    return v;
}
__device__ __forceinline__ void tok_info(int m, int& s, int& t) {
    if (m < M_P) { s = m >> 11; t = m & 2047; } else { int q = m - M_P; s = 8 + (q >> 3); t = q & 7; }
}
__device__ __forceinline__ const float* xrow(const Params& p, int m) {
    return m < M_P ? p.x_p + (size_t)m * DM : p.x_s + (size_t)(m - M_P) * DM;
}

__device__ __forceinline__ void tr8(const float* __restrict__ src, int Nsrc, bf16_t* __restrict__ dst, int K, int n, int kg) {
    float v[8];
    if (n < Nsrc) {
        const float* sp = src + (size_t)(kg * 8) * Nsrc + n;
#pragma unroll
        for (int i = 0; i < 8; ++i) v[i] = sp[(size_t)i * Nsrc];
    } else {
#pragma unroll
        for (int i = 0; i < 8; ++i) v[i] = 0.f;
    }
    uint4 o; o.x = pk2(v[0], v[1]); o.y = pk2(v[2], v[3]); o.z = pk2(v[4], v[5]); o.w = pk2(v[6], v[7]);
    *(uint4*)(dst + (size_t)n * K + kg * 8) = o;
}
__device__ void phaseA(const Params& p, float* sm, int bid, int nb) {
    const int tid = otid();
    if (bid == 0 && tid == 0) *p.ctr = 0u;
    constexpr int N_ADA = 48 * 17;
    for (int i = bid; i < N_ADA; i += nb) {
        const int ct = i % 48, rgp = i / 48;
        float* sc = sm;
        float* red = sm + 8192;
        {
            float cv[16];
#pragma unroll
            for (int q = 0; q < 16; ++q) {
                const int idx = tid + q * NTHR, sl = idx >> 10, k = idx & 1023, s = rgp * 8 + sl;
                const float* src = s < 8 ? p.c_p + s * 1024 : p.c_s + (s - 8) * 1024;
                cv[q] = src[k];
            }
#pragma unroll
            for (int q = 0; q < 16; ++q) sc[tid + q * NTHR] = silu(cv[q]);
        }
        __syncthreads();
        {
            const int lane = tid & 63, kq = tid >> 6, c4 = (lane & 15) * 4, ks = lane >> 4;
            float acc[8][4];
#pragma unroll
            for (int s = 0; s < 8; ++s) { acc[s][0] = 0.f; acc[s][1] = 0.f; acc[s][2] = 0.f; acc[s][3] = 0.f; }
            const float* wp = p.w_ada + (size_t)(kq * 128 + ks * 4) * 3072 + ct * 64 + c4;
#pragma unroll 2
            for (int j = 0; j < 8; ++j) {
                float4 w[4];
#pragma unroll
                for (int e = 0; e < 4; ++e) w[e] = *(const float4*)(wp + (size_t)(j * 16 + e) * 3072);
#pragma unroll
                for (int s = 0; s < 8; ++s) {
                    const float4 c = *(const float4*)(sc + s * 1024 + kq * 128 + j * 16 + ks * 4);
                    acc[s][0] += c.x * w[0].x + c.y * w[1].x + c.z * w[2].x + c.w * w[3].x;
                    acc[s][1] += c.x * w[0].y + c.y * w[1].y + c.z * w[2].y + c.w * w[3].y;
                    acc[s][2] += c.x * w[0].z + c.y * w[1].z + c.z * w[2].z + c.w * w[3].z;
                    acc[s][3] += c.x * w[0].w + c.y * w[1].w + c.z * w[2].w + c.w * w[3].w;
                }
            }
            const int part = kq * 4 + ks;
#pragma unroll
            for (int s = 0; s < 8; ++s) *(float4*)(red + (part * 8 + s) * 64 + c4) = make_float4(acc[s][0], acc[s][1], acc[s][2], acc[s][3]);
        }
        __syncthreads();
        {
            const int s = tid >> 6, col = tid & 63;
            float v = p.b_ada[ct * 64 + col];
#pragma unroll
            for (int q = 0; q < 32; ++q) v += red[(q * 8 + s) * 64 + col];
            __hip_atomic_store((unsigned*)(p.mod + (size_t)(rgp * 8 + s) * 3072 + ct * 64 + col), __float_as_uint(v), __ATOMIC_RELAXED, __HIP_MEMORY_SCOPE_AGENT);
        }
        asm volatile("s_waitcnt vmcnt(0)" ::: "memory");
        __syncthreads();
        if (tid == 0) (void)__hip_atomic_fetch_add(p.acnt, 1u, __ATOMIC_RELAXED, __HIP_MEMORY_SCOPE_AGENT);
    }
    constexpr int W_IN = NP * 128, W_UP = 1024 * 64, W_OUT = 1024 * 128;
    const int gt = bid * NTHR + tid, gs = nb * NTHR;
    for (int w = gt; w < W_IN; w += 2 * gs) {
        const int w2 = w + gs; const bool has2 = w2 < W_IN;
        const int n1 = w % NP, g1 = w / NP, n2 = has2 ? w2 % NP : n1, g2 = has2 ? w2 / NP : g1;
        float v1[8], v2[8];
        const float* s1 = p.w_in + (size_t)(g1 * 8) * N_IN + (n1 < N_IN ? n1 : 0);
        const float* s2 = p.w_in + (size_t)(g2 * 8) * N_IN + (n2 < N_IN ? n2 : 0);
#pragma unroll
        for (int i = 0; i < 8; ++i) { v1[i] = s1[(size_t)i * N_IN]; v2[i] = s2[(size_t)i * N_IN]; }
        uint4 o;
        if (n1 >= N_IN) { o = make_uint4(0u, 0u, 0u, 0u); } else { o.x = pk2(v1[0], v1[1]); o.y = pk2(v1[2], v1[3]); o.z = pk2(v1[4], v1[5]); o.w = pk2(v1[6], v1[7]); }
        *(uint4*)(p.WinT + (size_t)n1 * 1024 + g1 * 8) = o;
        if (has2) {
            if (n2 >= N_IN) { o = make_uint4(0u, 0u, 0u, 0u); } else { o.x = pk2(v2[0], v2[1]); o.y = pk2(v2[2], v2[3]); o.z = pk2(v2[4], v2[5]); o.w = pk2(v2[6], v2[7]); }
            *(uint4*)(p.WinT + (size_t)n2 * 1024 + g2 * 8) = o;
        }
    }
    for (int w = gt; w < W_UP; w += gs) { tr8(p.w_up_a, 1024, p.WupaT, 512, w & 1023, w >> 10); tr8(p.w_up_b, 1024, p.WupbT, 512, w & 1023, w >> 10); }
    for (int w = gt; w < W_OUT; w += gs) tr8(p.w_out, 1024, p.WoutT, 1024, w & 1023, w >> 10);
}

__device__ __forceinline__ void normrow_load(const float* xr, int lane, float4 (&v)[4]) {
#pragma unroll
    for (int i = 0; i < 4; ++i) v[i] = *(const float4*)(xr + i * 256 + lane * 4);
}
__device__ __forceinline__ float sumsq4(const float4 (&v)[4]) {
    float ss = 0.f;
#pragma unroll
    for (int i = 0; i < 4; ++i) ss += v[i].x * v[i].x + v[i].y * v[i].y + v[i].z * v[i].z + v[i].w * v[i].w;
    return ss;
}
__device__ __forceinline__ void hrow_store(const Params& p, int m, int lane, const float4 (&v)[4], float rstd) {
    int s, t; tok_info(m, s, t);
    const float* md = p.mod + (size_t)s * 3072;
#pragma unroll
    for (int i = 0; i < 4; ++i) {
        const int c = i * 256 + lane * 4;
        const float4 g = *(const float4*)(p.g_norm + c);
        const float4 sh = *(const float4*)(md + c);
        const float4 sl = *(const float4*)(md + 1024 + c);
        const float h0 = v[i].x * rstd * g.x * (1.f + sl.x) + sh.x;
        const float h1 = v[i].y * rstd * g.y * (1.f + sl.y) + sh.y;
        const float h2 = v[i].z * rstd * g.z * (1.f + sl.z) + sh.z;
        const float h3 = v[i].w * rstd * g.w * (1.f + sl.w) + sh.w;
        uint2 o; o.x = pk2(h0, h1); o.y = pk2(h2, h3);
        *(uint2*)(p.H + (size_t)m * 1024 + c) = o;
    }
}
__device__ void phaseB(const Params& p, int bid, int nb) {
    const int wid = otid() >> 6, lane = otid() & 63;
    if (otid() == 0) {
        unsigned spins = 0;
        while (__hip_atomic_load(p.acnt, __ATOMIC_RELAXED, __HIP_MEMORY_SCOPE_AGENT) < 816u) { __builtin_amdgcn_s_sleep(2); if (++spins > (1u << 22)) break; }
        __builtin_amdgcn_fence(__ATOMIC_ACQUIRE, "agent");
        asm volatile("s_waitcnt vmcnt(0)" ::: "memory");
    }
    __syncthreads();
    const int stride = nb * 8;
    for (int m = bid * 8 + wid; m < M_TOT; m += 2 * stride) {
        const int m2 = m + stride;
        const bool has2 = m2 < M_TOT;
        float4 va[4], vb[4];
        normrow_load(xrow(p, m), lane, va);
        normrow_load(xrow(p, has2 ? m2 : m), lane, vb);
        const float ra = rsqrtf(wave_sum(sumsq4(va)) * (1.f / 1024.f) + 1e-6f);
        const float rb = rsqrtf(wave_sum(sumsq4(vb)) * (1.f / 1024.f) + 1e-6f);
        hrow_store(p, m, lane, va, ra);
        if (has2) hrow_store(p, m2, lane, vb, rb);
    }
}

typedef unsigned u32x4v __attribute__((ext_vector_type(4)));
__device__ __forceinline__ bf16x8 pack8(const float (&v)[8]) {
    u32x4v t; t[0] = pk2(v[0], v[1]); t[1] = pk2(v[2], v[3]); t[2] = pk2(v[4], v[5]); t[3] = pk2(v[6], v[7]);
    return __builtin_bit_cast(bf16x8, t);
}
__device__ void phaseD(const Params& p, float* sm, int bid, int nb) {
    const int tid = otid(), wid = tid >> 6, lane = tid & 63, fr = lane & 15, fq = lane >> 4;
    bf16_t* twb = (bf16_t*)sm;
    bf16_t* alb = twb + 16 * 72;
    bf16x8 Bd[4][2], Bi[4][2];
#pragma unroll
    for (int ct = 0; ct < 4; ++ct)
#pragma unroll
        for (int ks = 0; ks < 2; ++ks) {
            const int n = wid * 64 + ct * 16 + fr, k0 = ks * 32 + fq * 8;
            float vd[8], vi[8];
#pragma unroll
            for (int j = 0; j < 8; ++j) { vd[j] = p.w_decay2[(k0 + j) * 512 + n]; vi[j] = p.w_iclr2[(k0 + j) * 512 + n]; }
            Bd[ct][ks] = pack8(vd); Bi[ct][ks] = pack8(vi);
        }
    float w0r[16], a0r[16];
#pragma unroll
    for (int q = 0; q < 16; ++q) { const int col = wid * 64 + (q >> 2) * 16 + fq * 4 + (q & 3); w0r[q] = p.w0[col]; a0r[q] = p.a0[col]; }
    unsigned cu[4], pv[4]; float st[4];
    auto fetchD = [&](int it) {
        const int m0 = it * 16;
#pragma unroll
        for (int q = 0; q < 4; ++q) {
            const int idx = tid + q * NTHR, tok = idx >> 7, j = idx & 127, col = C_WL + j, m = m0 + tok;
            int s, t; tok_info(m, s, t);
            cu[q] = p.P[(size_t)m * NP + col];
            pv[q] = p.P[(size_t)(t > 0 ? m - 1 : m) * NP + col];
            st[q] = p.st_shift[(size_t)(s >= 8 ? s - 8 : 0) * SHIFT_W + col];
        }
    };
    if (bid < M_TOT / 16) fetchD(bid);
    for (int it = bid; it < M_TOT / 16; it += nb) {
        const int m0 = it * 16;
        {
#pragma unroll
            for (int q = 0; q < 4; ++q) {
                const int idx = tid + q * NTHR, tok = idx >> 7, j = idx & 127, col = C_WL + j, m = m0 + tok;
                int s, t; tok_info(m, s, t);
                const float cur = __uint_as_float(cu[q] << 16);
                const float prev = t > 0 ? __uint_as_float(pv[q] << 16) : (s >= 8 ? st[q] : 0.f);
                const float v = cur + p.mu_shift[col] * (prev - cur);
                if (j < 64) twb[tok * 72 + j] = f2bf(tanhf(v)); else alb[tok * 72 + j - 64] = f2bf(v);
            }
        }
        if (it + nb < M_TOT / 16) fetchD(it + nb);
        lds_barrier();
        {
            const bf16x8 at0 = *(const bf16x8*)(twb + fr * 72 + fq * 8), at1 = *(const bf16x8*)(twb + fr * 72 + 32 + fq * 8);
            const bf16x8 aa0 = *(const bf16x8*)(alb + fr * 72 + fq * 8), aa1 = *(const bf16x8*)(alb + fr * 72 + 32 + fq * 8);
            const size_t mrow = (size_t)(m0 + fr) * 512 + wid * 64 + fq * 4;
#pragma unroll
            for (int ct = 0; ct < 4; ++ct) {
                f32x4 cw = (f32x4){0.f, 0.f, 0.f, 0.f}, ca = cw;
                cw = __builtin_amdgcn_mfma_f32_16x16x32_bf16(Bd[ct][0], at0, cw, 0, 0, 0);
                cw = __builtin_amdgcn_mfma_f32_16x16x32_bf16(Bd[ct][1], at1, cw, 0, 0, 0);
                ca = __builtin_amdgcn_mfma_f32_16x16x32_bf16(Bi[ct][0], aa0, ca, 0, 0, 0);
                ca = __builtin_amdgcn_mfma_f32_16x16x32_bf16(Bi[ct][1], aa1, ca, 0, 0, 0);
                float o[4], a[4];
#pragma unroll
                for (int r = 0; r < 4; ++r) {
                    const float sg = sigm(w0r[ct * 4 + r] + cw[r]);
                    o[r] = 1.f - __expf(-0.6065306597126334f * sg);
                    a[r] = sigm(a0r[ct * 4 + r] + ca[r]);
                }
                uint2 uo, ua; uo.x = pk2(o[0], o[1]); uo.y = pk2(o[2], o[3]); ua.x = pk2(a[0], a[1]); ua.y = pk2(a[2], a[3]);
                *(uint2*)(p.Omd + mrow + ct * 16) = uo;
                *(uint2*)(p.Aa + mrow + ct * 16) = ua;
            }
        }
        for (int tok = 0; tok < 16; ++tok) {
            const int m = m0 + tok;
            int s, t; tok_info(m, s, t);
            const int T = s < 8 ? 2048 : 8;
            if (t != T - 1) continue;
            float* osh = s < 8 ? p.out + O_PSHIFT + (size_t)s * SHIFT_W : p.out + O_SSHIFT + (size_t)(s - 8) * SHIFT_W;
            float* ocv = s < 8 ? p.out + O_PCONV + (size_t)s * 3072 : p.out + O_SCONV + (size_t)(s - 8) * 3072;
            for (int col = tid; col < SHIFT_W; col += NTHR) osh[col] = bf2f(p.P[(size_t)m * NP + col]);
            for (int idx = tid; idx < 3072; idx += NTHR) {
                const int r = idx >> 10, cc = idx & 1023;
                ocv[idx] = bf2f(p.P[(size_t)(m - 2 + r) * NP + C_QK + cc]);
            }
        }
        lds_barrier();
    }
    __syncthreads();
}

__device__ __forceinline__ float rdlane(float v, int l) { return __builtin_bit_cast(float, __builtin_amdgcn_readlane(__builtin_bit_cast(int, v), l)); }
__device__ __forceinline__ float wave_sum_fast(float v) {
    v = row16_sum(v);
    return (rdlane(v, 0) + rdlane(v, 16)) + (rdlane(v, 32) + rdlane(v, 48));
}
__device__ __forceinline__ float4 unpk4(uint2 u) {
    float4 f; f.x = __uint_as_float(u.x << 16); f.y = __uint_as_float(u.x & 0xFFFF0000u);
    f.z = __uint_as_float(u.y << 16); f.w = __uint_as_float(u.y & 0xFFFF0000u); return f;
}
__device__ void rwkv_item(const Params& p, int s, int h, int third, float* sm) {
    constexpr int BUF = 15680;
    constexpr int VC_OFF = 10368, Y_OFF = 13632, NCH = 64;
    const int tid = otid(), wid = tid >> 6, lane = tid & 63;
    const int mbase = s * 2048;
    const int r0 = third * 21 + (third > 0 ? 1 : 0), nr = third == 0 ? 22 : 21;
    if (wid >= 6) {
        const int pw = wid - 6, g = lane >> 4;
        const int c4 = (lane & 15) * 4, hc = h * 64 + c4;
        const int l128 = pw * 64 + lane;
        const float4 mu_r = *(const float4*)(p.mu_shift + C_R + hc), mu_k = *(const float4*)(p.mu_shift + C_K + hc), mu_v = *(const float4*)(p.mu_shift + C_V + hc);
        const float4 kkw = *(const float4*)(p.k_k + hc), kaw = *(const float4*)(p.k_a + hc);
        uint2 R[4][8];
        auto fetch = [&](int pass, uint2 (&q)[8]) {
            const int t = (pass >> 2) * 32 + (pass & 3) * 8 + pw * 4 + g;
            const bf16_t* pr = p.P + (size_t)(mbase + t) * NP + hc;
            const bf16_t* pp = t > 0 ? pr - NP : pr;
            q[0] = *(const uint2*)(pr + C_R); q[1] = *(const uint2*)(pr + C_K); q[2] = *(const uint2*)(pr + C_V);
            q[3] = *(const uint2*)(pp + C_R); q[4] = *(const uint2*)(pp + C_K); q[5] = *(const uint2*)(pp + C_V);
            q[6] = *(const uint2*)(p.Aa + (size_t)(mbase + t) * 512 + hc);
            q[7] = *(const uint2*)(p.Omd + (size_t)(mbase + t) * 512 + hc);
        };
        auto step = [&](int pass, uint2 (&q)[8]) {
            const uint2 cr = q[0], ck = q[1], cv = q[2], crp = q[3], ckp = q[4], cvp = q[5], ca = q[6], co = q[7];
            if (pass + 4 < NCH * 4) fetch(pass + 4, q);
            const int tok = (pass & 3) * 8 + pw * 4 + g, t = (pass >> 2) * 32 + tok;
            float* B = sm + ((pass >> 2) & 1) * BUF;
            float4 r = unpk4(cr), k = unpk4(ck), v = unpk4(cv), rp, kp_, vp;
            if (t > 0) { rp = unpk4(crp); kp_ = unpk4(ckp); vp = unpk4(cvp); }
            else { rp = make_float4(0.f, 0.f, 0.f, 0.f); kp_ = rp; vp = rp; }
            r.x += mu_r.x * (rp.x - r.x); r.y += mu_r.y * (rp.y - r.y); r.z += mu_r.z * (rp.z - r.z); r.w += mu_r.w * (rp.w - r.w);
            k.x += mu_k.x * (kp_.x - k.x); k.y += mu_k.y * (kp_.y - k.y); k.z += mu_k.z * (kp_.z - k.z); k.w += mu_k.w * (kp_.w - k.w);
            v.x += mu_v.x * (vp.x - v.x); v.y += mu_v.y * (vp.y - v.y); v.z += mu_v.z * (vp.z - v.z); v.w += mu_v.w * (vp.w - v.w);
            const float4 a = unpk4(ca), om = unpk4(co);
            float4 kk; kk.x = k.x * kkw.x; kk.y = k.y * kkw.y; kk.z = k.z * kkw.z; kk.w = k.w * kkw.w;
            const float nrm = sqrtf(row16_sum(kk.x * kk.x + kk.y * kk.y + kk.z * kk.z + kk.w * kk.w));
            const float inv = __builtin_amdgcn_rcpf(fmaxf(nrm, 1e-12f));
            kk.x *= inv; kk.y *= inv; kk.z *= inv; kk.w *= inv;
            float4 ka; ka.x = kk.x * a.x; ka.y = kk.y * a.y; ka.z = kk.z * a.z; ka.w = kk.w * a.w;
            float4 kp; kp.x = k.x * (1.f + (a.x - 1.f) * kaw.x); kp.y = k.y * (1.f + (a.y - 1.f) * kaw.y);
            kp.z = k.z * (1.f + (a.z - 1.f) * kaw.z); kp.w = k.w * (1.f + (a.w - 1.f) * kaw.w);
            float4 d; d.x = 1.f - om.x; d.y = 1.f - om.y; d.z = 1.f - om.z; d.w = 1.f - om.w;
            float4 dr; dr.x = d.x * r.x; dr.y = d.y * r.y; dr.z = d.z * r.z; dr.w = d.w * r.w;
            const float c1 = row16_sum(ka.x * r.x + ka.y * r.y + ka.z * r.z + ka.w * r.w);
            const float c2 = row16_sum(kp.x * r.x + kp.y * r.y + kp.z * r.z + kp.w * r.w);
            const int o = tok * 64 + c4;
            *(float4*)(B + o) = kk; *(float4*)(B + 2048 + o) = d; *(float4*)(B + 4096 + o) = ka;
            *(float4*)(B + 6144 + o) = kp; *(float4*)(B + 8192 + o) = dr;
            float4* vc = (float4*)(B + VC_OFF) + tok * 24;
            const int l0 = c4 - r0;
            if (l0 >= 0 && l0 < nr) vc[l0] = make_float4(v.x, c1, c2, 0.f);
            if (l0 + 1 >= 0 && l0 + 1 < nr) vc[l0 + 1] = make_float4(v.y, c1, c2, 0.f);
            if (l0 + 2 >= 0 && l0 + 2 < nr) vc[l0 + 2] = make_float4(v.z, c1, c2, 0.f);
            if (l0 + 3 >= 0 && l0 + 3 < nr) vc[l0 + 3] = make_float4(v.w, c1, c2, 0.f);
        };
        auto flush = [&](int c) {
            const float* Y = sm + (c & 1) * BUF + Y_OFF;
            const int tt = l128 >> 2, part = l128 & 3;
            bf16_t* dst = p.Yraw + (size_t)(mbase + c * 32 + tt) * 512 + h * 64 + r0;
#pragma unroll
            for (int k = 0; k < 6; ++k) { const int i = part + 4 * k; if (i < nr) dst[i] = f2bf(Y[tt * 64 + i]); }
        };
#pragma unroll
        for (int q = 0; q < 4; ++q) fetch(q, R[q]);
#pragma unroll
        for (int q = 0; q < 4; ++q) step(q, R[q]);
        lds_barrier();
#pragma unroll 1
        for (int c = 0; c < NCH; ++c) {
            if (c > 0) flush(c - 1);
            if (c + 1 < NCH) {
#pragma unroll
                for (int q = 0; q < 4; ++q) step((c + 1) * 4 + q, R[q]);
            }
            lds_barrier();
        }
        flush(NCH - 1);
    } else {
        const int lrow = wid * 4 + (lane >> 4);
        const int irow = r0 + (lrow < nr ? lrow : nr - 1);
        const int c4 = (lane & 15) * 4;
        const int yslot = ((lane & 15) == 0 && lrow < nr) ? lrow : 32 + (lane & 31);
        float S0 = 0.f, S1 = 0.f, S2 = 0.f, S3 = 0.f;
        lds_barrier();
#pragma unroll 1
        for (int c = 0; c < NCH; ++c) {
            const float* B = sm + (c & 1) * BUF;
            const float* bp = B + c4;
            const float4* vp4 = (const float4*)(B + VC_OFF) + (irow - r0);
            float4 kk4 = *(const float4*)(bp), d4 = *(const float4*)(bp + 2048), ka4 = *(const float4*)(bp + 4096);
            float4 kp4 = *(const float4*)(bp + 6144), dr4 = *(const float4*)(bp + 8192), vc = vp4[0];
            float4 kkB = *(const float4*)(bp + 64), dB = *(const float4*)(bp + 64 + 2048), kaB = *(const float4*)(bp + 64 + 4096);
            float4 kpB = *(const float4*)(bp + 64 + 6144), drB = *(const float4*)(bp + 64 + 8192), vcB = vp4[24];
            float* yp = sm + (c & 1) * BUF + Y_OFF + yslot;
#pragma unroll 8
            for (int tt = 0; tt < 32; ++tt) {
                const float* nb_ = bp + (tt + 2) * 64;
                const float4 nkk = *(const float4*)(nb_), nd = *(const float4*)(nb_ + 2048), nka = *(const float4*)(nb_ + 4096);
                const float4 nkp = *(const float4*)(nb_ + 6144), ndr = *(const float4*)(nb_ + 8192), nvc = vp4[(tt + 2) * 24];
                __builtin_amdgcn_sched_barrier(0);
                float p1 = S0 * kk4.x + S1 * kk4.y + S2 * kk4.z + S3 * kk4.w;
                float p2 = S0 * dr4.x + S1 * dr4.y + S2 * dr4.z + S3 * dr4.w;
                const float vi = vc.x;
                const float u0 = S0 * d4.x + vi * kp4.x, u1 = S1 * d4.y + vi * kp4.y, u2 = S2 * d4.z + vi * kp4.z, u3 = S3 * d4.w + vi * kp4.w;
                float z = p2 - vc.y * p1;
                p1 = row16_sum(p1);
                z = row16_sum(z);
                S0 = u0 - p1 * ka4.x; S1 = u1 - p1 * ka4.y; S2 = u2 - p1 * ka4.z; S3 = u3 - p1 * ka4.w;
                yp[tt * 64] = z + vi * vc.z;
                kk4 = kkB; d4 = dB; ka4 = kaB; kp4 = kpB; dr4 = drB; vc = vcB;
                kkB = nkk; dB = nd; kaB = nka; kpB = nkp; drB = ndr; vcB = nvc;
                __builtin_amdgcn_sched_barrier(0);
            }
            lds_barrier();
        }
        if (lrow < nr) {
            float* o = p.out + O_PS + (size_t)s * 8 * 4096 + ((size_t)(h * 64 + irow)) * 64 + c4;
            float4 v; v.x = S0; v.y = S1; v.z = S2; v.w = S3;
            *(float4*)o = v;
        }
    }
    __syncthreads();
}

__device__ void mlstm_item(const Params& p, int s, int h, float* sm) {
    float* sq = sm;
    float* sk = sm + 4160;
    float* sv = sm + 8320;
    float* sc = sm + 12480;
    float* sC = sm + 16640;
    float* sn = sm + 20800;
    float* sb = sn + 64;
    float* si = sn + 128;
    float* smt = sn + 192;
    float* swin = sn + 256;
    float* sden = sn + 320;
    float* sws = sn + 384;
    float* slf = sn + 448;
    float* smisc = sn + 512;
    const int tid = otid(), wid = tid >> 6, lane = tid & 63;
    const int T = s < 8 ? 2048 : 8, L = s < 8 ? 64 : 8, NC = T / L;
    const int mbase = s < 8 ? s * 2048 : M_P + (s - 8) * 8;
    for (int idx = tid; idx < 4096; idx += NTHR) {
        const int i = idx >> 6, j = idx & 63;
        sC[i * 65 + j] = s >= 8 ? p.st_C[(size_t)((s - 8) * 8 + h) * 4096 + idx] : 0.f;
    }
    if (tid < 64) sn[tid] = s >= 8 ? p.st_n[(size_t)((s - 8) * 8 + h) * 64 + tid] : 0.f;
    if (tid == 0) smisc[0] = s >= 8 ? p.st_m[(s - 8) * 8 + h] : 0.f;
    const float cwq[4] = {p.conv_w[0 * 1024 + h * 64 + lane], p.conv_w[1 * 1024 + h * 64 + lane], p.conv_w[2 * 1024 + h * 64 + lane], p.conv_w[3 * 1024 + h * 64 + lane]};
    const float cwk[4] = {p.conv_w[0 * 1024 + 512 + h * 64 + lane], p.conv_w[1 * 1024 + 512 + h * 64 + lane], p.conv_w[2 * 1024 + 512 + h * 64 + lane], p.conv_w[3 * 1024 + 512 + h * 64 + lane]};
    const float cbq = p.conv_b[h * 64 + lane], cbk = p.conv_b[512 + h * 64 + lane];
    const float gnw = p.gn_w[h * 64 + lane];
    const float bi = p.b_i[h], bfv = p.b_f[h];
    __syncthreads();
    for (int c = 0; c < NC; ++c) {
        const int t0 = c * L;
        for (int tt = wid; tt < L; tt += 8) {
            const int t = t0 + tt, m = mbase + t;
            float aq = cbq, ak = cbk;
#pragma unroll
            for (int j = 0; j < 4; ++j) {
                const int tau = t - 3 + j;
                float xq, xk;
                if (tau >= 0) {
                    const bf16_t* pr = p.P + (size_t)(mbase + tau) * NP + C_QK + h * 64 + lane;
                    xq = bf2f(pr[0]); xk = bf2f(pr[512]);
                } else if (s >= 8) {
                    const float* st = p.st_conv + ((size_t)(s - 8) * 3 + (3 + tau)) * 1024 + h * 64 + lane;
                    xq = st[0]; xk = st[512];
                } else { xq = 0.f; xk = 0.f; }
                aq += xq * cwq[j]; ak += xk * cwk[j];
            }
            sq[tt * 65 + lane] = silu(aq);
            sk[tt * 65 + lane] = silu(ak) * 0.125f;
            sv[tt * 65 + lane] = bf2f(p.P[(size_t)m * NP + C_VB + h * 64 + lane]);
        }
        if (tid < L) {
            const int m = mbase + t0 + tid;
            si[tid] = bf2f(p.P[(size_t)m * NP + C_IB + h]) + bi;
            const float f = bf2f(p.P[(size_t)m * NP + C_FB + h]) + bfv;
            slf[tid] = f > 0.f ? -log1pf(__expf(-f)) : f - log1pf(__expf(f));
        }
        __syncthreads();
        if (tid == 0) {
            const float mprev = smisc[0];
            float b = 0.f, run = mprev;
            for (int t = 0; t < L; ++t) {
                b += slf[t];
                run = fmaxf(run, si[t] - b);
                sb[t] = b; smt[t] = b + run; swin[t] = __expf(b + mprev - (b + run));
            }
            const float mnew = b + run;
            smisc[1] = mnew; smisc[2] = __expf(b + mprev - mnew);
            for (int t = 0; t < L; ++t) sws[t] = __expf(b - sb[t] + si[t] - mnew);
        }
        __syncthreads();
        for (int idx = tid; idx < L * L; idx += NTHR) {
            const int t = idx / L, u = idx % L;
            float v = 0.f;
            if (u <= t) {
                float dot = 0.f;
#pragma unroll 8
                for (int d = 0; d < 64; ++d) dot += sq[t * 65 + d] * sk[u * 65 + d];
                v = dot * __expf(sb[t] - sb[u] + si[u] - smt[t]);
            }
            sc[t * 65 + u] = v;
        }
        __syncthreads();
        if (tid < L) {
            float rs = 0.f, qn = 0.f;
            for (int u = 0; u < L; ++u) rs += sc[tid * 65 + u];
            for (int j = 0; j < 64; ++j) qn += sn[j] * sq[tid * 65 + j];
            const float den = rs + swin[tid] * qn;
            sden[tid] = fmaxf(fabsf(den), __expf(-smt[tid]));
        }
        __syncthreads();
        for (int tt = wid; tt < L; tt += 8) {
            float num = 0.f, inter = 0.f;
            for (int u = 0; u <= tt; ++u) num += sc[tt * 65 + u] * sv[u * 65 + lane];
#pragma unroll 8
            for (int j = 0; j < 64; ++j) inter += sC[lane * 65 + j] * sq[tt * 65 + j];
            const float hv = (num + swin[tt] * inter) / sden[tt];
            const float ms = wave_sum(hv * hv) * (1.f / 64.f);
            const float hn = hv * rsqrtf(ms + 1e-6f) * gnw;
            const int m = mbase + t0 + tt;
            const float ob = bf2f(p.P[(size_t)m * NP + C_OB + h * 64 + lane]);
            const float zb = bf2f(p.P[(size_t)m * NP + C_ZB + h * 64 + lane]);
            p.OutB[(size_t)m * 512 + h * 64 + lane] = f2bf(sigm(ob) * hn * silu(zb));
        }
        __syncthreads();
        {
            const float dec = smisc[2];
            const int j = lane;
#pragma unroll
            for (int ii = 0; ii < 8; ++ii) {
                const int i = wid + 8 * ii;
                float a = dec * sC[i * 65 + j];
                for (int u = 0; u < L; ++u) a += sws[u] * sv[u * 65 + i] * sk[u * 65 + j];
                sC[i * 65 + j] = a;
            }
            if (tid < 64) {
                float a = dec * sn[tid];
                for (int u = 0; u < L; ++u) a += sws[u] * sk[u * 65 + tid];
                sn[tid] = a;
            }
            if (tid == 0) smisc[0] = smisc[1];
        }
        __syncthreads();
    }
    {
        float* oC = s < 8 ? p.out + O_PC + (size_t)(s * 8 + h) * 4096 : p.out + O_SC + (size_t)((s - 8) * 8 + h) * 4096;
        float* on = s < 8 ? p.out + O_PN + (size_t)(s * 8 + h) * 64 : p.out + O_SN + (size_t)((s - 8) * 8 + h) * 64;
        float* om = s < 8 ? p.out + O_PM + (s * 8 + h) : p.out + O_SM + ((s - 8) * 8 + h);
        for (int idx = tid; idx < 4096; idx += NTHR) oC[idx] = sC[(idx >> 6) * 65 + (idx & 63)];
        if (tid < 64) on[tid] = sn[tid];
        if (tid == 0) om[0] = smisc[0];
    }
    __syncthreads();
}

__device__ __forceinline__ bf16x8 ldfrag(const bf16_t* base, int row, int ks, int fq) { return *(const bf16x8*)(base + row * 72 + ks * 32 + fq * 8); }
__device__ __forceinline__ float sum8(float v) { v += dpp_mov<0xB1>(v); v += dpp_mov<0x4E>(v); v += dpp_mov<0x141>(v); return v; }
__device__ void mlstm_prompt(const Params& p, int s, int h, float* sm) {
    bf16_t* Qs = (bf16_t*)sm; bf16_t* Ks = Qs + 4608; bf16_t* VT = Ks + 4608; bf16_t* KwT = VT + 4608; bf16_t* Ps = KwT + 4608; bf16_t* Cb = Ps + 4608;
    float* hs = sm + 13824;
    float* sn = hs + 64 * 68;
    float* sden = sn + 64;
    float* gv = sn + 128;
    float* Gg = sn + 128 + 768;
    float* Gl = Gg + 2048;
    float* Gb = Gl + 2048;
    const int tid = otid(), wid = tid >> 6, lane = tid & 63, fr = lane & 15, fq = lane >> 4;
    const int tr = wid >> 1, tc0 = (wid & 1) * 2;
    const int mbase = s * 2048;
    const int qc = h * 64 + lane;
    f32x4 accC[2];
    accC[0] = (f32x4){0.f, 0.f, 0.f, 0.f}; accC[1] = accC[0];
    if (tid < 64) sn[tid] = 0.f;
    {
        const float bi = p.b_i[h], bfv = p.b_f[h];
        for (int cc = wid; cc < 32; cc += 8) {
            const bf16_t* pr = p.P + (size_t)(mbase + cc * 64 + lane) * NP;
            const float it = bf2f(pr[C_IB + h]) + bi;
            const float f = bf2f(pr[C_FB + h]) + bfv;
            float b = f > 0.f ? -log1pf(__expf(-f)) : f - log1pf(__expf(f));
#pragma unroll
            for (int o = 1; o < 64; o <<= 1) { const float v = __shfl_up(b, o); if (lane >= o) b += v; }
            const float g = it - b;
            float run = g;
#pragma unroll
            for (int o = 1; o < 64; o <<= 1) { const float v = __shfl_up(run, o); if (lane >= o) run = fmaxf(run, v); }
            Gg[cc * 64 + lane] = g; Gl[cc * 64 + lane] = run; Gb[cc * 64 + lane] = b;
        }
    }
    const float cwq0 = p.conv_w[qc], cwq1 = p.conv_w[1024 + qc], cwq2 = p.conv_w[2048 + qc], cwq3 = p.conv_w[3072 + qc];
    const float cwk0 = p.conv_w[512 + qc], cwk1 = p.conv_w[1536 + qc], cwk2 = p.conv_w[2560 + qc], cwk3 = p.conv_w[3584 + qc];
    const float cbq = p.conv_b[qc], cbk = p.conv_b[512 + qc];
    const float gnw = p.gn_w[qc];
    unsigned xqr[11], xkr[11], vvr[8];
    auto load_raw = [&](int c) {
        const int tb = c * 64 + wid * 8 - 3;
#pragma unroll
        for (int r = 0; r < 11; ++r) {
            const int t = tb + r, tc = t < 0 ? 0 : t;
            const bf16_t* pr = p.P + (size_t)(mbase + tc) * NP + C_QK + qc;
            xqr[r] = pr[0]; xkr[r] = pr[512];
        }
#pragma unroll
        for (int k = 0; k < 8; ++k) vvr[k] = p.P[(size_t)(mbase + tb + 3 + k) * NP + C_VB + qc];
    };
    auto gates = [&](int c, float mprev) {
        float* v = gv + (c & 1) * 384;
        const float g = Gg[c * 64 + lane], b = Gb[c * 64 + lane];
        const float run = fmaxf(Gl[c * 64 + lane], mprev), runL = fmaxf(Gl[c * 64 + 63], mprev), bL = Gb[c * 64 + 63];
        v[lane] = g; v[64 + lane] = run; v[128 + lane] = __expf(mprev - run); v[192 + lane] = __expf(g - runL); v[256 + lane] = b;
        if (lane == 0) { v[320] = bL + runL; v[321] = __expf(mprev - runL); }
    };
    load_raw(0);
    __syncthreads();
    if (wid == 0) gates(0, 0.f);
    __syncthreads();
    for (int c = 0; c < 32; ++c) {
        const int t0 = c * 64, mb = mbase + t0;
        const float* sg = gv + (c & 1) * 384; const float* srun = sg + 64; const float* swin = sg + 128; const float* sws = sg + 192; const float* sb = sg + 256;
        const float dec = sg[321];
        {
            float kw[8], xq[11], xk[11], vv[8];
            const bool head = (c == 0 && wid == 0);
#pragma unroll
            for (int r = 0; r < 11; ++r) {
                const bool z = head && r < 3;
                xq[r] = z ? 0.f : __uint_as_float(xqr[r] << 16); xk[r] = z ? 0.f : __uint_as_float(xkr[r] << 16);
            }
#pragma unroll
            for (int k = 0; k < 8; ++k) vv[k] = __uint_as_float(vvr[k] << 16);
#pragma unroll
            for (int k = 0; k < 8; ++k) {
                const int tt = wid * 8 + k;
                const float q = silu(cbq + xq[k] * cwq0 + xq[k + 1] * cwq1 + xq[k + 2] * cwq2 + xq[k + 3] * cwq3);
                const float kk = silu(cbk + xk[k] * cwk0 + xk[k + 1] * cwk1 + xk[k + 2] * cwk2 + xk[k + 3] * cwk3) * 0.125f;
                Qs[tt * 72 + lane] = f2bf(q);
                Ks[tt * 72 + lane] = f2bf(kk);
                kw[k] = kk * sws[tt];
            }
            uint4 o; o.x = pk2(kw[0], kw[1]); o.y = pk2(kw[2], kw[3]); o.z = pk2(kw[4], kw[5]); o.w = pk2(kw[6], kw[7]);
            *(uint4*)(KwT + lane * 72 + wid * 8) = o;
            o.x = pk2(vv[0], vv[1]); o.y = pk2(vv[2], vv[3]); o.z = pk2(vv[4], vv[5]); o.w = pk2(vv[6], vv[7]);
            *(uint4*)(VT + lane * 72 + wid * 8) = o;
        }
#pragma unroll
        for (int n = 0; n < 2; ++n) {
            uint2 o; o.x = pk2(accC[n][0], accC[n][1]); o.y = pk2(accC[n][2], accC[n][3]);
            *(uint2*)(Cb + (tr * 16 + fr) * 72 + (tc0 + n) * 16 + fq * 4) = o;
        }
        if (c + 1 < 32) load_raw(c + 1);
        lds_barrier();
        unsigned obr[8], zbr[8];
#pragma unroll
        for (int k = 0; k < 8; ++k) {
            const bf16_t* pr = p.P + (size_t)(mb + wid * 8 + k) * NP;
            obr[k] = pr[C_OB + qc]; zbr[k] = pr[C_ZB + qc];
        }
#pragma unroll
        for (int n = 0; n < 2; ++n) {
            const int ut = tc0 + n;
            f32x4 a = (f32x4){0.f, 0.f, 0.f, 0.f};
            if (ut <= tr) {
#pragma unroll
                for (int ks = 0; ks < 2; ++ks) a = __builtin_amdgcn_mfma_f32_16x16x32_bf16(ldfrag(Ks, ut * 16 + fr, ks, fq), ldfrag(Qs, tr * 16 + fr, ks, fq), a, 0, 0, 0);
            }
            const int t = tr * 16 + fr;
            const float rn = srun[t];
            float w[4];
#pragma unroll
            for (int r = 0; r < 4; ++r) {
                const int u = ut * 16 + fq * 4 + r;
                w[r] = (u <= t) ? a[r] * __expf(sg[u] - rn) : 0.f;
            }
            uint2 o; o.x = pk2(w[0], w[1]); o.y = pk2(w[2], w[3]);
            *(uint2*)(Ps + t * 72 + ut * 16 + fq * 4) = o;
        }
        lds_barrier();
        {
            const int t = tid >> 3, seg = tid & 7;
            const uint4 pv = *(const uint4*)(Ps + t * 72 + seg * 8);
            const uint4 qv = *(const uint4*)(Qs + t * 72 + seg * 8);
            const float4 pa = unpk4(make_uint2(pv.x, pv.y)), pb = unpk4(make_uint2(pv.z, pv.w));
            const float4 qa = unpk4(make_uint2(qv.x, qv.y)), qb = unpk4(make_uint2(qv.z, qv.w));
            const float4 na = *(const float4*)(sn + seg * 8), nb4 = *(const float4*)(sn + seg * 8 + 4);
            float rs = (pa.x + pa.y) + (pa.z + pa.w) + (pb.x + pb.y) + (pb.z + pb.w);
            float qn = qa.x * na.x + qa.y * na.y + qa.z * na.z + qa.w * na.w + qb.x * nb4.x + qb.y * nb4.y + qb.z * nb4.z + qb.w * nb4.w;
            rs = sum8(rs); qn = sum8(qn);
            if (seg == 0) sden[t] = fmaxf(fabsf(rs + swin[t] * qn), __expf(-(sb[t] + srun[t])));
        }
        f32x4 num[2], itr[2];
#pragma unroll
        for (int n = 0; n < 2; ++n) {
            const int it = tc0 + n;
            num[n] = (f32x4){0.f, 0.f, 0.f, 0.f}; itr[n] = num[n];
#pragma unroll
            for (int ks = 0; ks < 2; ++ks) {
                num[n] = __builtin_amdgcn_mfma_f32_16x16x32_bf16(ldfrag(VT, it * 16 + fr, ks, fq), ldfrag(Ps, tr * 16 + fr, ks, fq), num[n], 0, 0, 0);
                itr[n] = __builtin_amdgcn_mfma_f32_16x16x32_bf16(ldfrag(Cb, it * 16 + fr, ks, fq), ldfrag(Qs, tr * 16 + fr, ks, fq), itr[n], 0, 0, 0);
            }
        }
        lds_barrier();
        {
            const int t = tr * 16 + fr;
            const float rd = 1.f / sden[t], wn = swin[t];
#pragma unroll
            for (int n = 0; n < 2; ++n) {
                float4 o;
                o.x = (num[n][0] + wn * itr[n][0]) * rd; o.y = (num[n][1] + wn * itr[n][1]) * rd;
                o.z = (num[n][2] + wn * itr[n][2]) * rd; o.w = (num[n][3] + wn * itr[n][3]) * rd;
                *(float4*)(hs + t * 68 + (tc0 + n) * 16 + fq * 4) = o;
            }
        }
#pragma unroll
        for (int n = 0; n < 2; ++n) {
            accC[n][0] *= dec; accC[n][1] *= dec; accC[n][2] *= dec; accC[n][3] *= dec;
#pragma unroll
            for (int ks = 0; ks < 2; ++ks)
                accC[n] = __builtin_amdgcn_mfma_f32_16x16x32_bf16(ldfrag(KwT, (tc0 + n) * 16 + fr, ks, fq), ldfrag(VT, tr * 16 + fr, ks, fq), accC[n], 0, 0, 0);
        }
        {
            const int j = tid >> 3, seg = tid & 7;
            const uint4 kv = *(const uint4*)(KwT + j * 72 + seg * 8);
            const float4 ka = unpk4(make_uint2(kv.x, kv.y)), kb = unpk4(make_uint2(kv.z, kv.w));
            float sum = (ka.x + ka.y) + (ka.z + ka.w) + (kb.x + kb.y) + (kb.z + kb.w);
            sum = sum8(sum);
            if (seg == 0) sn[j] = dec * sn[j] + sum;
        }
        if (wid == 0 && c + 1 < 32) gates(c + 1, sg[320]);
        lds_barrier();
#pragma unroll
        for (int k = 0; k < 8; ++k) {
            const int tt = wid * 8 + k;
            const float hv = hs[tt * 68 + lane];
            const float ms = wave_sum_fast(hv * hv) * (1.f / 64.f);
            const float hn = hv * rsqrtf(ms + 1e-6f) * gnw;
            p.OutB[(size_t)(mb + tt) * 512 + qc] = f2bf(sigm(__uint_as_float(obr[k] << 16)) * hn * silu(__uint_as_float(zbr[k] << 16)));
        }
    }
    {
        float* oC = p.out + O_PC + (size_t)(s * 8 + h) * 4096;
#pragma unroll
        for (int n = 0; n < 2; ++n) {
            float4 o; o.x = accC[n][0]; o.y = accC[n][1]; o.z = accC[n][2]; o.w = accC[n][3];
            *(float4*)(oC + (tr * 16 + fr) * 64 + (tc0 + n) * 16 + fq * 4) = o;
        }
        if (tid < 64) p.out[O_PN + (size_t)(s * 8 + h) * 64 + tid] = sn[tid];
        if (tid == 0) p.out[O_PM + s * 8 + h] = gv[384 + 320];
    }
    __syncthreads();
}

__device__ __forceinline__ void wave_lds_fence() { __builtin_amdgcn_fence(__ATOMIC_RELEASE, "wavefront"); __builtin_amdgcn_wave_barrier(); __builtin_amdgcn_fence(__ATOMIC_ACQUIRE, "wavefront"); }
__device__ void rwkv_sample_wave(const Params& p, int sb, int h, float* wsm) {
    const int lane = otid() & 63;
    const int hj = h * 64 + lane;
    const int m0 = M_P + sb * 8;
    {
        float rr[8], kr[8], vr[8], ar[8], dd[8];
#pragma unroll
        for (int t = 0; t < 8; ++t) {
            const bf16_t* pr = p.P + (size_t)(m0 + t) * NP;
            rr[t] = bf2f(pr[C_R + hj]); kr[t] = bf2f(pr[C_K + hj]); vr[t] = bf2f(pr[C_V + hj]);
            ar[t] = bf2f(p.Aa[(size_t)(m0 + t) * 512 + hj]); dd[t] = 1.f - bf2f(p.Omd[(size_t)(m0 + t) * 512 + hj]);
        }
        const float* st = p.st_shift + (size_t)sb * SHIFT_W;
        float rp = st[C_R + hj], kp_ = st[C_K + hj], vp = st[C_V + hj];
        const float mu_r = p.mu_shift[C_R + hj], mu_k = p.mu_shift[C_K + hj], mu_v = p.mu_shift[C_V + hj];
        const float kkw = p.k_k[hj], kaw = p.k_a[hj];
#pragma unroll
        for (int t = 0; t < 8; ++t) {
            const float r = rr[t] + mu_r * (rp - rr[t]), k = kr[t] + mu_k * (kp_ - kr[t]), v = vr[t] + mu_v * (vp - vr[t]);
            rp = rr[t]; kp_ = kr[t]; vp = vr[t];
            const float a = ar[t], d = dd[t];
            float kk = k * kkw;
            const float nrm = sqrtf(wave_sum_fast(kk * kk));
            kk = kk / fmaxf(nrm, 1e-12f);
            const float ka = kk * a, kp = k * (1.f + (a - 1.f) * kaw);
            const float c1 = wave_sum_fast(ka * r), c2 = wave_sum_fast(kp * r);
            float* w = wsm + t * 400;
            w[lane] = kk; w[64 + lane] = d; w[128 + lane] = ka; w[192 + lane] = kp; w[256 + lane] = d * r; w[320 + lane] = v;
            if (lane == 0) { w[384] = c1; w[385] = c2; }
        }
    }
    float S[64];
    {
        const float* srow = p.st_S + ((size_t)(sb * 8 + h) * 64 + lane) * 64;
#pragma unroll
        for (int q = 0; q < 16; ++q) { const float4 v = *(const float4*)(srow + q * 4); S[4 * q] = v.x; S[4 * q + 1] = v.y; S[4 * q + 2] = v.z; S[4 * q + 3] = v.w; }
    }
    wave_lds_fence();
#pragma unroll 1
    for (int t = 0; t < 8; ++t) {
        const float* w = wsm + t * 400;
        float p1 = 0.f, p2 = 0.f;
#pragma unroll
        for (int q = 0; q < 16; ++q) {
            const float4 k4 = *(const float4*)(w + q * 4), r4 = *(const float4*)(w + 256 + q * 4);
            p1 += S[4 * q] * k4.x + S[4 * q + 1] * k4.y + S[4 * q + 2] * k4.z + S[4 * q + 3] * k4.w;
            p2 += S[4 * q] * r4.x + S[4 * q + 1] * r4.y + S[4 * q + 2] * r4.z + S[4 * q + 3] * r4.w;
        }
        const float vi = w[320 + lane];
        const float y = p2 - p1 * w[384] + vi * w[385];
#pragma unroll
        for (int q = 0; q < 16; ++q) {
            const float4 d4 = *(const float4*)(w + 64 + q * 4), a4 = *(const float4*)(w + 128 + q * 4), k4 = *(const float4*)(w + 192 + q * 4);
            S[4 * q] = S[4 * q] * d4.x + vi * k4.x - p1 * a4.x;
            S[4 * q + 1] = S[4 * q + 1] * d4.y + vi * k4.y - p1 * a4.y;
            S[4 * q + 2] = S[4 * q + 2] * d4.z + vi * k4.z - p1 * a4.z;
            S[4 * q + 3] = S[4 * q + 3] * d4.w + vi * k4.w - p1 * a4.w;
        }
        p.Yraw[(size_t)(m0 + t) * 512 + hj] = f2bf(y);
    }
    {
        float* o = p.out + O_SS + ((size_t)(sb * 8 + h) * 64 + lane) * 64;
#pragma unroll
        for (int q = 0; q < 16; ++q) { float4 v; v.x = S[4 * q]; v.y = S[4 * q + 1]; v.z = S[4 * q + 2]; v.w = S[4 * q + 3]; *(float4*)(o + q * 4) = v; }
    }
    wave_lds_fence();
}

__device__ void mlstm_sample_wave(const Params& p, int sb, int h, float* wsm) {
    const int lane = otid() & 63;
    const int qc = h * 64 + lane;
    const int m0 = M_P + sb * 8;
    float gi = 0.f, gl = 0.f;
    {
        float xq[11], xk[11];
#pragma unroll
        for (int r = 0; r < 3; ++r) { const float* st = p.st_conv + ((size_t)sb * 3 + r) * 1024 + qc; xq[r] = st[0]; xk[r] = st[512]; }
#pragma unroll
        for (int t = 0; t < 8; ++t) { const bf16_t* pr = p.P + (size_t)(m0 + t) * NP + C_QK + qc; xq[3 + t] = bf2f(pr[0]); xk[3 + t] = bf2f(pr[512]); }
#pragma unroll
        for (int t = 0; t < 8; ++t) {
            const bf16_t* pr = p.P + (size_t)(m0 + t) * NP;
            wsm[1024 + t * 64 + lane] = bf2f(pr[C_VB + qc]); wsm[1536 + t * 64 + lane] = bf2f(pr[C_OB + qc]); wsm[2048 + t * 64 + lane] = bf2f(pr[C_ZB + qc]);
        }
        if (lane < 8) {
            const bf16_t* pr = p.P + (size_t)(m0 + lane) * NP;
            gi = bf2f(pr[C_IB + h]) + p.b_i[h];
            const float f = bf2f(pr[C_FB + h]) + p.b_f[h];
            gl = f > 0.f ? -log1pf(__expf(-f)) : f - log1pf(__expf(f));
        }
        const float cwq0 = p.conv_w[qc], cwq1 = p.conv_w[1024 + qc], cwq2 = p.conv_w[2048 + qc], cwq3 = p.conv_w[3072 + qc];
        const float cwk0 = p.conv_w[512 + qc], cwk1 = p.conv_w[1536 + qc], cwk2 = p.conv_w[2560 + qc], cwk3 = p.conv_w[3584 + qc];
        const float cbq = p.conv_b[qc], cbk = p.conv_b[512 + qc];
#pragma unroll
        for (int t = 0; t < 8; ++t) {
            wsm[t * 64 + lane] = silu(cbq + xq[t] * cwq0 + xq[t + 1] * cwq1 + xq[t + 2] * cwq2 + xq[t + 3] * cwq3);
            wsm[512 + t * 64 + lane] = silu(cbk + xk[t] * cwk0 + xk[t + 1] * cwk1 + xk[t + 2] * cwk2 + xk[t + 3] * cwk3) * 0.125f;
        }
    }
    const float gnw = p.gn_w[qc];
    float C[64];
    {
        const float* crow = p.st_C + ((size_t)(sb * 8 + h) * 64 + lane) * 64;
#pragma unroll
        for (int q = 0; q < 16; ++q) { const float4 v = *(const float4*)(crow + q * 4); C[4 * q] = v.x; C[4 * q + 1] = v.y; C[4 * q + 2] = v.z; C[4 * q + 3] = v.w; }
    }
    float nl = p.st_n[(size_t)(sb * 8 + h) * 64 + lane];
    float m = p.st_m[sb * 8 + h];
    wave_lds_fence();
#pragma unroll 1
    for (int t = 0; t < 8; ++t) {
        const float it = rdlane(gi, t), lf = rdlane(gl, t);
        const float mt = fmaxf(lf + m, it);
        const float fdec = __expf(lf + m - mt), iw = __expf(it - mt);
        m = mt;
        const float ql = wsm[t * 64 + lane], kl = wsm[512 + t * 64 + lane];
        nl = fdec * nl + iw * kl;
        const float den = wave_sum_fast(nl * ql);
        const float ai = iw * wsm[1024 + t * 64 + lane];
        float num = 0.f;
#pragma unroll
        for (int q = 0; q < 16; ++q) {
            const float4 k4 = *(const float4*)(wsm + 512 + t * 64 + q * 4), q4 = *(const float4*)(wsm + t * 64 + q * 4);
            C[4 * q] = fdec * C[4 * q] + ai * k4.x; C[4 * q + 1] = fdec * C[4 * q + 1] + ai * k4.y;
            C[4 * q + 2] = fdec * C[4 * q + 2] + ai * k4.z; C[4 * q + 3] = fdec * C[4 * q + 3] + ai * k4.w;
            num += C[4 * q] * q4.x + C[4 * q + 1] * q4.y + C[4 * q + 2] * q4.z + C[4 * q + 3] * q4.w;
        }
        const float hv = num / fmaxf(fabsf(den), __expf(-mt));
        const float ms = wave_sum_fast(hv * hv) * (1.f / 64.f);
        p.OutB[(size_t)(m0 + t) * 512 + qc] = f2bf(sigm(wsm[1536 + t * 64 + lane]) * hv * rsqrtf(ms + 1e-6f) * gnw * silu(wsm[2048 + t * 64 + lane]));
    }
    {
        float* o = p.out + O_SC + ((size_t)(sb * 8 + h) * 64 + lane) * 64;
#pragma unroll
        for (int q = 0; q < 16; ++q) { float4 v; v.x = C[4 * q]; v.y = C[4 * q + 1]; v.z = C[4 * q + 2]; v.w = C[4 * q + 3]; *(float4*)(o + q * 4) = v; }
        p.out[O_SN + (size_t)(sb * 8 + h) * 64 + lane] = nl;
        if (lane == 0) p.out[O_SM + sb * 8 + h] = m;
    }
    wave_lds_fence();
}

__device__ void phaseE(const Params& p, float* sm, int bid, int nb) {
    constexpr int N_RP = 192, N_MP = 64, N_RS = 128, N_MS = 128;
    int* s_item = (int*)(sm + 32768);
    for (;;) {
        if (otid() == 0) *s_item = (int)atomicAdd(p.ctr, 1u);
        __syncthreads();
        const int it = *s_item;
        __syncthreads();
        if (it >= N_RP + N_MP + N_RS + N_MS) break;
        if (it < N_RP) { rwkv_item(p, it / 24, (it / 3) & 7, it % 3, sm); }
        else if (it < N_RP + N_MP) { const int i = it - N_RP; mlstm_prompt(p, i >> 3, i & 7, sm); }
        else if (it < N_RP + N_MP + N_RS) { const int wid = otid() >> 6; const int i = (it - N_RP - N_MP) * 8 + wid; rwkv_sample_wave(p, i >> 3, i & 7, sm + wid * 3328); }
        else if (it < N_RP + N_MP + N_RS + N_MS) { const int wid = otid() >> 6; const int i = (it - N_RP - N_MP - N_RS) * 8 + wid; mlstm_sample_wave(p, i >> 3, i & 7, sm + wid * 3328); }
    }
}

__device__ void phaseF(const Params& p, int bid, int nb) {
    const int wid = otid() >> 6, lane = otid() & 63;
    const int c8 = lane * 8;
    float lnw[8], lnb[8], mur[8], muk[8], muv[8], kaw[8], rkw[8];
#pragma unroll
    for (int i = 0; i < 8; ++i) {
        lnw[i] = p.ln_w[c8 + i]; lnb[i] = p.ln_b[c8 + i]; mur[i] = p.mu_shift[C_R + c8 + i]; muk[i] = p.mu_shift[C_K + c8 + i];
        muv[i] = p.mu_shift[C_V + c8 + i]; kaw[i] = p.k_a[c8 + i]; rkw[i] = p.r_k[c8 + i];
    }
    auto un8 = [](const uint4 u, float* o) {
        o[0] = __uint_as_float(u.x << 16); o[1] = __uint_as_float(u.x & 0xFFFF0000u); o[2] = __uint_as_float(u.y << 16); o[3] = __uint_as_float(u.y & 0xFFFF0000u);
        o[4] = __uint_as_float(u.z << 16); o[5] = __uint_as_float(u.z & 0xFFFF0000u); o[6] = __uint_as_float(u.w << 16); o[7] = __uint_as_float(u.w & 0xFFFF0000u);
    };
    struct FR { uint4 uy, ur, uk, uv, uz, ua, urp, ukp, uvp; };
    auto loadF = [&](int m, FR& q) {
        int s, t; tok_info(m, s, t);
        const bf16_t* pr = p.P + (size_t)m * NP + c8;
        const bf16_t* pp = t > 0 ? pr - NP : pr;
        q.uy = *(const uint4*)(p.Yraw + (size_t)m * 512 + c8);
        q.ur = *(const uint4*)(pr + C_R); q.uk = *(const uint4*)(pr + C_K); q.uv = *(const uint4*)(pr + C_V); q.uz = *(const uint4*)(pr + C_ZA);
        q.ua = *(const uint4*)(p.Aa + (size_t)m * 512 + c8);
        q.urp = *(const uint4*)(pp + C_R); q.ukp = *(const uint4*)(pp + C_K); q.uvp = *(const uint4*)(pp + C_V);
    };
    auto computeF = [&](int m, const FR& q) {
        int s, t; tok_info(m, s, t);
        float y[8], r[8], k[8], v[8], z[8], a[8], rp[8], kp_[8], vp[8];
        if (t > 0) { un8(q.urp, rp); un8(q.ukp, kp_); un8(q.uvp, vp); }
        else if (s >= 8) {
            const float* st = p.st_shift + (size_t)(s - 8) * SHIFT_W + c8;
#pragma unroll
            for (int i = 0; i < 8; ++i) { rp[i] = st[C_R + i]; kp_[i] = st[C_K + i]; vp[i] = st[C_V + i]; }
        } else {
#pragma unroll
            for (int i = 0; i < 8; ++i) { rp[i] = 0.f; kp_[i] = 0.f; vp[i] = 0.f; }
        }
        un8(q.uy, y); un8(q.ur, r); un8(q.uk, k); un8(q.uv, v); un8(q.uz, z); un8(q.ua, a);
        float sy = 0.f;
#pragma unroll
        for (int i = 0; i < 8; ++i) sy += y[i];
        const float mean = sum8(sy) * (1.f / 64.f);
        float sv = 0.f, sbn = 0.f;
#pragma unroll
        for (int i = 0; i < 8; ++i) {
            y[i] -= mean; sv += y[i] * y[i];
            r[i] += mur[i] * (rp[i] - r[i]); k[i] += muk[i] * (kp_[i] - k[i]); v[i] += muv[i] * (vp[i] - v[i]);
            sbn += r[i] * (k[i] * (1.f + (a[i] - 1.f) * kaw[i])) * rkw[i];
        }
        const float rstd = rsqrtf(sum8(sv) * (1.f / 64.f) + 64e-5f);
        const float bonus = sum8(sbn);
        float o[8];
#pragma unroll
        for (int i = 0; i < 8; ++i) o[i] = (y[i] * rstd * lnw[i] + lnb[i] + bonus * v[i]) * silu(z[i]);
        uint4 ou; ou.x = pk2(o[0], o[1]); ou.y = pk2(o[2], o[3]); ou.z = pk2(o[4], o[5]); ou.w = pk2(o[6], o[7]);
        *(uint4*)(p.OutA + (size_t)m * 512 + c8) = ou;
    };
    const int stride = nb * 8;
    for (int m = bid * 8 + wid; m < M_TOT; m += 2 * stride) {
        const int m2 = m + stride; const bool has2 = m2 < M_TOT;
        FR qa, qb;
        loadF(m, qa); loadF(has2 ? m2 : m, qb);
        computeF(m, qa);
        if (has2) computeF(m2, qb);
    }
}

__device__ __forceinline__ void xnew_load(const Params& p, int m, int lane, float (&v)[16]) {
    const bf16_t* xb = p.P + (size_t)m * NP + 1024 + lane * 8;
    const uint4 u0 = *(const uint4*)xb, u1 = *(const uint4*)(xb + 512);
    const float4 a = unpk4(make_uint2(u0.x, u0.y)), b = unpk4(make_uint2(u0.z, u0.w)), c = unpk4(make_uint2(u1.x, u1.y)), d = unpk4(make_uint2(u1.z, u1.w));
    v[0] = a.x; v[1] = a.y; v[2] = a.z; v[3] = a.w; v[4] = b.x; v[5] = b.y; v[6] = b.z; v[7] = b.w;
    v[8] = c.x; v[9] = c.y; v[10] = c.z; v[11] = c.w; v[12] = d.x; v[13] = d.y; v[14] = d.z; v[15] = d.w;
}
__device__ __forceinline__ void ynorm_store(const Params& p, int m, int lane, const float (&v)[16], float rstd) {
    float* yr = p.out + (size_t)m * 1024 + lane * 8;
#pragma unroll
    for (int h = 0; h < 2; ++h)
#pragma unroll
        for (int q = 0; q < 2; ++q) {
            const float4 g = *(const float4*)(p.g_final + h * 512 + lane * 8 + q * 4);
            float4 o; o.x = v[h * 8 + q * 4] * rstd * g.x; o.y = v[h * 8 + q * 4 + 1] * rstd * g.y; o.z = v[h * 8 + q * 4 + 2] * rstd * g.z; o.w = v[h * 8 + q * 4 + 3] * rstd * g.w;
            *(float4*)(yr + h * 512 + q * 4) = o;
        }
}
__device__ void phaseI(const Params& p, int bid, int nb) {
    const int wid = otid() >> 6, lane = otid() & 63;
    const int stride = nb * 8;
    for (int m = bid * 8 + wid; m < M_TOT; m += 2 * stride) {
        const int m2 = m + stride;
        const bool has2 = m2 < M_TOT;
        float va[16], vb[16];
        xnew_load(p, m, lane, va);
        xnew_load(p, has2 ? m2 : m, lane, vb);
        float sa = 0.f, sb = 0.f;
#pragma unroll
        for (int i = 0; i < 16; ++i) { sa += va[i] * va[i]; sb += vb[i] * vb[i]; }
        const float ra = rsqrtf(wave_sum(sa) * (1.f / 1024.f) + 1e-6f);
        const float rb = rsqrtf(wave_sum(sb) * (1.f / 1024.f) + 1e-6f);
        ynorm_store(p, m, lane, va, ra);
        if (has2) ynorm_store(p, m2, lane, vb, rb);
    }
}

namespace pg8 {
#define PG8_LAS __attribute__((address_space(3)))
typedef unsigned short bf16_t;
typedef short bf16x8 __attribute__((ext_vector_type(8)));
typedef float f32x4 __attribute__((ext_vector_type(4)));
typedef unsigned u32x4 __attribute__((ext_vector_type(4)));
constexpr int BM = 256, BK = 64, HALF = 128, HTB = HALF * BK * 2  , STAGE_BYTES = 8 * HTB, NXCD = 8, WGM = 8;

__host__ __device__ __forceinline__ int lds_byte(int r, int c) { const int st = (r >> 4) * 2 + (c >> 5), rr = r & 15, cc = c & 31, ob = rr * 64 + cc * 2; return st * 1024 + (ob ^ (((ob >> 9) & 1) << 5)); }
__host__ __device__ __forceinline__ void stage_rc(int b, int& R, int& C) { const int st = b / 1024, sb = b % 1024, swz = sb ^ (((sb >> 9) & 1) << 5); R = (st >> 1) * 16 + swz / 64; C = (st & 1) * 32 + (swz % 64) / 2; }
__host__ __device__ __forceinline__ int perm32(int rho) { const int n = rho >> 4, i = rho & 15; return 8 * (i >> 2) + 4 * n + (i & 3); }

struct Unit { int pm, pn; };
struct Gemm { const bf16_t* A; const bf16_t* Bt; int M, N, K, lda, ldb; };

struct StaticOrder {
    int nM, nN, nwg, G, c;
    __host__ __device__ void init(int M, int N, int G_, int c_) { nM = M / BM; nN = N / BM; nwg = nM * nN; G = G_; c = c_; }
    __host__ __device__ bool next(int i, Unit& u) const {
        const long L = (long)i * G + c; if (L >= nwg) return false;
        int wgid = (int)L; { const int q = nwg / NXCD, r = nwg % NXCD, xcd = wgid % NXCD, off = wgid / NXCD; wgid = (xcd < r ? xcd * (q + 1) : r * (q + 1) + (xcd - r) * q) + off; }
        const int nig = WGM * nN, gid = wgid / nig, fm = gid * WGM, gsz = (nM - fm) < WGM ? (nM - fm) : WGM;
        u.pm = fm + ((wgid % nig) % gsz); u.pn = (wgid % nig) / gsz; return true;
    }
    __device__ __forceinline__ void a_ready(const Unit&) const {}
    __device__ __forceinline__ void done(const Unit&) const {}
};
template <class Epi, class Sched, bool STAMP = false>
__device__ __forceinline__ void gemm_phase(PG8_LAS unsigned char* lds, const Gemm g, const Sched& S, const Epi& E, unsigned long long* stamps) {
    const int tid = otid(), wid = __builtin_amdgcn_readfirstlane(tid >> 6), lane = tid & 63, wr = wid >> 2, wc = wid & 3, fr = lane & 15, fq = lane >> 4;
    const int K = g.K, nt = K / BK;
    int ts_lo = 0, ts_hi = 0, nts = 0; const unsigned long long rt_entry = STAMP ? (unsigned long long)wall_clock64() : 0ull;
#define PG8_STAMP() do { if (STAMP && wid == 0 && nts < 64) { const unsigned long long _c = (unsigned long long)clock64(); \
        ts_lo = (lane == nts) ? (int)(unsigned)_c : ts_lo; ts_hi = (lane == nts) ? (int)(unsigned)(_c >> 32) : ts_hi; ++nts; } } while (0)
    PG8_STAMP();
    unsigned voffA[2], voffB[2];
#pragma unroll
    for (int i = 0; i < 2; ++i) { int R, C; stage_rc(tid * 16 + i * 8192, R, C); const int Rb = Epi::PERM ? ((R & ~31) + perm32(R & 31)) : R;
        voffA[i] = (unsigned)(R * g.lda + C) * 2u; voffB[i] = (unsigned)(Rb * g.ldb + C) * 2u; }
    const size_t kstep = (size_t)(BK * 2);
    const size_t hstepA = (size_t)HALF * g.lda * 2, hstepB = (size_t)HALF * g.ldb * 2;
    const size_t tstepA = 2 * hstepA, tstepB = 2 * hstepB;
    const unsigned ldsw = (unsigned)wid * 1024u;
    const int aoff = lds_byte(wr * 64 + fr, fq * 8), boff = lds_byte(wc * 32 + fr, fq * 8);
#define PG8_SA(b, h) (((b) * 2 + (h)) * HTB)
#define PG8_SB(b, h) ((4 + (b) * 2 + (h)) * HTB)
#define PG8_STAGE(bufoff, gbase, voff) do { _Pragma("unroll") for (int _i = 0; _i < 2; ++_i) \
        __builtin_amdgcn_global_load_lds((const unsigned*)((const char*)(gbase) + (voff)[_i]), (PG8_LAS unsigned*)(lds + (bufoff) + ldsw + _i * 8192), 16, 0, 0); } while (0)
#define PG8_LDA(dst, b, h) do { _Pragma("unroll") for (int m = 0; m < 4; ++m) _Pragma("unroll") for (int k = 0; k < 2; ++k) dst[m][k] = *(const PG8_LAS bf16x8*)(lds + PG8_SA(b, h) + aoff + m * 2048 + k * 1024); } while (0)
#define PG8_LDB(dst, b, h) do { _Pragma("unroll") for (int n = 0; n < 2; ++n) _Pragma("unroll") for (int k = 0; k < 2; ++k) dst[n][k] = *(const PG8_LAS bf16x8*)(lds + PG8_SB(b, h) + boff + n * 2048 + k * 1024); } while (0)
#define PG8_MMA(ai, bj, At, Bt) do { __builtin_amdgcn_s_setprio(1); _Pragma("unroll") for (int m = 0; m < 4; ++m) _Pragma("unroll") for (int n = 0; n < 2; ++n) _Pragma("unroll") for (int k = 0; k < 2; ++k) \
        acc[ai][bj][m][n] = __builtin_amdgcn_mfma_f32_16x16x32_bf16(Bt[n][k], At[m][k], acc[ai][bj][m][n], 0, 0, 0); __builtin_amdgcn_s_setprio(0); } while (0)
#define PG8_WAIT_V(n) asm volatile("s_waitcnt vmcnt(" #n ")" ::: "memory")
#define PG8_WAIT_L(n) asm volatile("s_waitcnt lgkmcnt(" #n ")" ::: "memory")
#define PG8_BAR __builtin_amdgcn_s_barrier()
#define PG8_SCHED __builtin_amdgcn_sched_barrier(0)
    Unit cur, nxt; int ui = 0;
    if (!S.next(0, cur)) return;
    f32x4 acc[2][2][4][2];
#pragma unroll
    for (int a = 0; a < 2; ++a)
#pragma unroll
        for (int b = 0; b < 2; ++b)
#pragma unroll
            for (int m = 0; m < 4; ++m)
#pragma unroll
                for (int n = 0; n < 2; ++n) acc[a][b][m][n] = (f32x4){0.f, 0.f, 0.f, 0.f};
    bf16x8 At[4][2], B0[2][2], B1[2][2];
    const char* cA = (const char*)g.A + (size_t)cur.pm * tstepA; const char* cB = (const char*)g.Bt + (size_t)cur.pn * tstepB;
    S.a_ready(cur);
    PG8_STAGE(PG8_SB(0, 0), cB, voffB); PG8_STAGE(PG8_SA(0, 0), cA, voffA); PG8_STAGE(PG8_SB(0, 1), cB + hstepB, voffB); PG8_STAGE(PG8_SA(0, 1), cA + hstepA, voffA);
    if (wr == 1) PG8_BAR;
    PG8_WAIT_V(4); PG8_BAR;
    PG8_STAGE(PG8_SB(1, 0), cB + kstep, voffB); PG8_STAGE(PG8_SA(1, 0), cA + kstep, voffA); PG8_STAGE(PG8_SB(1, 1), cB + hstepB + kstep, voffB);
    PG8_WAIT_V(6); PG8_BAR;
    PG8_STAMP();
    for (;;) {
        const bool has_next = S.next(ui + 1, nxt);
        const char* nA = has_next ? (const char*)g.A + (size_t)nxt.pm * tstepA : cA; const char* nB = has_next ? (const char*)g.Bt + (size_t)nxt.pn * tstepB : cB;
        for (int t = 0; t < nt; t += 2) {
            const bool last = (t == nt - 2);
            const char* a1 = cA + (size_t)(t + 1) * kstep;
            const char* a2 = last ? nA : cA + (size_t)(t + 2) * kstep; const char* b2 = last ? nB : cB + (size_t)(t + 2) * kstep;
            const char* a3 = a2 + kstep; const char* b3 = b2 + kstep;
            if (last && has_next) S.a_ready(nxt);
            PG8_LDB(B0, 0, 0); PG8_SCHED; PG8_LDA(At, 0, 0); PG8_STAGE(PG8_SA(1, 1), a1 + hstepA, voffA);
            PG8_WAIT_L(8); PG8_BAR; PG8_WAIT_L(0); PG8_MMA(0, 0, At, B0); PG8_BAR; PG8_SCHED;
            PG8_LDB(B1, 0, 1); PG8_STAGE(PG8_SB(0, 0), b2, voffB);
            PG8_BAR; PG8_WAIT_L(0); PG8_MMA(0, 1, At, B1); PG8_BAR;
            PG8_LDA(At, 0, 1); PG8_STAGE(PG8_SA(0, 0), a2, voffA);
            PG8_BAR; PG8_WAIT_L(0); PG8_MMA(1, 0, At, B0); PG8_BAR; PG8_SCHED;
            PG8_STAGE(PG8_SB(0, 1), b2 + hstepB, voffB);
            PG8_WAIT_V(6); PG8_BAR; PG8_MMA(1, 1, At, B1); PG8_BAR;
            PG8_LDB(B0, 1, 0); PG8_SCHED; PG8_LDA(At, 1, 0); PG8_STAGE(PG8_SA(0, 1), a2 + hstepA, voffA);
            PG8_WAIT_L(8); PG8_BAR; PG8_WAIT_L(0); PG8_MMA(0, 0, At, B0); PG8_BAR; PG8_SCHED;
            PG8_LDB(B1, 1, 1); PG8_STAGE(PG8_SB(1, 0), b3, voffB);
            PG8_BAR; PG8_WAIT_L(0); PG8_MMA(0, 1, At, B1); PG8_BAR;
            PG8_LDA(At, 1, 1); PG8_STAGE(PG8_SA(1, 0), a3, voffA);
            PG8_BAR; PG8_WAIT_L(0); PG8_MMA(1, 0, At, B0); PG8_BAR; PG8_SCHED;
            PG8_STAGE(PG8_SB(1, 1), b3 + hstepB, voffB);
            PG8_WAIT_V(6); PG8_BAR; PG8_MMA(1, 1, At, B1); PG8_BAR;
        }
        PG8_STAMP();
        if constexpr (!Epi::AFTER_DRAIN) { E(acc, cur, wr, wc, fr, fq); S.done(cur); }
        PG8_STAMP();
        if (!has_next) break;
#pragma unroll
        for (int a = 0; a < 2; ++a)
#pragma unroll
            for (int b = 0; b < 2; ++b)
#pragma unroll
                for (int m = 0; m < 4; ++m)
#pragma unroll
                    for (int n = 0; n < 2; ++n) acc[a][b][m][n] = (f32x4){0.f, 0.f, 0.f, 0.f};
        cur = nxt; cA = nA; cB = nB; ++ui;
    }
    PG8_WAIT_V(0);
    if (wr == 0) PG8_BAR;
    PG8_BAR;
    if constexpr (Epi::AFTER_DRAIN) { E.fused(acc, cur, wr, wc, fr, fq, lds, wid, lane); S.done(cur); }
    PG8_STAMP();
    if (STAMP && wid == 0) { stamps[lane] = lane < nts ? (((unsigned long long)(unsigned)ts_hi << 32) | (unsigned)ts_lo) : 0ull;
        if (lane == 62) stamps[62] = rt_entry; if (lane == 63) stamps[63] = (unsigned long long)wall_clock64(); }
#undef PG8_STAMP
#undef PG8_SA
#undef PG8_SB
#undef PG8_STAGE
#undef PG8_LDA
#undef PG8_LDB
#undef PG8_MMA
#undef PG8_WAIT_V
#undef PG8_WAIT_L
#undef PG8_BAR
#undef PG8_SCHED
}
}

struct EpiP {
    static constexpr bool PERM = true, AFTER_DRAIN = false;
    bf16_t* O; int ldc;
    __device__ __forceinline__ void operator()(const f32x4 (&acc)[2][2][4][2], const pg8::Unit& u, int wr, int wc, int fr, int fq) const {
        const int row0 = u.pm * 256 + wr * 64 + fr, col0 = u.pn * 256 + wc * 32 + 8 * fq;
#pragma unroll
        for (int ai = 0; ai < 2; ++ai)
#pragma unroll
            for (int m = 0; m < 4; ++m) {
                bf16_t* rowp = O + (size_t)(row0 + ai * 128 + m * 16) * ldc + col0;
#pragma unroll
                for (int bj = 0; bj < 2; ++bj) {
                    const f32x4 v0 = acc[ai][bj][m][0], v1 = acc[ai][bj][m][1];
                    uint4 o; o.x = pk2(v0[0], v0[1]); o.y = pk2(v0[2], v0[3]); o.z = pk2(v1[0], v1[1]); o.w = pk2(v1[2], v1[3]);
                    *(uint4*)(rowp + bj * 128) = o;
                }
            }
    }
};
template <int SECOND> struct EpiMerge {
    static constexpr bool PERM = true, AFTER_DRAIN = false;
    bf16_t* P; int gcol;
    __device__ __forceinline__ void operator()(const f32x4 (&acc)[2][2][4][2], const pg8::Unit& u, int wr, int wc, int fr, int fq) const {
        const int row0 = u.pm * 256 + wr * 64 + fr, col0 = u.pn * 256 + wc * 32 + 8 * fq;
#pragma unroll
        for (int ai = 0; ai < 2; ++ai) {
            uint4 gq[4][2], pq[4][2];
#pragma unroll
            for (int m = 0; m < 4; ++m) {
                const bf16_t* rowp = P + (size_t)(row0 + ai * 128 + m * 16) * NP + col0;
#pragma unroll
                for (int bj = 0; bj < 2; ++bj) {
                    gq[m][bj] = *(const uint4*)(rowp + gcol + bj * 128);
                    if (SECOND) pq[m][bj] = *(const uint4*)(rowp + bj * 128);
                }
            }
#pragma unroll
            for (int m = 0; m < 4; ++m) {
                bf16_t* rowp = P + (size_t)(row0 + ai * 128 + m * 16) * NP + col0;
#pragma unroll
                for (int bj = 0; bj < 2; ++bj) {
                    const f32x4 v0 = acc[ai][bj][m][0], v1 = acc[ai][bj][m][1];
                    const uint4 g = gq[m][bj];
                    const float4 ga = unpk4(make_uint2(g.x, g.y)), gb = unpk4(make_uint2(g.z, g.w));
                    float r[8] = {sigm(ga.x) * v0[0], sigm(ga.y) * v0[1], sigm(ga.z) * v0[2], sigm(ga.w) * v0[3],
                                  sigm(gb.x) * v1[0], sigm(gb.y) * v1[1], sigm(gb.z) * v1[2], sigm(gb.w) * v1[3]};
                    if (SECOND) {
                        const uint4 pv = pq[m][bj];
                        const float4 pa = unpk4(make_uint2(pv.x, pv.y)), pb = unpk4(make_uint2(pv.z, pv.w));
                        r[0] += pa.x; r[1] += pa.y; r[2] += pa.z; r[3] += pa.w; r[4] += pb.x; r[5] += pb.y; r[6] += pb.z; r[7] += pb.w;
                    }
                    uint4 o; o.x = pk2(r[0], r[1]); o.y = pk2(r[2], r[3]); o.z = pk2(r[4], r[5]); o.w = pk2(r[6], r[7]);
                    *(uint4*)(rowp + bj * 128) = o;
                }
            }
        }
    }
};
struct EpiOut {
    static constexpr bool PERM = true, AFTER_DRAIN = false;
    const Params* pp;
    __device__ __forceinline__ void operator()(const f32x4 (&acc)[2][2][4][2], const pg8::Unit& u, int wr, int wc, int fr, int fq) const {
        const Params& p = *pp;
        const int row0 = u.pm * 256 + wr * 64 + fr, col0 = u.pn * 256 + wc * 32 + 8 * fq;
#pragma unroll
        for (int ai = 0; ai < 2; ++ai)
#pragma unroll
            for (int mp = 0; mp < 2; ++mp) {
                float4 xq[2][4], gq[2][4];
#pragma unroll
                for (int mm = 0; mm < 2; ++mm) {
                    const int row = row0 + ai * 128 + (mp * 2 + mm) * 16;
                    int s, t; tok_info(row, s, t);
                    const float* xr = xrow(p, row) + col0;
                    const float* gt = p.mod + (size_t)s * 3072 + 2048 + col0;
#pragma unroll
                    for (int q = 0; q < 4; ++q) { const int co = (q >> 1) * 128 + (q & 1) * 4; xq[mm][q] = *(const float4*)(xr + co); gq[mm][q] = *(const float4*)(gt + co); }
                }
#pragma unroll
                for (int mm = 0; mm < 2; ++mm) {
                    const int m = mp * 2 + mm, row = row0 + ai * 128 + m * 16;
                    bf16_t* orow = p.P + (size_t)row * NP + 1024 + col0;
#pragma unroll
                    for (int bj = 0; bj < 2; ++bj) {
                        const float4 x0 = xq[mm][bj * 2], x1 = xq[mm][bj * 2 + 1], g0 = gq[mm][bj * 2], g1 = gq[mm][bj * 2 + 1];
                        const f32x4 a0 = acc[ai][bj][m][0], a1 = acc[ai][bj][m][1];
                        uint4 o;
                        o.x = pk2(x0.x + g0.x * a0[0], x0.y + g0.y * a0[1]); o.y = pk2(x0.z + g0.z * a0[2], x0.w + g0.w * a0[3]);
                        o.z = pk2(x1.x + g1.x * a1[0], x1.y + g1.y * a1[1]); o.w = pk2(x1.z + g1.z * a1[2], x1.w + g1.w * a1[3]);
                        *(uint4*)(orow + bj * 128) = o;
                    }
                }
            }
    }
};
template <class Epi> __device__ __forceinline__ void run_gemm(float* sm, const bf16_t* A, int lda, const bf16_t* Bt, int ldb, int M, int N, int K, const Epi& E, int bid, int nb) {
    pg8::Gemm g; g.A = A; g.Bt = Bt; g.M = M; g.N = N; g.K = K; g.lda = lda; g.ldb = ldb;
    pg8::StaticOrder S; S.init(M, N, nb, bid);
    pg8::gemm_phase<Epi, pg8::StaticOrder, false>((PG8_LAS unsigned char*)sm, g, S, E, nullptr);
}
__device__ void phaseC(const Params& p, float* sm, int bid, int nb) {
    EpiP E; E.O = p.P; E.ldc = NP;
    run_gemm(sm, p.H, 1024, p.WinT, 1024, M_TOT, NP, 1024, E, bid, nb);
}
__device__ void phaseG(const Params& p, float* sm, int bid, int nb) {
    EpiMerge<0> E0; E0.P = p.P; E0.gcol = C_GLA;
    run_gemm(sm, p.OutA, 512, p.WupaT, 512, M_TOT, 1024, 512, E0, bid, nb);
    __syncthreads();
    EpiMerge<1> E1; E1.P = p.P; E1.gcol = C_GLB;
    run_gemm(sm, p.OutB, 512, p.WupbT, 512, M_TOT, 1024, 512, E1, bid, nb);
}
__device__ void phaseH(const Params& p, float* sm, int bid, int nb) {
    EpiOut E; E.pp = &p;
    run_gemm(sm, p.P, NP, p.WoutT, 1024, M_TOT, 1024, 1024, E, bid, nb);
}

#define XB_TMO      128
#define XB_XCNT(j)  (256  + 64 * (j))
#define XB_XSUB(j)  (1280 + 64 * (j))
#define XB_XGEN(j)  (2304 + 64 * (j))
#define XB_TOP      3328
#define XB_TOPGEN   3392
#define XCD_BAR_WORDS 3456
#define XB_SPIN_CAP (1u << 18)
#define LAS __attribute__((address_space(3)))

__device__ __forceinline__ unsigned xb_ld(unsigned* p)              { return __hip_atomic_load(p, __ATOMIC_RELAXED, __HIP_MEMORY_SCOPE_AGENT); }
__device__ __forceinline__ unsigned xb_add(unsigned* p, unsigned v) { return __hip_atomic_fetch_add(p, v, __ATOMIC_RELAXED, __HIP_MEMORY_SCOPE_AGENT); }
__device__ __forceinline__ unsigned xb_xcc_id() { return (unsigned)__builtin_amdgcn_s_getreg((3 << 11) | 20) & 0xFu; }
#define XB_SPIN(cond, bar) do { unsigned _sp = 0; while (cond) { __builtin_amdgcn_s_sleep(1); \
    if ((++_sp & 255u) == 0u) { if (xb_ld(&(bar)[XB_TMO])) break; if (_sp > XB_SPIN_CAP) { atomicAdd(&(bar)[XB_TMO], 1u); break; } } } } while (0)

struct XcdBarrier {
    unsigned* bar; unsigned x;
    volatile LAS unsigned* st;
};

__device__ __forceinline__ XcdBarrier xcd_barrier_post(unsigned* bar, volatile LAS unsigned* st) {
    XcdBarrier b; b.bar = bar; b.x = xb_xcc_id(); b.st = st;
    if (threadIdx.x == 0) (void)xb_add(&bar[XB_XCNT(b.x)], 1u);
    return b;
}
__device__ __forceinline__ void xcd_barrier_complete(unsigned* bar, unsigned x, unsigned& nloc, unsigned& nx) {
    const unsigned G = gridDim.x * gridDim.y * gridDim.z;
    unsigned sum, cnt, mine, sp = 0u;
    for (;;) {
        sum = 0u; cnt = 0u; mine = 0u;
#pragma unroll
        for (unsigned j = 0; j < 16; ++j) { const unsigned c = xb_ld(&bar[XB_XCNT(j)]); sum += c; cnt += (c > 0u) ? 1u : 0u; mine = (j == x) ? c : mine; }
        if (sum == G) break;
        __builtin_amdgcn_s_sleep(1);
        if ((++sp & 255u) == 0u) { if (xb_ld(&bar[XB_TMO])) break; if (sp > XB_SPIN_CAP) { atomicAdd(&bar[XB_TMO], 1u); break; } }
    }
    nloc = mine > 0u ? mine : 1u; nx = cnt > 0u ? cnt : 1u;
}

__device__ __forceinline__ void xcd_barrier(const XcdBarrier& b) {
    asm volatile("s_waitcnt vmcnt(0)" ::: "memory");
    __syncthreads();
    if (threadIdx.x == 0) {
        unsigned* bar = b.bar;
        __builtin_amdgcn_s_waitcnt(0);
        unsigned nloc = b.st[0], nx = b.st[1];
        if (nloc == 0u) { xcd_barrier_complete(bar, b.x, nloc, nx); b.st[0] = nloc; b.st[1] = nx; }
        const unsigned old = xb_add(&bar[XB_XSUB(b.x)], 1u);
        const unsigned gen = old / nloc;
        if (old + 1u == (gen + 1u) * nloc) {
            __builtin_amdgcn_fence(__ATOMIC_RELEASE, "agent");
            asm volatile("s_waitcnt vmcnt(0)" ::: "memory");
            const unsigned og = xb_add(&bar[XB_TOP], 1u);
            const unsigned tg = og / nx;
            if (og + 1u == (tg + 1u) * nx) xb_add(&bar[XB_TOPGEN], 1u);
            else XB_SPIN(xb_ld(&bar[XB_TOPGEN]) == tg, bar);
            __builtin_amdgcn_fence(__ATOMIC_ACQUIRE, "agent");
            xb_add(&bar[XB_XGEN(b.x)], 1u);
            asm volatile("s_waitcnt vmcnt(0)" ::: "memory");
        } else {
            XB_SPIN(xb_ld(&bar[XB_XGEN(b.x)]) == gen, bar);
            __builtin_amdgcn_fence(__ATOMIC_ACQUIRE, "agent");
            asm volatile("s_waitcnt vmcnt(0)" ::: "memory");
        }
    }
    __syncthreads();
}


#if MK_MULTI
#define PHASE_KERNEL(NAME, CALL) __global__ void __launch_bounds__(NTHR) NAME(Params p) { __shared__ __attribute__((aligned(16))) float sm[SMEM_FLOATS]; const int bid = blockIdx.x, nb = gridDim.x; (void)sm; CALL; }
PHASE_KERNEL(kA, phaseA(p, sm, bid, nb))
PHASE_KERNEL(kB, phaseB(p, bid, nb))
PHASE_KERNEL(kC, phaseC(p, sm, bid, nb))
PHASE_KERNEL(kD, phaseD(p, sm, bid, nb))
PHASE_KERNEL(kE, phaseE(p, sm, bid, nb))
PHASE_KERNEL(kF, phaseF(p, bid, nb))
PHASE_KERNEL(kG, phaseG(p, sm, bid, nb))
PHASE_KERNEL(kH, phaseH(p, sm, bid, nb))
PHASE_KERNEL(kI, phaseI(p, bid, nb))
#else
__global__ void __launch_bounds__(NTHR) fwd_megakernel(Params p) {
    __shared__ __attribute__((aligned(16))) float sm[SMEM_FLOATS];
    __shared__ uint4 xb_words;
    cg::grid_group grid = cg::this_grid();
    const int bid = blockIdx.x, nb = gridDim.x;
    if (threadIdx.x == 0) xb_words = make_uint4(0u, 0u, 0u, 0u);
    __syncthreads();
    XcdBarrier xb = xcd_barrier_post(p.bar, (volatile LAS unsigned*)&xb_words);
    phaseA(p, sm, bid, nb);
    if (__hip_atomic_load(p.acnt + 1, __ATOMIC_RELAXED, __HIP_MEMORY_SCOPE_AGENT) == 0xFFFFFFFFu) grid.sync();
    phaseB(p, bid, nb); xcd_barrier(xb);
    phaseC(p, sm, bid, nb); xcd_barrier(xb);
    phaseD(p, sm, bid, nb); xcd_barrier(xb);
    phaseE(p, sm, bid, nb); xcd_barrier(xb);
    phaseF(p, bid, nb); xcd_barrier(xb);
    phaseG(p, sm, bid, nb); xcd_barrier(xb);
    phaseH(p, sm, bid, nb); xcd_barrier(xb);
    phaseI(p, bid, nb);
}
#endif

extern "C" void kernel_launch(void* const* d_in, const int* in_sizes, int n_in, void* d_out, int out_size, void* d_ws, size_t ws_size,
                              hipStream_t stream) {
    Params p{};
    const float* const* in = (const float* const*)d_in;
    p.x_p = in[0]; p.x_s = in[1]; p.c_p = in[2]; p.c_s = in[3];
    p.st_shift = in[4]; p.st_S = in[5]; p.st_conv = in[6]; p.st_C = in[7]; p.st_n = in[8]; p.st_m = in[9];
    p.g_norm = in[10]; p.w_ada = in[11]; p.b_ada = in[12]; p.w_in = in[13]; p.mu_shift = in[14]; p.w_decay2 = in[15];
    p.w0 = in[16]; p.w_iclr2 = in[17]; p.a0 = in[18]; p.k_k = in[19]; p.k_a = in[20]; p.r_k = in[21];
    p.ln_w = in[22]; p.ln_b = in[23]; p.conv_w = in[24]; p.conv_b = in[25]; p.b_i = in[26]; p.b_f = in[27];
    p.gn_w = in[28]; p.w_up_a = in[29]; p.w_up_b = in[30]; p.w_out = in[31]; p.g_final = in[32];
    p.out = (float*)d_out;
    char* ws = (char*)d_ws;
    size_t off = 0;
    p.P = (bf16_t*)(ws + off); off += (size_t)M_TOT * NP * 2;
    p.WinT = (bf16_t*)(ws + off); off += (size_t)NP * 1024 * 2;
    p.WupaT = (bf16_t*)(ws + off); off += (size_t)1024 * 512 * 2;
    p.WupbT = (bf16_t*)(ws + off); off += (size_t)1024 * 512 * 2;
    p.WoutT = (bf16_t*)(ws + off); off += (size_t)1024 * 1024 * 2;
    p.mod = (float*)(ws + off); off += (size_t)NSEQ * 3072 * 4;
    p.ctr = (unsigned*)(ws + off); off += 256;
    p.bar = (unsigned*)(ws + off); off += (size_t)XCD_BAR_WORDS * 4;
    p.acnt = (unsigned*)(ws + off); off += 256;
    char* os = (char*)d_out;
    p.H = (bf16_t*)os;
    p.Yraw = (bf16_t*)os;
    p.OutB = (bf16_t*)(os + (size_t)M_TOT * 512 * 2);
    p.Omd = (bf16_t*)(os + (size_t)M_TOT * 1024 * 2);
    p.Aa = (bf16_t*)(os + (size_t)M_TOT * 1024 * 2 + (size_t)M_TOT * 512 * 2);
    p.OutA = p.Omd;
#if MK_MULTI
    const int G = 1024;
    kA<<<G, NTHR, 0, stream>>>(p);
    kB<<<G, NTHR, 0, stream>>>(p);
    kC<<<G, NTHR, 0, stream>>>(p);
    kD<<<G, NTHR, 0, stream>>>(p);
    kE<<<G, NTHR, 0, stream>>>(p);
    kF<<<G, NTHR, 0, stream>>>(p);
    kG<<<G, NTHR, 0, stream>>>(p);
    kH<<<G, NTHR, 0, stream>>>(p);
    kI<<<G, NTHR, 0, stream>>>(p);
#else
    static int grid_blocks = 0;
    if (!grid_blocks) {
        int dev = 0, cus = 0, per_cu = 0;
        hipGetDevice(&dev);
        hipDeviceGetAttribute(&cus, hipDeviceAttributeMultiprocessorCount, dev);
        hipOccupancyMaxActiveBlocksPerMultiprocessor(&per_cu, fwd_megakernel, NTHR, 0);
        if (per_cu > 1) per_cu = 1;
        grid_blocks = cus * per_cu;
    }
    (void)hipMemsetAsync(p.ctr, 0, 256 + (size_t)XCD_BAR_WORDS * 4 + 256, stream);
    void* args[] = {&p};
    hipError_t e = hipLaunchCooperativeKernel((void*)fwd_megakernel, dim3(grid_blocks), dim3(NTHR), args, 0, stream);
    if (e != hipSuccess) fprintf(stderr, "cooperative launch failed: %s (grid %d)\n", hipGetErrorString(e), grid_blocks);
#endif
}
```
